# Optimizing an MI355X kernel written in HIP

```python
import functools
import jax, jax.numpy as jnp
from jax import lax
import numpy as np

D_MODEL = 1024
BATCH = 32
SEQ = 256
DEPTH = 2
DEC_BATCH = 2
DEC_SEQ = 1024
PAST_LEN = 256

GRID_W = 64
DH = 64
H_A = 8
KV_A = 2
H_B = 8
H_C = 8
H_D = 8
KV_D = 2
D_MIX_EVEN = (H_A + H_B) * DH
D_MIX_ODD = (H_C + H_D) * DH
D_FF = 2816
ADA_CHUNKS = 9
QBLOCK = 128
MLSTM_CHUNK = 64
NA_KH = 8
NA_KW = 16
NA_SLAB = 2 * NA_KW
SWA_WIN = 128
ROPE_THETA = 10000.0
ROPE_FREQS = DH // 4
ATTN_SCALE = DH ** -0.5
NEG_INF = -1e30
EPS = 1e-6
EVEN_SIZES = (H_A * DH, KV_A * DH, KV_A * DH, H_B * DH, H_B * DH, H_B * DH, 4 * H_B, H_B * DH)
ODD_SIZES = (H_C * DH, H_C * DH, H_C * DH, H_D * DH, KV_D * DH, KV_D * DH)

kernel_name = "hybrid_diffusion_prefix_trunk_step"


def rms_norm(x, g):
    xf = x.astype(jnp.float32)
    y = xf * lax.rsqrt(jnp.mean(xf * xf, axis=-1, keepdims=True) + EPS)
    return (y * g.astype(jnp.float32)).astype(x.dtype)


def modulate(h, shift, scale):
    return h * (1 + scale) + shift


def adaln(cond, w, b):
    m = jax.nn.silu(cond) @ w + b
    m = m.reshape(-1, 1, ADA_CHUNKS, D_MODEL)
    return [m[:, :, i] for i in range(ADA_CHUNKS)]


def swiglu(h, w_in, w_out):
    g, u = jnp.split(h @ w_in, 2, axis=-1)
    return (jax.nn.silu(g) * u) @ w_out


def split_cols(p, sizes):
    return jnp.split(p, np.cumsum(sizes)[:-1].tolist(), axis=-1)


def axial_rope(L, dtype):
    t = jnp.arange(L)
    pos = jnp.stack([t // GRID_W, t % GRID_W], axis=-1).astype(jnp.float32)
    freqs = ROPE_THETA ** (-jnp.arange(ROPE_FREQS, dtype=jnp.float32) / ROPE_FREQS)
    ang = (pos[:, :, None] * freqs).reshape(L, 2 * ROPE_FREQS)
    return jnp.cos(ang)[:, None, :].astype(dtype), jnp.sin(ang)[:, None, :].astype(dtype)


def apply_rope(x, cos, sin):
    x1, x2 = jnp.split(x, 2, axis=-1)
    return jnp.concatenate([x1 * cos - x2 * sin, x2 * cos + x1 * sin], axis=-1)


def attend_dense(q, k, v, sink=None):
    B, L, H, dh = q.shape
    KV = k.shape[2]
    G = H // KV
    nb = L // QBLOCK
    qb = q.reshape(B, nb, QBLOCK, KV, G, dh).swapaxes(0, 1)

    def block(qblk):
        s = jnp.einsum('bqkgd,bskd->bkgqs', qblk, k).astype(jnp.float32) * ATTN_SCALE
        if sink is None:
            p = jax.nn.softmax(s, axis=-1)
        else:
            sk = jnp.broadcast_to(sink.astype(jnp.float32).reshape(KV, G, 1, 1), s.shape[:-1] + (1,))
            p = jax.nn.softmax(jnp.concatenate([sk, s], axis=-1), axis=-1)[..., 1:]
        return jnp.einsum('bkgqs,bskd->bqkgd', p.astype(v.dtype), v)

    o = lax.map(block, qb)
    return o.swapaxes(0, 1).reshape(B, L, H * dh)


def swa_latent(q, k, v, k_ctx, v_ctx, sink):
    B, L, H, dh = q.shape
    KV = k.shape[2]
    G = H // KV
    nb = L // QBLOCK
    span = QBLOCK + 2 * SWA_WIN
    pad = ((0, 0), (SWA_WIN, SWA_WIN), (0, 0), (0, 0))
    kidx = jnp.arange(nb)[:, None] * QBLOCK + jnp.arange(span)[None, :]
    kb = jnp.pad(k, pad)[:, kidx]
    vb = jnp.pad(v, pad)[:, kidx]
    qb = q.reshape(B, nb, QBLOCK, KV, G, dh)
    s_loc = jnp.einsum('bnqkgd,bnskd->bnkgqs', qb, kb).astype(jnp.float32) * ATTN_SCALE
    qpos = jnp.arange(L).reshape(nb, QBLOCK)
    kpos = kidx - SWA_WIN
    ok = ((kpos[:, None, :] >= 0) & (kpos[:, None, :] < L)
          & (jnp.abs(kpos[:, None, :] - qpos[:, :, None]) <= SWA_WIN))
    s_loc = jnp.where(ok[None, :, None, None], s_loc, NEG_INF)
    s_ctx = jnp.einsum('bnqkgd,bskd->bnkgqs', qb, k_ctx).astype(jnp.float32) * ATTN_SCALE
    sk = jnp.broadcast_to(sink.astype(jnp.float32).reshape(1, 1, KV, G, 1, 1), s_ctx.shape[:-1] + (1,))
    p = jax.nn.softmax(jnp.concatenate([sk, s_ctx, s_loc], axis=-1), axis=-1).astype(v.dtype)
    P = k_ctx.shape[1]
    o = (jnp.einsum('bnkgqs,bskd->bnqkgd', p[..., 1:1 + P], v_ctx)
         + jnp.einsum('bnkgqs,bnskd->bnqkgd', p[..., 1 + P:], vb))
    return o.reshape(B, L, H * dh)


def na_latent(q, k, v, k_ctx, v_ctx, rpb):
    B, L, H, dh = q.shape
    rows = L // GRID_W
    kh = min(NA_KH, rows)
    ncb = GRID_W // NA_KW
    r = jnp.arange(rows)
    row_idx = jnp.clip(r - kh // 2, 0, rows - kh)[:, None] + jnp.arange(kh)[None, :]
    qcol = jnp.arange(GRID_W).reshape(ncb, NA_KW)
    col_idx = (jnp.clip(jnp.arange(ncb) * NA_KW - NA_KW // 2, 0, GRID_W - NA_SLAB)[:, None]
               + jnp.arange(NA_SLAB)[None, :])
    win_start = jnp.clip(qcol - NA_KW // 2, 0, GRID_W - NA_KW)
    col_ok = ((col_idx[:, None, :] >= win_start[..., None])
              & (col_idx[:, None, :] < win_start[..., None] + NA_KW))
    mask = jnp.broadcast_to(col_ok[:, :, None, :], (ncb, NA_KW, kh, NA_SLAB)).reshape(ncb, NA_KW, kh * NA_SLAB)
    gi = row_idx[:, None, :, None]
    gj = col_idx[None, :, None, :]
    kg = k.reshape(B, rows, GRID_W, H, dh)[:, gi, gj].reshape(B, rows, ncb, kh * NA_SLAB, H, dh)
    vg = v.reshape(B, rows, GRID_W, H, dh)[:, gi, gj].reshape(B, rows, ncb, kh * NA_SLAB, H, dh)
    qg = q.reshape(B, rows, ncb, NA_KW, H, dh)
    s_win = jnp.einsum('brnqhd,brnshd->brnhqs', qg, kg).astype(jnp.float32) * ATTN_SCALE
    dy = row_idx - r[:, None] + (NA_KH - 1)
    dx = jnp.clip(col_idx[:, None, :] - qcol[..., None] + (NA_KW - 1), 0, 2 * NA_KW - 2)
    bias = rpb.astype(jnp.float32)[:, dy[:, None, None, :, None], dx[None, :, :, None, :]]
    bias = bias.transpose(1, 2, 0, 3, 4, 5).reshape(rows, ncb, H, NA_KW, kh * NA_SLAB)
    s_win = jnp.where(mask[None, None, :, None], s_win + bias[None], NEG_INF)
    s_ctx = jnp.einsum('brnqhd,bshd->brnhqs', qg, k_ctx).astype(jnp.float32) * ATTN_SCALE
    p = jax.nn.softmax(jnp.concatenate([s_ctx, s_win], axis=-1), axis=-1).astype(v.dtype)
    P = k_ctx.shape[1]
    o = (jnp.einsum('brnhqs,bshd->brnqhd', p[..., :P], v_ctx)
         + jnp.einsum('brnhqs,brnshd->brnqhd', p[..., P:], vg))
    return o.reshape(B, L, H * dh)


def mlstm_scan(q, k, v, i_pre, f_pre, C0, n0, m0):
    B, L, H, dh = q.shape
    nc = L // MLSTM_CHUNK
    f32 = jnp.float32

    def chunks(a):
        return a.astype(f32).reshape((B, nc, MLSTM_CHUNK) + a.shape[2:]).swapaxes(0, 1)

    xs = (chunks(q), chunks(k) * (dh ** -0.5), chunks(v), chunks(i_pre),
          chunks(jax.nn.log_sigmoid(f_pre.astype(f32))))
    tri = jnp.tril(jnp.ones((MLSTM_CHUNK, MLSTM_CHUNK), dtype=bool))

    def step(carry, xc):
        C, n, m = carry
        qc, kc, vc, li, lf = xc
        li = li.swapaxes(1, 2)
        b = jnp.cumsum(lf.swapaxes(1, 2), axis=-1)
        d = jnp.where(tri, b[..., :, None] - b[..., None, :] + li[..., None, :], -jnp.inf)
        inter = b + m[..., None]
        mt = jnp.maximum(inter, d.max(axis=-1))
        w = jnp.exp(d - mt[..., None]) * jnp.einsum('bthd,bshd->bhts', qc, kc)
        w_inter = jnp.exp(inter - mt)
        num = (jnp.einsum('bhts,bshd->bhtd', w, vc)
               + w_inter[..., None] * jnp.einsum('bthk,bhkv->bhtv', qc, C))
        den = w.sum(axis=-1) + w_inter * jnp.einsum('bthk,bhk->bht', qc, n)
        h = num / jnp.maximum(jnp.abs(den), jnp.exp(-mt))[..., None]
        b_last = b[..., -1]
        dec = b_last[..., None] - b + li
        m_new = jnp.maximum(b_last + m, dec.max(axis=-1))
        ws = jnp.exp(dec - m_new[..., None])
        wc = jnp.exp(b_last + m - m_new)
        C_new = wc[..., None, None] * C + jnp.einsum('bhs,bshk,bshv->bhkv', ws, kc, vc)
        n_new = wc[..., None] * n + jnp.einsum('bhs,bshk->bhk', ws, kc)
        return (C_new, n_new, m_new), h.swapaxes(1, 2)

    (C, n, m), hs = lax.scan(step, (C0.astype(f32), n0.astype(f32), m0.astype(f32)), xs)
    return hs.swapaxes(0, 1).reshape(B, L, H, dh), C, n, m


def mlstm_bidir(qb, kb, vb, gates, ob, head_g, C0, n0, m0):
    B, L = qb.shape[:2]
    flip = lambda a: a[:, ::-1]
    hf, Cf, nf, mf = mlstm_scan(qb, kb, vb, gates[:, :, 0], gates[:, :, 1], C0[:, 0], n0[:, 0], m0[:, 0])
    hb, Cb, nb_, mb = mlstm_scan(flip(qb), flip(kb), flip(vb), flip(gates[:, :, 2]), flip(gates[:, :, 3]),
                                 C0[:, 1], n0[:, 1], m0[:, 1])
    h = (hf + flip(hb)).astype(qb.dtype)
    y = jax.nn.sigmoid(ob) * rms_norm(h, head_g.reshape(H_B, DH)).reshape(B, L, H_B * DH)
    return y, jnp.stack([Cf, Cb], axis=1), jnp.stack([nf, nb_], axis=1), jnp.stack([mf, mb], axis=1)


def even_project(h, w_in, qk_g, gate_b):
    B, L, _ = h.shape
    qa, ka, va, qb, kb, vb, gates, ob = split_cols(h @ w_in, EVEN_SIZES)
    qa = rms_norm(qa.reshape(B, L, H_A, DH), qk_g[0])
    ka = rms_norm(ka.reshape(B, L, KV_A, DH), qk_g[1])
    va = va.reshape(B, L, KV_A, DH)
    heads = lambda a: a.reshape(B, L, H_B, DH)
    gates = (gates + gate_b).reshape(B, L, 4, H_B)
    return qa, ka, va, heads(qb), heads(kb), heads(vb), gates, ob


def even_mixer_context(h, params):
    w_in, w_out, qk_g, gate_b, head_g = params
    B = h.shape[0]
    qa, ka, va, qb, kb, vb, gates, ob = even_project(h, w_in, qk_g, gate_b)
    ya = attend_dense(qa, ka, va)
    C0 = jnp.zeros((B, 2, H_B, DH, DH), jnp.float32)
    n0 = jnp.zeros((B, 2, H_B, DH), jnp.float32)
    m0 = jnp.zeros((B, 2, H_B), jnp.float32)
    yb, C, n, m = mlstm_bidir(qb, kb, vb, gates, ob, head_g, C0, n0, m0)
    return jnp.concatenate([ya, yb], axis=-1) @ w_out, (ka, va, C, n, m)


def even_mixer_latent(h, params, cache):
    w_in, w_out, qk_g, gate_b, head_g = params
    k_ctx, v_ctx, C0, n0, m0 = cache
    L = h.shape[1]
    qa, ka, va, qb, kb, vb, gates, ob = even_project(h, w_in, qk_g, gate_b)
    cos, sin = axial_rope(L, qa.dtype)
    qa, ka = apply_rope(qa, cos, sin), apply_rope(ka, cos, sin)
    ya = attend_dense(qa, jnp.concatenate([k_ctx.astype(ka.dtype), ka], axis=1),
                      jnp.concatenate([v_ctx.astype(va.dtype), va], axis=1))
    yb = mlstm_bidir(qb, kb, vb, gates, ob, head_g, C0, n0, m0)[0]
    return jnp.concatenate([ya, yb], axis=-1) @ w_out, ()


def odd_project(h, w_in):
    B, L, _ = h.shape
    qc, kc, vc, qd, kd, vd = split_cols(h @ w_in, ODD_SIZES)
    c_heads = lambda a: a.reshape(B, L, H_C, DH)
    return (c_heads(qc), c_heads(kc), c_heads(vc), qd.reshape(B, L, H_D, DH),
            kd.reshape(B, L, KV_D, DH), vd.reshape(B, L, KV_D, DH))


def odd_mixer_context(h, params):
    w_in, w_out, rpb, sink = params
    qc, kc, vc, qd, kd, vd = odd_project(h, w_in)
    yc = attend_dense(qc, kc, vc)
    yd = attend_dense(qd, kd, vd, sink)
    return jnp.concatenate([yc, yd], axis=-1) @ w_out, (kc, vc, kd, vd)


def odd_mixer_latent(h, params, cache):
    w_in, w_out, rpb, sink = params
    kc_ctx, vc_ctx, kd_ctx, vd_ctx = cache
    L = h.shape[1]
    qc, kc, vc, qd, kd, vd = odd_project(h, w_in)
    yc = na_latent(qc, kc, vc, kc_ctx.astype(kc.dtype), vc_ctx.astype(vc.dtype), rpb)
    cos, sin = axial_rope(L, qd.dtype)
    yd = swa_latent(apply_rope(qd, cos, sin), apply_rope(kd, cos, sin), vd,
                    kd_ctx.astype(kd.dtype), vd_ctx.astype(vd.dtype), sink)
    return jnp.concatenate([yc, yd], axis=-1) @ w_out, ()


def trunk_layer(x, mod, norm_g, f1_in, f1_out, f2_in, f2_out, mixer):
    sh1, sc1, g1, sh2, sc2, g2, sh3, sc3, g3 = mod
    x = x + 0.5 * g1 * swiglu(modulate(rms_norm(x, norm_g[0]), sh1, sc1), f1_in, f1_out)
    mo, st = mixer(modulate(rms_norm(x, norm_g[1]), sh2, sc2))
    x = x + g2 * mo
    x = x + 0.5 * g3 * swiglu(modulate(rms_norm(x, norm_g[2]), sh3, sc3), f2_in, f2_out)
    return x, st


def setup_inputs(seed: int = 0) -> dict:
    key = jax.random.key(seed)
    ks = iter(list(jax.random.split(key, 80)))

    def rnd(shape, scale, offset=0.0):
        return offset + scale * jax.random.normal(next(ks), shape, jnp.float32)

    D = D_MODEL
    inp = {}
    inp['x_prompt'] = rnd((BATCH, SEQ, D), 1.0)
    inp['x_sample'] = rnd((DEC_BATCH, DEC_SEQ, D), 1.0)
    inp['cache_l0_attn_k'] = rnd((DEC_BATCH, PAST_LEN, KV_A, DH), 1.0)
    inp['cache_l0_attn_v'] = rnd((DEC_BATCH, PAST_LEN, KV_A, DH), 1.0)
    inp['state_l0_mlstm_C'] = rnd((DEC_BATCH, 2, H_B, DH, DH), 0.3)
    inp['state_l0_mlstm_n'] = rnd((DEC_BATCH, 2, H_B, DH), 0.3)
    inp['state_l0_mlstm_m'] = rnd((DEC_BATCH, 2, H_B), 1.0)
    inp['cache_l1_na_k'] = rnd((DEC_BATCH, PAST_LEN, H_C, DH), 1.0)
    inp['cache_l1_na_v'] = rnd((DEC_BATCH, PAST_LEN, H_C, DH), 1.0)
    inp['cache_l1_swa_k'] = rnd((DEC_BATCH, PAST_LEN, KV_D, DH), 1.0)
    inp['cache_l1_swa_v'] = rnd((DEC_BATCH, PAST_LEN, KV_D, DH), 1.0)
    inp['c'] = rnd((DEC_BATCH, D), 1.0)
    inp['c_ctx'] = rnd((D,), 1.0)
    inp['norm_final'] = rnd((D,), 0.05, 1.0)
    for l, (p_in, d_mix) in enumerate(((sum(EVEN_SIZES), D_MIX_EVEN), (sum(ODD_SIZES), D_MIX_ODD))):
        inp[f'ada_w_l{l}'] = rnd((D, ADA_CHUNKS * D), 0.5 * D ** -0.5)
        inp[f'ada_b_l{l}'] = rnd((ADA_CHUNKS * D,), 0.1)
        inp[f'norm_l{l}'] = rnd((3, D), 0.05, 1.0)
        inp[f'ffn1_in_l{l}'] = rnd((D, 2 * D_FF), D ** -0.5)
        inp[f'ffn1_out_l{l}'] = rnd((D_FF, D), D_FF ** -0.5)
        inp[f'ffn2_in_l{l}'] = rnd((D, 2 * D_FF), D ** -0.5)
        inp[f'ffn2_out_l{l}'] = rnd((D_FF, D), D_FF ** -0.5)
        inp[f'mix_in_l{l}'] = rnd((D, p_in), D ** -0.5)
        inp[f'mix_out_l{l}'] = rnd((d_mix, D), d_mix ** -0.5)
        if l == 0:
            inp['qk_norm_l0'] = rnd((2, DH), 0.05, 1.0)
            inp['gate_bias_l0'] = jnp.concatenate([rnd((H_B,), 0.1, -1.0), rnd((H_B,), 0.1, 3.0),
                                                   rnd((H_B,), 0.1, -1.0), rnd((H_B,), 0.1, 3.0)])
            inp['head_norm_l0'] = rnd((H_B * DH,), 0.05, 1.0)
        else:
            inp['rpb_l1'] = rnd((H_C, 2 * NA_KH - 1, 2 * NA_KW - 1), 0.1)
            inp['sink_l1'] = rnd((H_D,), 0.5)
    return inp


def reference(x_prompt, x_sample, cache_l0_attn_k, cache_l0_attn_v, state_l0_mlstm_C, state_l0_mlstm_n,
              state_l0_mlstm_m, cache_l1_na_k, cache_l1_na_v, cache_l1_swa_k, cache_l1_swa_v, c, c_ctx,
              norm_final,
              ada_w_l0, ada_b_l0, norm_l0, ffn1_in_l0, ffn1_out_l0, ffn2_in_l0, ffn2_out_l0,
              mix_in_l0, mix_out_l0, qk_norm_l0, gate_bias_l0, head_norm_l0,
              ada_w_l1, ada_b_l1, norm_l1, ffn1_in_l1, ffn1_out_l1, ffn2_in_l1, ffn2_out_l1,
              mix_in_l1, mix_out_l1, rpb_l1, sink_l1):
    common = ((ada_w_l0, ada_b_l0, norm_l0, ffn1_in_l0, ffn1_out_l0, ffn2_in_l0, ffn2_out_l0),
              (ada_w_l1, ada_b_l1, norm_l1, ffn1_in_l1, ffn1_out_l1, ffn2_in_l1, ffn2_out_l1))
    mixers = ((mix_in_l0, mix_out_l0, qk_norm_l0, gate_bias_l0, head_norm_l0),
              (mix_in_l1, mix_out_l1, rpb_l1, sink_l1))
    caches = ((cache_l0_attn_k, cache_l0_attn_v, state_l0_mlstm_C, state_l0_mlstm_n, state_l0_mlstm_m),
              (cache_l1_na_k, cache_l1_na_v, cache_l1_swa_k, cache_l1_swa_v))
    xp, xs = x_prompt, x_sample
    ctx_states = []
    for l in range(DEPTH):
        ada_w, ada_b, norm_g, f1_in, f1_out, f2_in, f2_out = common[l]
        even = l % 2 == 0
        ctx_mixer = functools.partial(even_mixer_context if even else odd_mixer_context, params=mixers[l])
        lat_mixer = functools.partial(even_mixer_latent if even else odd_mixer_latent,
                                      params=mixers[l], cache=caches[l])
        xp, st = trunk_layer(xp, adaln(c_ctx, ada_w, ada_b), norm_g, f1_in, f1_out, f2_in, f2_out, ctx_mixer)
        xs, _ = trunk_layer(xs, adaln(c, ada_w, ada_b), norm_g, f1_in, f1_out, f2_in, f2_out, lat_mixer)
        ctx_states.append(st)
    y_prompt = rms_norm(xp, norm_final)
    y_sample = rms_norm(xs, norm_final)
    (k0, v0, C0, n0, m0), (kc1, vc1, kd1, vd1) = ctx_states
    return (y_prompt, y_sample, k0, v0, C0, n0, m0, kc1, vc1, kd1, vd1)
```

```cpp
#include <hip/hip_runtime.h>
#include <hip/hip_cooperative_groups.h>
#include <cstdio>
namespace cg = cooperative_groups;

#ifndef SINGLE_LAUNCH
#define SINGLE_LAUNCH 0
#endif

typedef unsigned short u16;
typedef __attribute__((ext_vector_type(8))) short bf16x8;
typedef __attribute__((ext_vector_type(4))) float f32x4;
typedef __attribute__((ext_vector_type(4))) unsigned u32x4;

constexpr int D = 1024, NCTX = 8192, MTOK = 10240;
constexpr int DFF = 2816, NFF = 5632;
constexpr int P0N = 2848, P0P = 2944, P1N = 2304;
constexpr int PSTR = 2944;
constexpr float EPS = 1e-6f;

enum { I_XP = 0, I_XS, I_C0K, I_C0V, I_SC, I_SN, I_SM, I_NAK, I_NAV, I_SWK, I_SWV, I_C, I_CCTX, I_NF,
       I_L0 = 14, I_L1 = 26 };
enum { L_ADAW = 0, L_ADAB, L_NORM, L_F1I, L_F1O, L_F2I, L_F2O, L_MI, L_MO, L_X0, L_X1, L_X2 };

constexpr size_t O_X = 0, O_K0 = 10485760, O_V0 = 11534336, O_C = 12582912, O_N = 14680064, O_M = 14712832,
                 O_KC1 = 14713344, O_VC1 = 18907648, O_KD1 = 23101952, O_VD1 = 24150528;

constexpr size_t SZ_WIN = (size_t)NFF * D * 2;
constexpr size_t SZ_WOUT = (size_t)D * DFF * 2;
constexpr size_t OFF_WIN = 0;
constexpr size_t OFF_WOUT = OFF_WIN + 4 * SZ_WIN;
constexpr size_t OFF_WMI0 = OFF_WOUT + 4 * SZ_WOUT;
constexpr size_t OFF_WMI1 = OFF_WMI0 + (size_t)P0P * D * 2;
constexpr size_t OFF_WMO = OFF_WMI1 + (size_t)P1N * D * 2;
constexpr size_t OFF_MOD = OFF_WMO + 2 * (size_t)D * D * 2;
constexpr size_t OFF_ROPE = OFF_MOD + 2 * 3 * 9216 * 4;
constexpr size_t OFF_CTR = OFF_ROPE + 2 * 1024 * 32 * 4;
constexpr size_t OFF_XN = OFF_CTR + 256;
constexpr size_t OFF_YMIX = OFF_XN + (size_t)MTOK * D * 2;
constexpr size_t OFF_HP = OFF_YMIX + (size_t)MTOK * D * 2;
constexpr size_t OFF_GATES = OFF_HP + (size_t)MTOK * PSTR * 2;
constexpr size_t OFF_STC = OFF_GATES + (size_t)MTOK * 32 * 4;
constexpr size_t OFF_STN = OFF_STC + (size_t)2560 * 4096 * 4;
constexpr size_t OFF_STM = OFF_STN + (size_t)2560 * 64 * 4;
constexpr size_t WS_TOTAL = OFF_STM + 2560 * 4;

constexpr int TS = 68;
constexpr int TILE_F = 64 * TS;
constexpr int SMEM_BYTES = 4 * TILE_F * 4 + 2048;

struct Params {
  const float* in[37];
  float* out;
  char* ws;
};

__device__ __forceinline__ int get_tid() { int t = threadIdx.x; asm volatile("" : "+v"(t)); return t; }
__device__ __forceinline__ u16 f2bf(float f) {
  unsigned u = __float_as_uint(f);
  u += 0x7fffu + ((u >> 16) & 1u);
  return (u16)(u >> 16);
}
__device__ __forceinline__ unsigned pack2(float a, float b) { return (unsigned)f2bf(a) | ((unsigned)f2bf(b) << 16); }
__device__ __forceinline__ float bflo(unsigned x) { return __uint_as_float(x << 16); }
__device__ __forceinline__ float bfhi(unsigned x) { return __uint_as_float(x & 0xffff0000u); }
__device__ __forceinline__ float grp16_sum(float v) {
  v += __shfl_xor(v, 1); v += __shfl_xor(v, 2); v += __shfl_xor(v, 4); v += __shfl_xor(v, 8); return v;
}
__device__ __forceinline__ float grp16_max(float v) {
  v = fmaxf(v, __shfl_xor(v, 1)); v = fmaxf(v, __shfl_xor(v, 2)); v = fmaxf(v, __shfl_xor(v, 4)); v = fmaxf(v, __shfl_xor(v, 8)); return v;
}
__device__ __forceinline__ float wave_sum(float v) {
  for (int o = 32; o; o >>= 1) v += __shfl_xor(v, o);
  return v;
}
__device__ __forceinline__ float wave_max(float v) {
  for (int o = 32; o; o >>= 1) v = fmaxf(v, __shfl_xor(v, o));
  return v;
}
__device__ __forceinline__ float wave_scan_add(float v, int lane) {
  for (int o = 1; o < 64; o <<= 1) { float t = __shfl_up(v, o); if (lane >= o) v += t; }
  return v;
}
__device__ __forceinline__ float wave_scan_max(float v, int lane) {
  for (int o = 1; o < 64; o <<= 1) { float t = __shfl_up(v, o); if (lane >= o) v = fmaxf(v, t); }
  return v;
}
__device__ __forceinline__ int cond_of(int row) { return row < NCTX ? 0 : 1 + ((row - NCTX) >> 10); }
__device__ __forceinline__ float sigmoidf_(float x) { return 1.f / (1.f + expf(-x)); }
__device__ __forceinline__ float logsigmoidf_(float x) { return fminf(x, 0.f) - log1pf(expf(-fabsf(x))); }

__device__ void conv_tile(const float* __restrict__ W, int K, int N, u16* __restrict__ Wt, int perm, int kt, int nt, float* T) {
  const int tid = get_tid();
  {
    int r = tid >> 4, c4 = tid & 15;
    int c = c4 * 4;
    int src;
    if (perm) src = (c < 32) ? (nt * 32 + c) : (DFF + nt * 32 + (c - 32));
    else src = nt * 64 + c;
    bool ok = src < N;
#pragma unroll
    for (int ps = 0; ps < 4; ++ps) {
      int k = r + ps * 16;
      float4 v = make_float4(0.f, 0.f, 0.f, 0.f);
      if (ok) v = *(const float4*)(W + (size_t)(kt * 64 + k) * N + src);
      float* t = T + k * 65 + c;
      t[0] = v.x; t[1] = v.y; t[2] = v.z; t[3] = v.w;
    }
  }
  __syncthreads();
  {
    int n = tid >> 2, kp = tid & 3;
    unsigned o[8];
#pragma unroll
    for (int i = 0; i < 8; ++i) {
      float a = T[(kp * 16 + 2 * i) * 65 + n], b = T[(kp * 16 + 2 * i + 1) * 65 + n];
      o[i] = pack2(a, b);
    }
    uint4* dst = (uint4*)(Wt + (size_t)(nt * 64 + n) * K + kt * 64 + kp * 16);
    dst[0] = make_uint4(o[0], o[1], o[2], o[3]);
    dst[1] = make_uint4(o[4], o[5], o[6], o[7]);
  }
  __syncthreads();
}

__device__ void adaln_unit(const Params& p, int u, float* sm) {
  const int tid = get_tid();
  int l = u / 144, cg_ = u % 144;
  const float* W = p.in[(l ? I_L1 : I_L0) + L_ADAW];
  const float* B = p.in[(l ? I_L1 : I_L0) + L_ADAB];
  float* sc = sm;
  float* red = sm + 3072;
  for (int i = tid; i < 3072; i += 256) {
    int cnd = i >> 10, k = i & 1023;
    float v = (cnd == 0) ? p.in[I_CCTX][k] : p.in[I_C][(cnd - 1) * 1024 + k];
    sc[i] = v / (1.f + expf(-v));
  }
  __syncthreads();
  int kp = tid >> 4, c4 = tid & 15;
  float acc[3][4];
#pragma unroll
  for (int a = 0; a < 3; ++a)
#pragma unroll
    for (int e = 0; e < 4; ++e) acc[a][e] = 0.f;
  for (int kk = 0; kk < 64; ++kk) {
    int k = kp * 64 + kk;
    float4 w = *(const float4*)(W + (size_t)k * 9216 + cg_ * 64 + c4 * 4);
#pragma unroll
    for (int a = 0; a < 3; ++a) {
      float s = sc[a * 1024 + k];
      acc[a][0] += s * w.x; acc[a][1] += s * w.y; acc[a][2] += s * w.z; acc[a][3] += s * w.w;
    }
  }
#pragma unroll
  for (int a = 0; a < 3; ++a)
#pragma unroll
    for (int e = 0; e < 4; ++e) red[(kp * 3 + a) * 64 + c4 * 4 + e] = acc[a][e];
  __syncthreads();
  if (tid < 192) {
    int a = tid >> 6, col = tid & 63;
    float s = 0.f;
    for (int q = 0; q < 16; ++q) s += red[(q * 3 + a) * 64 + col];
    s += B[cg_ * 64 + col];
    float* mod = (float*)(p.ws + OFF_MOD);
    mod[(l * 3 + a) * 9216 + cg_ * 64 + col] = s;
  }
  __syncthreads();
}

__device__ void prep_phase(const Params& p, float* sm) {
  const int tid = get_tid();
  if (blockIdx.x == 0 && tid < 64) ((int*)(p.ws + OFF_CTR))[tid] = 0;
  constexpr int U_CONV = 10272, U_ADA = 288, U_ROPE = 128, U_COPY = 640;
  constexpr int U_TOT = U_CONV + U_ADA + U_ROPE + U_COPY;
  for (int u = blockIdx.x; u < U_TOT; u += gridDim.x) {
    if (u < U_CONV) {
      const float* W; u16* Wt; int K, N, perm, t, ntn;
      if (u < 5632) {
        int mi = u / 1408; t = u % 1408;
        int l = mi >> 1, f = mi & 1;
        W = p.in[(l ? I_L1 : I_L0) + (f ? L_F2I : L_F1I)];
        Wt = (u16*)(p.ws + OFF_WIN + mi * SZ_WIN);
        K = 1024; N = NFF; perm = 1; ntn = 88;
      } else if (u < 8448) {
        int v = u - 5632; int mi = v / 704; t = v % 704;
        int l = mi >> 1, f = mi & 1;
        W = p.in[(l ? I_L1 : I_L0) + (f ? L_F2O : L_F1O)];
        Wt = (u16*)(p.ws + OFF_WOUT + mi * SZ_WOUT);
        K = DFF; N = 1024; perm = 0; ntn = 16;
      } else if (u < 9184) {
        t = u - 8448; W = p.in[I_L0 + L_MI]; Wt = (u16*)(p.ws + OFF_WMI0); K = 1024; N = P0N; perm = 0; ntn = 46;
      } else if (u < 9760) {
        t = u - 9184; W = p.in[I_L1 + L_MI]; Wt = (u16*)(p.ws + OFF_WMI1); K = 1024; N = P1N; perm = 0; ntn = 36;
      } else {
        int v = u - 9760; int l = v / 256; t = v % 256;
        W = p.in[(l ? I_L1 : I_L0) + L_MO]; Wt = (u16*)(p.ws + OFF_WMO + (size_t)l * D * D * 2); K = 1024; N = 1024; perm = 0; ntn = 16;
      }
      int nt = t % ntn, kt = t / ntn;
      conv_tile(W, K, N, Wt, perm, kt, nt, sm);
    } else if (u < U_CONV + U_ADA) {
      adaln_unit(p, u - U_CONV, sm);
    } else if (u < U_CONV + U_ADA + U_ROPE) {
      int e = (u - U_CONV - U_ADA) * 256 + tid;
      int t = e >> 5, i = e & 31;
      float pos = (i < 16) ? (float)(t >> 6) : (float)(t & 63);
      float fr = powf(10000.f, -(float)(i & 15) / 16.f);
      float ang = pos * fr;
      float* rc = (float*)(p.ws + OFF_ROPE);
      rc[e] = cosf(ang);
      rc[32768 + e] = sinf(ang);
    } else {
      int v = u - U_CONV - U_ADA - U_ROPE;
      float4* dst = (float4*)(p.out + O_X);
#pragma unroll 4
      for (int i = 0; i < 16; ++i) {
        size_t idx = (size_t)v * 4096 + i * 256 + tid;
        float4 val = (idx < (size_t)NCTX * 256) ? ((const float4*)p.in[I_XP])[idx] : ((const float4*)p.in[I_XS])[idx - (size_t)NCTX * 256];
        dst[idx] = val;
      }
    }
  }
}

__device__ void norm_phase(const Params& p, int l, int which) {
  const int tid = get_tid(), lane = tid & 63, w = tid >> 6;
  float* x = p.out + O_X;
  const float* mod = (const float*)(p.ws + OFF_MOD);
  u16* xn = (u16*)(p.ws + OFF_XN);
  for (int row = blockIdx.x * 4 + w; row < MTOK; row += gridDim.x * 4) {
    float4* xr = (float4*)(x + (size_t)row * D);
    float4 v[4];
    float ss = 0.f;
#pragma unroll
    for (int i = 0; i < 4; ++i) {
      v[i] = xr[lane + i * 64];
      ss += v[i].x * v[i].x + v[i].y * v[i].y + v[i].z * v[i].z + v[i].w * v[i].w;
    }
    ss = wave_sum(ss);
    float rstd = rsqrtf(ss * (1.f / 1024.f) + EPS);
    if (which == 3) {
      const float4* g = (const float4*)p.in[I_NF];
#pragma unroll
      for (int i = 0; i < 4; ++i) {
        float4 gg = g[lane + i * 64];
        float4 o = make_float4(v[i].x * rstd * gg.x, v[i].y * rstd * gg.y, v[i].z * rstd * gg.z, v[i].w * rstd * gg.w);
        xr[lane + i * 64] = o;
      }
    } else {
      const float4* g = (const float4*)(p.in[(l ? I_L1 : I_L0) + L_NORM] + which * 1024);
      const float* mb = mod + (l * 3 + cond_of(row)) * 9216;
      const float4* sh = (const float4*)(mb + (3 * which) * 1024);
      const float4* sc = (const float4*)(mb + (3 * which + 1) * 1024);
#pragma unroll
      for (int i = 0; i < 4; ++i) {
        int q = lane + i * 64;
        float4 gg = g[q], s1 = sh[q], s2 = sc[q];
        float a = (v[i].x * rstd * gg.x) * (1.f + s2.x) + s1.x;
        float b = (v[i].y * rstd * gg.y) * (1.f + s2.y) + s1.y;
        float c = (v[i].z * rstd * gg.z) * (1.f + s2.z) + s1.z;
        float d = (v[i].w * rstd * gg.w) * (1.f + s2.w) + s1.w;
        uint2 o = make_uint2(pack2(a, b), pack2(c, d));
        *(uint2*)(xn + (size_t)row * D + q * 4) = o;
      }
    }
  }
}

enum { EPI_SWIGLU = 0, EPI_RESID = 1, EPI_MIX0 = 2, EPI_MIX1 = 3 };
constexpr int LS = 72;

template <int EPI>
__device__ __forceinline__ void gemm_tile(const Params& p, const u16* __restrict__ A, const u16* __restrict__ Bt, int K,
                                          int m0, int n0, int l, int gchunk, float coef, u16* smem) {
  const int tid = get_tid(), lane = tid & 63, wid = tid >> 6;
  const int wr = wid >> 1, wc = wid & 1, fr = lane & 15, fq = lane >> 4;
  u16* As = smem;
  u16* Bs = smem + 128 * LS;
  f32x4 acc[4][4];
#pragma unroll
  for (int i = 0; i < 4; ++i)
#pragma unroll
    for (int j = 0; j < 4; ++j) acc[i][j] = (f32x4){0.f, 0.f, 0.f, 0.f};
  u32x4 ra[4], rb[4];
  const int lrow = tid >> 3, lkc = tid & 7;
  const u16* Ag = A + (size_t)(m0 + lrow) * K + lkc * 8;
  const u16* Bg = Bt + (size_t)(n0 + lrow) * K + lkc * 8;
  const int nk = K >> 6;
#pragma unroll
  for (int i = 0; i < 4; ++i) {
    ra[i] = *(const u32x4*)(Ag + (size_t)(i * 32) * K);
    rb[i] = *(const u32x4*)(Bg + (size_t)(i * 32) * K);
  }
  for (int kt = 0; kt < nk; ++kt) {
    __syncthreads();
#pragma unroll
    for (int i = 0; i < 4; ++i) {
      *(u32x4*)(As + (lrow + i * 32) * LS + lkc * 8) = ra[i];
      *(u32x4*)(Bs + (lrow + i * 32) * LS + lkc * 8) = rb[i];
    }
    __syncthreads();
    if (kt + 1 < nk) {
#pragma unroll
      for (int i = 0; i < 4; ++i) {
        ra[i] = *(const u32x4*)(Ag + (size_t)(i * 32) * K + (kt + 1) * 64);
        rb[i] = *(const u32x4*)(Bg + (size_t)(i * 32) * K + (kt + 1) * 64);
      }
    }
#pragma unroll
    for (int ks = 0; ks < 2; ++ks) {
      bf16x8 a[4], b[4];
#pragma unroll
      for (int i = 0; i < 4; ++i) {
        a[i] = *(const bf16x8*)(As + (wr * 64 + i * 16 + fr) * LS + ks * 32 + fq * 8);
        b[i] = *(const bf16x8*)(Bs + (wc * 64 + i * 16 + fr) * LS + ks * 32 + fq * 8);
      }
#pragma unroll
      for (int i = 0; i < 4; ++i)
#pragma unroll
        for (int j = 0; j < 4; ++j) acc[i][j] = __builtin_amdgcn_mfma_f32_16x16x32_bf16(a[i], b[j], acc[i][j], 0, 0, 0);
    }
  }
  const int rbase = m0 + wr * 64 + fq * 4;
  const int c0 = n0 + wc * 64;
  if (EPI == EPI_SWIGLU) {
    u16* H = (u16*)(p.ws + OFF_HP);
    const int hc0 = c0 >> 1;
#pragma unroll
    for (int mi = 0; mi < 4; ++mi)
#pragma unroll
      for (int j = 0; j < 4; ++j) {
        int row = rbase + mi * 16 + j;
#pragma unroll
        for (int ni = 0; ni < 2; ++ni) {
          float g = acc[mi][ni][j], u = acc[mi][ni + 2][j];
          float h = g / (1.f + __expf(-g)) * u;
          H[(size_t)row * DFF + hc0 + ni * 16 + fr] = f2bf(h);
        }
      }
  } else if (EPI == EPI_RESID) {
    float* x = p.out + O_X;
    const float* mod = (const float*)(p.ws + OFF_MOD);
#pragma unroll
    for (int mi = 0; mi < 4; ++mi)
#pragma unroll
      for (int j = 0; j < 4; ++j) {
        int row = rbase + mi * 16 + j;
        const float* gp = mod + (l * 3 + cond_of(row)) * 9216 + gchunk * 1024;
#pragma unroll
        for (int ni = 0; ni < 4; ++ni) {
          int col = c0 + ni * 16 + fr;
          size_t idx = (size_t)row * D + col;
          x[idx] = x[idx] + coef * gp[col] * acc[mi][ni][j];
        }
      }
  } else {
    u16* proj = (u16*)(p.ws + OFF_HP);
    const bool isctx = m0 < NCTX;
    const float* rc = (const float*)(p.ws + OFF_ROPE);
    bool do_norm = false, do_rope = false;
    const float* ng = nullptr;
    float* o32 = nullptr; int ostr = 0;
    bool elementwise = false;
    if (EPI == EPI_MIX0) {
      if (c0 < 512) { do_norm = true; ng = p.in[I_L0 + L_X0]; do_rope = !isctx; }
      else if (c0 < 640) { do_norm = true; ng = p.in[I_L0 + L_X0] + 64; do_rope = !isctx; if (isctx) { o32 = p.out + O_K0 + (c0 - 512); ostr = 128; } }
      else if (c0 < 768) { if (isctx) { o32 = p.out + O_V0 + (c0 - 640); ostr = 128; } }
      else if (c0 >= 2304) elementwise = true;
    } else {
      if (c0 < 512) {}
      else if (c0 < 1024) { if (isctx) { o32 = p.out + O_KC1 + (c0 - 512); ostr = 512; } }
      else if (c0 < 1536) { if (isctx) { o32 = p.out + O_VC1 + (c0 - 1024); ostr = 512; } }
      else if (c0 < 2048) { do_rope = !isctx; }
      else if (c0 < 2176) { do_rope = !isctx; if (isctx) { o32 = p.out + O_KD1 + (c0 - 2048); ostr = 128; } }
      else { if (isctx) { o32 = p.out + O_VD1 + (c0 - 2176); ostr = 128; } }
    }
    if (elementwise) {
      float* gates = (float*)(p.ws + OFF_GATES);
      const float* gb = p.in[I_L0 + L_X1];
#pragma unroll
      for (int mi = 0; mi < 4; ++mi)
#pragma unroll
        for (int j = 0; j < 4; ++j) {
          int row = rbase + mi * 16 + j;
#pragma unroll
          for (int ni = 0; ni < 4; ++ni) {
            int col = c0 + ni * 16 + fr;
            float v = acc[mi][ni][j];
            if (col < 2336) gates[(size_t)row * 32 + (col - 2304)] = v + gb[col - 2304];
            else if (col < P0N) proj[(size_t)row * PSTR + col] = f2bf(v);
          }
        }
    } else {
#pragma unroll
      for (int mi = 0; mi < 4; ++mi)
#pragma unroll
        for (int j = 0; j < 4; ++j) {
          int row = rbase + mi * 16 + j;
          float v0 = acc[mi][0][j], v1 = acc[mi][1][j], v2 = acc[mi][2][j], v3 = acc[mi][3][j];
          if (do_norm) {
            float ss = v0 * v0 + v1 * v1 + v2 * v2 + v3 * v3;
            ss = grp16_sum(ss);
            float rstd = rsqrtf(ss * (1.f / 64.f) + EPS);
            v0 = v0 * rstd * ng[fr]; v1 = v1 * rstd * ng[16 + fr]; v2 = v2 * rstd * ng[32 + fr]; v3 = v3 * rstd * ng[48 + fr];
          }
          if (do_rope) {
            int t = (row - NCTX) & 1023;
            float ca = rc[t * 32 + fr], sa = rc[32768 + t * 32 + fr];
            float cb = rc[t * 32 + 16 + fr], sb = rc[32768 + t * 32 + 16 + fr];
            float a0 = v0 * ca - v2 * sa, a2 = v2 * ca + v0 * sa;
            float a1 = v1 * cb - v3 * sb, a3 = v3 * cb + v1 * sb;
            v0 = a0; v1 = a1; v2 = a2; v3 = a3;
          }
          u16* pr = proj + (size_t)row * PSTR + c0 + fr;
          pr[0] = f2bf(v0); pr[16] = f2bf(v1); pr[32] = f2bf(v2); pr[48] = f2bf(v3);
          if (o32) {
            float* o = o32 + (size_t)row * ostr + fr;
            o[0] = v0; o[16] = v1; o[32] = v2; o[48] = v3;
          }
        }
    }
  }
}

template <int EPI>
__device__ void gemm_phase(const Params& p, const u16* A, const u16* Bt, int K, int NT, int l, int gchunk, float coef, u16* smem) {
  const int ntiles = 80 * NT;
  for (int t = blockIdx.x; t < ntiles; t += gridDim.x) {
    int mt = t % 80, nt = t / 80;
    gemm_tile<EPI>(p, A, Bt, K, mt * 128, nt * 128, l, gchunk, coef, smem);
  }
}

__device__ __forceinline__ void load_tile_bf16(float* dst, const u16* src, long rstride, float scale, int tid) {
  int r = tid >> 2, part = tid & 3;
  const uint4* s = (const uint4*)(src + (long)r * rstride + part * 16);
  uint4 a = s[0], b = s[1];
  float4* d = (float4*)(dst + r * TS + part * 16);
  d[0] = make_float4(bflo(a.x) * scale, bfhi(a.x) * scale, bflo(a.y) * scale, bfhi(a.y) * scale);
  d[1] = make_float4(bflo(a.z) * scale, bfhi(a.z) * scale, bflo(a.w) * scale, bfhi(a.w) * scale);
  d[2] = make_float4(bflo(b.x) * scale, bfhi(b.x) * scale, bflo(b.y) * scale, bfhi(b.y) * scale);
  d[3] = make_float4(bflo(b.z) * scale, bfhi(b.z) * scale, bflo(b.w) * scale, bfhi(b.w) * scale);
}
__device__ __forceinline__ void load_tile_f32(float* dst, const float* src, long rstride, int tid) {
  int r = tid >> 2, part = tid & 3;
  const float4* s = (const float4*)(src + (long)r * rstride + part * 16);
  float4* d = (float4*)(dst + r * TS + part * 16);
  d[0] = s[0]; d[1] = s[1]; d[2] = s[2]; d[3] = s[3];
}
__device__ __forceinline__ void qk_micro(const float* Qs, const float* Ks, int ty, int tx, float s[4][4]) {
#pragma unroll
  for (int i = 0; i < 4; ++i)
#pragma unroll
    for (int j = 0; j < 4; ++j) s[i][j] = 0.f;
#pragma unroll 4
  for (int d4 = 0; d4 < 16; ++d4) {
    float4 q[4], k[4];
#pragma unroll
    for (int i = 0; i < 4; ++i) q[i] = *(const float4*)(Qs + (ty * 4 + i) * TS + d4 * 4);
#pragma unroll
    for (int j = 0; j < 4; ++j) k[j] = *(const float4*)(Ks + (tx + 16 * j) * TS + d4 * 4);
#pragma unroll
    for (int i = 0; i < 4; ++i)
#pragma unroll
      for (int j = 0; j < 4; ++j)
        s[i][j] += q[i].x * k[j].x + q[i].y * k[j].y + q[i].z * k[j].z + q[i].w * k[j].w;
  }
}
__device__ __forceinline__ void pv_micro(const float* Ps, const float* Vs, int ty, int tx, float o[4][4]) {
#pragma unroll 4
  for (int s4 = 0; s4 < 16; ++s4) {
    float4 pp[4], v[4];
#pragma unroll
    for (int i = 0; i < 4; ++i) pp[i] = *(const float4*)(Ps + (ty * 4 + i) * TS + s4 * 4);
#pragma unroll
    for (int q = 0; q < 4; ++q) v[q] = *(const float4*)(Vs + (s4 * 4 + q) * TS + tx * 4);
#pragma unroll
    for (int i = 0; i < 4; ++i) {
      o[i][0] += pp[i].x * v[0].x + pp[i].y * v[1].x + pp[i].z * v[2].x + pp[i].w * v[3].x;
      o[i][1] += pp[i].x * v[0].y + pp[i].y * v[1].y + pp[i].z * v[2].y + pp[i].w * v[3].y;
      o[i][2] += pp[i].x * v[0].z + pp[i].y * v[1].z + pp[i].z * v[2].z + pp[i].w * v[3].z;
      o[i][3] += pp[i].x * v[0].w + pp[i].y * v[1].w + pp[i].z * v[2].w + pp[i].w * v[3].w;
    }
  }
}

struct AttnDesc {
  int qrow0, qcol, ocol;
  const float* ck; const float* cv; int cstride; int nctx;
  int krow0, nloc, kcol, vcol;
  int mode;
  int a0;
  const float* rpb;
  float sink; int has_sink;
};

__device__ void attn_item(const Params& p, const AttnDesc& d, float* sm) {
  const int tid = get_tid(), ty = tid >> 4, tx = tid & 15;
  const u16* proj = (const u16*)(p.ws + OFF_HP);
  float* Qs = sm; float* Ks = sm + TILE_F; float* Vs = sm + 2 * TILE_F; float* Ps = sm + 3 * TILE_F;
  __syncthreads();
  load_tile_bf16(Qs, proj + (size_t)d.qrow0 * PSTR + d.qcol, PSTR, 0.125f, tid);
  float m_i[4], l_i[4], o[4][4];
#pragma unroll
  for (int i = 0; i < 4; ++i) {
    m_i[i] = d.has_sink ? d.sink : -1e30f;
    l_i[i] = d.has_sink ? 1.f : 0.f;
#pragma unroll
    for (int j = 0; j < 4; ++j) o[i][j] = 0.f;
  }
  const int ntiles = d.nctx + d.nloc;
  for (int tile = 0; tile < ntiles; ++tile) {
    __syncthreads();
    const int lt = tile - d.nctx;
    if (tile < d.nctx) {
      load_tile_f32(Ks, d.ck + (size_t)tile * 64 * d.cstride, d.cstride, tid);
      load_tile_f32(Vs, d.cv + (size_t)tile * 64 * d.cstride, d.cstride, tid);
    } else {
      const u16* base = proj + (size_t)(d.krow0 + lt * 64) * PSTR;
      load_tile_bf16(Ks, base + d.kcol, PSTR, 1.f, tid);
      load_tile_bf16(Vs, base + d.vcol, PSTR, 1.f, tid);
    }
    __syncthreads();
    float s[4][4];
    qk_micro(Qs, Ks, ty, tx, s);
    if (lt >= 0 && d.mode == 1) {
      const float* rp = d.rpb + (d.a0 + lt) * 31;
#pragma unroll
      for (int i = 0; i < 4; ++i) {
        int qc = ty * 4 + i;
        int ws = min(max(qc - 8, 0), 48);
#pragma unroll
        for (int j = 0; j < 4; ++j) {
          int kc = tx + 16 * j;
          bool ok = (kc >= ws) && (kc < ws + 16);
          int dx = min(max(kc - qc + 15, 0), 30);
          s[i][j] = ok ? s[i][j] + rp[dx] : -1e30f;
        }
      }
    } else if (lt >= 0 && d.mode == 2) {
      int off = d.a0 + lt * 64;
#pragma unroll
      for (int i = 0; i < 4; ++i)
#pragma unroll
        for (int j = 0; j < 4; ++j) {
          int dd = off + (tx + 16 * j) - (ty * 4 + i);
          bool ok = (dd <= 128) && (dd >= -128);
          s[i][j] = ok ? s[i][j] : -1e30f;
        }
    }
#pragma unroll
    for (int i = 0; i < 4; ++i) {
      float mx = fmaxf(fmaxf(s[i][0], s[i][1]), fmaxf(s[i][2], s[i][3]));
      mx = grp16_max(mx);
      float mn = fmaxf(m_i[i], mx);
      float alpha = expf(m_i[i] - mn);
      float rs = 0.f;
#pragma unroll
      for (int j = 0; j < 4; ++j) {
        float pj = expf(s[i][j] - mn);
        rs += pj;
        Ps[(ty * 4 + i) * TS + tx + 16 * j] = pj;
      }
      rs = grp16_sum(rs);
      l_i[i] = l_i[i] * alpha + rs;
      m_i[i] = mn;
#pragma unroll
      for (int j = 0; j < 4; ++j) o[i][j] *= alpha;
    }
    __syncthreads();
    pv_micro(Ps, Vs, ty, tx, o);
  }
  u16* ymix = (u16*)(p.ws + OFF_YMIX);
#pragma unroll
  for (int i = 0; i < 4; ++i) {
    float inv = 1.f / l_i[i];
    uint2 ov = make_uint2(pack2(o[i][0] * inv, o[i][1] * inv), pack2(o[i][2] * inv, o[i][3] * inv));
    *(uint2*)(ymix + (size_t)(d.qrow0 + ty * 4 + i) * D + d.ocol + tx * 4) = ov;
  }
}

__device__ __forceinline__ int st_slot(int isctx, int b, int dir, int head, int cc) {
  int ch = (b * 2 + dir) * 8 + head;
  return isctx ? (ch * 4 + cc) : (2048 + ch * 16 + cc);
}

__device__ void mlstm_state_item(const Params& p, int isctx, int b, int dir, int head, float* sm) {
  const int tid = get_tid(), ty = tid >> 4, tx = tid & 15, lane = tid & 63;
  const u16* proj = (const u16*)(p.ws + OFF_HP);
  const float* gates = (const float*)(p.ws + OFF_GATES);
  float* stC = (float*)(p.ws + OFF_STC);
  float* stn = (float*)(p.ws + OFF_STN);
  float* stm = (float*)(p.ws + OFF_STM);
  float* Ks = sm; float* Vs = sm + TILE_F;
  float* sws = sm + 4 * TILE_F;
  float* sn = sws + 64;
  float* ssc = sn + 64;
  const int nc = isctx ? 4 : 16, L = isctx ? 256 : 1024;
  const int seq0 = isctx ? b * 256 : NCTX + b * 1024;
  float c[4][4];
  float m;
  __syncthreads();
  if (isctx) {
#pragma unroll
    for (int i = 0; i < 4; ++i)
#pragma unroll
      for (int j = 0; j < 4; ++j) c[i][j] = 0.f;
    if (tid < 64) sn[tid] = 0.f;
    m = 0.f;
  } else {
    int ch = (b * 2 + dir) * 8 + head;
    const float* C0 = p.in[I_SC] + (size_t)ch * 4096;
#pragma unroll
    for (int i = 0; i < 4; ++i) {
      float4 v = *(const float4*)(C0 + (ty * 4 + i) * 64 + tx * 4);
      c[i][0] = v.x; c[i][1] = v.y; c[i][2] = v.z; c[i][3] = v.w;
    }
    if (tid < 64) sn[tid] = p.in[I_SN][ch * 64 + tid];
    m = p.in[I_SM][ch];
  }
  for (int cc = 0; cc < nc; ++cc) {
    __syncthreads();
    const int slot = st_slot(isctx, b, dir, head, cc);
#pragma unroll
    for (int i = 0; i < 4; ++i)
      *(float4*)(stC + (size_t)slot * 4096 + (ty * 4 + i) * 64 + tx * 4) = make_float4(c[i][0], c[i][1], c[i][2], c[i][3]);
    if (tid < 64) stn[slot * 64 + tid] = sn[tid];
    if (tid == 0) stm[slot] = m;
    const int tok0 = dir ? (L - 1 - cc * 64) : cc * 64;
    const long rs = dir ? -(long)PSTR : (long)PSTR;
    const u16* base = proj + (size_t)(seq0 + tok0) * PSTR;
    load_tile_bf16(Ks, base + 1280 + head * 64, rs, 0.125f, tid);
    load_tile_bf16(Vs, base + 1792 + head * 64, rs, 1.f, tid);
    if (tid < 64) {
      int tr = seq0 + (dir ? tok0 - lane : tok0 + lane);
      float li = gates[(size_t)tr * 32 + (dir * 2) * 8 + head];
      float fp = gates[(size_t)tr * 32 + (dir * 2 + 1) * 8 + head];
      float lf = logsigmoidf_(fp);
      float bb = wave_scan_add(lf, lane);
      float a = li - bb;
      float amax = wave_max(a);
      float blast = __shfl(bb, 63);
      float mnew = blast + fmaxf(m, amax);
      sws[lane] = expf(blast + a - mnew);
      if (lane == 0) { ssc[0] = expf(blast + m - mnew); ssc[1] = mnew; }
    }
    __syncthreads();
    const float wc = ssc[0];
    m = ssc[1];
#pragma unroll
    for (int i = 0; i < 4; ++i)
#pragma unroll
      for (int j = 0; j < 4; ++j) c[i][j] *= wc;
    float nacc = 0.f;
#pragma unroll 4
    for (int s = 0; s < 64; ++s) {
      float w = sws[s];
      float4 kk = *(const float4*)(Ks + s * TS + ty * 4);
      float4 vv = *(const float4*)(Vs + s * TS + tx * 4);
      float k0 = kk.x * w, k1 = kk.y * w, k2 = kk.z * w, k3 = kk.w * w;
      c[0][0] += k0 * vv.x; c[0][1] += k0 * vv.y; c[0][2] += k0 * vv.z; c[0][3] += k0 * vv.w;
      c[1][0] += k1 * vv.x; c[1][1] += k1 * vv.y; c[1][2] += k1 * vv.z; c[1][3] += k1 * vv.w;
      c[2][0] += k2 * vv.x; c[2][1] += k2 * vv.y; c[2][2] += k2 * vv.z; c[2][3] += k2 * vv.w;
      c[3][0] += k3 * vv.x; c[3][1] += k3 * vv.y; c[3][2] += k3 * vv.z; c[3][3] += k3 * vv.w;
      if (tid < 64) nacc += w * Ks[s * TS + tid];
    }
    if (tid < 64) sn[tid] = wc * sn[tid] + nacc;
  }
  __syncthreads();
  if (isctx) {
    int ch = (b * 2 + dir) * 8 + head;
    float* Co = p.out + O_C + (size_t)ch * 4096;
#pragma unroll
    for (int i = 0; i < 4; ++i)
      *(float4*)(Co + (ty * 4 + i) * 64 + tx * 4) = make_float4(c[i][0], c[i][1], c[i][2], c[i][3]);
    if (tid < 64) p.out[O_N + ch * 64 + tid] = sn[tid];
    if (tid == 0) p.out[O_M + ch] = m;
  }
}

__device__ void mlstm_out_item(const Params& p, int isctx, int b, int head, int c, float* sm) {
  const int tid = get_tid(), ty = tid >> 4, tx = tid & 15, lane = tid & 63;
  const u16* proj = (const u16*)(p.ws + OFF_HP);
  const float* gates = (const float*)(p.ws + OFF_GATES);
  const float* stC = (const float*)(p.ws + OFF_STC);
  const float* stn = (const float*)(p.ws + OFF_STN);
  const float* stm = (const float*)(p.ws + OFF_STM);
  float* Qs = sm; float* KCs = sm + TILE_F; float* Vs = sm + 2 * TILE_F; float* Ws = sm + 3 * TILE_F;
  float* sa = sm + 4 * TILE_F;
  float* sM = sa + 64;
  float* sb = sM + 64;
  float* sn = sb + 64;
  const int nc = isctx ? 4 : 16;
  const int mb = (isctx ? b * 256 : NCTX + b * 1024) + c * 64;
  float hacc[4][4];
  for (int dir = 0; dir < 2; ++dir) {
    const int cc = dir ? nc - 1 - c : c;
    const int slot = st_slot(isctx, b, dir, head, cc);
    const float m0 = stm[slot];
    __syncthreads();
    const long rs = dir ? -(long)PSTR : (long)PSTR;
    const u16* base = proj + (size_t)(mb + (dir ? 63 : 0)) * PSTR;
    load_tile_bf16(Qs, base + 768 + head * 64, rs, 1.f, tid);
    load_tile_bf16(KCs, base + 1280 + head * 64, rs, 0.125f, tid);
    load_tile_bf16(Vs, base + 1792 + head * 64, rs, 1.f, tid);
    if (tid < 64) {
      int tr = mb + (dir ? 63 - lane : lane);
      float li = gates[(size_t)tr * 32 + (dir * 2) * 8 + head];
      float fp = gates[(size_t)tr * 32 + (dir * 2 + 1) * 8 + head];
      float lf = logsigmoidf_(fp);
      float bb = wave_scan_add(lf, lane);
      float a = li - bb;
      float pm = wave_scan_max(a, lane);
      sa[lane] = a; sM[lane] = fmaxf(m0, pm); sb[lane] = bb;
      sn[lane] = stn[slot * 64 + lane];
    }
    __syncthreads();
    float s[4][4];
    qk_micro(Qs, KCs, ty, tx, s);
    float rsum[4];
#pragma unroll
    for (int i = 0; i < 4; ++i) {
      int t = ty * 4 + i;
      float Mt = sM[t];
      float r = 0.f;
#pragma unroll
      for (int j = 0; j < 4; ++j) {
        int sidx = tx + 16 * j;
        float w = (sidx <= t) ? expf(sa[sidx] - Mt) * s[i][j] : 0.f;
        Ws[t * TS + sidx] = w;
        r += w;
      }
      rsum[i] = grp16_sum(r);
    }
    __syncthreads();
    load_tile_f32(KCs, stC + (size_t)slot * 4096, 64, tid);
    __syncthreads();
    float num[4][4], qc[4][4];
#pragma unroll
    for (int i = 0; i < 4; ++i)
#pragma unroll
      for (int j = 0; j < 4; ++j) { num[i][j] = 0.f; qc[i][j] = 0.f; }
    pv_micro(Ws, Vs, ty, tx, num);
    pv_micro(Qs, KCs, ty, tx, qc);
    float hd[4][4];
#pragma unroll
    for (int i = 0; i < 4; ++i) {
      int t = ty * 4 + i;
      float4 q4 = *(const float4*)(Qs + t * TS + tx * 4);
      float4 n4 = *(const float4*)(sn + tx * 4);
      float qn = q4.x * n4.x + q4.y * n4.y + q4.z * n4.z + q4.w * n4.w;
      qn = grp16_sum(qn);
      float Mt = sM[t];
      float wi = expf(m0 - Mt);
      float den = rsum[i] + wi * qn;
      float mt = sb[t] + Mt;
      float dn = fmaxf(fabsf(den), expf(-mt));
      float inv = 1.f / dn;
#pragma unroll
      for (int j = 0; j < 4; ++j) hd[i][j] = (num[i][j] + wi * qc[i][j]) * inv;
    }
    if (dir == 0) {
#pragma unroll
      for (int i = 0; i < 4; ++i)
#pragma unroll
        for (int j = 0; j < 4; ++j) hacc[i][j] = hd[i][j];
    } else {
      __syncthreads();
#pragma unroll
      for (int i = 0; i < 4; ++i)
        *(float4*)(Ws + (63 - (ty * 4 + i)) * TS + tx * 4) = make_float4(hd[i][0], hd[i][1], hd[i][2], hd[i][3]);
      __syncthreads();
#pragma unroll
      for (int i = 0; i < 4; ++i) {
        float4 v = *(const float4*)(Ws + (ty * 4 + i) * TS + tx * 4);
        hacc[i][0] += v.x; hacc[i][1] += v.y; hacc[i][2] += v.z; hacc[i][3] += v.w;
      }
    }
  }
  const float* hg = p.in[I_L0 + L_X2] + head * 64 + tx * 4;
  u16* ymix = (u16*)(p.ws + OFF_YMIX);
#pragma unroll
  for (int i = 0; i < 4; ++i) {
    float ss = hacc[i][0] * hacc[i][0] + hacc[i][1] * hacc[i][1] + hacc[i][2] * hacc[i][2] + hacc[i][3] * hacc[i][3];
    ss = grp16_sum(ss);
    float rstd = rsqrtf(ss * (1.f / 64.f) + EPS);
    int tr = mb + ty * 4 + i;
    uint2 ob = *(const uint2*)(proj + (size_t)tr * PSTR + 2336 + head * 64 + tx * 4);
    float y0 = sigmoidf_(bflo(ob.x)) * (hacc[i][0] * rstd * hg[0]);
    float y1 = sigmoidf_(bfhi(ob.x)) * (hacc[i][1] * rstd * hg[1]);
    float y2 = sigmoidf_(bflo(ob.y)) * (hacc[i][2] * rstd * hg[2]);
    float y3 = sigmoidf_(bfhi(ob.y)) * (hacc[i][3] * rstd * hg[3]);
    *(uint2*)(ymix + (size_t)tr * D + 512 + head * 64 + tx * 4) = make_uint2(pack2(y0, y1), pack2(y2, y3));
  }
}

__device__ __forceinline__ int next_item(int* ctr, int* s_item) {
  __syncthreads();
  if (get_tid() == 0) *s_item = atomicAdd(ctr, 1);
  __syncthreads();
  return *s_item;
}

__device__ void mix0_phase_a(const Params& p, float* sm, int* s_item) {
  int* ctr = (int*)(p.ws + OFF_CTR) + 0;
  for (;;) {
    int it = next_item(ctr, s_item);
    if (it >= 1824) break;
    if (it < 32) {
      int b = it >> 4, dir = (it >> 3) & 1, head = it & 7;
      mlstm_state_item(p, 0, b, dir, head, sm);
    } else if (it < 288) {
      int v = it - 32; int b = v >> 7, h = (v >> 4) & 7, qb = v & 15;
      AttnDesc d;
      d.qrow0 = NCTX + b * 1024 + qb * 64; d.qcol = h * 64; d.ocol = h * 64;
      d.ck = p.in[I_C0K] + (size_t)b * 256 * 128 + (h >> 2) * 64; d.cv = p.in[I_C0V] + (size_t)b * 256 * 128 + (h >> 2) * 64;
      d.cstride = 128; d.nctx = 4;
      d.krow0 = NCTX + b * 1024; d.nloc = 16; d.kcol = 512 + (h >> 2) * 64; d.vcol = 640 + (h >> 2) * 64;
      d.mode = 0; d.a0 = 0; d.rpb = nullptr; d.sink = 0.f; d.has_sink = 0;
      attn_item(p, d, sm);
    } else if (it < 800) {
      int v = it - 288; int b = v >> 4, dir = (v >> 3) & 1, head = v & 7;
      mlstm_state_item(p, 1, b, dir, head, sm);
    } else {
      int v = it - 800; int b = v >> 5, h = (v >> 2) & 7, qb = v & 3;
      AttnDesc d;
      d.qrow0 = b * 256 + qb * 64; d.qcol = h * 64; d.ocol = h * 64;
      d.ck = nullptr; d.cv = nullptr; d.cstride = 0; d.nctx = 0;
      d.krow0 = b * 256; d.nloc = 4; d.kcol = 512 + (h >> 2) * 64; d.vcol = 640 + (h >> 2) * 64;
      d.mode = 0; d.a0 = 0; d.rpb = nullptr; d.sink = 0.f; d.has_sink = 0;
      attn_item(p, d, sm);
    }
  }
}

__device__ void mix0_phase_b(const Params& p, float* sm, int* s_item) {
  int* ctr = (int*)(p.ws + OFF_CTR) + 1;
  for (;;) {
    int it = next_item(ctr, s_item);
    if (it >= 1280) break;
    if (it < 256) {
      int b = it >> 7, head = (it >> 4) & 7, c = it & 15;
      mlstm_out_item(p, 0, b, head, c, sm);
    } else {
      int v = it - 256; int b = v >> 5, head = (v >> 2) & 7, c = v & 3;
      mlstm_out_item(p, 1, b, head, c, sm);
    }
  }
}

__device__ void mix1_phase(const Params& p, float* sm, int* s_item) {
  int* ctr = (int*)(p.ws + OFF_CTR) + 2;
  const float* sink = p.in[I_L1 + L_X1];
  for (;;) {
    int it = next_item(ctr, s_item);
    if (it >= 2560) break;
    AttnDesc d;
    d.mode = 0; d.a0 = 0; d.rpb = nullptr; d.sink = 0.f; d.has_sink = 0;
    if (it < 256) {
      int b = it >> 7, h = (it >> 4) & 7, r = it & 15;
      int r0 = min(max(r - 4, 0), 8);
      d.qrow0 = NCTX + b * 1024 + r * 64; d.qcol = h * 64; d.ocol = h * 64;
      d.ck = p.in[I_NAK] + (size_t)b * 256 * 512 + h * 64; d.cv = p.in[I_NAV] + (size_t)b * 256 * 512 + h * 64;
      d.cstride = 512; d.nctx = 4;
      d.krow0 = NCTX + b * 1024 + r0 * 64; d.nloc = 8; d.kcol = 512 + h * 64; d.vcol = 1024 + h * 64;
      d.mode = 1; d.a0 = r0 - r + 7; d.rpb = p.in[I_L1 + L_X0] + h * 15 * 31;
    } else if (it < 512) {
      int v = it - 256; int b = v >> 7, h = (v >> 4) & 7, qb = v & 15;
      int t0 = qb * 64;
      int s0 = max(t0 - 128, 0);
      int s1 = min(t0 + 192, 1024);
      d.qrow0 = NCTX + b * 1024 + t0; d.qcol = 1536 + h * 64; d.ocol = 512 + h * 64;
      d.ck = p.in[I_SWK] + (size_t)b * 256 * 128 + (h >> 2) * 64; d.cv = p.in[I_SWV] + (size_t)b * 256 * 128 + (h >> 2) * 64;
      d.cstride = 128; d.nctx = 4;
      d.krow0 = NCTX + b * 1024 + s0; d.nloc = (s1 - s0) >> 6; d.kcol = 2048 + (h >> 2) * 64; d.vcol = 2176 + (h >> 2) * 64;
      d.mode = 2; d.a0 = s0 - t0;
      d.sink = sink[h]; d.has_sink = 1;
    } else if (it < 1536) {
      int v = it - 512; int b = v >> 5, h = (v >> 2) & 7, qb = v & 3;
      d.qrow0 = b * 256 + qb * 64; d.qcol = h * 64; d.ocol = h * 64;
      d.ck = nullptr; d.cv = nullptr; d.cstride = 0; d.nctx = 0;
      d.krow0 = b * 256; d.nloc = 4; d.kcol = 512 + h * 64; d.vcol = 1024 + h * 64;
    } else {
      int v = it - 1536; int b = v >> 5, h = (v >> 2) & 7, qb = v & 3;
      d.qrow0 = b * 256 + qb * 64; d.qcol = 1536 + h * 64; d.ocol = 512 + h * 64;
      d.ck = nullptr; d.cv = nullptr; d.cstride = 0; d.nctx = 0;
      d.krow0 = b * 256; d.nloc = 4; d.kcol = 2048 + (h >> 2) * 64; d.vcol = 2176 + (h >> 2) * 64;
      d.sink = sink[h]; d.has_sink = 1;
    }
    attn_item(p, d, sm);
  }
}

constexpr int NPHASE = 23;

__device__ void run_phase(const Params& p, int ph, char* smem, int* s_item) {
  float* smf = (float*)smem;
  u16* smh = (u16*)smem;
  const u16* xn = (const u16*)(p.ws + OFF_XN);
  const u16* hp = (const u16*)(p.ws + OFF_HP);
  const u16* ymix = (const u16*)(p.ws + OFF_YMIX);
  if (ph == 0) { prep_phase(p, smf); return; }
  if (ph == 22) { norm_phase(p, 0, 3); return; }
  int l = (ph - 1) / 11, q = (ph - 1) % 11;
  if (l == 1 && q >= 6) q += 1;
  switch (q) {
    case 0: norm_phase(p, l, 0); break;
    case 1: gemm_phase<EPI_SWIGLU>(p, xn, (const u16*)(p.ws + OFF_WIN + (l * 2 + 0) * SZ_WIN), 1024, 44, l, 0, 0.f, smh); break;
    case 2: gemm_phase<EPI_RESID>(p, hp, (const u16*)(p.ws + OFF_WOUT + (l * 2 + 0) * SZ_WOUT), DFF, 8, l, 2, 0.5f, smh); break;
    case 3: norm_phase(p, l, 1); break;
    case 4:
      if (l == 0) gemm_phase<EPI_MIX0>(p, xn, (const u16*)(p.ws + OFF_WMI0), 1024, 23, l, 0, 0.f, smh);
      else gemm_phase<EPI_MIX1>(p, xn, (const u16*)(p.ws + OFF_WMI1), 1024, 18, l, 0, 0.f, smh);
      break;
    case 5:
      if (l == 0) mix0_phase_a(p, smf, s_item); else mix1_phase(p, smf, s_item);
      break;
    case 6: mix0_phase_b(p, smf, s_item); break;
    case 7: gemm_phase<EPI_RESID>(p, ymix, (const u16*)(p.ws + OFF_WMO + (size_t)l * D * D * 2), 1024, 8, l, 5, 1.f, smh); break;
    case 8: norm_phase(p, l, 2); break;
    case 9: gemm_phase<EPI_SWIGLU>(p, xn, (const u16*)(p.ws + OFF_WIN + (l * 2 + 1) * SZ_WIN), 1024, 44, l, 0, 0.f, smh); break;
    case 10: gemm_phase<EPI_RESID>(p, hp, (const u16*)(p.ws + OFF_WOUT + (l * 2 + 1) * SZ_WOUT), DFF, 8, l, 8, 0.5f, smh); break;
  }
}

__global__ void __launch_bounds__(256, 2) mega(Params p, int ph0, int ph1) {
  __shared__ __attribute__((aligned(16))) char smem[SMEM_BYTES];
  __shared__ int s_item;
  cg::grid_group grid = cg::this_grid();
  for (int ph = ph0; ph < ph1; ++ph) {
    if (ph > ph0) grid.sync();
    run_phase(p, ph, smem, &s_item);
  }
}

extern "C" void kernel_launch(void* const* d_in, const int* in_sizes, int n_in, void* d_out, int out_size, void* d_ws,
                              size_t ws_size, hipStream_t stream) {
  static int grid_blocks = 0;
  if (!grid_blocks) {
    int dev = 0, cus = 0, per_cu = 0;
    hipGetDevice(&dev);
    hipDeviceGetAttribute(&cus, hipDeviceAttributeMultiprocessorCount, dev);
    hipOccupancyMaxActiveBlocksPerMultiprocessor(&per_cu, mega, 256, 0);
    if (per_cu > 2) per_cu = 2;
    if (per_cu < 1) per_cu = 1;
    grid_blocks = cus * per_cu;
  }
  if (ws_size < WS_TOTAL) fprintf(stderr, "workspace too small: %zu < %zu\n", ws_size, (size_t)WS_TOTAL);
  Params p{};
  for (int i = 0; i < 37; ++i) p.in[i] = (const float*)d_in[i];
  p.out = (float*)d_out;
  p.ws = (char*)d_ws;
#if SINGLE_LAUNCH
  int ph0 = 0, ph1 = NPHASE;
  void* args[] = {&p, &ph0, &ph1};
  hipError_t e = hipLaunchCooperativeKernel((void*)mega, dim3(grid_blocks), dim3(256), args, 0, stream);
  if (e != hipSuccess) fprintf(stderr, "cooperative launch failed: %s (grid %d)\n", hipGetErrorString(e), grid_blocks);
#else
  for (int ph = 0; ph < NPHASE; ++ph) mega<<<grid_blocks, 256, 0, stream>>>(p, ph, ph + 1);
#endif
}
```

```cpp
#include <hip/hip_runtime.h>
#include <hip/hip_cooperative_groups.h>
#include <cstdio>
namespace cg = cooperative_groups;

#ifndef SINGLE_LAUNCH
#define SINGLE_LAUNCH 1
#endif

typedef unsigned short u16;
typedef __attribute__((ext_vector_type(8))) short bf16x8;
typedef __attribute__((ext_vector_type(4))) float f32x4;
typedef __attribute__((ext_vector_type(4))) unsigned u32x4;

constexpr int D = 1024, NCTX = 8192, MTOK = 10240;
constexpr int DFF = 2816, NFF = 5632;
constexpr int P0N = 2848, P0P = 2944, P1N = 2304;
constexpr int PSTR = 2944;
constexpr float EPS = 1e-6f;

enum { I_XP = 0, I_XS, I_C0K, I_C0V, I_SC, I_SN, I_SM, I_NAK, I_NAV, I_SWK, I_SWV, I_C, I_CCTX, I_NF,
       I_L0 = 14, I_L1 = 26 };
enum { L_ADAW = 0, L_ADAB, L_NORM, L_F1I, L_F1O, L_F2I, L_F2O, L_MI, L_MO, L_X0, L_X1, L_X2 };

constexpr size_t O_X = 0, O_K0 = 10485760, O_V0 = 11534336, O_C = 12582912, O_N = 14680064, O_M = 14712832,
                 O_KC1 = 14713344, O_VC1 = 18907648, O_KD1 = 23101952, O_VD1 = 24150528;

constexpr size_t SZ_WIN = (size_t)NFF * D * 2;
constexpr size_t SZ_WOUT = (size_t)D * DFF * 2;
constexpr size_t OFF_WIN = 0;
constexpr size_t OFF_WOUT = OFF_WIN + 4 * SZ_WIN;
constexpr size_t OFF_WMI0 = OFF_WOUT + 4 * SZ_WOUT;
constexpr size_t OFF_WMI1 = OFF_WMI0 + (size_t)P0P * D * 2;
constexpr size_t OFF_WMO = OFF_WMI1 + (size_t)P1N * D * 2;
constexpr size_t OFF_MOD = OFF_WMO + 2 * (size_t)D * D * 2;
constexpr size_t OFF_ROPE = OFF_MOD + 2 * 3 * 9216 * 4;
constexpr size_t OFF_CTR = OFF_ROPE + 2 * 1024 * 32 * 4;
constexpr size_t OFF_XN = OFF_CTR + 256;
constexpr size_t OFF_YMIX = OFF_XN + (size_t)MTOK * D * 2;
constexpr size_t OFF_HP = OFF_YMIX + (size_t)MTOK * D * 2;
constexpr size_t OFF_GATES = OFF_HP + (size_t)MTOK * PSTR * 2;
constexpr size_t OFF_STC = OFF_GATES + (size_t)MTOK * 32 * 4;
constexpr size_t OFF_STN = OFF_STC + (size_t)2560 * 4096 * 4;
constexpr size_t OFF_STM = OFF_STN + (size_t)2560 * 64 * 4;
constexpr size_t WS_TOTAL = OFF_STM + 2560 * 4;

constexpr int TS = 68;
constexpr int TILE_F = 64 * TS;
constexpr int SMEM_BYTES = 4 * TILE_F * 4 + 2048;

struct Params {
  const float* in[37];
  float* out;
  char* ws;
};

__device__ __forceinline__ int get_tid() { int t = threadIdx.x; asm volatile("" : "+v"(t)); return t; }
__device__ __forceinline__ u16 f2bf(float f) {
  unsigned u = __float_as_uint(f);
  u += 0x7fffu + ((u >> 16) & 1u);
  return (u16)(u >> 16);
}
__device__ __forceinline__ unsigned pack2(float a, float b) { return (unsigned)f2bf(a) | ((unsigned)f2bf(b) << 16); }
__device__ __forceinline__ float bflo(unsigned x) { return __uint_as_float(x << 16); }
__device__ __forceinline__ float bfhi(unsigned x) { return __uint_as_float(x & 0xffff0000u); }
__device__ __forceinline__ float grp16_sum(float v) {
  v += __shfl_xor(v, 1); v += __shfl_xor(v, 2); v += __shfl_xor(v, 4); v += __shfl_xor(v, 8); return v;
}
__device__ __forceinline__ float grp16_max(float v) {
  v = fmaxf(v, __shfl_xor(v, 1)); v = fmaxf(v, __shfl_xor(v, 2)); v = fmaxf(v, __shfl_xor(v, 4)); v = fmaxf(v, __shfl_xor(v, 8)); return v;
}
__device__ __forceinline__ float wave_sum(float v) {
  for (int o = 32; o; o >>= 1) v += __shfl_xor(v, o);
  return v;
}
__device__ __forceinline__ float wave_max(float v) {
  for (int o = 32; o; o >>= 1) v = fmaxf(v, __shfl_xor(v, o));
  return v;
}
__device__ __forceinline__ float wave_scan_add(float v, int lane) {
  for (int o = 1; o < 64; o <<= 1) { float t = __shfl_up(v, o); if (lane >= o) v += t; }
  return v;
}
__device__ __forceinline__ float wave_scan_max(float v, int lane) {
  for (int o = 1; o < 64; o <<= 1) { float t = __shfl_up(v, o); if (lane >= o) v = fmaxf(v, t); }
  return v;
}
__device__ __forceinline__ int cond_of(int row) { return row < NCTX ? 0 : 1 + ((row - NCTX) >> 10); }
__device__ __forceinline__ float sigmoidf_(float x) { return 1.f / (1.f + expf(-x)); }
__device__ __forceinline__ float logsigmoidf_(float x) { return fminf(x, 0.f) - log1pf(expf(-fabsf(x))); }

__device__ void conv_tile(const float* __restrict__ W, int K, int N, u16* __restrict__ Wt, int perm, int kt, int nt, float* T) {
  const int tid = get_tid();
  {
    int r = tid >> 4, c4 = tid & 15;
    int c = c4 * 4;
    int src;
    if (perm) src = (c < 32) ? (nt * 32 + c) : (DFF + nt * 32 + (c - 32));
    else src = nt * 64 + c;
    bool ok = src < N;
#pragma unroll
    for (int ps = 0; ps < 4; ++ps) {
      int k = r + ps * 16;
      float4 v = make_float4(0.f, 0.f, 0.f, 0.f);
      if (ok) v = *(const float4*)(W + (size_t)(kt * 64 + k) * N + src);
      float* t = T + k * 65 + c;
      t[0] = v.x; t[1] = v.y; t[2] = v.z; t[3] = v.w;
    }
  }
  __syncthreads();
  {
    int n = tid >> 2, kp = tid & 3;
    unsigned o[8];
#pragma unroll
    for (int i = 0; i < 8; ++i) {
      float a = T[(kp * 16 + 2 * i) * 65 + n], b = T[(kp * 16 + 2 * i + 1) * 65 + n];
      o[i] = pack2(a, b);
    }
    uint4* dst = (uint4*)(Wt + (size_t)(nt * 64 + n) * K + kt * 64 + kp * 16);
    dst[0] = make_uint4(o[0], o[1], o[2], o[3]);
    dst[1] = make_uint4(o[4], o[5], o[6], o[7]);
  }
  __syncthreads();
}

__device__ void adaln_unit(const Params& p, int u, float* sm) {
  const int tid = get_tid();
  int l = u / 144, cg_ = u % 144;
  const float* W = p.in[(l ? I_L1 : I_L0) + L_ADAW];
  const float* B = p.in[(l ? I_L1 : I_L0) + L_ADAB];
  float* sc = sm;
  float* red = sm + 3072;
  for (int i = tid; i < 3072; i += 256) {
    int cnd = i >> 10, k = i & 1023;
    float v = (cnd == 0) ? p.in[I_CCTX][k] : p.in[I_C][(cnd - 1) * 1024 + k];
    sc[i] = v / (1.f + expf(-v));
  }
  __syncthreads();
  int kp = tid >> 4, c4 = tid & 15;
  float acc[3][4];
#pragma unroll
  for (int a = 0; a < 3; ++a)
#pragma unroll
    for (int e = 0; e < 4; ++e) acc[a][e] = 0.f;
  for (int kk = 0; kk < 64; ++kk) {
    int k = kp * 64 + kk;
    float4 w = *(const float4*)(W + (size_t)k * 9216 + cg_ * 64 + c4 * 4);
#pragma unroll
    for (int a = 0; a < 3; ++a) {
      float s = sc[a * 1024 + k];
      acc[a][0] += s * w.x; acc[a][1] += s * w.y; acc[a][2] += s * w.z; acc[a][3] += s * w.w;
    }
  }
#pragma unroll
  for (int a = 0; a < 3; ++a)
#pragma unroll
    for (int e = 0; e < 4; ++e) red[(kp * 3 + a) * 64 + c4 * 4 + e] = acc[a][e];
  __syncthreads();
  if (tid < 192) {
    int a = tid >> 6, col = tid & 63;
    float s = 0.f;
    for (int q = 0; q < 16; ++q) s += red[(q * 3 + a) * 64 + col];
    s += B[cg_ * 64 + col];
    float* mod = (float*)(p.ws + OFF_MOD);
    mod[(l * 3 + a) * 9216 + cg_ * 64 + col] = s;
  }
  __syncthreads();
}

__device__ void prep_phase(const Params& p, float* sm) {
  const int tid = get_tid();
  if (blockIdx.x == 0 && tid < 64) ((int*)(p.ws + OFF_CTR))[tid] = 0;
  constexpr int U_CONV = 10272, U_ADA = 288, U_ROPE = 128, U_COPY = 640;
  constexpr int U_TOT = U_CONV + U_ADA + U_ROPE + U_COPY;
  for (int u = blockIdx.x; u < U_TOT; u += gridDim.x) {
    if (u < U_CONV) {
      const float* W; u16* Wt; int K, N, perm, t, ntn;
      if (u < 5632) {
        int mi = u / 1408; t = u % 1408;
        int l = mi >> 1, f = mi & 1;
        W = p.in[(l ? I_L1 : I_L0) + (f ? L_F2I : L_F1I)];
        Wt = (u16*)(p.ws + OFF_WIN + mi * SZ_WIN);
        K = 1024; N = NFF; perm = 1; ntn = 88;
      } else if (u < 8448) {
        int v = u - 5632; int mi = v / 704; t = v % 704;
        int l = mi >> 1, f = mi & 1;
        W = p.in[(l ? I_L1 : I_L0) + (f ? L_F2O : L_F1O)];
        Wt = (u16*)(p.ws + OFF_WOUT + mi * SZ_WOUT);
        K = DFF; N = 1024; perm = 0; ntn = 16;
      } else if (u < 9184) {
        t = u - 8448; W = p.in[I_L0 + L_MI]; Wt = (u16*)(p.ws + OFF_WMI0); K = 1024; N = P0N; perm = 0; ntn = 46;
      } else if (u < 9760) {
        t = u - 9184; W = p.in[I_L1 + L_MI]; Wt = (u16*)(p.ws + OFF_WMI1); K = 1024; N = P1N; perm = 0; ntn = 36;
      } else {
        int v = u - 9760; int l = v / 256; t = v % 256;
        W = p.in[(l ? I_L1 : I_L0) + L_MO]; Wt = (u16*)(p.ws + OFF_WMO + (size_t)l * D * D * 2); K = 1024; N = 1024; perm = 0; ntn = 16;
      }
      int nt = t % ntn, kt = t / ntn;
      conv_tile(W, K, N, Wt, perm, kt, nt, sm);
    } else if (u < U_CONV + U_ADA) {
      adaln_unit(p, u - U_CONV, sm);
    } else if (u < U_CONV + U_ADA + U_ROPE) {
      int e = (u - U_CONV - U_ADA) * 256 + tid;
      int t = e >> 5, i = e & 31;
      float pos = (i < 16) ? (float)(t >> 6) : (float)(t & 63);
      float fr = powf(10000.f, -(float)(i & 15) / 16.f);
      float ang = pos * fr;
      float* rc = (float*)(p.ws + OFF_ROPE);
      rc[e] = cosf(ang);
      rc[32768 + e] = sinf(ang);
    } else {
      int v = u - U_CONV - U_ADA - U_ROPE;
      float4* dst = (float4*)(p.out + O_X);
#pragma unroll 4
      for (int i = 0; i < 16; ++i) {
        size_t idx = (size_t)v * 4096 + i * 256 + tid;
        float4 val = (idx < (size_t)NCTX * 256) ? ((const float4*)p.in[I_XP])[idx] : ((const float4*)p.in[I_XS])[idx - (size_t)NCTX * 256];
        dst[idx] = val;
      }
    }
  }
}

__device__ void norm_phase(const Params& p, int l, int which) {
  const int tid = get_tid(), lane = tid & 63, w = tid >> 6;
  float* x = p.out + O_X;
  const float* mod = (const float*)(p.ws + OFF_MOD);
  u16* xn = (u16*)(p.ws + OFF_XN);
  for (int row = blockIdx.x * 4 + w; row < MTOK; row += gridDim.x * 4) {
    float4* xr = (float4*)(x + (size_t)row * D);
    float4 v[4];
    float ss = 0.f;
#pragma unroll
    for (int i = 0; i < 4; ++i) {
      v[i] = xr[lane + i * 64];
      ss += v[i].x * v[i].x + v[i].y * v[i].y + v[i].z * v[i].z + v[i].w * v[i].w;
    }
    ss = wave_sum(ss);
    float rstd = rsqrtf(ss * (1.f / 1024.f) + EPS);
    if (which == 3) {
      const float4* g = (const float4*)p.in[I_NF];
#pragma unroll
      for (int i = 0; i < 4; ++i) {
        float4 gg = g[lane + i * 64];
        float4 o = make_float4(v[i].x * rstd * gg.x, v[i].y * rstd * gg.y, v[i].z * rstd * gg.z, v[i].w * rstd * gg.w);
        xr[lane + i * 64] = o;
      }
    } else {
      const float4* g = (const float4*)(p.in[(l ? I_L1 : I_L0) + L_NORM] + which * 1024);
      const float* mb = mod + (l * 3 + cond_of(row)) * 9216;
      const float4* sh = (const float4*)(mb + (3 * which) * 1024);
      const float4* sc = (const float4*)(mb + (3 * which + 1) * 1024);
#pragma unroll
      for (int i = 0; i < 4; ++i) {
        int q = lane + i * 64;
        float4 gg = g[q], s1 = sh[q], s2 = sc[q];
        float a = (v[i].x * rstd * gg.x) * (1.f + s2.x) + s1.x;
        float b = (v[i].y * rstd * gg.y) * (1.f + s2.y) + s1.y;
        float c = (v[i].z * rstd * gg.z) * (1.f + s2.z) + s1.z;
        float d = (v[i].w * rstd * gg.w) * (1.f + s2.w) + s1.w;
        uint2 o = make_uint2(pack2(a, b), pack2(c, d));
        *(uint2*)(xn + (size_t)row * D + q * 4) = o;
      }
    }
  }
}

enum { EPI_SWIGLU = 0, EPI_RESID = 1, EPI_MIX0 = 2, EPI_MIX1 = 3 };
constexpr int LS = 72;

template <int EPI>
__device__ __forceinline__ void gemm_tile(const Params& p, const u16* __restrict__ A, const u16* __restrict__ Bt, int K,
                                          int m0, int n0, int l, int gchunk, float coef, u16* smem) {
  const int tid = get_tid(), lane = tid & 63, wid = tid >> 6;
  const int wr = wid >> 1, wc = wid & 1, fr = lane & 15, fq = lane >> 4;
  u16* As = smem;
  u16* Bs = smem + 128 * LS;
  f32x4 acc[4][4];
#pragma unroll
  for (int i = 0; i < 4; ++i)
#pragma unroll
    for (int j = 0; j < 4; ++j) acc[i][j] = (f32x4){0.f, 0.f, 0.f, 0.f};
  u32x4 ra[4], rb[4];
  const int lrow = tid >> 3, lkc = tid & 7;
  const u16* Ag = A + (size_t)(m0 + lrow) * K + lkc * 8;
  const u16* Bg = Bt + (size_t)(n0 + lrow) * K + lkc * 8;
  const int nk = K >> 6;
#pragma unroll
  for (int i = 0; i < 4; ++i) {
    ra[i] = *(const u32x4*)(Ag + (size_t)(i * 32) * K);
    rb[i] = *(const u32x4*)(Bg + (size_t)(i * 32) * K);
  }
  for (int kt = 0; kt < nk; ++kt) {
    __syncthreads();
#pragma unroll
    for (int i = 0; i < 4; ++i) {
      *(u32x4*)(As + (lrow + i * 32) * LS + lkc * 8) = ra[i];
      *(u32x4*)(Bs + (lrow + i * 32) * LS + lkc * 8) = rb[i];
    }
    __syncthreads();
    if (kt + 1 < nk) {
#pragma unroll
      for (int i = 0; i < 4; ++i) {
        ra[i] = *(const u32x4*)(Ag + (size_t)(i * 32) * K + (kt + 1) * 64);
        rb[i] = *(const u32x4*)(Bg + (size_t)(i * 32) * K + (kt + 1) * 64);
      }
    }
#pragma unroll
    for (int ks = 0; ks < 2; ++ks) {
      bf16x8 a[4], b[4];
#pragma unroll
      for (int i = 0; i < 4; ++i) {
        a[i] = *(const bf16x8*)(As + (wr * 64 + i * 16 + fr) * LS + ks * 32 + fq * 8);
        b[i] = *(const bf16x8*)(Bs + (wc * 64 + i * 16 + fr) * LS + ks * 32 + fq * 8);
      }
#pragma unroll
      for (int i = 0; i < 4; ++i)
#pragma unroll
        for (int j = 0; j < 4; ++j) acc[i][j] = __builtin_amdgcn_mfma_f32_16x16x32_bf16(a[i], b[j], acc[i][j], 0, 0, 0);
    }
  }
  const int rbase = m0 + wr * 64 + fq * 4;
  const int c0 = n0 + wc * 64;
  if (EPI == EPI_SWIGLU) {
    u16* H = (u16*)(p.ws + OFF_HP);
    const int hc0 = c0 >> 1;
#pragma unroll
    for (int mi = 0; mi < 4; ++mi)
#pragma unroll
      for (int j = 0; j < 4; ++j) {
        int row = rbase + mi * 16 + j;
#pragma unroll
        for (int ni = 0; ni < 2; ++ni) {
          float g = acc[mi][ni][j], u = acc[mi][ni + 2][j];
          float h = g / (1.f + __expf(-g)) * u;
          H[(size_t)row * DFF + hc0 + ni * 16 + fr] = f2bf(h);
        }
      }
  } else if (EPI == EPI_RESID) {
    float* x = p.out + O_X;
    const float* mod = (const float*)(p.ws + OFF_MOD);
#pragma unroll
    for (int mi = 0; mi < 4; ++mi)
#pragma unroll
      for (int j = 0; j < 4; ++j) {
        int row = rbase + mi * 16 + j;
        const float* gp = mod + (l * 3 + cond_of(row)) * 9216 + gchunk * 1024;
#pragma unroll
        for (int ni = 0; ni < 4; ++ni) {
          int col = c0 + ni * 16 + fr;
          size_t idx = (size_t)row * D + col;
          x[idx] = x[idx] + coef * gp[col] * acc[mi][ni][j];
        }
      }
  } else {
    u16* proj = (u16*)(p.ws + OFF_HP);
    const bool isctx = m0 < NCTX;
    const float* rc = (const float*)(p.ws + OFF_ROPE);
    bool do_norm = false, do_rope = false;
    const float* ng = nullptr;
    float* o32 = nullptr; int ostr = 0;
    bool elementwise = false;
    if (EPI == EPI_MIX0) {
      if (c0 < 512) { do_norm = true; ng = p.in[I_L0 + L_X0]; do_rope = !isctx; }
      else if (c0 < 640) { do_norm = true; ng = p.in[I_L0 + L_X0] + 64; do_rope = !isctx; if (isctx) { o32 = p.out + O_K0 + (c0 - 512); ostr = 128; } }
      else if (c0 < 768) { if (isctx) { o32 = p.out + O_V0 + (c0 - 640); ostr = 128; } }
      else if (c0 >= 2304) elementwise = true;
    } else {
      if (c0 < 512) {}
      else if (c0 < 1024) { if (isctx) { o32 = p.out + O_KC1 + (c0 - 512); ostr = 512; } }
      else if (c0 < 1536) { if (isctx) { o32 = p.out + O_VC1 + (c0 - 1024); ostr = 512; } }
      else if (c0 < 2048) { do_rope = !isctx; }
      else if (c0 < 2176) { do_rope = !isctx; if (isctx) { o32 = p.out + O_KD1 + (c0 - 2048); ostr = 128; } }
      else { if (isctx) { o32 = p.out + O_VD1 + (c0 - 2176); ostr = 128; } }
    }
    if (elementwise) {
      float* gates = (float*)(p.ws + OFF_GATES);
      const float* gb = p.in[I_L0 + L_X1];
#pragma unroll
      for (int mi = 0; mi < 4; ++mi)
#pragma unroll
        for (int j = 0; j < 4; ++j) {
          int row = rbase + mi * 16 + j;
#pragma unroll
          for (int ni = 0; ni < 4; ++ni) {
            int col = c0 + ni * 16 + fr;
            float v = acc[mi][ni][j];
            if (col < 2336) gates[(size_t)row * 32 + (col - 2304)] = v + gb[col - 2304];
            else if (col < P0N) proj[(size_t)row * PSTR + col] = f2bf(v);
          }
        }
    } else {
#pragma unroll
      for (int mi = 0; mi < 4; ++mi)
#pragma unroll
        for (int j = 0; j < 4; ++j) {
          int row = rbase + mi * 16 + j;
          float v0 = acc[mi][0][j], v1 = acc[mi][1][j], v2 = acc[mi][2][j], v3 = acc[mi][3][j];
          if (do_norm) {
            float ss = v0 * v0 + v1 * v1 + v2 * v2 + v3 * v3;
            ss = grp16_sum(ss);
            float rstd = rsqrtf(ss * (1.f / 64.f) + EPS);
            v0 = v0 * rstd * ng[fr]; v1 = v1 * rstd * ng[16 + fr]; v2 = v2 * rstd * ng[32 + fr]; v3 = v3 * rstd * ng[48 + fr];
          }
          if (do_rope) {
            int t = (row - NCTX) & 1023;
            float ca = rc[t * 32 + fr], sa = rc[32768 + t * 32 + fr];
            float cb = rc[t * 32 + 16 + fr], sb = rc[32768 + t * 32 + 16 + fr];
            float a0 = v0 * ca - v2 * sa, a2 = v2 * ca + v0 * sa;
            float a1 = v1 * cb - v3 * sb, a3 = v3 * cb + v1 * sb;
            v0 = a0; v1 = a1; v2 = a2; v3 = a3;
          }
          u16* pr = proj + (size_t)row * PSTR + c0 + fr;
          pr[0] = f2bf(v0); pr[16] = f2bf(v1); pr[32] = f2bf(v2); pr[48] = f2bf(v3);
          if (o32) {
            float* o = o32 + (size_t)row * ostr + fr;
            o[0] = v0; o[16] = v1; o[32] = v2; o[48] = v3;
          }
        }
    }
  }
}

template <int EPI>
__device__ void gemm_phase(const Params& p, const u16* A, const u16* Bt, int K, int NT, int l, int gchunk, float coef, u16* smem) {
  const int ntiles = 80 * NT;
  for (int t = blockIdx.x; t < ntiles; t += gridDim.x) {
    int mt = t % 80, nt = t / 80;
    gemm_tile<EPI>(p, A, Bt, K, mt * 128, nt * 128, l, gchunk, coef, smem);
  }
}

__device__ __forceinline__ void load_tile_bf16(float* dst, const u16* src, long rstride, float scale, int tid) {
  int r = tid >> 2, part = tid & 3;
  const uint4* s = (const uint4*)(src + (long)r * rstride + part * 16);
  uint4 a = s[0], b = s[1];
  float4* d = (float4*)(dst + r * TS + part * 16);
  d[0] = make_float4(bflo(a.x) * scale, bfhi(a.x) * scale, bflo(a.y) * scale, bfhi(a.y) * scale);
  d[1] = make_float4(bflo(a.z) * scale, bfhi(a.z) * scale, bflo(a.w) * scale, bfhi(a.w) * scale);
  d[2] = make_float4(bflo(b.x) * scale, bfhi(b.x) * scale, bflo(b.y) * scale, bfhi(b.y) * scale);
  d[3] = make_float4(bflo(b.z) * scale, bfhi(b.z) * scale, bflo(b.w) * scale, bfhi(b.w) * scale);
}
__device__ __forceinline__ void load_tile_f32(float* dst, const float* src, long rstride, int tid) {
  int r = tid >> 2, part = tid & 3;
  const float4* s = (const float4*)(src + (long)r * rstride + part * 16);
  float4* d = (float4*)(dst + r * TS + part * 16);
  d[0] = s[0]; d[1] = s[1]; d[2] = s[2]; d[3] = s[3];
}
__device__ __forceinline__ void qk_micro(const float* Qs, const float* Ks, int ty, int tx, float s[4][4]) {
#pragma unroll
  for (int i = 0; i < 4; ++i)
#pragma unroll
    for (int j = 0; j < 4; ++j) s[i][j] = 0.f;
#pragma unroll 4
  for (int d4 = 0; d4 < 16; ++d4) {
    float4 q[4], k[4];
#pragma unroll
    for (int i = 0; i < 4; ++i) q[i] = *(const float4*)(Qs + (ty * 4 + i) * TS + d4 * 4);
#pragma unroll
    for (int j = 0; j < 4; ++j) k[j] = *(const float4*)(Ks + (tx + 16 * j) * TS + d4 * 4);
#pragma unroll
    for (int i = 0; i < 4; ++i)
#pragma unroll
      for (int j = 0; j < 4; ++j)
        s[i][j] += q[i].x * k[j].x + q[i].y * k[j].y + q[i].z * k[j].z + q[i].w * k[j].w;
  }
}
__device__ __forceinline__ void pv_micro(const float* Ps, const float* Vs, int ty, int tx, float o[4][4]) {
#pragma unroll 4
  for (int s4 = 0; s4 < 16; ++s4) {
    float4 pp[4], v[4];
#pragma unroll
    for (int i = 0; i < 4; ++i) pp[i] = *(const float4*)(Ps + (ty * 4 + i) * TS + s4 * 4);
#pragma unroll
    for (int q = 0; q < 4; ++q) v[q] = *(const float4*)(Vs + (s4 * 4 + q) * TS + tx * 4);
#pragma unroll
    for (int i = 0; i < 4; ++i) {
      o[i][0] += pp[i].x * v[0].x + pp[i].y * v[1].x + pp[i].z * v[2].x + pp[i].w * v[3].x;
      o[i][1] += pp[i].x * v[0].y + pp[i].y * v[1].y + pp[i].z * v[2].y + pp[i].w * v[3].y;
      o[i][2] += pp[i].x * v[0].z + pp[i].y * v[1].z + pp[i].z * v[2].z + pp[i].w * v[3].z;
      o[i][3] += pp[i].x * v[0].w + pp[i].y * v[1].w + pp[i].z * v[2].w + pp[i].w * v[3].w;
    }
  }
}

struct AttnDesc {
  int qrow0, qcol, ocol;
  const float* ck; const float* cv; int cstride; int nctx;
  int krow0, nloc, kcol, vcol;
  int mode;
  int a0;
  const float* rpb;
  float sink; int has_sink;
};

__device__ void attn_item(const Params& p, const AttnDesc& d, float* sm) {
  const int tid = get_tid(), ty = tid >> 4, tx = tid & 15;
  const u16* proj = (const u16*)(p.ws + OFF_HP);
  float* Qs = sm; float* Ks = sm + TILE_F; float* Vs = sm + 2 * TILE_F; float* Ps = sm + 3 * TILE_F;
  __syncthreads();
  load_tile_bf16(Qs, proj + (size_t)d.qrow0 * PSTR + d.qcol, PSTR, 0.125f, tid);
  float m_i[4], l_i[4], o[4][4];
#pragma unroll
  for (int i = 0; i < 4; ++i) {
    m_i[i] = d.has_sink ? d.sink : -1e30f;
    l_i[i] = d.has_sink ? 1.f : 0.f;
#pragma unroll
    for (int j = 0; j < 4; ++j) o[i][j] = 0.f;
  }
  const int ntiles = d.nctx + d.nloc;
  for (int tile = 0; tile < ntiles; ++tile) {
    __syncthreads();
    const int lt = tile - d.nctx;
    if (tile < d.nctx) {
      load_tile_f32(Ks, d.ck + (size_t)tile * 64 * d.cstride, d.cstride, tid);
      load_tile_f32(Vs, d.cv + (size_t)tile * 64 * d.cstride, d.cstride, tid);
    } else {
      const u16* base = proj + (size_t)(d.krow0 + lt * 64) * PSTR;
      load_tile_bf16(Ks, base + d.kcol, PSTR, 1.f, tid);
      load_tile_bf16(Vs, base + d.vcol, PSTR, 1.f, tid);
    }
    __syncthreads();
    float s[4][4];
    qk_micro(Qs, Ks, ty, tx, s);
    if (lt >= 0 && d.mode == 1) {
      const float* rp = d.rpb + (d.a0 + lt) * 31;
#pragma unroll
      for (int i = 0; i < 4; ++i) {
        int qc = ty * 4 + i;
        int ws = min(max(qc - 8, 0), 48);
#pragma unroll
        for (int j = 0; j < 4; ++j) {
          int kc = tx + 16 * j;
          bool ok = (kc >= ws) && (kc < ws + 16);
          int dx = min(max(kc - qc + 15, 0), 30);
          s[i][j] = ok ? s[i][j] + rp[dx] : -1e30f;
        }
      }
    } else if (lt >= 0 && d.mode == 2) {
      int off = d.a0 + lt * 64;
#pragma unroll
      for (int i = 0; i < 4; ++i)
#pragma unroll
        for (int j = 0; j < 4; ++j) {
          int dd = off + (tx + 16 * j) - (ty * 4 + i);
          bool ok = (dd <= 128) && (dd >= -128);
          s[i][j] = ok ? s[i][j] : -1e30f;
        }
    }
#pragma unroll
    for (int i = 0; i < 4; ++i) {
      float mx = fmaxf(fmaxf(s[i][0], s[i][1]), fmaxf(s[i][2], s[i][3]));
      mx = grp16_max(mx);
      float mn = fmaxf(m_i[i], mx);
      float alpha = expf(m_i[i] - mn);
      float rs = 0.f;
#pragma unroll
      for (int j = 0; j < 4; ++j) {
        float pj = expf(s[i][j] - mn);
        rs += pj;
        Ps[(ty * 4 + i) * TS + tx + 16 * j] = pj;
      }
      rs = grp16_sum(rs);
      l_i[i] = l_i[i] * alpha + rs;
      m_i[i] = mn;
#pragma unroll
      for (int j = 0; j < 4; ++j) o[i][j] *= alpha;
    }
    __syncthreads();
    pv_micro(Ps, Vs, ty, tx, o);
  }
  u16* ymix = (u16*)(p.ws + OFF_YMIX);
#pragma unroll
  for (int i = 0; i < 4; ++i) {
    float inv = 1.f / l_i[i];
    uint2 ov = make_uint2(pack2(o[i][0] * inv, o[i][1] * inv), pack2(o[i][2] * inv, o[i][3] * inv));
    *(uint2*)(ymix + (size_t)(d.qrow0 + ty * 4 + i) * D + d.ocol + tx * 4) = ov;
  }
}

__device__ __forceinline__ int st_slot(int isctx, int b, int dir, int head, int cc) {
  int ch = (b * 2 + dir) * 8 + head;
  return isctx ? (ch * 4 + cc) : (2048 + ch * 16 + cc);
}

__device__ void mlstm_state_item(const Params& p, int isctx, int b, int dir, int head, float* sm) {
  const int tid = get_tid(), ty = tid >> 4, tx = tid & 15, lane = tid & 63;
  const u16* proj = (const u16*)(p.ws + OFF_HP);
  const float* gates = (const float*)(p.ws + OFF_GATES);
  float* stC = (float*)(p.ws + OFF_STC);
  float* stn = (float*)(p.ws + OFF_STN);
  float* stm = (float*)(p.ws + OFF_STM);
  float* Ks = sm; float* Vs = sm + TILE_F;
  float* sws = sm + 4 * TILE_F;
  float* sn = sws + 64;
  float* ssc = sn + 64;
  const int nc = isctx ? 4 : 16, L = isctx ? 256 : 1024;
  const int seq0 = isctx ? b * 256 : NCTX + b * 1024;
  float c[4][4];
  float m;
  __syncthreads();
  if (isctx) {
#pragma unroll
    for (int i = 0; i < 4; ++i)
#pragma unroll
      for (int j = 0; j < 4; ++j) c[i][j] = 0.f;
    if (tid < 64) sn[tid] = 0.f;
    m = 0.f;
  } else {
    int ch = (b * 2 + dir) * 8 + head;
    const float* C0 = p.in[I_SC] + (size_t)ch * 4096;
#pragma unroll
    for (int i = 0; i < 4; ++i) {
      float4 v = *(const float4*)(C0 + (ty * 4 + i) * 64 + tx * 4);
      c[i][0] = v.x; c[i][1] = v.y; c[i][2] = v.z; c[i][3] = v.w;
    }
    if (tid < 64) sn[tid] = p.in[I_SN][ch * 64 + tid];
    m = p.in[I_SM][ch];
  }
  for (int cc = 0; cc < nc; ++cc) {
    __syncthreads();
    const int slot = st_slot(isctx, b, dir, head, cc);
#pragma unroll
    for (int i = 0; i < 4; ++i)
      *(float4*)(stC + (size_t)slot * 4096 + (ty * 4 + i) * 64 + tx * 4) = make_float4(c[i][0], c[i][1], c[i][2], c[i][3]);
    if (tid < 64) stn[slot * 64 + tid] = sn[tid];
    if (tid == 0) stm[slot] = m;
    const int tok0 = dir ? (L - 1 - cc * 64) : cc * 64;
    const long rs = dir ? -(long)PSTR : (long)PSTR;
    const u16* base = proj + (size_t)(seq0 + tok0) * PSTR;
    load_tile_bf16(Ks, base + 1280 + head * 64, rs, 0.125f, tid);
    load_tile_bf16(Vs, base + 1792 + head * 64, rs, 1.f, tid);
    if (tid < 64) {
      int tr = seq0 + (dir ? tok0 - lane : tok0 + lane);
      float li = gates[(size_t)tr * 32 + (dir * 2) * 8 + head];
      float fp = gates[(size_t)tr * 32 + (dir * 2 + 1) * 8 + head];
      float lf = logsigmoidf_(fp);
      float bb = wave_scan_add(lf, lane);
      float a = li - bb;
      float amax = wave_max(a);
      float blast = __shfl(bb, 63);
      float mnew = blast + fmaxf(m, amax);
      sws[lane] = expf(blast + a - mnew);
      if (lane == 0) { ssc[0] = expf(blast + m - mnew); ssc[1] = mnew; }
    }
    __syncthreads();
    const float wc = ssc[0];
    m = ssc[1];
#pragma unroll
    for (int i = 0; i < 4; ++i)
#pragma unroll
      for (int j = 0; j < 4; ++j) c[i][j] *= wc;
    float nacc = 0.f;
#pragma unroll 4
    for (int s = 0; s < 64; ++s) {
      float w = sws[s];
      float4 kk = *(const float4*)(Ks + s * TS + ty * 4);
      float4 vv = *(const float4*)(Vs + s * TS + tx * 4);
      float k0 = kk.x * w, k1 = kk.y * w, k2 = kk.z * w, k3 = kk.w * w;
      c[0][0] += k0 * vv.x; c[0][1] += k0 * vv.y; c[0][2] += k0 * vv.z; c[0][3] += k0 * vv.w;
      c[1][0] += k1 * vv.x; c[1][1] += k1 * vv.y; c[1][2] += k1 * vv.z; c[1][3] += k1 * vv.w;
      c[2][0] += k2 * vv.x; c[2][1] += k2 * vv.y; c[2][2] += k2 * vv.z; c[2][3] += k2 * vv.w;
      c[3][0] += k3 * vv.x; c[3][1] += k3 * vv.y; c[3][2] += k3 * vv.z; c[3][3] += k3 * vv.w;
      if (tid < 64) nacc += w * Ks[s * TS + tid];
    }
    if (tid < 64) sn[tid] = wc * sn[tid] + nacc;
  }
  __syncthreads();
  if (isctx) {
    int ch = (b * 2 + dir) * 8 + head;
    float* Co = p.out + O_C + (size_t)ch * 4096;
#pragma unroll
    for (int i = 0; i < 4; ++i)
      *(float4*)(Co + (ty * 4 + i) * 64 + tx * 4) = make_float4(c[i][0], c[i][1], c[i][2], c[i][3]);
    if (tid < 64) p.out[O_N + ch * 64 + tid] = sn[tid];
    if (tid == 0) p.out[O_M + ch] = m;
  }
}

__device__ void mlstm_out_item(const Params& p, int isctx, int b, int head, int c, float* sm) {
  const int tid = get_tid(), ty = tid >> 4, tx = tid & 15, lane = tid & 63;
  const u16* proj = (const u16*)(p.ws + OFF_HP);
  const float* gates = (const float*)(p.ws + OFF_GATES);
  const float* stC = (const float*)(p.ws + OFF_STC);
  const float* stn = (const float*)(p.ws + OFF_STN);
  const float* stm = (const float*)(p.ws + OFF_STM);
  float* Qs = sm; float* KCs = sm + TILE_F; float* Vs = sm + 2 * TILE_F; float* Ws = sm + 3 * TILE_F;
  float* sa = sm + 4 * TILE_F;
  float* sM = sa + 64;
  float* sb = sM + 64;
  float* sn = sb + 64;
  const int nc = isctx ? 4 : 16;
  const int mb = (isctx ? b * 256 : NCTX + b * 1024) + c * 64;
  float hacc[4][4];
  for (int dir = 0; dir < 2; ++dir) {
    const int cc = dir ? nc - 1 - c : c;
    const int slot = st_slot(isctx, b, dir, head, cc);
    const float m0 = stm[slot];
    __syncthreads();
    const long rs = dir ? -(long)PSTR : (long)PSTR;
    const u16* base = proj + (size_t)(mb + (dir ? 63 : 0)) * PSTR;
    load_tile_bf16(Qs, base + 768 + head * 64, rs, 1.f, tid);
    load_tile_bf16(KCs, base + 1280 + head * 64, rs, 0.125f, tid);
    load_tile_bf16(Vs, base + 1792 + head * 64, rs, 1.f, tid);
    if (tid < 64) {
      int tr = mb + (dir ? 63 - lane : lane);
      float li = gates[(size_t)tr * 32 + (dir * 2) * 8 + head];
      float fp = gates[(size_t)tr * 32 + (dir * 2 + 1) * 8 + head];
      float lf = logsigmoidf_(fp);
      float bb = wave_scan_add(lf, lane);
      float a = li - bb;
      float pm = wave_scan_max(a, lane);
      sa[lane] = a; sM[lane] = fmaxf(m0, pm); sb[lane] = bb;
      sn[lane] = stn[slot * 64 + lane];
    }
    __syncthreads();
    float s[4][4];
    qk_micro(Qs, KCs, ty, tx, s);
    float rsum[4];
#pragma unroll
    for (int i = 0; i < 4; ++i) {
      int t = ty * 4 + i;
      float Mt = sM[t];
      float r = 0.f;
#pragma unroll
      for (int j = 0; j < 4; ++j) {
        int sidx = tx + 16 * j;
        float w = (sidx <= t) ? expf(sa[sidx] - Mt) * s[i][j] : 0.f;
        Ws[t * TS + sidx] = w;
        r += w;
      }
      rsum[i] = grp16_sum(r);
    }
    __syncthreads();
    load_tile_f32(KCs, stC + (size_t)slot * 4096, 64, tid);
    __syncthreads();
    float num[4][4], qc[4][4];
#pragma unroll
    for (int i = 0; i < 4; ++i)
#pragma unroll
      for (int j = 0; j < 4; ++j) { num[i][j] = 0.f; qc[i][j] = 0.f; }
    pv_micro(Ws, Vs, ty, tx, num);
    pv_micro(Qs, KCs, ty, tx, qc);
    float hd[4][4];
#pragma unroll
    for (int i = 0; i < 4; ++i) {
      int t = ty * 4 + i;
      float4 q4 = *(const float4*)(Qs + t * TS + tx * 4);
      float4 n4 = *(const float4*)(sn + tx * 4);
      float qn = q4.x * n4.x + q4.y * n4.y + q4.z * n4.z + q4.w * n4.w;
      qn = grp16_sum(qn);
      float Mt = sM[t];
      float wi = expf(m0 - Mt);
      float den = rsum[i] + wi * qn;
      float mt = sb[t] + Mt;
      float dn = fmaxf(fabsf(den), expf(-mt));
      float inv = 1.f / dn;
#pragma unroll
      for (int j = 0; j < 4; ++j) hd[i][j] = (num[i][j] + wi * qc[i][j]) * inv;
    }
    if (dir == 0) {
#pragma unroll
      for (int i = 0; i < 4; ++i)
#pragma unroll
        for (int j = 0; j < 4; ++j) hacc[i][j] = hd[i][j];
    } else {
      __syncthreads();
#pragma unroll
      for (int i = 0; i < 4; ++i)
        *(float4*)(Ws + (63 - (ty * 4 + i)) * TS + tx * 4) = make_float4(hd[i][0], hd[i][1], hd[i][2], hd[i][3]);
      __syncthreads();
#pragma unroll
      for (int i = 0; i < 4; ++i) {
        float4 v = *(const float4*)(Ws + (ty * 4 + i) * TS + tx * 4);
        hacc[i][0] += v.x; hacc[i][1] += v.y; hacc[i][2] += v.z; hacc[i][3] += v.w;
      }
    }
  }
  const float* hg = p.in[I_L0 + L_X2] + head * 64 + tx * 4;
  u16* ymix = (u16*)(p.ws + OFF_YMIX);
#pragma unroll
  for (int i = 0; i < 4; ++i) {
    float ss = hacc[i][0] * hacc[i][0] + hacc[i][1] * hacc[i][1] + hacc[i][2] * hacc[i][2] + hacc[i][3] * hacc[i][3];
    ss = grp16_sum(ss);
    float rstd = rsqrtf(ss * (1.f / 64.f) + EPS);
    int tr = mb + ty * 4 + i;
    uint2 ob = *(const uint2*)(proj + (size_t)tr * PSTR + 2336 + head * 64 + tx * 4);
    float y0 = sigmoidf_(bflo(ob.x)) * (hacc[i][0] * rstd * hg[0]);
    float y1 = sigmoidf_(bfhi(ob.x)) * (hacc[i][1] * rstd * hg[1]);
    float y2 = sigmoidf_(bflo(ob.y)) * (hacc[i][2] * rstd * hg[2]);
    float y3 = sigmoidf_(bfhi(ob.y)) * (hacc[i][3] * rstd * hg[3]);
    *(uint2*)(ymix + (size_t)tr * D + 512 + head * 64 + tx * 4) = make_uint2(pack2(y0, y1), pack2(y2, y3));
  }
}

__device__ __forceinline__ int next_item(int* ctr, int* s_item) {
  __syncthreads();
  if (get_tid() == 0) *s_item = atomicAdd(ctr, 1);
  __syncthreads();
  return *s_item;
}

__device__ void mix0_phase_a(const Params& p, float* sm, int* s_item) {
  int* ctr = (int*)(p.ws + OFF_CTR) + 0;
  for (;;) {
    int it = next_item(ctr, s_item);
    if (it >= 1824) break;
    if (it < 32) {
      int b = it >> 4, dir = (it >> 3) & 1, head = it & 7;
      mlstm_state_item(p, 0, b, dir, head, sm);
    } else if (it < 288) {
      int v = it - 32; int b = v >> 7, h = (v >> 4) & 7, qb = v & 15;
      AttnDesc d;
      d.qrow0 = NCTX + b * 1024 + qb * 64; d.qcol = h * 64; d.ocol = h * 64;
      d.ck = p.in[I_C0K] + (size_t)b * 256 * 128 + (h >> 2) * 64; d.cv = p.in[I_C0V] + (size_t)b * 256 * 128 + (h >> 2) * 64;
      d.cstride = 128; d.nctx = 4;
      d.krow0 = NCTX + b * 1024; d.nloc = 16; d.kcol = 512 + (h >> 2) * 64; d.vcol = 640 + (h >> 2) * 64;
      d.mode = 0; d.a0 = 0; d.rpb = nullptr; d.sink = 0.f; d.has_sink = 0;
      attn_item(p, d, sm);
    } else if (it < 800) {
      int v = it - 288; int b = v >> 4, dir = (v >> 3) & 1, head = v & 7;
      mlstm_state_item(p, 1, b, dir, head, sm);
    } else {
      int v = it - 800; int b = v >> 5, h = (v >> 2) & 7, qb = v & 3;
      AttnDesc d;
      d.qrow0 = b * 256 + qb * 64; d.qcol = h * 64; d.ocol = h * 64;
      d.ck = nullptr; d.cv = nullptr; d.cstride = 0; d.nctx = 0;
      d.krow0 = b * 256; d.nloc = 4; d.kcol = 512 + (h >> 2) * 64; d.vcol = 640 + (h >> 2) * 64;
      d.mode = 0; d.a0 = 0; d.rpb = nullptr; d.sink = 0.f; d.has_sink = 0;
      attn_item(p, d, sm);
    }
  }
}

__device__ void mix0_phase_b(const Params& p, float* sm, int* s_item) {
  int* ctr = (int*)(p.ws + OFF_CTR) + 1;
  for (;;) {
    int it = next_item(ctr, s_item);
    if (it >= 1280) break;
    if (it < 256) {
      int b = it >> 7, head = (it >> 4) & 7, c = it & 15;
      mlstm_out_item(p, 0, b, head, c, sm);
    } else {
      int v = it - 256; int b = v >> 5, head = (v >> 2) & 7, c = v & 3;
      mlstm_out_item(p, 1, b, head, c, sm);
    }
  }
}

__device__ void mix1_phase(const Params& p, float* sm, int* s_item) {
  int* ctr = (int*)(p.ws + OFF_CTR) + 2;
  const float* sink = p.in[I_L1 + L_X1];
  for (;;) {
    int it = next_item(ctr, s_item);
    if (it >= 2560) break;
    AttnDesc d;
    d.mode = 0; d.a0 = 0; d.rpb = nullptr; d.sink = 0.f; d.has_sink = 0;
    if (it < 256) {
      int b = it >> 7, h = (it >> 4) & 7, r = it & 15;
      int r0 = min(max(r - 4, 0), 8);
      d.qrow0 = NCTX + b * 1024 + r * 64; d.qcol = h * 64; d.ocol = h * 64;
      d.ck = p.in[I_NAK] + (size_t)b * 256 * 512 + h * 64; d.cv = p.in[I_NAV] + (size_t)b * 256 * 512 + h * 64;
      d.cstride = 512; d.nctx = 4;
      d.krow0 = NCTX + b * 1024 + r0 * 64; d.nloc = 8; d.kcol = 512 + h * 64; d.vcol = 1024 + h * 64;
      d.mode = 1; d.a0 = r0 - r + 7; d.rpb = p.in[I_L1 + L_X0] + h * 15 * 31;
    } else if (it < 512) {
      int v = it - 256; int b = v >> 7, h = (v >> 4) & 7, qb = v & 15;
      int t0 = qb * 64;
      int s0 = max(t0 - 128, 0);
      int s1 = min(t0 + 192, 1024);
      d.qrow0 = NCTX + b * 1024 + t0; d.qcol = 1536 + h * 64; d.ocol = 512 + h * 64;
      d.ck = p.in[I_SWK] + (size_t)b * 256 * 128 + (h >> 2) * 64; d.cv = p.in[I_SWV] + (size_t)b * 256 * 128 + (h >> 2) * 64;
      d.cstride = 128; d.nctx = 4;
      d.krow0 = NCTX + b * 1024 + s0; d.nloc = (s1 - s0) >> 6; d.kcol = 2048 + (h >> 2) * 64; d.vcol = 2176 + (h >> 2) * 64;
      d.mode = 2; d.a0 = s0 - t0;
      d.sink = sink[h]; d.has_sink = 1;
    } else if (it < 1536) {
      int v = it - 512; int b = v >> 5, h = (v >> 2) & 7, qb = v & 3;
      d.qrow0 = b * 256 + qb * 64; d.qcol = h * 64; d.ocol = h * 64;
      d.ck = nullptr; d.cv = nullptr; d.cstride = 0; d.nctx = 0;
      d.krow0 = b * 256; d.nloc = 4; d.kcol = 512 + h * 64; d.vcol = 1024 + h * 64;
    } else {
      int v = it - 1536; int b = v >> 5, h = (v >> 2) & 7, qb = v & 3;
      d.qrow0 = b * 256 + qb * 64; d.qcol = 1536 + h * 64; d.ocol = 512 + h * 64;
      d.ck = nullptr; d.cv = nullptr; d.cstride = 0; d.nctx = 0;
      d.krow0 = b * 256; d.nloc = 4; d.kcol = 2048 + (h >> 2) * 64; d.vcol = 2176 + (h >> 2) * 64;
      d.sink = sink[h]; d.has_sink = 1;
    }
    attn_item(p, d, sm);
  }
}

constexpr int NPHASE = 23;

__device__ void run_phase(const Params& p, int ph, char* smem, int* s_item) {
  float* smf = (float*)smem;
  u16* smh = (u16*)smem;
  const u16* xn = (const u16*)(p.ws + OFF_XN);
  const u16* hp = (const u16*)(p.ws + OFF_HP);
  const u16* ymix = (const u16*)(p.ws + OFF_YMIX);
  if (ph == 0) { prep_phase(p, smf); return; }
  if (ph == 22) { norm_phase(p, 0, 3); return; }
  int l = (ph - 1) / 11, q = (ph - 1) % 11;
  if (l == 1 && q >= 6) q += 1;
  switch (q) {
    case 0: norm_phase(p, l, 0); break;
    case 1: gemm_phase<EPI_SWIGLU>(p, xn, (const u16*)(p.ws + OFF_WIN + (l * 2 + 0) * SZ_WIN), 1024, 44, l, 0, 0.f, smh); break;
    case 2: gemm_phase<EPI_RESID>(p, hp, (const u16*)(p.ws + OFF_WOUT + (l * 2 + 0) * SZ_WOUT), DFF, 8, l, 2, 0.5f, smh); break;
    case 3: norm_phase(p, l, 1); break;
    case 4:
      if (l == 0) gemm_phase<EPI_MIX0>(p, xn, (const u16*)(p.ws + OFF_WMI0), 1024, 23, l, 0, 0.f, smh);
      else gemm_phase<EPI_MIX1>(p, xn, (const u16*)(p.ws + OFF_WMI1), 1024, 18, l, 0, 0.f, smh);
      break;
    case 5:
      if (l == 0) mix0_phase_a(p, smf, s_item); else mix1_phase(p, smf, s_item);
      break;
    case 6: mix0_phase_b(p, smf, s_item); break;
    case 7: gemm_phase<EPI_RESID>(p, ymix, (const u16*)(p.ws + OFF_WMO + (size_t)l * D * D * 2), 1024, 8, l, 5, 1.f, smh); break;
    case 8: norm_phase(p, l, 2); break;
    case 9: gemm_phase<EPI_SWIGLU>(p, xn, (const u16*)(p.ws + OFF_WIN + (l * 2 + 1) * SZ_WIN), 1024, 44, l, 0, 0.f, smh); break;
    case 10: gemm_phase<EPI_RESID>(p, hp, (const u16*)(p.ws + OFF_WOUT + (l * 2 + 1) * SZ_WOUT), DFF, 8, l, 8, 0.5f, smh); break;
  }
}

__global__ void __launch_bounds__(256, 2) mega(Params p, int ph0, int ph1) {
  __shared__ __attribute__((aligned(16))) char smem[SMEM_BYTES];
  __shared__ int s_item;
  cg::grid_group grid = cg::this_grid();
  for (int ph = ph0; ph < ph1; ++ph) {
    if (ph > ph0) grid.sync();
    run_phase(p, ph, smem, &s_item);
  }
}

extern "C" void kernel_launch(void* const* d_in, const int* in_sizes, int n_in, void* d_out, int out_size, void* d_ws,
                              size_t ws_size, hipStream_t stream) {
  static int grid_blocks = 0;
  if (!grid_blocks) {
    int dev = 0, cus = 0, per_cu = 0;
    hipGetDevice(&dev);
    hipDeviceGetAttribute(&cus, hipDeviceAttributeMultiprocessorCount, dev);
    hipOccupancyMaxActiveBlocksPerMultiprocessor(&per_cu, mega, 256, 0);
    if (per_cu > 2) per_cu = 2;
    if (per_cu < 1) per_cu = 1;
    grid_blocks = cus * per_cu;
  }
  if (ws_size < WS_TOTAL) fprintf(stderr, "workspace too small: %zu < %zu\n", ws_size, (size_t)WS_TOTAL);
  Params p{};
  for (int i = 0; i < 37; ++i) p.in[i] = (const float*)d_in[i];
  p.out = (float*)d_out;
  p.ws = (char*)d_ws;
#if SINGLE_LAUNCH
  int ph0 = 0, ph1 = NPHASE;
  void* args[] = {&p, &ph0, &ph1};
  hipError_t e = hipLaunchCooperativeKernel((void*)mega, dim3(grid_blocks), dim3(256), args, 0, stream);
  if (e != hipSuccess) fprintf(stderr, "cooperative launch failed: %s (grid %d)\n", hipGetErrorString(e), grid_blocks);
#else
  for (int ph = 0; ph < NPHASE; ++ph) mega<<<grid_blocks, 256, 0, stream>>>(p, ph, ph + 1);
#endif
}
```

```cpp
#include <hip/hip_runtime.h>
#include <hip/hip_cooperative_groups.h>
#include <cstdio>
namespace cg = cooperative_groups;

#ifndef SINGLE_LAUNCH
#define SINGLE_LAUNCH 1
#endif

typedef unsigned short u16;
typedef __attribute__((ext_vector_type(8))) short bf16x8;
typedef __attribute__((ext_vector_type(4))) float f32x4;
typedef __attribute__((ext_vector_type(4))) unsigned u32x4;

constexpr int D = 1024, NCTX = 8192, MTOK = 10240;
constexpr int DFF = 2816, NFF = 5632;
constexpr int P0N = 2848, P0P = 2944, P1N = 2304;
constexpr int PSTR = 2944;
constexpr float EPS = 1e-6f;

enum { I_XP = 0, I_XS, I_C0K, I_C0V, I_SC, I_SN, I_SM, I_NAK, I_NAV, I_SWK, I_SWV, I_C, I_CCTX, I_NF,
       I_L0 = 14, I_L1 = 26 };
enum { L_ADAW = 0, L_ADAB, L_NORM, L_F1I, L_F1O, L_F2I, L_F2O, L_MI, L_MO, L_X0, L_X1, L_X2 };

constexpr size_t O_X = 0, O_K0 = 10485760, O_V0 = 11534336, O_C = 12582912, O_N = 14680064, O_M = 14712832,
                 O_KC1 = 14713344, O_VC1 = 18907648, O_KD1 = 23101952, O_VD1 = 24150528;

constexpr size_t SZ_WIN = (size_t)NFF * D * 2;
constexpr size_t SZ_WOUT = (size_t)D * DFF * 2;
constexpr size_t OFF_WIN = 0;
constexpr size_t OFF_WOUT = OFF_WIN + 4 * SZ_WIN;
constexpr size_t OFF_WMI0 = OFF_WOUT + 4 * SZ_WOUT;
constexpr size_t OFF_WMI1 = OFF_WMI0 + (size_t)P0P * D * 2;
constexpr size_t OFF_WMO = OFF_WMI1 + (size_t)P1N * D * 2;
constexpr size_t OFF_MOD = OFF_WMO + 2 * (size_t)D * D * 2;
constexpr size_t OFF_ROPE = OFF_MOD + 2 * 3 * 9216 * 4;
constexpr size_t OFF_CTR = OFF_ROPE + 2 * 1024 * 32 * 4;
constexpr size_t OFF_BAR = OFF_CTR + 256;
constexpr size_t OFF_XN = OFF_BAR + 16384 - 256;
constexpr size_t OFF_YMIX = OFF_XN + (size_t)MTOK * D * 2;
constexpr size_t OFF_HP = OFF_YMIX + (size_t)MTOK * D * 2;
constexpr size_t OFF_GATES = OFF_HP + (size_t)MTOK * PSTR * 2;
constexpr size_t OFF_STC = OFF_GATES + (size_t)MTOK * 32 * 4;
constexpr size_t OFF_STN = OFF_STC + (size_t)2560 * 4096 * 4;
constexpr size_t OFF_STM = OFF_STN + (size_t)2560 * 64 * 4;
constexpr size_t WS_TOTAL = OFF_STM + 2560 * 4;

constexpr int TS = 68;
constexpr int TILE_F = 64 * TS;
constexpr int SMEM_BYTES = 4 * TILE_F * 4 + 2048;

struct Params {
  const float* in[37];
  float* out;
  char* ws;
};

__device__ __forceinline__ int get_tid() { int t = threadIdx.x; asm volatile("" : "+v"(t)); return t; }
__device__ __forceinline__ u16 f2bf(float f) {
  unsigned u = __float_as_uint(f);
  u += 0x7fffu + ((u >> 16) & 1u);
  return (u16)(u >> 16);
}
__device__ __forceinline__ unsigned pack2(float a, float b) { return (unsigned)f2bf(a) | ((unsigned)f2bf(b) << 16); }
__device__ __forceinline__ float bflo(unsigned x) { return __uint_as_float(x << 16); }
__device__ __forceinline__ float bfhi(unsigned x) { return __uint_as_float(x & 0xffff0000u); }
__device__ __forceinline__ float grp16_sum(float v) {
  v += __shfl_xor(v, 1); v += __shfl_xor(v, 2); v += __shfl_xor(v, 4); v += __shfl_xor(v, 8); return v;
}
__device__ __forceinline__ float grp16_max(float v) {
  v = fmaxf(v, __shfl_xor(v, 1)); v = fmaxf(v, __shfl_xor(v, 2)); v = fmaxf(v, __shfl_xor(v, 4)); v = fmaxf(v, __shfl_xor(v, 8)); return v;
}
__device__ __forceinline__ float wave_sum(float v) {
  for (int o = 32; o; o >>= 1) v += __shfl_xor(v, o);
  return v;
}
__device__ __forceinline__ float wave_max(float v) {
  for (int o = 32; o; o >>= 1) v = fmaxf(v, __shfl_xor(v, o));
  return v;
}
__device__ __forceinline__ float wave_scan_add(float v, int lane) {
  for (int o = 1; o < 64; o <<= 1) { float t = __shfl_up(v, o); if (lane >= o) v += t; }
  return v;
}
__device__ __forceinline__ float wave_scan_max(float v, int lane) {
  for (int o = 1; o < 64; o <<= 1) { float t = __shfl_up(v, o); if (lane >= o) v = fmaxf(v, t); }
  return v;
}
__device__ __forceinline__ int cond_of(int row) { return row < NCTX ? 0 : 1 + ((row - NCTX) >> 10); }
__device__ __forceinline__ float sigmoidf_(float x) { return 1.f / (1.f + expf(-x)); }
__device__ __forceinline__ float logsigmoidf_(float x) { return fminf(x, 0.f) - log1pf(expf(-fabsf(x))); }

__device__ void conv_tile(const float* __restrict__ W, int K, int N, u16* __restrict__ Wt, int perm, int kt, int nt, float* T) {
  const int tid = get_tid();
  {
    int r = tid >> 4, c4 = tid & 15;
    int c = c4 * 4;
    int src;
    if (perm) src = (c < 32) ? (nt * 32 + c) : (DFF + nt * 32 + (c - 32));
    else src = nt * 64 + c;
    bool ok = src < N;
#pragma unroll
    for (int ps = 0; ps < 4; ++ps) {
      int k = r + ps * 16;
      float4 v = make_float4(0.f, 0.f, 0.f, 0.f);
      if (ok) v = *(const float4*)(W + (size_t)(kt * 64 + k) * N + src);
      float* t = T + k * 65 + c;
      t[0] = v.x; t[1] = v.y; t[2] = v.z; t[3] = v.w;
    }
  }
  __syncthreads();
  {
    int n = tid >> 2, kp = tid & 3;
    unsigned o[8];
#pragma unroll
    for (int i = 0; i < 8; ++i) {
      float a = T[(kp * 16 + 2 * i) * 65 + n], b = T[(kp * 16 + 2 * i + 1) * 65 + n];
      o[i] = pack2(a, b);
    }
    uint4* dst = (uint4*)(Wt + (size_t)(nt * 64 + n) * K + kt * 64 + kp * 16);
    dst[0] = make_uint4(o[0], o[1], o[2], o[3]);
    dst[1] = make_uint4(o[4], o[5], o[6], o[7]);
  }
  __syncthreads();
}

__device__ void adaln_unit(const Params& p, int u, float* sm) {
  const int tid = get_tid();
  int l = u / 144, cg_ = u % 144;
  const float* W = p.in[(l ? I_L1 : I_L0) + L_ADAW];
  const float* B = p.in[(l ? I_L1 : I_L0) + L_ADAB];
  float* sc = sm;
  float* red = sm + 3072;
  for (int i = tid; i < 3072; i += 256) {
    int cnd = i >> 10, k = i & 1023;
    float v = (cnd == 0) ? p.in[I_CCTX][k] : p.in[I_C][(cnd - 1) * 1024 + k];
    sc[i] = v / (1.f + expf(-v));
  }
  __syncthreads();
  int kp = tid >> 4, c4 = tid & 15;
  float acc[3][4];
#pragma unroll
  for (int a = 0; a < 3; ++a)
#pragma unroll
    for (int e = 0; e < 4; ++e) acc[a][e] = 0.f;
  for (int kk = 0; kk < 64; ++kk) {
    int k = kp * 64 + kk;
    float4 w = *(const float4*)(W + (size_t)k * 9216 + cg_ * 64 + c4 * 4);
#pragma unroll
    for (int a = 0; a < 3; ++a) {
      float s = sc[a * 1024 + k];
      acc[a][0] += s * w.x; acc[a][1] += s * w.y; acc[a][2] += s * w.z; acc[a][3] += s * w.w;
    }
  }
#pragma unroll
  for (int a = 0; a < 3; ++a)
#pragma unroll
    for (int e = 0; e < 4; ++e) red[(kp * 3 + a) * 64 + c4 * 4 + e] = acc[a][e];
  __syncthreads();
  if (tid < 192) {
    int a = tid >> 6, col = tid & 63;
    float s = 0.f;
    for (int q = 0; q < 16; ++q) s += red[(q * 3 + a) * 64 + col];
    s += B[cg_ * 64 + col];
    float* mod = (float*)(p.ws + OFF_MOD);
    mod[(l * 3 + a) * 9216 + cg_ * 64 + col] = s;
  }
  __syncthreads();
}

__device__ void prep_phase(const Params& p, float* sm) {
  const int tid = get_tid();
  constexpr int U_CONV = 10272, U_ADA = 288, U_ROPE = 128, U_COPY = 640;
  constexpr int U_TOT = U_CONV + U_ADA + U_ROPE + U_COPY;
  for (int u = blockIdx.x; u < U_TOT; u += gridDim.x) {
    if (u < U_CONV) {
      const float* W; u16* Wt; int K, N, perm, t, ntn;
      if (u < 5632) {
        int mi = u / 1408; t = u % 1408;
        int l = mi >> 1, f = mi & 1;
        W = p.in[(l ? I_L1 : I_L0) + (f ? L_F2I : L_F1I)];
        Wt = (u16*)(p.ws + OFF_WIN + mi * SZ_WIN);
        K = 1024; N = NFF; perm = 1; ntn = 88;
      } else if (u < 8448) {
        int v = u - 5632; int mi = v / 704; t = v % 704;
        int l = mi >> 1, f = mi & 1;
        W = p.in[(l ? I_L1 : I_L0) + (f ? L_F2O : L_F1O)];
        Wt = (u16*)(p.ws + OFF_WOUT + mi * SZ_WOUT);
        K = DFF; N = 1024; perm = 0; ntn = 16;
      } else if (u < 9184) {
        t = u - 8448; W = p.in[I_L0 + L_MI]; Wt = (u16*)(p.ws + OFF_WMI0); K = 1024; N = P0N; perm = 0; ntn = 46;
      } else if (u < 9760) {
        t = u - 9184; W = p.in[I_L1 + L_MI]; Wt = (u16*)(p.ws + OFF_WMI1); K = 1024; N = P1N; perm = 0; ntn = 36;
      } else {
        int v = u - 9760; int l = v / 256; t = v % 256;
        W = p.in[(l ? I_L1 : I_L0) + L_MO]; Wt = (u16*)(p.ws + OFF_WMO + (size_t)l * D * D * 2); K = 1024; N = 1024; perm = 0; ntn = 16;
      }
      int nt = t % ntn, kt = t / ntn;
      conv_tile(W, K, N, Wt, perm, kt, nt, sm);
    } else if (u < U_CONV + U_ADA) {
      adaln_unit(p, u - U_CONV, sm);
    } else if (u < U_CONV + U_ADA + U_ROPE) {
      int e = (u - U_CONV - U_ADA) * 256 + tid;
      int t = e >> 5, i = e & 31;
      float pos = (i < 16) ? (float)(t >> 6) : (float)(t & 63);
      float fr = powf(10000.f, -(float)(i & 15) / 16.f);
      float ang = pos * fr;
      float* rc = (float*)(p.ws + OFF_ROPE);
      rc[e] = cosf(ang);
      rc[32768 + e] = sinf(ang);
    } else {
      int v = u - U_CONV - U_ADA - U_ROPE;
      float4* dst = (float4*)(p.out + O_X);
#pragma unroll 4
      for (int i = 0; i < 16; ++i) {
        size_t idx = (size_t)v * 4096 + i * 256 + tid;
        float4 val = (idx < (size_t)NCTX * 256) ? ((const float4*)p.in[I_XP])[idx] : ((const float4*)p.in[I_XS])[idx - (size_t)NCTX * 256];
        dst[idx] = val;
      }
    }
  }
}

__device__ void norm_phase(const Params& p, int l, int which) {
  const int tid = get_tid(), lane = tid & 63, w = tid >> 6;
  float* x = p.out + O_X;
  const float* mod = (const float*)(p.ws + OFF_MOD);
  u16* xn = (u16*)(p.ws + OFF_XN);
  for (int row = blockIdx.x * 4 + w; row < MTOK; row += gridDim.x * 4) {
    float4* xr = (float4*)(x + (size_t)row * D);
    float4 v[4];
    float ss = 0.f;
#pragma unroll
    for (int i = 0; i < 4; ++i) {
      v[i] = xr[lane + i * 64];
      ss += v[i].x * v[i].x + v[i].y * v[i].y + v[i].z * v[i].z + v[i].w * v[i].w;
    }
    ss = wave_sum(ss);
    float rstd = rsqrtf(ss * (1.f / 1024.f) + EPS);
    if (which == 3) {
      const float4* g = (const float4*)p.in[I_NF];
#pragma unroll
      for (int i = 0; i < 4; ++i) {
        float4 gg = g[lane + i * 64];
        float4 o = make_float4(v[i].x * rstd * gg.x, v[i].y * rstd * gg.y, v[i].z * rstd * gg.z, v[i].w * rstd * gg.w);
        xr[lane + i * 64] = o;
      }
    } else {
      const float4* g = (const float4*)(p.in[(l ? I_L1 : I_L0) + L_NORM] + which * 1024);
      const float* mb = mod + (l * 3 + cond_of(row)) * 9216;
      const float4* sh = (const float4*)(mb + (3 * which) * 1024);
      const float4* sc = (const float4*)(mb + (3 * which + 1) * 1024);
#pragma unroll
      for (int i = 0; i < 4; ++i) {
        int q = lane + i * 64;
        float4 gg = g[q], s1 = sh[q], s2 = sc[q];
        float a = (v[i].x * rstd * gg.x) * (1.f + s2.x) + s1.x;
        float b = (v[i].y * rstd * gg.y) * (1.f + s2.y) + s1.y;
        float c = (v[i].z * rstd * gg.z) * (1.f + s2.z) + s1.z;
        float d = (v[i].w * rstd * gg.w) * (1.f + s2.w) + s1.w;
        uint2 o = make_uint2(pack2(a, b), pack2(c, d));
        *(uint2*)(xn + (size_t)row * D + q * 4) = o;
      }
    }
  }
}

enum { EPI_SWIGLU = 0, EPI_RESID = 1, EPI_MIX0 = 2, EPI_MIX1 = 3 };
constexpr int LS = 72;

template <int EPI>
__device__ __forceinline__ void gemm_tile(const Params& p, const u16* __restrict__ A, const u16* __restrict__ Bt, int K,
                                          int m0, int n0, int l, int gchunk, float coef, u16* smem) {
  const int tid = get_tid(), lane = tid & 63, wid = tid >> 6;
  const int wr = wid >> 1, wc = wid & 1, fr = lane & 15, fq = lane >> 4;
  u16* As = smem;
  u16* Bs = smem + 128 * LS;
  f32x4 acc[4][4];
#pragma unroll
  for (int i = 0; i < 4; ++i)
#pragma unroll
    for (int j = 0; j < 4; ++j) acc[i][j] = (f32x4){0.f, 0.f, 0.f, 0.f};
  u32x4 ra[4], rb[4];
  const int lrow = tid >> 3, lkc = tid & 7;
  const u16* Ag = A + (size_t)(m0 + lrow) * K + lkc * 8;
  const u16* Bg = Bt + (size_t)(n0 + lrow) * K + lkc * 8;
  const int nk = K >> 6;
#pragma unroll
  for (int i = 0; i < 4; ++i) {
    ra[i] = *(const u32x4*)(Ag + (size_t)(i * 32) * K);
    rb[i] = *(const u32x4*)(Bg + (size_t)(i * 32) * K);
  }
  for (int kt = 0; kt < nk; ++kt) {
    __syncthreads();
#pragma unroll
    for (int i = 0; i < 4; ++i) {
      *(u32x4*)(As + (lrow + i * 32) * LS + lkc * 8) = ra[i];
      *(u32x4*)(Bs + (lrow + i * 32) * LS + lkc * 8) = rb[i];
    }
    __syncthreads();
    if (kt + 1 < nk) {
#pragma unroll
      for (int i = 0; i < 4; ++i) {
        ra[i] = *(const u32x4*)(Ag + (size_t)(i * 32) * K + (kt + 1) * 64);
        rb[i] = *(const u32x4*)(Bg + (size_t)(i * 32) * K + (kt + 1) * 64);
      }
    }
#pragma unroll
    for (int ks = 0; ks < 2; ++ks) {
      bf16x8 a[4], b[4];
#pragma unroll
      for (int i = 0; i < 4; ++i) {
        a[i] = *(const bf16x8*)(As + (wr * 64 + i * 16 + fr) * LS + ks * 32 + fq * 8);
        b[i] = *(const bf16x8*)(Bs + (wc * 64 + i * 16 + fr) * LS + ks * 32 + fq * 8);
      }
#pragma unroll
      for (int i = 0; i < 4; ++i)
#pragma unroll
        for (int j = 0; j < 4; ++j) acc[i][j] = __builtin_amdgcn_mfma_f32_16x16x32_bf16(a[i], b[j], acc[i][j], 0, 0, 0);
    }
  }
  const int rbase = m0 + wr * 64 + fq * 4;
  const int c0 = n0 + wc * 64;
  if (EPI == EPI_SWIGLU) {
    u16* H = (u16*)(p.ws + OFF_HP);
    const int hc0 = c0 >> 1;
#pragma unroll
    for (int mi = 0; mi < 4; ++mi)
#pragma unroll
      for (int j = 0; j < 4; ++j) {
        int row = rbase + mi * 16 + j;
#pragma unroll
        for (int ni = 0; ni < 2; ++ni) {
          float g = acc[mi][ni][j], u = acc[mi][ni + 2][j];
          float h = g / (1.f + __expf(-g)) * u;
          H[(size_t)row * DFF + hc0 + ni * 16 + fr] = f2bf(h);
        }
      }
  } else if (EPI == EPI_RESID) {
    float* x = p.out + O_X;
    const float* mod = (const float*)(p.ws + OFF_MOD);
#pragma unroll
    for (int mi = 0; mi < 4; ++mi)
#pragma unroll
      for (int j = 0; j < 4; ++j) {
        int row = rbase + mi * 16 + j;
        const float* gp = mod + (l * 3 + cond_of(row)) * 9216 + gchunk * 1024;
#pragma unroll
        for (int ni = 0; ni < 4; ++ni) {
          int col = c0 + ni * 16 + fr;
          size_t idx = (size_t)row * D + col;
          x[idx] = x[idx] + coef * gp[col] * acc[mi][ni][j];
        }
      }
  } else {
    u16* proj = (u16*)(p.ws + OFF_HP);
    const bool isctx = m0 < NCTX;
    const float* rc = (const float*)(p.ws + OFF_ROPE);
    bool do_norm = false, do_rope = false;
    const float* ng = nullptr;
    float* o32 = nullptr; int ostr = 0;
    bool elementwise = false;
    if (EPI == EPI_MIX0) {
      if (c0 < 512) { do_norm = true; ng = p.in[I_L0 + L_X0]; do_rope = !isctx; }
      else if (c0 < 640) { do_norm = true; ng = p.in[I_L0 + L_X0] + 64; do_rope = !isctx; if (isctx) { o32 = p.out + O_K0 + (c0 - 512); ostr = 128; } }
      else if (c0 < 768) { if (isctx) { o32 = p.out + O_V0 + (c0 - 640); ostr = 128; } }
      else if (c0 >= 2304) elementwise = true;
    } else {
      if (c0 < 512) {}
      else if (c0 < 1024) { if (isctx) { o32 = p.out + O_KC1 + (c0 - 512); ostr = 512; } }
      else if (c0 < 1536) { if (isctx) { o32 = p.out + O_VC1 + (c0 - 1024); ostr = 512; } }
      else if (c0 < 2048) { do_rope = !isctx; }
      else if (c0 < 2176) { do_rope = !isctx; if (isctx) { o32 = p.out + O_KD1 + (c0 - 2048); ostr = 128; } }
      else { if (isctx) { o32 = p.out + O_VD1 + (c0 - 2176); ostr = 128; } }
    }
    if (elementwise) {
      float* gates = (float*)(p.ws + OFF_GATES);
      const float* gb = p.in[I_L0 + L_X1];
#pragma unroll
      for (int mi = 0; mi < 4; ++mi)
#pragma unroll
        for (int j = 0; j < 4; ++j) {
          int row = rbase + mi * 16 + j;
#pragma unroll
          for (int ni = 0; ni < 4; ++ni) {
            int col = c0 + ni * 16 + fr;
            float v = acc[mi][ni][j];
            if (col < 2336) gates[(size_t)row * 32 + (col - 2304)] = v + gb[col - 2304];
            else if (col < P0N) proj[(size_t)row * PSTR + col] = f2bf(v);
          }
        }
    } else {
#pragma unroll
      for (int mi = 0; mi < 4; ++mi)
#pragma unroll
        for (int j = 0; j < 4; ++j) {
          int row = rbase + mi * 16 + j;
          float v0 = acc[mi][0][j], v1 = acc[mi][1][j], v2 = acc[mi][2][j], v3 = acc[mi][3][j];
          if (do_norm) {
            float ss = v0 * v0 + v1 * v1 + v2 * v2 + v3 * v3;
            ss = grp16_sum(ss);
            float rstd = rsqrtf(ss * (1.f / 64.f) + EPS);
            v0 = v0 * rstd * ng[fr]; v1 = v1 * rstd * ng[16 + fr]; v2 = v2 * rstd * ng[32 + fr]; v3 = v3 * rstd * ng[48 + fr];
          }
          if (do_rope) {
            int t = (row - NCTX) & 1023;
            float ca = rc[t * 32 + fr], sa = rc[32768 + t * 32 + fr];
            float cb = rc[t * 32 + 16 + fr], sb = rc[32768 + t * 32 + 16 + fr];
            float a0 = v0 * ca - v2 * sa, a2 = v2 * ca + v0 * sa;
            float a1 = v1 * cb - v3 * sb, a3 = v3 * cb + v1 * sb;
            v0 = a0; v1 = a1; v2 = a2; v3 = a3;
          }
          u16* pr = proj + (size_t)row * PSTR + c0 + fr;
          pr[0] = f2bf(v0); pr[16] = f2bf(v1); pr[32] = f2bf(v2); pr[48] = f2bf(v3);
          if (o32) {
            float* o = o32 + (size_t)row * ostr + fr;
            o[0] = v0; o[16] = v1; o[32] = v2; o[48] = v3;
          }
        }
    }
  }
}

template <int EPI>
__device__ void gemm_phase(const Params& p, const u16* A, const u16* Bt, int K, int NT, int l, int gchunk, float coef, u16* smem) {
  const int ntiles = 80 * NT;
  for (int t = blockIdx.x; t < ntiles; t += gridDim.x) {
    int mt = t % 80, nt = t / 80;
    gemm_tile<EPI>(p, A, Bt, K, mt * 128, nt * 128, l, gchunk, coef, smem);
  }
}

__device__ __forceinline__ void load_tile_bf16(float* dst, const u16* src, long rstride, float scale, int tid) {
  int r = tid >> 2, part = tid & 3;
  const uint4* s = (const uint4*)(src + (long)r * rstride + part * 16);
  uint4 a = s[0], b = s[1];
  float4* d = (float4*)(dst + r * TS + part * 16);
  d[0] = make_float4(bflo(a.x) * scale, bfhi(a.x) * scale, bflo(a.y) * scale, bfhi(a.y) * scale);
  d[1] = make_float4(bflo(a.z) * scale, bfhi(a.z) * scale, bflo(a.w) * scale, bfhi(a.w) * scale);
  d[2] = make_float4(bflo(b.x) * scale, bfhi(b.x) * scale, bflo(b.y) * scale, bfhi(b.y) * scale);
  d[3] = make_float4(bflo(b.z) * scale, bfhi(b.z) * scale, bflo(b.w) * scale, bfhi(b.w) * scale);
}
__device__ __forceinline__ void load_tile_f32(float* dst, const float* src, long rstride, int tid) {
  int r = tid >> 2, part = tid & 3;
  const float4* s = (const float4*)(src + (long)r * rstride + part * 16);
  float4* d = (float4*)(dst + r * TS + part * 16);
  d[0] = s[0]; d[1] = s[1]; d[2] = s[2]; d[3] = s[3];
}
__device__ __forceinline__ void qk_micro(const float* Qs, const float* Ks, int ty, int tx, float s[4][4]) {
#pragma unroll
  for (int i = 0; i < 4; ++i)
#pragma unroll
    for (int j = 0; j < 4; ++j) s[i][j] = 0.f;
#pragma unroll 4
  for (int d4 = 0; d4 < 16; ++d4) {
    float4 q[4], k[4];
#pragma unroll
    for (int i = 0; i < 4; ++i) q[i] = *(const float4*)(Qs + (ty * 4 + i) * TS + d4 * 4);
#pragma unroll
    for (int j = 0; j < 4; ++j) k[j] = *(const float4*)(Ks + (tx + 16 * j) * TS + d4 * 4);
#pragma unroll
    for (int i = 0; i < 4; ++i)
#pragma unroll
      for (int j = 0; j < 4; ++j)
        s[i][j] += q[i].x * k[j].x + q[i].y * k[j].y + q[i].z * k[j].z + q[i].w * k[j].w;
  }
}
__device__ __forceinline__ void pv_micro(const float* Ps, const float* Vs, int ty, int tx, float o[4][4]) {
#pragma unroll 4
  for (int s4 = 0; s4 < 16; ++s4) {
    float4 pp[4], v[4];
#pragma unroll
    for (int i = 0; i < 4; ++i) pp[i] = *(const float4*)(Ps + (ty * 4 + i) * TS + s4 * 4);
#pragma unroll
    for (int q = 0; q < 4; ++q) v[q] = *(const float4*)(Vs + (s4 * 4 + q) * TS + tx * 4);
#pragma unroll
    for (int i = 0; i < 4; ++i) {
      o[i][0] += pp[i].x * v[0].x + pp[i].y * v[1].x + pp[i].z * v[2].x + pp[i].w * v[3].x;
      o[i][1] += pp[i].x * v[0].y + pp[i].y * v[1].y + pp[i].z * v[2].y + pp[i].w * v[3].y;
      o[i][2] += pp[i].x * v[0].z + pp[i].y * v[1].z + pp[i].z * v[2].z + pp[i].w * v[3].z;
      o[i][3] += pp[i].x * v[0].w + pp[i].y * v[1].w + pp[i].z * v[2].w + pp[i].w * v[3].w;
    }
  }
}

struct AttnDesc {
  int qrow0, qcol, ocol;
  const float* ck; const float* cv; int cstride; int nctx;
  int krow0, nloc, kcol, vcol;
  int mode;
  int a0;
  const float* rpb;
  float sink; int has_sink;
};

__device__ void attn_item(const Params& p, const AttnDesc& d, float* sm) {
  const int tid = get_tid(), ty = tid >> 4, tx = tid & 15;
  const u16* proj = (const u16*)(p.ws + OFF_HP);
  float* Qs = sm; float* Ks = sm + TILE_F; float* Vs = sm + 2 * TILE_F; float* Ps = sm + 3 * TILE_F;
  __syncthreads();
  load_tile_bf16(Qs, proj + (size_t)d.qrow0 * PSTR + d.qcol, PSTR, 0.125f, tid);
  float m_i[4], l_i[4], o[4][4];
#pragma unroll
  for (int i = 0; i < 4; ++i) {
    m_i[i] = d.has_sink ? d.sink : -1e30f;
    l_i[i] = d.has_sink ? 1.f : 0.f;
#pragma unroll
    for (int j = 0; j < 4; ++j) o[i][j] = 0.f;
  }
  const int ntiles = d.nctx + d.nloc;
  for (int tile = 0; tile < ntiles; ++tile) {
    __syncthreads();
    const int lt = tile - d.nctx;
    if (tile < d.nctx) {
      load_tile_f32(Ks, d.ck + (size_t)tile * 64 * d.cstride, d.cstride, tid);
      load_tile_f32(Vs, d.cv + (size_t)tile * 64 * d.cstride, d.cstride, tid);
    } else {
      const u16* base = proj + (size_t)(d.krow0 + lt * 64) * PSTR;
      load_tile_bf16(Ks, base + d.kcol, PSTR, 1.f, tid);
      load_tile_bf16(Vs, base + d.vcol, PSTR, 1.f, tid);
    }
    __syncthreads();
    float s[4][4];
    qk_micro(Qs, Ks, ty, tx, s);
    if (lt >= 0 && d.mode == 1) {
      const float* rp = d.rpb + (d.a0 + lt) * 31;
#pragma unroll
      for (int i = 0; i < 4; ++i) {
        int qc = ty * 4 + i;
        int ws = min(max(qc - 8, 0), 48);
#pragma unroll
        for (int j = 0; j < 4; ++j) {
          int kc = tx + 16 * j;
          bool ok = (kc >= ws) && (kc < ws + 16);
          int dx = min(max(kc - qc + 15, 0), 30);
          s[i][j] = ok ? s[i][j] + rp[dx] : -1e30f;
        }
      }
    } else if (lt >= 0 && d.mode == 2) {
      int off = d.a0 + lt * 64;
#pragma unroll
      for (int i = 0; i < 4; ++i)
#pragma unroll
        for (int j = 0; j < 4; ++j) {
          int dd = off + (tx + 16 * j) - (ty * 4 + i);
          bool ok = (dd <= 128) && (dd >= -128);
          s[i][j] = ok ? s[i][j] : -1e30f;
        }
    }
#pragma unroll
    for (int i = 0; i < 4; ++i) {
      float mx = fmaxf(fmaxf(s[i][0], s[i][1]), fmaxf(s[i][2], s[i][3]));
      mx = grp16_max(mx);
      float mn = fmaxf(m_i[i], mx);
      float alpha = expf(m_i[i] - mn);
      float rs = 0.f;
#pragma unroll
      for (int j = 0; j < 4; ++j) {
        float pj = expf(s[i][j] - mn);
        rs += pj;
        Ps[(ty * 4 + i) * TS + tx + 16 * j] = pj;
      }
      rs = grp16_sum(rs);
      l_i[i] = l_i[i] * alpha + rs;
      m_i[i] = mn;
#pragma unroll
      for (int j = 0; j < 4; ++j) o[i][j] *= alpha;
    }
    __syncthreads();
    pv_micro(Ps, Vs, ty, tx, o);
  }
  u16* ymix = (u16*)(p.ws + OFF_YMIX);
#pragma unroll
  for (int i = 0; i < 4; ++i) {
    float inv = 1.f / l_i[i];
    uint2 ov = make_uint2(pack2(o[i][0] * inv, o[i][1] * inv), pack2(o[i][2] * inv, o[i][3] * inv));
    *(uint2*)(ymix + (size_t)(d.qrow0 + ty * 4 + i) * D + d.ocol + tx * 4) = ov;
  }
}

__device__ __forceinline__ int st_slot(int isctx, int b, int dir, int head, int cc) {
  int ch = (b * 2 + dir) * 8 + head;
  return isctx ? (ch * 4 + cc) : (2048 + ch * 16 + cc);
}

__device__ void mlstm_state_item(const Params& p, int isctx, int b, int dir, int head, float* sm) {
  const int tid = get_tid(), ty = tid >> 4, tx = tid & 15, lane = tid & 63;
  const u16* proj = (const u16*)(p.ws + OFF_HP);
  const float* gates = (const float*)(p.ws + OFF_GATES);
  float* stC = (float*)(p.ws + OFF_STC);
  float* stn = (float*)(p.ws + OFF_STN);
  float* stm = (float*)(p.ws + OFF_STM);
  float* Ks = sm; float* Vs = sm + TILE_F;
  float* sws = sm + 4 * TILE_F;
  float* sn = sws + 64;
  float* ssc = sn + 64;
  const int nc = isctx ? 4 : 16, L = isctx ? 256 : 1024;
  const int seq0 = isctx ? b * 256 : NCTX + b * 1024;
  float c[4][4];
  float m;
  __syncthreads();
  if (isctx) {
#pragma unroll
    for (int i = 0; i < 4; ++i)
#pragma unroll
      for (int j = 0; j < 4; ++j) c[i][j] = 0.f;
    if (tid < 64) sn[tid] = 0.f;
    m = 0.f;
  } else {
    int ch = (b * 2 + dir) * 8 + head;
    const float* C0 = p.in[I_SC] + (size_t)ch * 4096;
#pragma unroll
    for (int i = 0; i < 4; ++i) {
      float4 v = *(const float4*)(C0 + (ty * 4 + i) * 64 + tx * 4);
      c[i][0] = v.x; c[i][1] = v.y; c[i][2] = v.z; c[i][3] = v.w;
    }
    if (tid < 64) sn[tid] = p.in[I_SN][ch * 64 + tid];
    m = p.in[I_SM][ch];
  }
  for (int cc = 0; cc < nc; ++cc) {
    __syncthreads();
    const int slot = st_slot(isctx, b, dir, head, cc);
#pragma unroll
    for (int i = 0; i < 4; ++i)
      *(float4*)(stC + (size_t)slot * 4096 + (ty * 4 + i) * 64 + tx * 4) = make_float4(c[i][0], c[i][1], c[i][2], c[i][3]);
    if (tid < 64) stn[slot * 64 + tid] = sn[tid];
    if (tid == 0) stm[slot] = m;
    const int tok0 = dir ? (L - 1 - cc * 64) : cc * 64;
    const long rs = dir ? -(long)PSTR : (long)PSTR;
    const u16* base = proj + (size_t)(seq0 + tok0) * PSTR;
    load_tile_bf16(Ks, base + 1280 + head * 64, rs, 0.125f, tid);
    load_tile_bf16(Vs, base + 1792 + head * 64, rs, 1.f, tid);
    if (tid < 64) {
      int tr = seq0 + (dir ? tok0 - lane : tok0 + lane);
      float li = gates[(size_t)tr * 32 + (dir * 2) * 8 + head];
      float fp = gates[(size_t)tr * 32 + (dir * 2 + 1) * 8 + head];
      float lf = logsigmoidf_(fp);
      float bb = wave_scan_add(lf, lane);
      float a = li - bb;
      float amax = wave_max(a);
      float blast = __shfl(bb, 63);
      float mnew = blast + fmaxf(m, amax);
      sws[lane] = expf(blast + a - mnew);
      if (lane == 0) { ssc[0] = expf(blast + m - mnew); ssc[1] = mnew; }
    }
    __syncthreads();
    const float wc = ssc[0];
    m = ssc[1];
#pragma unroll
    for (int i = 0; i < 4; ++i)
#pragma unroll
      for (int j = 0; j < 4; ++j) c[i][j] *= wc;
    float nacc = 0.f;
#pragma unroll 4
    for (int s = 0; s < 64; ++s) {
      float w = sws[s];
      float4 kk = *(const float4*)(Ks + s * TS + ty * 4);
      float4 vv = *(const float4*)(Vs + s * TS + tx * 4);
      float k0 = kk.x * w, k1 = kk.y * w, k2 = kk.z * w, k3 = kk.w * w;
      c[0][0] += k0 * vv.x; c[0][1] += k0 * vv.y; c[0][2] += k0 * vv.z; c[0][3] += k0 * vv.w;
      c[1][0] += k1 * vv.x; c[1][1] += k1 * vv.y; c[1][2] += k1 * vv.z; c[1][3] += k1 * vv.w;
      c[2][0] += k2 * vv.x; c[2][1] += k2 * vv.y; c[2][2] += k2 * vv.z; c[2][3] += k2 * vv.w;
      c[3][0] += k3 * vv.x; c[3][1] += k3 * vv.y; c[3][2] += k3 * vv.z; c[3][3] += k3 * vv.w;
      if (tid < 64) nacc += w * Ks[s * TS + tid];
    }
    if (tid < 64) sn[tid] = wc * sn[tid] + nacc;
  }
  __syncthreads();
  if (isctx) {
    int ch = (b * 2 + dir) * 8 + head;
    float* Co = p.out + O_C + (size_t)ch * 4096;
#pragma unroll
    for (int i = 0; i < 4; ++i)
      *(float4*)(Co + (ty * 4 + i) * 64 + tx * 4) = make_float4(c[i][0], c[i][1], c[i][2], c[i][3]);
    if (tid < 64) p.out[O_N + ch * 64 + tid] = sn[tid];
    if (tid == 0) p.out[O_M + ch] = m;
  }
}

__device__ void mlstm_out_item(const Params& p, int isctx, int b, int head, int c, float* sm) {
  const int tid = get_tid(), ty = tid >> 4, tx = tid & 15, lane = tid & 63;
  const u16* proj = (const u16*)(p.ws + OFF_HP);
  const float* gates = (const float*)(p.ws + OFF_GATES);
  const float* stC = (const float*)(p.ws + OFF_STC);
  const float* stn = (const float*)(p.ws + OFF_STN);
  const float* stm = (const float*)(p.ws + OFF_STM);
  float* Qs = sm; float* KCs = sm + TILE_F; float* Vs = sm + 2 * TILE_F; float* Ws = sm + 3 * TILE_F;
  float* sa = sm + 4 * TILE_F;
  float* sM = sa + 64;
  float* sb = sM + 64;
  float* sn = sb + 64;
  const int nc = isctx ? 4 : 16;
  const int mb = (isctx ? b * 256 : NCTX + b * 1024) + c * 64;
  float hacc[4][4];
  for (int dir = 0; dir < 2; ++dir) {
    const int cc = dir ? nc - 1 - c : c;
    const int slot = st_slot(isctx, b, dir, head, cc);
    const float m0 = stm[slot];
    __syncthreads();
    const long rs = dir ? -(long)PSTR : (long)PSTR;
    const u16* base = proj + (size_t)(mb + (dir ? 63 : 0)) * PSTR;
    load_tile_bf16(Qs, base + 768 + head * 64, rs, 1.f, tid);
    load_tile_bf16(KCs, base + 1280 + head * 64, rs, 0.125f, tid);
    load_tile_bf16(Vs, base + 1792 + head * 64, rs, 1.f, tid);
    if (tid < 64) {
      int tr = mb + (dir ? 63 - lane : lane);
      float li = gates[(size_t)tr * 32 + (dir * 2) * 8 + head];
      float fp = gates[(size_t)tr * 32 + (dir * 2 + 1) * 8 + head];
      float lf = logsigmoidf_(fp);
      float bb = wave_scan_add(lf, lane);
      float a = li - bb;
      float pm = wave_scan_max(a, lane);
      sa[lane] = a; sM[lane] = fmaxf(m0, pm); sb[lane] = bb;
      sn[lane] = stn[slot * 64 + lane];
    }
    __syncthreads();
    float s[4][4];
    qk_micro(Qs, KCs, ty, tx, s);
    float rsum[4];
#pragma unroll
    for (int i = 0; i < 4; ++i) {
      int t = ty * 4 + i;
      float Mt = sM[t];
      float r = 0.f;
#pragma unroll
      for (int j = 0; j < 4; ++j) {
        int sidx = tx + 16 * j;
        float w = (sidx <= t) ? expf(sa[sidx] - Mt) * s[i][j] : 0.f;
        Ws[t * TS + sidx] = w;
        r += w;
      }
      rsum[i] = grp16_sum(r);
    }
    __syncthreads();
    load_tile_f32(KCs, stC + (size_t)slot * 4096, 64, tid);
    __syncthreads();
    float num[4][4], qc[4][4];
#pragma unroll
    for (int i = 0; i < 4; ++i)
#pragma unroll
      for (int j = 0; j < 4; ++j) { num[i][j] = 0.f; qc[i][j] = 0.f; }
    pv_micro(Ws, Vs, ty, tx, num);
    pv_micro(Qs, KCs, ty, tx, qc);
    float hd[4][4];
#pragma unroll
    for (int i = 0; i < 4; ++i) {
      int t = ty * 4 + i;
      float4 q4 = *(const float4*)(Qs + t * TS + tx * 4);
      float4 n4 = *(const float4*)(sn + tx * 4);
      float qn = q4.x * n4.x + q4.y * n4.y + q4.z * n4.z + q4.w * n4.w;
      qn = grp16_sum(qn);
      float Mt = sM[t];
      float wi = expf(m0 - Mt);
      float den = rsum[i] + wi * qn;
      float mt = sb[t] + Mt;
      float dn = fmaxf(fabsf(den), expf(-mt));
      float inv = 1.f / dn;
#pragma unroll
      for (int j = 0; j < 4; ++j) hd[i][j] = (num[i][j] + wi * qc[i][j]) * inv;
    }
    if (dir == 0) {
#pragma unroll
      for (int i = 0; i < 4; ++i)
#pragma unroll
        for (int j = 0; j < 4; ++j) hacc[i][j] = hd[i][j];
    } else {
      __syncthreads();
#pragma unroll
      for (int i = 0; i < 4; ++i)
        *(float4*)(Ws + (63 - (ty * 4 + i)) * TS + tx * 4) = make_float4(hd[i][0], hd[i][1], hd[i][2], hd[i][3]);
      __syncthreads();
#pragma unroll
      for (int i = 0; i < 4; ++i) {
        float4 v = *(const float4*)(Ws + (ty * 4 + i) * TS + tx * 4);
        hacc[i][0] += v.x; hacc[i][1] += v.y; hacc[i][2] += v.z; hacc[i][3] += v.w;
      }
    }
  }
  const float* hg = p.in[I_L0 + L_X2] + head * 64 + tx * 4;
  u16* ymix = (u16*)(p.ws + OFF_YMIX);
#pragma unroll
  for (int i = 0; i < 4; ++i) {
    float ss = hacc[i][0] * hacc[i][0] + hacc[i][1] * hacc[i][1] + hacc[i][2] * hacc[i][2] + hacc[i][3] * hacc[i][3];
    ss = grp16_sum(ss);
    float rstd = rsqrtf(ss * (1.f / 64.f) + EPS);
    int tr = mb + ty * 4 + i;
    uint2 ob = *(const uint2*)(proj + (size_t)tr * PSTR + 2336 + head * 64 + tx * 4);
    float y0 = sigmoidf_(bflo(ob.x)) * (hacc[i][0] * rstd * hg[0]);
    float y1 = sigmoidf_(bfhi(ob.x)) * (hacc[i][1] * rstd * hg[1]);
    float y2 = sigmoidf_(bflo(ob.y)) * (hacc[i][2] * rstd * hg[2]);
    float y3 = sigmoidf_(bfhi(ob.y)) * (hacc[i][3] * rstd * hg[3]);
    *(uint2*)(ymix + (size_t)tr * D + 512 + head * 64 + tx * 4) = make_uint2(pack2(y0, y1), pack2(y2, y3));
  }
}

__device__ __forceinline__ int next_item(int* ctr, int* s_item) {
  __syncthreads();
  if (get_tid() == 0) *s_item = atomicAdd(ctr, 1);
  __syncthreads();
  return *s_item;
}

__device__ void mix0_phase_a(const Params& p, float* sm, int* s_item) {
  int* ctr = (int*)(p.ws + OFF_CTR) + 0;
  for (;;) {
    int it = next_item(ctr, s_item);
    if (it >= 1824) break;
    if (it < 32) {
      int b = it >> 4, dir = (it >> 3) & 1, head = it & 7;
      mlstm_state_item(p, 0, b, dir, head, sm);
    } else if (it < 288) {
      int v = it - 32; int b = v >> 7, h = (v >> 4) & 7, qb = v & 15;
      AttnDesc d;
      d.qrow0 = NCTX + b * 1024 + qb * 64; d.qcol = h * 64; d.ocol = h * 64;
      d.ck = p.in[I_C0K] + (size_t)b * 256 * 128 + (h >> 2) * 64; d.cv = p.in[I_C0V] + (size_t)b * 256 * 128 + (h >> 2) * 64;
      d.cstride = 128; d.nctx = 4;
      d.krow0 = NCTX + b * 1024; d.nloc = 16; d.kcol = 512 + (h >> 2) * 64; d.vcol = 640 + (h >> 2) * 64;
      d.mode = 0; d.a0 = 0; d.rpb = nullptr; d.sink = 0.f; d.has_sink = 0;
      attn_item(p, d, sm);
    } else if (it < 800) {
      int v = it - 288; int b = v >> 4, dir = (v >> 3) & 1, head = v & 7;
      mlstm_state_item(p, 1, b, dir, head, sm);
    } else {
      int v = it - 800; int b = v >> 5, h = (v >> 2) & 7, qb = v & 3;
      AttnDesc d;
      d.qrow0 = b * 256 + qb * 64; d.qcol = h * 64; d.ocol = h * 64;
      d.ck = nullptr; d.cv = nullptr; d.cstride = 0; d.nctx = 0;
      d.krow0 = b * 256; d.nloc = 4; d.kcol = 512 + (h >> 2) * 64; d.vcol = 640 + (h >> 2) * 64;
      d.mode = 0; d.a0 = 0; d.rpb = nullptr; d.sink = 0.f; d.has_sink = 0;
      attn_item(p, d, sm);
    }
  }
}

__device__ void mix0_phase_b(const Params& p, float* sm, int* s_item) {
  int* ctr = (int*)(p.ws + OFF_CTR) + 1;
  for (;;) {
    int it = next_item(ctr, s_item);
    if (it >= 1280) break;
    if (it < 256) {
      int b = it >> 7, head = (it >> 4) & 7, c = it & 15;
      mlstm_out_item(p, 0, b, head, c, sm);
    } else {
      int v = it - 256; int b = v >> 5, head = (v >> 2) & 7, c = v & 3;
      mlstm_out_item(p, 1, b, head, c, sm);
    }
  }
}

__device__ void mix1_phase(const Params& p, float* sm, int* s_item) {
  int* ctr = (int*)(p.ws + OFF_CTR) + 2;
  const float* sink = p.in[I_L1 + L_X1];
  for (;;) {
    int it = next_item(ctr, s_item);
    if (it >= 2560) break;
    AttnDesc d;
    d.mode = 0; d.a0 = 0; d.rpb = nullptr; d.sink = 0.f; d.has_sink = 0;
    if (it < 256) {
      int b = it >> 7, h = (it >> 4) & 7, r = it & 15;
      int r0 = min(max(r - 4, 0), 8);
      d.qrow0 = NCTX + b * 1024 + r * 64; d.qcol = h * 64; d.ocol = h * 64;
      d.ck = p.in[I_NAK] + (size_t)b * 256 * 512 + h * 64; d.cv = p.in[I_NAV] + (size_t)b * 256 * 512 + h * 64;
      d.cstride = 512; d.nctx = 4;
      d.krow0 = NCTX + b * 1024 + r0 * 64; d.nloc = 8; d.kcol = 512 + h * 64; d.vcol = 1024 + h * 64;
      d.mode = 1; d.a0 = r0 - r + 7; d.rpb = p.in[I_L1 + L_X0] + h * 15 * 31;
    } else if (it < 512) {
      int v = it - 256; int b = v >> 7, h = (v >> 4) & 7, qb = v & 15;
      int t0 = qb * 64;
      int s0 = max(t0 - 128, 0);
      int s1 = min(t0 + 192, 1024);
      d.qrow0 = NCTX + b * 1024 + t0; d.qcol = 1536 + h * 64; d.ocol = 512 + h * 64;
      d.ck = p.in[I_SWK] + (size_t)b * 256 * 128 + (h >> 2) * 64; d.cv = p.in[I_SWV] + (size_t)b * 256 * 128 + (h >> 2) * 64;
      d.cstride = 128; d.nctx = 4;
      d.krow0 = NCTX + b * 1024 + s0; d.nloc = (s1 - s0) >> 6; d.kcol = 2048 + (h >> 2) * 64; d.vcol = 2176 + (h >> 2) * 64;
      d.mode = 2; d.a0 = s0 - t0;
      d.sink = sink[h]; d.has_sink = 1;
    } else if (it < 1536) {
      int v = it - 512; int b = v >> 5, h = (v >> 2) & 7, qb = v & 3;
      d.qrow0 = b * 256 + qb * 64; d.qcol = h * 64; d.ocol = h * 64;
      d.ck = nullptr; d.cv = nullptr; d.cstride = 0; d.nctx = 0;
      d.krow0 = b * 256; d.nloc = 4; d.kcol = 512 + h * 64; d.vcol = 1024 + h * 64;
    } else {
      int v = it - 1536; int b = v >> 5, h = (v >> 2) & 7, qb = v & 3;
      d.qrow0 = b * 256 + qb * 64; d.qcol = 1536 + h * 64; d.ocol = 512 + h * 64;
      d.ck = nullptr; d.cv = nullptr; d.cstride = 0; d.nctx = 0;
      d.krow0 = b * 256; d.nloc = 4; d.kcol = 2048 + (h >> 2) * 64; d.vcol = 2176 + (h >> 2) * 64;
      d.sink = sink[h]; d.has_sink = 1;
    }
    attn_item(p, d, sm);
  }
}


#define XB_TMO      128
#define XB_XCNT(j)  (256  + 64 * (j))
#define XB_XSUB(j)  (1280 + 64 * (j))
#define XB_XGEN(j)  (2304 + 64 * (j))
#define XB_TOP      3328
#define XB_TOPGEN   3392
#define XCD_BAR_WORDS 3456
#define XB_SPIN_CAP (1u << 22)
#define LAS __attribute__((address_space(3)))
__device__ __forceinline__ unsigned xb_ld(unsigned* p) { return __hip_atomic_load(p, __ATOMIC_RELAXED, __HIP_MEMORY_SCOPE_AGENT); }
__device__ __forceinline__ unsigned xb_add(unsigned* p, unsigned v) { return __hip_atomic_fetch_add(p, v, __ATOMIC_RELAXED, __HIP_MEMORY_SCOPE_AGENT); }
__device__ __forceinline__ unsigned xb_xcc_id() { return (unsigned)__builtin_amdgcn_s_getreg((3 << 11) | 20) & 0xFu; }
#define XB_SPIN(cond, bar) do { unsigned _sp = 0; while (cond) { __builtin_amdgcn_s_sleep(1); \
    if ((++_sp & 255u) == 0u) { if (xb_ld(&(bar)[XB_TMO])) break; if (_sp > XB_SPIN_CAP) { atomicAdd(&(bar)[XB_TMO], 1u); break; } } } } while (0)
struct XcdBarrier { unsigned* bar; unsigned x; volatile LAS unsigned* st; };
__device__ __forceinline__ XcdBarrier xcd_barrier_post(unsigned* bar, volatile LAS unsigned* st) {
  XcdBarrier b; b.bar = bar; b.x = xb_xcc_id(); b.st = st;
  if (threadIdx.x == 0) (void)xb_add(&bar[XB_XCNT(b.x)], 1u);
  return b;
}
__device__ __forceinline__ void xcd_barrier_complete(unsigned* bar, unsigned x, unsigned& nloc, unsigned& nx) {
  const unsigned G = gridDim.x * gridDim.y * gridDim.z;
  unsigned sum, cnt, mine, sp = 0u;
  for (;;) {
    sum = 0u; cnt = 0u; mine = 0u;
#pragma unroll
    for (unsigned j = 0; j < 16; ++j) { const unsigned c = xb_ld(&bar[XB_XCNT(j)]); sum += c; cnt += (c > 0u) ? 1u : 0u; mine = (j == x) ? c : mine; }
    if (sum == G) break;
    __builtin_amdgcn_s_sleep(1);
    if ((++sp & 255u) == 0u) { if (xb_ld(&bar[XB_TMO])) break; if (sp > XB_SPIN_CAP) { atomicAdd(&bar[XB_TMO], 1u); break; } }
  }
  nloc = mine > 0u ? mine : 1u; nx = cnt > 0u ? cnt : 1u;
}
__device__ __forceinline__ void xcd_barrier(const XcdBarrier& b) {
  asm volatile("s_waitcnt vmcnt(0)" ::: "memory");
  __syncthreads();
  if (threadIdx.x == 0) {
    unsigned* bar = b.bar;
    __builtin_amdgcn_s_waitcnt(0);
    unsigned nloc = b.st[0], nx = b.st[1];
    if (nloc == 0u) { xcd_barrier_complete(bar, b.x, nloc, nx); b.st[0] = nloc; b.st[1] = nx; }
    const unsigned old = xb_add(&bar[XB_XSUB(b.x)], 1u);
    const unsigned gen = old / nloc;
    if (old + 1u == (gen + 1u) * nloc) {
      __builtin_amdgcn_fence(__ATOMIC_RELEASE, "agent");
      asm volatile("s_waitcnt vmcnt(0)" ::: "memory");
      const unsigned og = xb_add(&bar[XB_TOP], 1u);
      const unsigned tg = og / nx;
      if (og + 1u == (tg + 1u) * nx) xb_add(&bar[XB_TOPGEN], 1u);
      else XB_SPIN(xb_ld(&bar[XB_TOPGEN]) == tg, bar);
      __builtin_amdgcn_fence(__ATOMIC_ACQUIRE, "agent");
      xb_add(&bar[XB_XGEN(b.x)], 1u);
      asm volatile("s_waitcnt vmcnt(0)" ::: "memory");
    } else {
      XB_SPIN(xb_ld(&bar[XB_XGEN(b.x)]) == gen, bar);
      __builtin_amdgcn_fence(__ATOMIC_ACQUIRE, "agent");
      asm volatile("s_waitcnt vmcnt(0)" ::: "memory");
    }
  }
  __syncthreads();
}

constexpr int NPHASE = 23;

__device__ void run_phase(const Params& p, int ph, char* smem, int* s_item) {
  float* smf = (float*)smem;
  u16* smh = (u16*)smem;
  const u16* xn = (const u16*)(p.ws + OFF_XN);
  const u16* hp = (const u16*)(p.ws + OFF_HP);
  const u16* ymix = (const u16*)(p.ws + OFF_YMIX);
  if (ph == 0) { prep_phase(p, smf); return; }
  if (ph == 22) { norm_phase(p, 0, 3); return; }
  int l = (ph - 1) / 11, q = (ph - 1) % 11;
  if (l == 1 && q >= 6) q += 1;
  switch (q) {
    case 0: norm_phase(p, l, 0); break;
    case 1: gemm_phase<EPI_SWIGLU>(p, xn, (const u16*)(p.ws + OFF_WIN + (l * 2 + 0) * SZ_WIN), 1024, 44, l, 0, 0.f, smh); break;
    case 2: gemm_phase<EPI_RESID>(p, hp, (const u16*)(p.ws + OFF_WOUT + (l * 2 + 0) * SZ_WOUT), DFF, 8, l, 2, 0.5f, smh); break;
    case 3: norm_phase(p, l, 1); break;
    case 4:
      if (l == 0) gemm_phase<EPI_MIX0>(p, xn, (const u16*)(p.ws + OFF_WMI0), 1024, 23, l, 0, 0.f, smh);
      else gemm_phase<EPI_MIX1>(p, xn, (const u16*)(p.ws + OFF_WMI1), 1024, 18, l, 0, 0.f, smh);
      break;
    case 5:
      if (l == 0) mix0_phase_a(p, smf, s_item); else mix1_phase(p, smf, s_item);
      break;
    case 6: mix0_phase_b(p, smf, s_item); break;
    case 7: gemm_phase<EPI_RESID>(p, ymix, (const u16*)(p.ws + OFF_WMO + (size_t)l * D * D * 2), 1024, 8, l, 5, 1.f, smh); break;
    case 8: norm_phase(p, l, 2); break;
    case 9: gemm_phase<EPI_SWIGLU>(p, xn, (const u16*)(p.ws + OFF_WIN + (l * 2 + 1) * SZ_WIN), 1024, 44, l, 0, 0.f, smh); break;
    case 10: gemm_phase<EPI_RESID>(p, hp, (const u16*)(p.ws + OFF_WOUT + (l * 2 + 1) * SZ_WOUT), DFF, 8, l, 8, 0.5f, smh); break;
  }
}

__global__ void __launch_bounds__(256, 2) mega(Params p, int ph0, int ph1) {
  __shared__ __attribute__((aligned(16))) char smem[SMEM_BYTES];
  __shared__ int s_item;
  __shared__ uint4 xb_words;
  if (threadIdx.x == 0) xb_words = make_uint4(0u, 0u, 0u, 0u);
  __syncthreads();
  XcdBarrier xb = xcd_barrier_post((unsigned*)(p.ws + OFF_BAR), (volatile LAS unsigned*)&xb_words);
  if (ph1 < 0) cg::this_grid().sync();
  for (int ph = ph0; ph < ph1; ++ph) {
    if (ph > ph0) xcd_barrier(xb);
    run_phase(p, ph, smem, &s_item);
  }
}

extern "C" void kernel_launch(void* const* d_in, const int* in_sizes, int n_in, void* d_out, int out_size, void* d_ws,
                              size_t ws_size, hipStream_t stream) {
  static int grid_blocks = 0;
  if (!grid_blocks) {
    int dev = 0, cus = 0, per_cu = 0;
    hipGetDevice(&dev);
    hipDeviceGetAttribute(&cus, hipDeviceAttributeMultiprocessorCount, dev);
    hipOccupancyMaxActiveBlocksPerMultiprocessor(&per_cu, mega, 256, 0);
    if (per_cu > 2) per_cu = 2;
    if (per_cu < 1) per_cu = 1;
    grid_blocks = cus * per_cu;
  }
  if (ws_size < WS_TOTAL) fprintf(stderr, "workspace too small: %zu < %zu\n", ws_size, (size_t)WS_TOTAL);
  Params p{};
  for (int i = 0; i < 37; ++i) p.in[i] = (const float*)d_in[i];
  p.out = (float*)d_out;
  p.ws = (char*)d_ws;
  hipMemsetAsync((char*)d_ws + OFF_CTR, 0, 16384, stream);
#if SINGLE_LAUNCH
  int ph0 = 0, ph1 = NPHASE;
  void* args[] = {&p, &ph0, &ph1};
  hipError_t e = hipLaunchCooperativeKernel((void*)mega, dim3(grid_blocks), dim3(256), args, 0, stream);
  if (e != hipSuccess) fprintf(stderr, "cooperative launch failed: %s (grid %d)\n", hipGetErrorString(e), grid_blocks);
#else
  for (int ph = 0; ph < NPHASE; ++ph) mega<<<grid_blocks, 256, 0, stream>>>(p, ph, ph + 1);
#endif
}
```

```cpp
#include <hip/hip_runtime.h>
#include <hip/hip_cooperative_groups.h>
#include <cstdio>
namespace cg = cooperative_groups;

#ifndef SINGLE_LAUNCH
#define SINGLE_LAUNCH 1
#endif

typedef unsigned short u16;
typedef __attribute__((ext_vector_type(8))) short bf16x8;
typedef __attribute__((ext_vector_type(4))) float f32x4;
typedef __attribute__((ext_vector_type(4))) unsigned u32x4;
#define LAS __attribute__((address_space(3)))

constexpr int D = 1024, NCTX = 8192, MTOK = 10240;
constexpr int DFF = 2816, NFF = 5632;
constexpr int P0N = 2848, P0P = 3072, P1N = 2304;
constexpr int PSTR = 2944;
constexpr float EPS = 1e-6f;

enum { I_XP = 0, I_XS, I_C0K, I_C0V, I_SC, I_SN, I_SM, I_NAK, I_NAV, I_SWK, I_SWV, I_C, I_CCTX, I_NF,
       I_L0 = 14, I_L1 = 26 };
enum { L_ADAW = 0, L_ADAB, L_NORM, L_F1I, L_F1O, L_F2I, L_F2O, L_MI, L_MO, L_X0, L_X1, L_X2 };

constexpr size_t O_X = 0, O_K0 = 10485760, O_V0 = 11534336, O_C = 12582912, O_N = 14680064, O_M = 14712832,
                 O_KC1 = 14713344, O_VC1 = 18907648, O_KD1 = 23101952, O_VD1 = 24150528;

constexpr size_t SZ_WIN = (size_t)NFF * D * 2;
constexpr size_t SZ_WOUT = (size_t)D * DFF * 2;
constexpr size_t OFF_WIN = 0;
constexpr size_t OFF_WOUT = OFF_WIN + 4 * SZ_WIN;
constexpr size_t OFF_WMI0 = OFF_WOUT + 4 * SZ_WOUT;
constexpr size_t OFF_WMI1 = OFF_WMI0 + (size_t)P0P * D * 2;
constexpr size_t OFF_WMO = OFF_WMI1 + (size_t)P1N * D * 2;
constexpr size_t OFF_MOD = OFF_WMO + 2 * (size_t)D * D * 2;
constexpr size_t OFF_ROPE = OFF_MOD + 2 * 3 * 9216 * 4;
constexpr size_t OFF_CTR = OFF_ROPE + 2 * 1024 * 32 * 4;
constexpr size_t OFF_BAR = OFF_CTR + 256;
constexpr size_t OFF_XN = OFF_BAR + 16384 - 256;
constexpr size_t OFF_YMIX = OFF_XN + (size_t)MTOK * D * 2;
constexpr size_t OFF_HP = OFF_YMIX + (size_t)MTOK * D * 2;
constexpr size_t OFF_GATES = OFF_HP + (size_t)MTOK * PSTR * 2;
constexpr size_t OFF_STC = OFF_GATES + (size_t)MTOK * 32 * 4;
constexpr size_t OFF_STN = OFF_STC + (size_t)2560 * 4096 * 4;
constexpr size_t OFF_STM = OFF_STN + (size_t)2560 * 64 * 4;
constexpr size_t WS_TOTAL = OFF_STM + 2560 * 4;

constexpr int TS = 68;
constexpr int TILE_F = 64 * TS;
constexpr int SMEM_BYTES = 8 * TILE_F * 4 + 4096;
constexpr int NTH = 512;
constexpr int DYN_LDS = SMEM_BYTES + 32;

struct Params {
  const float* in[37];
  float* out;
  char* ws;
};

__device__ __forceinline__ int get_tid() { int t = threadIdx.x; asm volatile("" : "+v"(t)); return t; }
__device__ __forceinline__ u16 f2bf(float f) {
  unsigned u = __float_as_uint(f);
  u += 0x7fffu + ((u >> 16) & 1u);
  return (u16)(u >> 16);
}
__device__ __forceinline__ unsigned pack2(float a, float b) { return (unsigned)f2bf(a) | ((unsigned)f2bf(b) << 16); }
__device__ __forceinline__ float bflo(unsigned x) { return __uint_as_float(x << 16); }
__device__ __forceinline__ float bfhi(unsigned x) { return __uint_as_float(x & 0xffff0000u); }
__device__ __forceinline__ float grp16_sum(float v) {
  v += __shfl_xor(v, 1); v += __shfl_xor(v, 2); v += __shfl_xor(v, 4); v += __shfl_xor(v, 8); return v;
}
__device__ __forceinline__ float grp16_max(float v) {
  v = fmaxf(v, __shfl_xor(v, 1)); v = fmaxf(v, __shfl_xor(v, 2)); v = fmaxf(v, __shfl_xor(v, 4)); v = fmaxf(v, __shfl_xor(v, 8)); return v;
}
__device__ __forceinline__ float wave_sum(float v) {
  for (int o = 32; o; o >>= 1) v += __shfl_xor(v, o);
  return v;
}
__device__ __forceinline__ float wave_max(float v) {
  for (int o = 32; o; o >>= 1) v = fmaxf(v, __shfl_xor(v, o));
  return v;
}
__device__ __forceinline__ float wave_scan_add(float v, int lane) {
  for (int o = 1; o < 64; o <<= 1) { float t = __shfl_up(v, o); if (lane >= o) v += t; }
  return v;
}
__device__ __forceinline__ float wave_scan_max(float v, int lane) {
  for (int o = 1; o < 64; o <<= 1) { float t = __shfl_up(v, o); if (lane >= o) v = fmaxf(v, t); }
  return v;
}
__device__ __forceinline__ int cond_of(int row) { return row < NCTX ? 0 : 1 + ((row - NCTX) >> 10); }
__device__ __forceinline__ float sigmoidf_(float x) { return 1.f / (1.f + expf(-x)); }
__device__ __forceinline__ float logsigmoidf_(float x) { return fminf(x, 0.f) - log1pf(expf(-fabsf(x))); }

__device__ void conv_tile(const float* __restrict__ W, int K, int N, u16* __restrict__ Wt, int perm, int kt, int nt, float* T, int t, bool valid) {
  {
    int r = t >> 4, c4 = t & 15;
    int c = c4 * 4;
    int src;
    if (perm == 1) src = ((nt & 3) < 2 ? 0 : DFF) + (nt >> 2) * 128 + (nt & 1) * 64 + c;
    else if (perm == 2) {
      int bj = (nt & 3) >> 1, wc = (nt & 1) * 2 + (c >> 5), w = c & 31;
      src = (nt >> 2) * 256 + wc * 64 + bj * 32 + w;
    } else src = nt * 64 + c;
    bool ok = valid && (src < N);
#pragma unroll
    for (int ps = 0; ps < 4; ++ps) {
      int k = r + ps * 16;
      float4 v = make_float4(0.f, 0.f, 0.f, 0.f);
      if (ok) v = *(const float4*)(W + (size_t)(kt * 64 + k) * N + src);
      float* tt = T + k * 65 + c;
      tt[0] = v.x; tt[1] = v.y; tt[2] = v.z; tt[3] = v.w;
    }
  }
  __syncthreads();
  if (valid) {
    int n = t >> 2, kp = t & 3;
    unsigned o[8];
#pragma unroll
    for (int i = 0; i < 8; ++i) {
      float a = T[(kp * 16 + 2 * i) * 65 + n], b = T[(kp * 16 + 2 * i + 1) * 65 + n];
      o[i] = pack2(a, b);
    }
    uint4* dst = (uint4*)(Wt + (size_t)(nt * 64 + n) * K + kt * 64 + kp * 16);
    dst[0] = make_uint4(o[0], o[1], o[2], o[3]);
    dst[1] = make_uint4(o[4], o[5], o[6], o[7]);
  }
  __syncthreads();
}

__device__ void adaln_unit(const Params& p, int u, float* sm, int t, bool valid) {
  int l = u / 144, cg_ = u % 144;
  if (!valid) { l = 0; cg_ = 0; }
  const float* W = p.in[(l ? I_L1 : I_L0) + L_ADAW];
  const float* B = p.in[(l ? I_L1 : I_L0) + L_ADAB];
  float* sc = sm;
  float* red = sm + 3072;
  for (int i = t; i < 3072; i += 256) {
    int cnd = i >> 10, k = i & 1023;
    float v = (cnd == 0) ? p.in[I_CCTX][k] : p.in[I_C][(cnd - 1) * 1024 + k];
    sc[i] = v / (1.f + expf(-v));
  }
  __syncthreads();
  int kp = t >> 4, c4 = t & 15;
  float acc[3][4];
#pragma unroll
  for (int a = 0; a < 3; ++a)
#pragma unroll
    for (int e = 0; e < 4; ++e) acc[a][e] = 0.f;
  for (int kk = 0; kk < 64; ++kk) {
    int k = kp * 64 + kk;
    float4 w = *(const float4*)(W + (size_t)k * 9216 + cg_ * 64 + c4 * 4);
#pragma unroll
    for (int a = 0; a < 3; ++a) {
      float s = sc[a * 1024 + k];
      acc[a][0] += s * w.x; acc[a][1] += s * w.y; acc[a][2] += s * w.z; acc[a][3] += s * w.w;
    }
  }
#pragma unroll
  for (int a = 0; a < 3; ++a)
#pragma unroll
    for (int e = 0; e < 4; ++e) red[(kp * 3 + a) * 64 + c4 * 4 + e] = acc[a][e];
  __syncthreads();
  if (valid && t < 192) {
    int a = t >> 6, col = t & 63;
    float s = 0.f;
    for (int q = 0; q < 16; ++q) s += red[(q * 3 + a) * 64 + col];
    s += B[cg_ * 64 + col];
    float* mod = (float*)(p.ws + OFF_MOD);
    mod[(l * 3 + a) * 9216 + cg_ * 64 + col] = s;
  }
  __syncthreads();
}

__device__ __forceinline__ void prep_phase(const Params& p, float* sm) {
  const int tid = get_tid(), half = tid >> 8, t = tid & 255;
  float* smh = sm + half * 8192;
  constexpr int U_CONV = 10304, U_ADA = 288, U_ROPE = 64, U_COPY = 320;
  for (int ub = blockIdx.x * 2; ub < U_CONV; ub += gridDim.x * 2) {
    int u = ub + half;
    bool valid = u < U_CONV;
    if (!valid) u = 0;
    const float* W; u16* Wt; int K, N, perm, tt, ntn;
    if (u < 5632) {
      int mi = u / 1408; tt = u % 1408;
      int l = mi >> 1, f = mi & 1;
      W = p.in[(l ? I_L1 : I_L0) + (f ? L_F2I : L_F1I)];
      Wt = (u16*)(p.ws + OFF_WIN + mi * SZ_WIN);
      K = 1024; N = NFF; perm = 1; ntn = 88;
    } else if (u < 8448) {
      int v = u - 5632; int mi = v / 704; tt = v % 704;
      int l = mi >> 1, f = mi & 1;
      W = p.in[(l ? I_L1 : I_L0) + (f ? L_F2O : L_F1O)];
      Wt = (u16*)(p.ws + OFF_WOUT + mi * SZ_WOUT);
      K = DFF; N = 1024; perm = 0; ntn = 16;
    } else if (u < 9216) {
      tt = u - 8448; W = p.in[I_L0 + L_MI]; Wt = (u16*)(p.ws + OFF_WMI0); K = 1024; N = P0N; perm = 2; ntn = 48;
    } else if (u < 9792) {
      tt = u - 9216; W = p.in[I_L1 + L_MI]; Wt = (u16*)(p.ws + OFF_WMI1); K = 1024; N = P1N; perm = 2; ntn = 36;
    } else {
      int v = u - 9792; int l = v / 256; tt = v % 256;
      W = p.in[(l ? I_L1 : I_L0) + L_MO]; Wt = (u16*)(p.ws + OFF_WMO + (size_t)l * D * D * 2); K = 1024; N = 1024; perm = 0; ntn = 16;
    }
    int nt = tt % ntn, kt = tt / ntn;
    conv_tile(W, K, N, Wt, perm, kt, nt, smh, t, valid);
  }
  for (int ub = blockIdx.x * 2; ub < U_ADA; ub += gridDim.x * 2) {
    int u = ub + half;
    adaln_unit(p, u, smh, t, u < U_ADA);
  }
  for (int u = blockIdx.x; u < U_ROPE; u += gridDim.x) {
    int e = u * 512 + tid;
    int tk = e >> 5, i = e & 31;
    float pos = (i < 16) ? (float)(tk >> 6) : (float)(tk & 63);
    float fr = powf(10000.f, -(float)(i & 15) / 16.f);
    float ang = pos * fr;
    float* rc = (float*)(p.ws + OFF_ROPE);
    rc[e] = cosf(ang);
    rc[32768 + e] = sinf(ang);
  }
  for (int v = blockIdx.x; v < U_COPY; v += gridDim.x) {
    float4* dst = (float4*)(p.out + O_X);
#pragma unroll 4
    for (int i = 0; i < 16; ++i) {
      size_t idx = (size_t)v * 8192 + i * 512 + tid;
      float4 val = (idx < (size_t)NCTX * 256) ? ((const float4*)p.in[I_XP])[idx] : ((const float4*)p.in[I_XS])[idx - (size_t)NCTX * 256];
      dst[idx] = val;
    }
  }
}

__device__ __forceinline__ void norm_phase(const Params& p, int l, int which) {
  const int tid = get_tid(), lane = tid & 63, w = tid >> 6;
  float* x = p.out + O_X;
  const float* mod = (const float*)(p.ws + OFF_MOD);
  u16* xn = (u16*)(p.ws + OFF_XN);
  for (int row = blockIdx.x * 8 + w; row < MTOK; row += gridDim.x * 8) {
    float4* xr = (float4*)(x + (size_t)row * D);
    float4 v[4];
    float ss = 0.f;
#pragma unroll
    for (int i = 0; i < 4; ++i) {
      v[i] = xr[lane + i * 64];
      ss += v[i].x * v[i].x + v[i].y * v[i].y + v[i].z * v[i].z + v[i].w * v[i].w;
    }
    ss = wave_sum(ss);
    float rstd = rsqrtf(ss * (1.f / 1024.f) + EPS);
    if (which == 3) {
      const float4* g = (const float4*)p.in[I_NF];
#pragma unroll
      for (int i = 0; i < 4; ++i) {
        float4 gg = g[lane + i * 64];
        float4 o = make_float4(v[i].x * rstd * gg.x, v[i].y * rstd * gg.y, v[i].z * rstd * gg.z, v[i].w * rstd * gg.w);
        xr[lane + i * 64] = o;
      }
    } else {
      const float4* g = (const float4*)(p.in[(l ? I_L1 : I_L0) + L_NORM] + which * 1024);
      const float* mb = mod + (l * 3 + cond_of(row)) * 9216;
      const float4* sh = (const float4*)(mb + (3 * which) * 1024);
      const float4* sc = (const float4*)(mb + (3 * which + 1) * 1024);
#pragma unroll
      for (int i = 0; i < 4; ++i) {
        int q = lane + i * 64;
        float4 gg = g[q], s1 = sh[q], s2 = sc[q];
        float a = (v[i].x * rstd * gg.x) * (1.f + s2.x) + s1.x;
        float b = (v[i].y * rstd * gg.y) * (1.f + s2.y) + s1.y;
        float c = (v[i].z * rstd * gg.z) * (1.f + s2.z) + s1.z;
        float d = (v[i].w * rstd * gg.w) * (1.f + s2.w) + s1.w;
        uint2 o = make_uint2(pack2(a, b), pack2(c, d));
        *(uint2*)(xn + (size_t)row * D + q * 4) = o;
      }
    }
  }
}

enum { EPI_SWIGLU = 0, EPI_RESID = 1, EPI_MIX0 = 2, EPI_MIX1 = 3 };
constexpr int BM = 256, BK = 64, HALF = 128, HT = HALF * BK, NXCD = 8, WGM = 8;

__device__ __forceinline__ int lds_byte(int r, int c) {
  int st = (r >> 4) * 2 + (c >> 5), rr = r & 15, cc = c & 31, ob = rr * 64 + cc * 2;
  return st * 1024 + (ob ^ (((ob >> 9) & 1) << 5));
}
__device__ __forceinline__ void stage_rc(int b, int& R, int& C) {
  int st = b / 1024, sb = b % 1024, swz = sb ^ (((sb >> 9) & 1) << 5);
  R = (st >> 1) * 16 + swz / 64; C = (st & 1) * 32 + (swz % 64) / 2;
}

template <int EPI>
__device__ __forceinline__ void gemm256_tile(const Params& p, const u16* A, const u16* Bt, const int K,
                                             const int brow, const int bcol, int l, int gchunk, float coef, u16* shm, const int tid) {
#define SAI(b, h) ((b) * 2 + (h))
#define SBI(b, h) (4 + (b) * 2 + (h))
#define STAGE(PI, BASE, br, kt) do { \
    const char* _gb = (const char*)(BASE) + ((long)(br) * K + (long)(kt) * BK) * 2; \
    char* _lp = (char*)shm + (PI) * (HT * 2) + wave_lds; \
    __builtin_amdgcn_global_load_lds((const unsigned*)(_gb + voff0), (LAS unsigned*)(_lp), 16, 0, 0); \
    __builtin_amdgcn_global_load_lds((const unsigned*)(_gb + (long)K * 128 + voff0), (LAS unsigned*)(_lp + 8192), 16, 0, 0); } while (0)
#define LDA(dst, PI) do { unsigned _o = sw_ + a_uni; asm volatile("" : "+v"(_o)); _o &= 0x23F0u; \
    _Pragma("unroll") for (int m = 0; m < 4; ++m) _Pragma("unroll") for (int k = 0; k < 2; ++k) \
      dst[m][k] = *reinterpret_cast<const bf16x8*>((const char*)shm + (PI) * (HT * 2) + m * 2048 + k * 1024 + _o); } while (0)
#define LDB(dst, PI) do { unsigned _o = sw_ + b_uni; asm volatile("" : "+v"(_o)); _o &= 0x33F0u; \
    _Pragma("unroll") for (int n = 0; n < 2; ++n) _Pragma("unroll") for (int k = 0; k < 2; ++k) \
      dst[n][k] = *reinterpret_cast<const bf16x8*>((const char*)shm + (PI) * (HT * 2) + n * 2048 + k * 1024 + _o); } while (0)
#define MMA(ai, bj, At_, Bt_) do { __builtin_amdgcn_s_setprio(1); \
    _Pragma("unroll") for (int m = 0; m < 4; ++m) _Pragma("unroll") for (int n = 0; n < 2; ++n) _Pragma("unroll") for (int k = 0; k < 2; ++k) \
      acc[ai][bj][m][n] = __builtin_amdgcn_mfma_f32_16x16x32_bf16(At_[m][k], Bt_[n][k], acc[ai][bj][m][n], 0, 0, 0); \
    __builtin_amdgcn_s_setprio(0); } while (0)
#define WAIT_V(n) asm volatile("s_waitcnt vmcnt(" #n ")" ::: "memory")
#define WAIT_L(n) asm volatile("s_waitcnt lgkmcnt(" #n ")" ::: "memory")
#define BAR __builtin_amdgcn_s_barrier()
#define SCHED __builtin_amdgcn_sched_barrier(0)
  const int wid = __builtin_amdgcn_readfirstlane(tid >> 6), lane = tid & 63, wr = wid >> 2, wc = wid & 3, fr = lane & 15, fq = lane >> 4;
  const int wave_lds = (wid & 7) * 1024;
  unsigned voff0;
  { int r_, c_; stage_rc(tid * 16, r_, c_); voff0 = (unsigned)(r_ * K + c_) * 2u; }
  const unsigned sw_ = (unsigned)((fr * 64 + fq * 16) ^ ((((fr * 64 + fq * 16) >> 9) & 1) << 5));
  const unsigned a_uni = (unsigned)(wr * 8192), b_uni = (unsigned)(wc * 4096);
  f32x4 acc[2][2][4][2];
#pragma unroll
  for (int a = 0; a < 2; ++a)
#pragma unroll
    for (int b = 0; b < 2; ++b)
#pragma unroll
      for (int m = 0; m < 4; ++m)
#pragma unroll
        for (int n = 0; n < 2; ++n) acc[a][b][m][n] = (f32x4){0.f, 0.f, 0.f, 0.f};
  bf16x8 At[4][2], B0[2][2], B1[2][2];
  const int nt = K / BK;
  WAIT_V(0);
  __syncthreads();
  STAGE(SBI(0, 0), Bt, bcol, 0); STAGE(SAI(0, 0), A, brow, 0);
  STAGE(SBI(0, 1), Bt, bcol + HALF, 0); STAGE(SAI(0, 1), A, brow + HALF, 0);
  if (wr == 1) BAR;
  WAIT_V(4); BAR;
  STAGE(SBI(1, 0), Bt, bcol, 1); STAGE(SAI(1, 0), A, brow, 1); STAGE(SBI(1, 1), Bt, bcol + HALF, 1);
  WAIT_V(6); BAR;
  for (int t = 0; t < nt - 2; t += 2) {
    LDB(B0, SBI(0, 0)); SCHED; LDA(At, SAI(0, 0)); STAGE(SAI(1, 1), A, brow + HALF, t + 1);
    WAIT_L(8); BAR; WAIT_L(0); MMA(0, 0, At, B0); BAR; SCHED;
    LDB(B1, SBI(0, 1)); STAGE(SBI(0, 0), Bt, bcol, t + 2);
    BAR; WAIT_L(0); MMA(0, 1, At, B1); BAR;
    LDA(At, SAI(0, 1)); STAGE(SAI(0, 0), A, brow, t + 2);
    BAR; WAIT_L(0); MMA(1, 0, At, B0); BAR; SCHED;
    STAGE(SBI(0, 1), Bt, bcol + HALF, t + 2);
    WAIT_V(6); BAR; MMA(1, 1, At, B1); BAR;
    LDB(B0, SBI(1, 0)); SCHED; LDA(At, SAI(1, 0)); STAGE(SAI(0, 1), A, brow + HALF, t + 2);
    WAIT_L(8); BAR; WAIT_L(0); MMA(0, 0, At, B0); BAR; SCHED;
    LDB(B1, SBI(1, 1)); STAGE(SBI(1, 0), Bt, bcol, t + 3);
    BAR; WAIT_L(0); MMA(0, 1, At, B1); BAR;
    LDA(At, SAI(1, 1)); STAGE(SAI(1, 0), A, brow, t + 3);
    BAR; WAIT_L(0); MMA(1, 0, At, B0); BAR; SCHED;
    STAGE(SBI(1, 1), Bt, bcol + HALF, t + 3);
    WAIT_V(6); BAR; MMA(1, 1, At, B1); BAR;
  }
  { LDB(B0, SBI(0, 0)); LDA(At, SAI(0, 0)); STAGE(SAI(1, 1), A, brow + HALF, nt - 1);
    BAR; WAIT_L(0); MMA(0, 0, At, B0); BAR;
    LDB(B1, SBI(0, 1)); BAR; WAIT_L(0); MMA(0, 1, At, B1); BAR;
    LDA(At, SAI(0, 1)); WAIT_V(4); BAR; WAIT_L(0); MMA(1, 0, At, B0); MMA(1, 1, At, B1); BAR; }
  { LDB(B0, SBI(1, 0)); LDA(At, SAI(1, 0)); WAIT_V(2); BAR; WAIT_L(0); MMA(0, 0, At, B0); BAR;
    LDB(B1, SBI(1, 1)); WAIT_V(0); BAR; WAIT_L(0); MMA(0, 1, At, B1); BAR;
    LDA(At, SAI(1, 1)); BAR; WAIT_L(0); MMA(1, 0, At, B0); MMA(1, 1, At, B1); BAR; }
  if (wr == 0) BAR;
#undef SAI
#undef SBI
#undef STAGE
#undef LDA
#undef LDB
#undef MMA
#undef WAIT_V
#undef WAIT_L
#undef BAR
#undef SCHED
  if (EPI == EPI_SWIGLU) {
    u16* H = (u16*)(p.ws + OFF_HP);
    const int hc0 = (bcol >> 1) + wc * 32 + fr;
#pragma unroll
    for (int ai = 0; ai < 2; ++ai)
#pragma unroll
      for (int m = 0; m < 4; ++m)
#pragma unroll
        for (int j = 0; j < 4; ++j) {
          int row = brow + ai * 128 + wr * 64 + m * 16 + fq * 4 + j;
#pragma unroll
          for (int n = 0; n < 2; ++n) {
            float g = acc[ai][0][m][n][j], u = acc[ai][1][m][n][j];
            float h = g / (1.f + __expf(-g)) * u;
            H[(size_t)row * DFF + hc0 + n * 16] = f2bf(h);
          }
        }
  } else if (EPI == EPI_RESID) {
    float* x = p.out + O_X;
    const float* mod = (const float*)(p.ws + OFF_MOD);
#pragma unroll
    for (int ai = 0; ai < 2; ++ai)
#pragma unroll
      for (int m = 0; m < 4; ++m)
#pragma unroll
        for (int j = 0; j < 4; ++j) {
          int row = brow + ai * 128 + wr * 64 + m * 16 + fq * 4 + j;
          const float* gp = mod + (l * 3 + cond_of(row)) * 9216 + gchunk * 1024;
#pragma unroll
          for (int bj = 0; bj < 2; ++bj)
#pragma unroll
            for (int n = 0; n < 2; ++n) {
              int col = bcol + bj * 128 + wc * 32 + n * 16 + fr;
              size_t idx = (size_t)row * D + col;
              x[idx] = x[idx] + coef * gp[col] * acc[ai][bj][m][n][j];
            }
        }
  } else {
    u16* proj = (u16*)(p.ws + OFF_HP);
    const bool isctx = brow < NCTX;
    const int c0 = bcol + wc * 64;
    const float* rc = (const float*)(p.ws + OFF_ROPE);
    bool do_norm = false, do_rope = false;
    const float* ng = nullptr;
    float* o32 = nullptr; int ostr = 0;
    bool elementwise = false;
    if (EPI == EPI_MIX0) {
      if (c0 < 512) { do_norm = true; ng = p.in[I_L0 + L_X0]; do_rope = !isctx; }
      else if (c0 < 640) { do_norm = true; ng = p.in[I_L0 + L_X0] + 64; do_rope = !isctx; if (isctx) { o32 = p.out + O_K0 + (c0 - 512); ostr = 128; } }
      else if (c0 < 768) { if (isctx) { o32 = p.out + O_V0 + (c0 - 640); ostr = 128; } }
      else if (c0 >= 2304) elementwise = true;
    } else {
      if (c0 < 512) {}
      else if (c0 < 1024) { if (isctx) { o32 = p.out + O_KC1 + (c0 - 512); ostr = 512; } }
      else if (c0 < 1536) { if (isctx) { o32 = p.out + O_VC1 + (c0 - 1024); ostr = 512; } }
      else if (c0 < 2048) { do_rope = !isctx; }
      else if (c0 < 2176) { do_rope = !isctx; if (isctx) { o32 = p.out + O_KD1 + (c0 - 2048); ostr = 128; } }
      else { if (isctx) { o32 = p.out + O_VD1 + (c0 - 2176); ostr = 128; } }
    }
    if (elementwise) {
      float* gates = (float*)(p.ws + OFF_GATES);
      const float* gb = p.in[I_L0 + L_X1];
#pragma unroll
      for (int ai = 0; ai < 2; ++ai)
#pragma unroll
        for (int m = 0; m < 4; ++m)
#pragma unroll
          for (int j = 0; j < 4; ++j) {
            int row = brow + ai * 128 + wr * 64 + m * 16 + fq * 4 + j;
#pragma unroll
            for (int bj = 0; bj < 2; ++bj)
#pragma unroll
              for (int n = 0; n < 2; ++n) {
                int col = c0 + bj * 32 + n * 16 + fr;
                float v = acc[ai][bj][m][n][j];
                if (col < 2336) gates[(size_t)row * 32 + (col - 2304)] = v + gb[col - 2304];
                else if (col < P0N) proj[(size_t)row * PSTR + col] = f2bf(v);
              }
          }
    } else {
#pragma unroll
      for (int ai = 0; ai < 2; ++ai)
#pragma unroll
        for (int m = 0; m < 4; ++m)
#pragma unroll
          for (int j = 0; j < 4; ++j) {
            int row = brow + ai * 128 + wr * 64 + m * 16 + fq * 4 + j;
            float v0 = acc[ai][0][m][0][j], v1 = acc[ai][0][m][1][j], v2 = acc[ai][1][m][0][j], v3 = acc[ai][1][m][1][j];
            if (do_norm) {
              float ss = v0 * v0 + v1 * v1 + v2 * v2 + v3 * v3;
              ss = grp16_sum(ss);
              float rstd = rsqrtf(ss * (1.f / 64.f) + EPS);
              v0 = v0 * rstd * ng[fr]; v1 = v1 * rstd * ng[16 + fr]; v2 = v2 * rstd * ng[32 + fr]; v3 = v3 * rstd * ng[48 + fr];
            }
            if (do_rope) {
              int tk = (row - NCTX) & 1023;
              float ca = rc[tk * 32 + fr], sa = rc[32768 + tk * 32 + fr];
              float cb = rc[tk * 32 + 16 + fr], sb = rc[32768 + tk * 32 + 16 + fr];
              float a0 = v0 * ca - v2 * sa, a2 = v2 * ca + v0 * sa;
              float a1 = v1 * cb - v3 * sb, a3 = v3 * cb + v1 * sb;
              v0 = a0; v1 = a1; v2 = a2; v3 = a3;
            }
            u16* pr = proj + (size_t)row * PSTR + c0 + fr;
            pr[0] = f2bf(v0); pr[16] = f2bf(v1); pr[32] = f2bf(v2); pr[48] = f2bf(v3);
            if (o32) {
              float* o = o32 + (size_t)row * ostr + fr;
              o[0] = v0; o[16] = v1; o[32] = v2; o[48] = v3;
            }
          }
    }
  }
}

template <int EPI>
__device__ __forceinline__ void gemm_phase(const Params& p, const u16* A, const u16* Bt, int K, int nN, int l, int gchunk, float coef, u16* smem) {
  const int tid = get_tid();
  const int nM = MTOK / BM, nwg = nM * nN;
  for (int t = blockIdx.x; t < nwg; t += gridDim.x) {
    int wgid = t;
    { int q = nwg / NXCD, r = nwg % NXCD, xcd = wgid % NXCD, off = wgid / NXCD;
      wgid = (xcd < r ? xcd * (q + 1) : r * (q + 1) + (xcd - r) * q) + off; }
    int nig = WGM * nN, gid = wgid / nig, fm = gid * WGM, gsz = min(nM - fm, WGM);
    int pm = fm + ((wgid % nig) % gsz), pn = (wgid % nig) / gsz;
    gemm256_tile<EPI>(p, A, Bt, K, pm * BM, pn * BM, l, gchunk, coef, smem, tid);
  }
}

__device__ __forceinline__ void load_tile_bf16(float* dst, const u16* src, long rstride, float scale, int tid) {
  int r = tid >> 2, part = tid & 3;
  const uint4* s = (const uint4*)(src + (long)r * rstride + part * 16);
  uint4 a = s[0], b = s[1];
  float4* d = (float4*)(dst + r * TS + part * 16);
  d[0] = make_float4(bflo(a.x) * scale, bfhi(a.x) * scale, bflo(a.y) * scale, bfhi(a.y) * scale);
  d[1] = make_float4(bflo(a.z) * scale, bfhi(a.z) * scale, bflo(a.w) * scale, bfhi(a.w) * scale);
  d[2] = make_float4(bflo(b.x) * scale, bfhi(b.x) * scale, bflo(b.y) * scale, bfhi(b.y) * scale);
  d[3] = make_float4(bflo(b.z) * scale, bfhi(b.z) * scale, bflo(b.w) * scale, bfhi(b.w) * scale);
}
__device__ __forceinline__ void load_tile_f32(float* dst, const float* src, long rstride, int tid) {
  int r = tid >> 2, part = tid & 3;
  const float4* s = (const float4*)(src + (long)r * rstride + part * 16);
  float4* d = (float4*)(dst + r * TS + part * 16);
  d[0] = s[0]; d[1] = s[1]; d[2] = s[2]; d[3] = s[3];
}
__device__ __forceinline__ void qk_micro(const float* Qs, const float* Ks, int ty, int tx, float s[4][4]) {
#pragma unroll
  for (int i = 0; i < 4; ++i)
#pragma unroll
    for (int j = 0; j < 4; ++j) s[i][j] = 0.f;
#pragma unroll 2
  for (int d4 = 0; d4 < 16; ++d4) {
    float4 q[4], k[4];
#pragma unroll
    for (int i = 0; i < 4; ++i) q[i] = *(const float4*)(Qs + (ty * 4 + i) * TS + d4 * 4);
#pragma unroll
    for (int j = 0; j < 4; ++j) k[j] = *(const float4*)(Ks + (tx + 16 * j) * TS + d4 * 4);
#pragma unroll
    for (int i = 0; i < 4; ++i)
#pragma unroll
      for (int j = 0; j < 4; ++j)
        s[i][j] += q[i].x * k[j].x + q[i].y * k[j].y + q[i].z * k[j].z + q[i].w * k[j].w;
  }
}
__device__ __forceinline__ void pv_micro(const float* Ps, const float* Vs, int ty, int tx, float o[4][4]) {
#pragma unroll 2
  for (int s4 = 0; s4 < 16; ++s4) {
    float4 pp[4], v[4];
#pragma unroll
    for (int i = 0; i < 4; ++i) pp[i] = *(const float4*)(Ps + (ty * 4 + i) * TS + s4 * 4);
#pragma unroll
    for (int q = 0; q < 4; ++q) v[q] = *(const float4*)(Vs + (s4 * 4 + q) * TS + tx * 4);
#pragma unroll
    for (int i = 0; i < 4; ++i) {
      o[i][0] += pp[i].x * v[0].x + pp[i].y * v[1].x + pp[i].z * v[2].x + pp[i].w * v[3].x;
      o[i][1] += pp[i].x * v[0].y + pp[i].y * v[1].y + pp[i].z * v[2].y + pp[i].w * v[3].y;
      o[i][2] += pp[i].x * v[0].z + pp[i].y * v[1].z + pp[i].z * v[2].z + pp[i].w * v[3].z;
      o[i][3] += pp[i].x * v[0].w + pp[i].y * v[1].w + pp[i].z * v[2].w + pp[i].w * v[3].w;
    }
  }
}

struct AttnDesc {
  int qrow0, qcol, ocol;
  const float* ck; const float* cv; int cstride; int nctx;
  int krow0, nloc, kcol, vcol;
  int mode;
  int a0;
  int r0;
  const float* rpb;
  float sink; int has_sink;
};

__device__ __forceinline__ void attn_item(const Params& p, const AttnDesc& d, float* sm) {
  const int tid = get_tid(), half = tid >> 8, t = tid & 255, ty = t >> 4, tx = t & 15;
  const u16* proj = (const u16*)(p.ws + OFF_HP);
  float* Qs = sm + half * TILE_F; float* Ks = sm + 2 * TILE_F; float* Vs = sm + 3 * TILE_F; float* Ps = sm + (4 + half) * TILE_F;
  const int qrow = d.qrow0 + half * 64;
  __syncthreads();
  load_tile_bf16(Qs, proj + (size_t)qrow * PSTR + d.qcol, PSTR, 0.125f, t);
  float m_i[4], l_i[4], o[4][4];
#pragma unroll
  for (int i = 0; i < 4; ++i) {
    m_i[i] = d.has_sink ? d.sink : -1e30f;
    l_i[i] = d.has_sink ? 1.f : 0.f;
#pragma unroll
    for (int j = 0; j < 4; ++j) o[i][j] = 0.f;
  }
  const int ntiles = d.nctx + d.nloc;
  for (int tile = 0; tile < ntiles; ++tile) {
    __syncthreads();
    const int lt = tile - d.nctx;
    if (tile < d.nctx) {
      const float* src = (half ? d.cv : d.ck) + (size_t)tile * 64 * d.cstride;
      load_tile_f32(half ? Vs : Ks, src, d.cstride, t);
    } else {
      const u16* base = proj + (size_t)(d.krow0 + lt * 64) * PSTR;
      load_tile_bf16(half ? Vs : Ks, base + (half ? d.vcol : d.kcol), PSTR, 1.f, t);
    }
    __syncthreads();
    float s[4][4];
    qk_micro(Qs, Ks, ty, tx, s);
    if (lt >= 0 && d.mode == 1) {
      const int rq = d.a0 + half;
      const int kr = d.r0 + lt;
      const int rq0 = min(max(rq - 4, 0), 8);
      const bool rowok = (kr >= rq0) && (kr < rq0 + 8);
      const int dy = min(max(kr - rq + 7, 0), 14);
      const float* rp = d.rpb + dy * 31;
#pragma unroll
      for (int i = 0; i < 4; ++i) {
        int qc = ty * 4 + i;
        int ws = min(max(qc - 8, 0), 48);
#pragma unroll
        for (int j = 0; j < 4; ++j) {
          int kc = tx + 16 * j;
          bool ok = rowok && (kc >= ws) && (kc < ws + 16);
          int dx = min(max(kc - qc + 15, 0), 30);
          s[i][j] = ok ? s[i][j] + rp[dx] : -1e30f;
        }
      }
    } else if (lt >= 0 && d.mode == 2) {
      int off = d.a0 + lt * 64 - half * 64;
#pragma unroll
      for (int i = 0; i < 4; ++i)
#pragma unroll
        for (int j = 0; j < 4; ++j) {
          int dd = off + (tx + 16 * j) - (ty * 4 + i);
          bool ok = (dd <= 128) && (dd >= -128);
          s[i][j] = ok ? s[i][j] : -1e30f;
        }
    }
#pragma unroll
    for (int i = 0; i < 4; ++i) {
      float mx = fmaxf(fmaxf(s[i][0], s[i][1]), fmaxf(s[i][2], s[i][3]));
      mx = grp16_max(mx);
      float mn = fmaxf(m_i[i], mx);
      float alpha = expf(m_i[i] - mn);
      float rs = 0.f;
#pragma unroll
      for (int j = 0; j < 4; ++j) {
        float pj = expf(s[i][j] - mn);
        rs += pj;
        Ps[(ty * 4 + i) * TS + tx + 16 * j] = pj;
      }
      rs = grp16_sum(rs);
      l_i[i] = l_i[i] * alpha + rs;
      m_i[i] = mn;
#pragma unroll
      for (int j = 0; j < 4; ++j) o[i][j] *= alpha;
    }
    __syncthreads();
    pv_micro(Ps, Vs, ty, tx, o);
  }
  u16* ymix = (u16*)(p.ws + OFF_YMIX);
#pragma unroll
  for (int i = 0; i < 4; ++i) {
    float inv = 1.f / l_i[i];
    uint2 ov = make_uint2(pack2(o[i][0] * inv, o[i][1] * inv), pack2(o[i][2] * inv, o[i][3] * inv));
    *(uint2*)(ymix + (size_t)(qrow + ty * 4 + i) * D + d.ocol + tx * 4) = ov;
  }
}

__device__ __forceinline__ int st_slot(int isctx, int b, int dir, int head, int cc) {
  int ch = (b * 2 + dir) * 8 + head;
  return isctx ? (ch * 4 + cc) : (2048 + ch * 16 + cc);
}

__device__ __forceinline__ void mlstm_state_item(const Params& p, int isctx, int b, int head, float* sm) {
  const int tid = get_tid(), dir = tid >> 8, t = tid & 255, ty = t >> 4, tx = t & 15, lane = t & 63;
  const u16* proj = (const u16*)(p.ws + OFF_HP);
  const float* gates = (const float*)(p.ws + OFF_GATES);
  float* stC = (float*)(p.ws + OFF_STC);
  float* stn = (float*)(p.ws + OFF_STN);
  float* stm = (float*)(p.ws + OFF_STM);
  float* Ks = sm + (dir * 2) * TILE_F; float* Vs = sm + (dir * 2 + 1) * TILE_F;
  float* sws = sm + 8 * TILE_F + dir * 256;
  float* sn = sws + 64;
  float* ssc = sn + 64;
  const int nc = isctx ? 4 : 16, L = isctx ? 256 : 1024;
  const int seq0 = isctx ? b * 256 : NCTX + b * 1024;
  float c[4][4];
  float m;
  __syncthreads();
  if (isctx) {
#pragma unroll
    for (int i = 0; i < 4; ++i)
#pragma unroll
      for (int j = 0; j < 4; ++j) c[i][j] = 0.f;
    if (t < 64) sn[t] = 0.f;
    m = 0.f;
  } else {
    int ch = (b * 2 + dir) * 8 + head;
    const float* C0 = p.in[I_SC] + (size_t)ch * 4096;
#pragma unroll
    for (int i = 0; i < 4; ++i) {
      float4 v = *(const float4*)(C0 + (ty * 4 + i) * 64 + tx * 4);
      c[i][0] = v.x; c[i][1] = v.y; c[i][2] = v.z; c[i][3] = v.w;
    }
    if (t < 64) sn[t] = p.in[I_SN][ch * 64 + t];
    m = p.in[I_SM][ch];
  }
  for (int cc = 0; cc < nc; ++cc) {
    __syncthreads();
    const int slot = st_slot(isctx, b, dir, head, cc);
#pragma unroll
    for (int i = 0; i < 4; ++i)
      *(float4*)(stC + (size_t)slot * 4096 + (ty * 4 + i) * 64 + tx * 4) = make_float4(c[i][0], c[i][1], c[i][2], c[i][3]);
    if (t < 64) stn[slot * 64 + t] = sn[t];
    if (t == 0) stm[slot] = m;
    const int tok0 = dir ? (L - 1 - cc * 64) : cc * 64;
    const long rs = dir ? -(long)PSTR : (long)PSTR;
    const u16* base = proj + (size_t)(seq0 + tok0) * PSTR;
    load_tile_bf16(Ks, base + 1280 + head * 64, rs, 0.125f, t);
    load_tile_bf16(Vs, base + 1792 + head * 64, rs, 1.f, t);
    if (t < 64) {
      int tr = seq0 + (dir ? tok0 - lane : tok0 + lane);
      float li = gates[(size_t)tr * 32 + (dir * 2) * 8 + head];
      float fp = gates[(size_t)tr * 32 + (dir * 2 + 1) * 8 + head];
      float lf = logsigmoidf_(fp);
      float bb = wave_scan_add(lf, lane);
      float a = li - bb;
      float amax = wave_max(a);
      float blast = __shfl(bb, 63);
      float mnew = blast + fmaxf(m, amax);
      sws[lane] = expf(blast + a - mnew);
      if (lane == 0) { ssc[0] = expf(blast + m - mnew); ssc[1] = mnew; }
    }
    __syncthreads();
    const float wc = ssc[0];
    m = ssc[1];
#pragma unroll
    for (int i = 0; i < 4; ++i)
#pragma unroll
      for (int j = 0; j < 4; ++j) c[i][j] *= wc;
    float nacc = 0.f;
#pragma unroll 4
    for (int s = 0; s < 64; ++s) {
      float w = sws[s];
      float4 kk = *(const float4*)(Ks + s * TS + ty * 4);
      float4 vv = *(const float4*)(Vs + s * TS + tx * 4);
      float k0 = kk.x * w, k1 = kk.y * w, k2 = kk.z * w, k3 = kk.w * w;
      c[0][0] += k0 * vv.x; c[0][1] += k0 * vv.y; c[0][2] += k0 * vv.z; c[0][3] += k0 * vv.w;
      c[1][0] += k1 * vv.x; c[1][1] += k1 * vv.y; c[1][2] += k1 * vv.z; c[1][3] += k1 * vv.w;
      c[2][0] += k2 * vv.x; c[2][1] += k2 * vv.y; c[2][2] += k2 * vv.z; c[2][3] += k2 * vv.w;
      c[3][0] += k3 * vv.x; c[3][1] += k3 * vv.y; c[3][2] += k3 * vv.z; c[3][3] += k3 * vv.w;
      if (t < 64) nacc += w * Ks[s * TS + t];
    }
    if (t < 64) sn[t] = wc * sn[t] + nacc;
  }
  __syncthreads();
  if (isctx) {
    int ch = (b * 2 + dir) * 8 + head;
    float* Co = p.out + O_C + (size_t)ch * 4096;
#pragma unroll
    for (int i = 0; i < 4; ++i)
      *(float4*)(Co + (ty * 4 + i) * 64 + tx * 4) = make_float4(c[i][0], c[i][1], c[i][2], c[i][3]);
    if (t < 64) p.out[O_N + ch * 64 + t] = sn[t];
    if (t == 0) p.out[O_M + ch] = m;
  }
}

__device__ __forceinline__ void mlstm_out_item(const Params& p, int isctx, int b, int head, int c, float* sm) {
  const int tid = get_tid(), dir = tid >> 8, t = tid & 255, ty = t >> 4, tx = t & 15, lane = t & 63;
  const u16* proj = (const u16*)(p.ws + OFF_HP);
  const float* gates = (const float*)(p.ws + OFF_GATES);
  const float* stC = (const float*)(p.ws + OFF_STC);
  const float* stn = (const float*)(p.ws + OFF_STN);
  const float* stm = (const float*)(p.ws + OFF_STM);
  float* Qs = sm + (dir * 4) * TILE_F; float* KCs = Qs + TILE_F; float* Vs = Qs + 2 * TILE_F; float* Ws = Qs + 3 * TILE_F;
  float* Ws1 = sm + 7 * TILE_F;
  float* sa = sm + 8 * TILE_F + dir * 256;
  float* sM = sa + 64;
  float* sb = sM + 64;
  float* sn = sb + 64;
  const int nc = isctx ? 4 : 16;
  const int mb = (isctx ? b * 256 : NCTX + b * 1024) + c * 64;
  const int cc = dir ? nc - 1 - c : c;
  const int slot = st_slot(isctx, b, dir, head, cc);
  const float m0 = stm[slot];
  __syncthreads();
  const long rs = dir ? -(long)PSTR : (long)PSTR;
  const u16* base = proj + (size_t)(mb + (dir ? 63 : 0)) * PSTR;
  load_tile_bf16(Qs, base + 768 + head * 64, rs, 1.f, t);
  load_tile_bf16(KCs, base + 1280 + head * 64, rs, 0.125f, t);
  load_tile_bf16(Vs, base + 1792 + head * 64, rs, 1.f, t);
  if (t < 64) {
    int tr = mb + (dir ? 63 - lane : lane);
    float li = gates[(size_t)tr * 32 + (dir * 2) * 8 + head];
    float fp = gates[(size_t)tr * 32 + (dir * 2 + 1) * 8 + head];
    float lf = logsigmoidf_(fp);
    float bb = wave_scan_add(lf, lane);
    float a = li - bb;
    float pm = wave_scan_max(a, lane);
    sa[lane] = a; sM[lane] = fmaxf(m0, pm); sb[lane] = bb;
    sn[lane] = stn[slot * 64 + lane];
  }
  __syncthreads();
  float hd[4][4];
  {
    float s[4][4];
    qk_micro(Qs, KCs, ty, tx, s);
    float rsum[4];
#pragma unroll
    for (int i = 0; i < 4; ++i) {
      int tq = ty * 4 + i;
      float Mt = sM[tq];
      float r = 0.f;
#pragma unroll
      for (int j = 0; j < 4; ++j) {
        int sidx = tx + 16 * j;
        float w = (sidx <= tq) ? expf(sa[sidx] - Mt) * s[i][j] : 0.f;
        Ws[tq * TS + sidx] = w;
        r += w;
      }
      rsum[i] = grp16_sum(r);
    }
    __syncthreads();
    load_tile_f32(KCs, stC + (size_t)slot * 4096, 64, t);
    __syncthreads();
    float num[4][4], qc[4][4];
#pragma unroll
    for (int i = 0; i < 4; ++i)
#pragma unroll
      for (int j = 0; j < 4; ++j) { num[i][j] = 0.f; qc[i][j] = 0.f; }
    pv_micro(Ws, Vs, ty, tx, num);
    pv_micro(Qs, KCs, ty, tx, qc);
#pragma unroll
    for (int i = 0; i < 4; ++i) {
      int tq = ty * 4 + i;
      float4 q4 = *(const float4*)(Qs + tq * TS + tx * 4);
      float4 n4 = *(const float4*)(sn + tx * 4);
      float qn = q4.x * n4.x + q4.y * n4.y + q4.z * n4.z + q4.w * n4.w;
      qn = grp16_sum(qn);
      float Mt = sM[tq];
      float wi = expf(m0 - Mt);
      float den = rsum[i] + wi * qn;
      float mt = sb[tq] + Mt;
      float dn = fmaxf(fabsf(den), expf(-mt));
      float inv = 1.f / dn;
#pragma unroll
      for (int j = 0; j < 4; ++j) hd[i][j] = (num[i][j] + wi * qc[i][j]) * inv;
    }
  }
  __syncthreads();
  if (dir == 1) {
#pragma unroll
    for (int i = 0; i < 4; ++i)
      *(float4*)(Ws1 + (63 - (ty * 4 + i)) * TS + tx * 4) = make_float4(hd[i][0], hd[i][1], hd[i][2], hd[i][3]);
  }
  __syncthreads();
  if (dir == 0) {
    const float* hg = p.in[I_L0 + L_X2] + head * 64 + tx * 4;
    u16* ymix = (u16*)(p.ws + OFF_YMIX);
#pragma unroll
    for (int i = 0; i < 4; ++i) {
      float4 v = *(const float4*)(Ws1 + (ty * 4 + i) * TS + tx * 4);
      float h0 = hd[i][0] + v.x, h1 = hd[i][1] + v.y, h2 = hd[i][2] + v.z, h3 = hd[i][3] + v.w;
      float ss = h0 * h0 + h1 * h1 + h2 * h2 + h3 * h3;
      ss = grp16_sum(ss);
      float rstd = rsqrtf(ss * (1.f / 64.f) + EPS);
      int tr = mb + ty * 4 + i;
      uint2 ob = *(const uint2*)(proj + (size_t)tr * PSTR + 2336 + head * 64 + tx * 4);
      float y0 = sigmoidf_(bflo(ob.x)) * (h0 * rstd * hg[0]);
      float y1 = sigmoidf_(bfhi(ob.x)) * (h1 * rstd * hg[1]);
      float y2 = sigmoidf_(bflo(ob.y)) * (h2 * rstd * hg[2]);
      float y3 = sigmoidf_(bfhi(ob.y)) * (h3 * rstd * hg[3]);
      *(uint2*)(ymix + (size_t)tr * D + 512 + head * 64 + tx * 4) = make_uint2(pack2(y0, y1), pack2(y2, y3));
    }
  }
}

__device__ __forceinline__ int next_item(int* ctr, int* s_item) {
  __syncthreads();
  if (get_tid() == 0) *s_item = atomicAdd(ctr, 1);
  __syncthreads();
  return *s_item;
}

__device__ __forceinline__ void mix0_phase_a(const Params& p, float* sm, int* s_item) {
  int* ctr = (int*)(p.ws + OFF_CTR) + 0;
  for (;;) {
    int it = next_item(ctr, s_item);
    if (it >= 912) break;
    if (it >= 128 && it < 144) {
      int v = it - 128; int b = v >> 3, head = v & 7;
      mlstm_state_item(p, 0, b, head, sm);
    } else if (it >= 656) {
      int v = it - 656; int b = v >> 3, head = v & 7;
      mlstm_state_item(p, 1, b, head, sm);
    } else {
      AttnDesc d;
      d.mode = 0; d.a0 = 0; d.r0 = 0; d.rpb = nullptr; d.sink = 0.f; d.has_sink = 0;
      if (it < 128) {
        int b = it >> 6, h = (it >> 3) & 7, qb = it & 7;
        d.qrow0 = NCTX + b * 1024 + qb * 128; d.qcol = h * 64; d.ocol = h * 64;
        d.ck = p.in[I_C0K] + (size_t)b * 256 * 128 + (h >> 2) * 64; d.cv = p.in[I_C0V] + (size_t)b * 256 * 128 + (h >> 2) * 64;
        d.cstride = 128; d.nctx = 4;
        d.krow0 = NCTX + b * 1024; d.nloc = 16; d.kcol = 512 + (h >> 2) * 64; d.vcol = 640 + (h >> 2) * 64;
      } else {
        int v = it - 144; int b = v >> 4, h = (v >> 1) & 7, qb = v & 1;
        d.qrow0 = b * 256 + qb * 128; d.qcol = h * 64; d.ocol = h * 64;
        d.ck = nullptr; d.cv = nullptr; d.cstride = 0; d.nctx = 0;
        d.krow0 = b * 256; d.nloc = 4; d.kcol = 512 + (h >> 2) * 64; d.vcol = 640 + (h >> 2) * 64;
      }
      attn_item(p, d, sm);
    }
  }
}

__device__ __forceinline__ void mix0_phase_b(const Params& p, float* sm, int* s_item) {
  int* ctr = (int*)(p.ws + OFF_CTR) + 1;
  for (;;) {
    int it = next_item(ctr, s_item);
    if (it >= 1280) break;
    if (it < 256) {
      int b = it >> 7, head = (it >> 4) & 7, c = it & 15;
      mlstm_out_item(p, 0, b, head, c, sm);
    } else {
      int v = it - 256; int b = v >> 5, head = (v >> 2) & 7, c = v & 3;
      mlstm_out_item(p, 1, b, head, c, sm);
    }
  }
}

__device__ __forceinline__ void mix1_phase(const Params& p, float* sm, int* s_item) {
  int* ctr = (int*)(p.ws + OFF_CTR) + 2;
  const float* sink = p.in[I_L1 + L_X1];
  for (;;) {
    int it = next_item(ctr, s_item);
    if (it >= 1280) break;
    AttnDesc d;
    d.mode = 0; d.a0 = 0; d.r0 = 0; d.rpb = nullptr; d.sink = 0.f; d.has_sink = 0;
    if (it < 128) {
      int b = it >> 6, h = (it >> 3) & 7, r = (it & 7) * 2;
      int r0 = min(max(r - 4, 0), 8);
      int r1 = min(max(r + 1 - 4, 0), 8) + 8;
      d.qrow0 = NCTX + b * 1024 + r * 64; d.qcol = h * 64; d.ocol = h * 64;
      d.ck = p.in[I_NAK] + (size_t)b * 256 * 512 + h * 64; d.cv = p.in[I_NAV] + (size_t)b * 256 * 512 + h * 64;
      d.cstride = 512; d.nctx = 4;
      d.krow0 = NCTX + b * 1024 + r0 * 64; d.nloc = r1 - r0; d.kcol = 512 + h * 64; d.vcol = 1024 + h * 64;
      d.mode = 1; d.a0 = r; d.r0 = r0; d.rpb = p.in[I_L1 + L_X0] + h * 15 * 31;
    } else if (it < 256) {
      int v = it - 128; int b = v >> 6, h = (v >> 3) & 7, qb = v & 7;
      int t0 = qb * 128;
      int s0 = max(t0 - 128, 0);
      int s1 = min(t0 + 256, 1024);
      d.qrow0 = NCTX + b * 1024 + t0; d.qcol = 1536 + h * 64; d.ocol = 512 + h * 64;
      d.ck = p.in[I_SWK] + (size_t)b * 256 * 128 + (h >> 2) * 64; d.cv = p.in[I_SWV] + (size_t)b * 256 * 128 + (h >> 2) * 64;
      d.cstride = 128; d.nctx = 4;
      d.krow0 = NCTX + b * 1024 + s0; d.nloc = (s1 - s0) >> 6; d.kcol = 2048 + (h >> 2) * 64; d.vcol = 2176 + (h >> 2) * 64;
      d.mode = 2; d.a0 = s0 - t0;
      d.sink = sink[h]; d.has_sink = 1;
    } else if (it < 768) {
      int v = it - 256; int b = v >> 4, h = (v >> 1) & 7, qb = v & 1;
      d.qrow0 = b * 256 + qb * 128; d.qcol = h * 64; d.ocol = h * 64;
      d.ck = nullptr; d.cv = nullptr; d.cstride = 0; d.nctx = 0;
      d.krow0 = b * 256; d.nloc = 4; d.kcol = 512 + h * 64; d.vcol = 1024 + h * 64;
    } else {
      int v = it - 768; int b = v >> 4, h = (v >> 1) & 7, qb = v & 1;
      d.qrow0 = b * 256 + qb * 128; d.qcol = 1536 + h * 64; d.ocol = 512 + h * 64;
      d.ck = nullptr; d.cv = nullptr; d.cstride = 0; d.nctx = 0;
      d.krow0 = b * 256; d.nloc = 4; d.kcol = 2048 + (h >> 2) * 64; d.vcol = 2176 + (h >> 2) * 64;
      d.sink = sink[h]; d.has_sink = 1;
    }
    attn_item(p, d, sm);
  }
}

#define XB_TMO      128
#define XB_XCNT(j)  (256  + 64 * (j))
#define XB_XSUB(j)  (1280 + 64 * (j))
#define XB_XGEN(j)  (2304 + 64 * (j))
#define XB_TOP      3328
#define XB_TOPGEN   3392
#define XCD_BAR_WORDS 3456
#define XB_SPIN_CAP (1u << 22)
__device__ __forceinline__ unsigned xb_ld(unsigned* p) { return __hip_atomic_load(p, __ATOMIC_RELAXED, __HIP_MEMORY_SCOPE_AGENT); }
__device__ __forceinline__ unsigned xb_add(unsigned* p, unsigned v) { return __hip_atomic_fetch_add(p, v, __ATOMIC_RELAXED, __HIP_MEMORY_SCOPE_AGENT); }
__device__ __forceinline__ unsigned xb_xcc_id() { return (unsigned)__builtin_amdgcn_s_getreg((3 << 11) | 20) & 0xFu; }
#define XB_SPIN(cond, bar) do { unsigned _sp = 0; while (cond) { __builtin_amdgcn_s_sleep(1); \
    if ((++_sp & 255u) == 0u) { if (xb_ld(&(bar)[XB_TMO])) break; if (_sp > XB_SPIN_CAP) { atomicAdd(&(bar)[XB_TMO], 1u); break; } } } } while (0)
struct XcdBarrier { unsigned* bar; unsigned x; volatile LAS unsigned* st; };
__device__ __forceinline__ XcdBarrier xcd_barrier_post(unsigned* bar, volatile LAS unsigned* st) {
  XcdBarrier b; b.bar = bar; b.x = xb_xcc_id(); b.st = st;
  if (threadIdx.x == 0) (void)xb_add(&bar[XB_XCNT(b.x)], 1u);
  return b;
}
__device__ __forceinline__ void xcd_barrier_complete(unsigned* bar, unsigned x, unsigned& nloc, unsigned& nx) {
  const unsigned G = gridDim.x * gridDim.y * gridDim.z;
  unsigned sum, cnt, mine, sp = 0u;
  for (;;) {
    sum = 0u; cnt = 0u; mine = 0u;
#pragma unroll
    for (unsigned j = 0; j < 16; ++j) { const unsigned c = xb_ld(&bar[XB_XCNT(j)]); sum += c; cnt += (c > 0u) ? 1u : 0u; mine = (j == x) ? c : mine; }
    if (sum == G) break;
    __builtin_amdgcn_s_sleep(1);
    if ((++sp & 255u) == 0u) { if (xb_ld(&bar[XB_TMO])) break; if (sp > XB_SPIN_CAP) { atomicAdd(&bar[XB_TMO], 1u); break; } }
  }
  nloc = mine > 0u ? mine : 1u; nx = cnt > 0u ? cnt : 1u;
}
__device__ __forceinline__ void xcd_barrier(const XcdBarrier& b) {
  asm volatile("s_waitcnt vmcnt(0)" ::: "memory");
  __syncthreads();
  if (threadIdx.x == 0) {
    unsigned* bar = b.bar;
    __builtin_amdgcn_s_waitcnt(0);
    unsigned nloc = b.st[0], nx = b.st[1];
    if (nloc == 0u) { xcd_barrier_complete(bar, b.x, nloc, nx); b.st[0] = nloc; b.st[1] = nx; }
    const unsigned old = xb_add(&bar[XB_XSUB(b.x)], 1u);
    const unsigned gen = old / nloc;
    if (old + 1u == (gen + 1u) * nloc) {
      __builtin_amdgcn_fence(__ATOMIC_RELEASE, "agent");
      asm volatile("s_waitcnt vmcnt(0)" ::: "memory");
      const unsigned og = xb_add(&bar[XB_TOP], 1u);
      const unsigned tg = og / nx;
      if (og + 1u == (tg + 1u) * nx) xb_add(&bar[XB_TOPGEN], 1u);
      else XB_SPIN(xb_ld(&bar[XB_TOPGEN]) == tg, bar);
      __builtin_amdgcn_fence(__ATOMIC_ACQUIRE, "agent");
      xb_add(&bar[XB_XGEN(b.x)], 1u);
      asm volatile("s_waitcnt vmcnt(0)" ::: "memory");
    } else {
      XB_SPIN(xb_ld(&bar[XB_XGEN(b.x)]) == gen, bar);
      __builtin_amdgcn_fence(__ATOMIC_ACQUIRE, "agent");
      asm volatile("s_waitcnt vmcnt(0)" ::: "memory");
    }
  }
  __syncthreads();
}

constexpr int NPHASE = 23;

__device__ __forceinline__ void run_phase(const Params& p, int ph, char* smem, int* s_item) {
  float* smf = (float*)smem;
  u16* smh = (u16*)smem;
  const u16* xn = (const u16*)(p.ws + OFF_XN);
  const u16* hp = (const u16*)(p.ws + OFF_HP);
  const u16* ymix = (const u16*)(p.ws + OFF_YMIX);
  if (ph == 0) { prep_phase(p, smf); return; }
  if (ph == 22) { norm_phase(p, 0, 3); return; }
  int l = (ph - 1) / 11, q = (ph - 1) % 11;
  if (l == 1 && q >= 6) q += 1;
  if (q == 0 || q == 3 || q == 8) { norm_phase(p, l, q == 0 ? 0 : (q == 3 ? 1 : 2)); return; }
  if (q == 1 || q == 9) {
    const int f = (q == 9) ? 1 : 0;
    gemm_phase<EPI_SWIGLU>(p, xn, (const u16*)(p.ws + OFF_WIN + (l * 2 + f) * SZ_WIN), 1024, 22, l, 0, 0.f, smh);
    return;
  }
  if (q == 2 || q == 7 || q == 10) {
    const u16* A = (q == 7) ? ymix : hp;
    const u16* Bt = (q == 7) ? (const u16*)(p.ws + OFF_WMO + (size_t)l * D * D * 2)
                             : (const u16*)(p.ws + OFF_WOUT + (l * 2 + (q == 10 ? 1 : 0)) * SZ_WOUT);
    const int K = (q == 7) ? 1024 : DFF;
    const int gch = (q == 2) ? 2 : (q == 7 ? 5 : 8);
    const float coef = (q == 7) ? 1.f : 0.5f;
    gemm_phase<EPI_RESID>(p, A, Bt, K, 4, l, gch, coef, smh);
    return;
  }
  if (q == 4) {
    if (l == 0) gemm_phase<EPI_MIX0>(p, xn, (const u16*)(p.ws + OFF_WMI0), 1024, 12, l, 0, 0.f, smh);
    else gemm_phase<EPI_MIX1>(p, xn, (const u16*)(p.ws + OFF_WMI1), 1024, 9, l, 0, 0.f, smh);
    return;
  }
  if (q == 5) { if (l == 0) mix0_phase_a(p, smf, s_item); else mix1_phase(p, smf, s_item); return; }
  if (q == 6) { mix0_phase_b(p, smf, s_item); return; }
}

__global__ void __launch_bounds__(512, 2) mega(Params p, int ph0, int ph1) {
  extern __shared__ __attribute__((aligned(16))) char smem[];
  int* s_item_p = (int*)(smem + SMEM_BYTES);
  uint4* xb_words_p = (uint4*)(smem + SMEM_BYTES + 16);
  if (threadIdx.x == 0) *xb_words_p = make_uint4(0u, 0u, 0u, 0u);
  __syncthreads();
  XcdBarrier xb = xcd_barrier_post((unsigned*)(p.ws + OFF_BAR), (volatile LAS unsigned*)xb_words_p);
  if (ph1 < 0) cg::this_grid().sync();
  for (int ph = ph0; ph < ph1; ++ph) {
    if (ph > ph0) xcd_barrier(xb);
    run_phase(p, ph, smem, s_item_p);
  }
}

extern "C" void kernel_launch(void* const* d_in, const int* in_sizes, int n_in, void* d_out, int out_size, void* d_ws,
                              size_t ws_size, hipStream_t stream) {
  static int grid_blocks = 0;
  if (!grid_blocks) {
    int dev = 0, cus = 0, per_cu = 0;
    hipGetDevice(&dev);
    hipDeviceGetAttribute(&cus, hipDeviceAttributeMultiprocessorCount, dev);
    hipFuncSetAttribute((const void*)mega, hipFuncAttributeMaxDynamicSharedMemorySize, DYN_LDS);
    hipOccupancyMaxActiveBlocksPerMultiprocessor(&per_cu, mega, NTH, DYN_LDS);
    if (per_cu > 1) per_cu = 1;
    if (per_cu < 1) per_cu = 1;
    grid_blocks = cus * per_cu;
  }
  if (ws_size < WS_TOTAL) fprintf(stderr, "workspace too small: %zu < %zu\n", ws_size, (size_t)WS_TOTAL);
  Params p{};
  for (int i = 0; i < 37; ++i) p.in[i] = (const float*)d_in[i];
  p.out = (float*)d_out;
  p.ws = (char*)d_ws;
  hipMemsetAsync((char*)d_ws + OFF_CTR, 0, 16384, stream);
#if SINGLE_LAUNCH
  int ph0 = 0, ph1 = NPHASE;
  void* args[] = {&p, &ph0, &ph1};
  hipError_t e = hipLaunchCooperativeKernel((void*)mega, dim3(grid_blocks), dim3(NTH), args, DYN_LDS, stream);
  if (e != hipSuccess) fprintf(stderr, "cooperative launch failed: %s (grid %d)\n", hipGetErrorString(e), grid_blocks);
#else
  for (int ph = 0; ph < NPHASE; ++ph) mega<<<grid_blocks, NTH, DYN_LDS, stream>>>(p, ph, ph + 1);
#endif
}
```

```cpp
#include <hip/hip_runtime.h>
#include <hip/hip_cooperative_groups.h>
#include <cstdio>
namespace cg = cooperative_groups;

#ifndef REP_MASK
#define REP_MASK 0
#endif
#ifndef SINGLE_LAUNCH
#define SINGLE_LAUNCH 1
#endif

typedef unsigned short u16;
typedef __attribute__((ext_vector_type(8))) short bf16x8;
typedef __attribute__((ext_vector_type(4))) float f32x4;
typedef __attribute__((ext_vector_type(4))) unsigned u32x4;
#define LAS __attribute__((address_space(3)))

constexpr int D = 1024, NCTX = 8192, MTOK = 10240;
constexpr int DFF = 2816, NFF = 5632;
constexpr int P0N = 2848, P0P = 3072, P1N = 2304;
constexpr int PSTR = 2944;
constexpr float EPS = 1e-6f;

enum { I_XP = 0, I_XS, I_C0K, I_C0V, I_SC, I_SN, I_SM, I_NAK, I_NAV, I_SWK, I_SWV, I_C, I_CCTX, I_NF,
       I_L0 = 14, I_L1 = 26 };
enum { L_ADAW = 0, L_ADAB, L_NORM, L_F1I, L_F1O, L_F2I, L_F2O, L_MI, L_MO, L_X0, L_X1, L_X2 };

constexpr size_t O_X = 0, O_K0 = 10485760, O_V0 = 11534336, O_C = 12582912, O_N = 14680064, O_M = 14712832,
                 O_KC1 = 14713344, O_VC1 = 18907648, O_KD1 = 23101952, O_VD1 = 24150528;

constexpr size_t SZ_WIN = (size_t)NFF * D * 2;
constexpr size_t SZ_WOUT = (size_t)D * DFF * 2;
constexpr size_t OFF_WIN = 0;
constexpr size_t OFF_WOUT = OFF_WIN + 4 * SZ_WIN;
constexpr size_t OFF_WMI0 = OFF_WOUT + 4 * SZ_WOUT;
constexpr size_t OFF_WMI1 = OFF_WMI0 + (size_t)P0P * D * 2;
constexpr size_t OFF_WMO = OFF_WMI1 + (size_t)P1N * D * 2;
constexpr size_t OFF_MOD = OFF_WMO + 2 * (size_t)D * D * 2;
constexpr size_t OFF_ROPE = OFF_MOD + 2 * 3 * 9216 * 4;
constexpr size_t OFF_CTR = OFF_ROPE + 2 * 1024 * 32 * 4;
constexpr size_t OFF_BAR = OFF_CTR + 256;
constexpr size_t OFF_XN = OFF_BAR + 16384 - 256;
constexpr size_t OFF_YMIX = OFF_XN + (size_t)MTOK * D * 2;
constexpr size_t OFF_HP = OFF_YMIX + (size_t)MTOK * D * 2;
constexpr size_t OFF_GATES = OFF_HP + (size_t)MTOK * PSTR * 2;
constexpr size_t OFF_STC = OFF_GATES + (size_t)MTOK * 32 * 4;
constexpr size_t OFF_STN = OFF_STC + (size_t)2560 * 4096 * 4;
constexpr size_t OFF_STM = OFF_STN + (size_t)2560 * 64 * 4;
constexpr size_t WS_TOTAL = OFF_STM + 2560 * 4;

constexpr int TS = 68;
constexpr int TILE_F = 64 * TS;
constexpr int SMEM_BYTES = 8 * TILE_F * 4 + 4096;
constexpr int NTH = 512;
constexpr int DYN_LDS = SMEM_BYTES + 32;

struct Params {
  const float* in[37];
  float* out;
  char* ws;
};
typedef const __attribute__((address_space(4))) Params* CP;

__device__ __forceinline__ int get_tid() { int t = threadIdx.x; asm volatile("" : "+v"(t)); return t; }
__device__ __forceinline__ u16 f2bf(float f) {
  unsigned u = __float_as_uint(f);
  u += 0x7fffu + ((u >> 16) & 1u);
  return (u16)(u >> 16);
}
__device__ __forceinline__ unsigned pack2(float a, float b) { return (unsigned)f2bf(a) | ((unsigned)f2bf(b) << 16); }
__device__ __forceinline__ float bflo(unsigned x) { return __uint_as_float(x << 16); }
__device__ __forceinline__ float bfhi(unsigned x) { return __uint_as_float(x & 0xffff0000u); }
__device__ __forceinline__ float grp16_sum(float v) {
  v += __shfl_xor(v, 1); v += __shfl_xor(v, 2); v += __shfl_xor(v, 4); v += __shfl_xor(v, 8); return v;
}
__device__ __forceinline__ float grp16_max(float v) {
  v = fmaxf(v, __shfl_xor(v, 1)); v = fmaxf(v, __shfl_xor(v, 2)); v = fmaxf(v, __shfl_xor(v, 4)); v = fmaxf(v, __shfl_xor(v, 8)); return v;
}
__device__ __forceinline__ float wave_sum(float v) {
  for (int o = 32; o; o >>= 1) v += __shfl_xor(v, o);
  return v;
}
__device__ __forceinline__ float wave_max(float v) {
  for (int o = 32; o; o >>= 1) v = fmaxf(v, __shfl_xor(v, o));
  return v;
}
__device__ __forceinline__ float wave_scan_add(float v, int lane) {
  for (int o = 1; o < 64; o <<= 1) { float t = __shfl_up(v, o); if (lane >= o) v += t; }
  return v;
}
__device__ __forceinline__ float wave_scan_max(float v, int lane) {
  for (int o = 1; o < 64; o <<= 1) { float t = __shfl_up(v, o); if (lane >= o) v = fmaxf(v, t); }
  return v;
}
__device__ __forceinline__ int cond_of(int row) { return row < NCTX ? 0 : 1 + ((row - NCTX) >> 10); }
__device__ __forceinline__ float sigmoidf_(float x) { return 1.f / (1.f + expf(-x)); }
__device__ __forceinline__ float logsigmoidf_(float x) { return fminf(x, 0.f) - log1pf(expf(-fabsf(x))); }

__device__ void conv_tile(const float* __restrict__ W, int K, int N, u16* __restrict__ Wt, int perm, int kt, int nt, float* T, int t, bool valid) {
  {
    int r = t >> 4, c4 = t & 15;
    int c = c4 * 4;
    int src;
    if (perm == 1) src = ((nt & 3) < 2 ? 0 : DFF) + (nt >> 2) * 128 + (nt & 1) * 64 + c;
    else if (perm == 2) {
      int bj = (nt & 3) >> 1, wc = (nt & 1) * 2 + (c >> 5), w = c & 31;
      src = (nt >> 2) * 256 + wc * 64 + bj * 32 + w;
    } else src = nt * 64 + c;
    bool ok = valid && (src < N);
#pragma unroll
    for (int ps = 0; ps < 4; ++ps) {
      int k = r + ps * 16;
      float4 v = make_float4(0.f, 0.f, 0.f, 0.f);
      if (ok) v = *(const float4*)(W + (size_t)(kt * 64 + k) * N + src);
      float* tt = T + k * 65 + c;
      tt[0] = v.x; tt[1] = v.y; tt[2] = v.z; tt[3] = v.w;
    }
  }
  __syncthreads();
  if (valid) {
    int n = t >> 2, kp = t & 3;
    unsigned o[8];
#pragma unroll
    for (int i = 0; i < 8; ++i) {
      float a = T[(kp * 16 + 2 * i) * 65 + n], b = T[(kp * 16 + 2 * i + 1) * 65 + n];
      o[i] = pack2(a, b);
    }
    uint4* dst = (uint4*)(Wt + (size_t)(nt * 64 + n) * K + kt * 64 + kp * 16);
    dst[0] = make_uint4(o[0], o[1], o[2], o[3]);
    dst[1] = make_uint4(o[4], o[5], o[6], o[7]);
  }
  __syncthreads();
}

__device__ void adaln_unit(CP p, int u, float* sm, int t, bool valid) {
  int l = u / 144, cg_ = u % 144;
  if (!valid) { l = 0; cg_ = 0; }
  const float* W = p->in[(l ? I_L1 : I_L0) + L_ADAW];
  const float* B = p->in[(l ? I_L1 : I_L0) + L_ADAB];
  float* sc = sm;
  float* red = sm + 3072;
  for (int i = t; i < 3072; i += 256) {
    int cnd = i >> 10, k = i & 1023;
    float v = (cnd == 0) ? p->in[I_CCTX][k] : p->in[I_C][(cnd - 1) * 1024 + k];
    sc[i] = v / (1.f + expf(-v));
  }
  __syncthreads();
  int kp = t >> 4, c4 = t & 15;
  float acc[3][4];
#pragma unroll
  for (int a = 0; a < 3; ++a)
#pragma unroll
    for (int e = 0; e < 4; ++e) acc[a][e] = 0.f;
  for (int kk = 0; kk < 64; ++kk) {
    int k = kp * 64 + kk;
    float4 w = *(const float4*)(W + (size_t)k * 9216 + cg_ * 64 + c4 * 4);
#pragma unroll
    for (int a = 0; a < 3; ++a) {
      float s = sc[a * 1024 + k];
      acc[a][0] += s * w.x; acc[a][1] += s * w.y; acc[a][2] += s * w.z; acc[a][3] += s * w.w;
    }
  }
#pragma unroll
  for (int a = 0; a < 3; ++a)
#pragma unroll
    for (int e = 0; e < 4; ++e) red[(kp * 3 + a) * 64 + c4 * 4 + e] = acc[a][e];
  __syncthreads();
  if (valid && t < 192) {
    int a = t >> 6, col = t & 63;
    float s = 0.f;
    for (int q = 0; q < 16; ++q) s += red[(q * 3 + a) * 64 + col];
    s += B[cg_ * 64 + col];
    float* mod = (float*)(p->ws + OFF_MOD);
    mod[(l * 3 + a) * 9216 + cg_ * 64 + col] = s;
  }
  __syncthreads();
}

__device__ __forceinline__ void prep_phase(CP p, float* sm) {
  const int tid = get_tid(), half = tid >> 8, t = tid & 255;
  float* smh = sm + half * 8192;
  constexpr int U_CONV = 10304, U_ADA = 288, U_ROPE = 64, U_COPY = 320;
  for (int ub = blockIdx.x * 2; ub < U_CONV; ub += gridDim.x * 2) {
    int u = ub + half;
    bool valid = u < U_CONV;
    if (!valid) u = 0;
    const float* W; u16* Wt; int K, N, perm, tt, ntn;
    if (u < 5632) {
      int mi = u / 1408; tt = u % 1408;
      int l = mi >> 1, f = mi & 1;
      W = p->in[(l ? I_L1 : I_L0) + (f ? L_F2I : L_F1I)];
      Wt = (u16*)(p->ws + OFF_WIN + mi * SZ_WIN);
      K = 1024; N = NFF; perm = 1; ntn = 88;
    } else if (u < 8448) {
      int v = u - 5632; int mi = v / 704; tt = v % 704;
      int l = mi >> 1, f = mi & 1;
      W = p->in[(l ? I_L1 : I_L0) + (f ? L_F2O : L_F1O)];
      Wt = (u16*)(p->ws + OFF_WOUT + mi * SZ_WOUT);
      K = DFF; N = 1024; perm = 0; ntn = 16;
    } else if (u < 9216) {
      tt = u - 8448; W = p->in[I_L0 + L_MI]; Wt = (u16*)(p->ws + OFF_WMI0); K = 1024; N = P0N; perm = 2; ntn = 48;
    } else if (u < 9792) {
      tt = u - 9216; W = p->in[I_L1 + L_MI]; Wt = (u16*)(p->ws + OFF_WMI1); K = 1024; N = P1N; perm = 2; ntn = 36;
    } else {
      int v = u - 9792; int l = v / 256; tt = v % 256;
      W = p->in[(l ? I_L1 : I_L0) + L_MO]; Wt = (u16*)(p->ws + OFF_WMO + (size_t)l * D * D * 2); K = 1024; N = 1024; perm = 0; ntn = 16;
    }
    int nt = tt % ntn, kt = tt / ntn;
    conv_tile(W, K, N, Wt, perm, kt, nt, smh, t, valid);
  }
  for (int ub = blockIdx.x * 2; ub < U_ADA; ub += gridDim.x * 2) {
    int u = ub + half;
    adaln_unit(p, u, smh, t, u < U_ADA);
  }
  for (int u = blockIdx.x; u < U_ROPE; u += gridDim.x) {
    int e = u * 512 + tid;
    int tk = e >> 5, i = e & 31;
    float pos = (i < 16) ? (float)(tk >> 6) : (float)(tk & 63);
    float fr = powf(10000.f, -(float)(i & 15) / 16.f);
    float ang = pos * fr;
    float* rc = (float*)(p->ws + OFF_ROPE);
    rc[e] = cosf(ang);
    rc[32768 + e] = sinf(ang);
  }
  for (int v = blockIdx.x; v < U_COPY; v += gridDim.x) {
    float4* dst = (float4*)(p->out + O_X);
#pragma unroll 4
    for (int i = 0; i < 16; ++i) {
      size_t idx = (size_t)v * 8192 + i * 512 + tid;
      float4 val = (idx < (size_t)NCTX * 256) ? ((const float4*)p->in[I_XP])[idx] : ((const float4*)p->in[I_XS])[idx - (size_t)NCTX * 256];
      dst[idx] = val;
    }
  }
}

__device__ __forceinline__ void norm_phase(CP p, int l, int which) {
  const int tid = get_tid(), lane = tid & 63, w = tid >> 6;
  float* x = p->out + O_X;
  const float* mod = (const float*)(p->ws + OFF_MOD);
  u16* xn = (u16*)(p->ws + OFF_XN);
  for (int row = blockIdx.x * 8 + w; row < MTOK; row += gridDim.x * 8) {
    float4* xr = (float4*)(x + (size_t)row * D);
    float4 v[4];
    float ss = 0.f;
#pragma unroll
    for (int i = 0; i < 4; ++i) {
      v[i] = xr[lane + i * 64];
      ss += v[i].x * v[i].x + v[i].y * v[i].y + v[i].z * v[i].z + v[i].w * v[i].w;
    }
    ss = wave_sum(ss);
    float rstd = rsqrtf(ss * (1.f / 1024.f) + EPS);
    if (which == 3) {
      const float4* g = (const float4*)p->in[I_NF];
#pragma unroll
      for (int i = 0; i < 4; ++i) {
        float4 gg = g[lane + i * 64];
        float4 o = make_float4(v[i].x * rstd * gg.x, v[i].y * rstd * gg.y, v[i].z * rstd * gg.z, v[i].w * rstd * gg.w);
        xr[lane + i * 64] = o;
      }
    } else {
      const float4* g = (const float4*)(p->in[(l ? I_L1 : I_L0) + L_NORM] + which * 1024);
      const float* mb = mod + (l * 3 + cond_of(row)) * 9216;
      const float4* sh = (const float4*)(mb + (3 * which) * 1024);
      const float4* sc = (const float4*)(mb + (3 * which + 1) * 1024);
#pragma unroll
      for (int i = 0; i < 4; ++i) {
        int q = lane + i * 64;
        float4 gg = g[q], s1 = sh[q], s2 = sc[q];
        float a = (v[i].x * rstd * gg.x) * (1.f + s2.x) + s1.x;
        float b = (v[i].y * rstd * gg.y) * (1.f + s2.y) + s1.y;
        float c = (v[i].z * rstd * gg.z) * (1.f + s2.z) + s1.z;
        float d = (v[i].w * rstd * gg.w) * (1.f + s2.w) + s1.w;
        uint2 o = make_uint2(pack2(a, b), pack2(c, d));
        *(uint2*)(xn + (size_t)row * D + q * 4) = o;
      }
    }
  }
}

enum { EPI_SWIGLU = 0, EPI_RESID = 1, EPI_MIX0 = 2, EPI_MIX1 = 3 };
constexpr int BM = 256, BK = 64, HALF = 128, HT = HALF * BK, NXCD = 8, WGM = 8;

__device__ __forceinline__ int lds_byte(int r, int c) {
  int st = (r >> 4) * 2 + (c >> 5), rr = r & 15, cc = c & 31, ob = rr * 64 + cc * 2;
  return st * 1024 + (ob ^ (((ob >> 9) & 1) << 5));
}
__device__ __forceinline__ void stage_rc(int b, int& R, int& C) {
  int st = b / 1024, sb = b % 1024, swz = sb ^ (((sb >> 9) & 1) << 5);
  R = (st >> 1) * 16 + swz / 64; C = (st & 1) * 32 + (swz % 64) / 2;
}

template <int EPI>
__device__ __forceinline__ void gemm256_tile(CP p, const u16* A, const u16* Bt, const int K,
                                             const int brow, const int bcol, int l, int gchunk, float coef, u16* shm, const int tid) {
#define SAI(b, h) ((b) * 2 + (h))
#define SBI(b, h) (4 + (b) * 2 + (h))
#define STAGE(PI, BASE, br, kt) do { \
    const char* _gb = (const char*)(BASE) + ((long)(br) * K + (long)(kt) * BK) * 2; \
    char* _lp = (char*)shm + (PI) * (HT * 2) + wave_lds; \
    __builtin_amdgcn_global_load_lds((const unsigned*)(_gb + voff0), (LAS unsigned*)(_lp), 16, 0, 0); \
    __builtin_amdgcn_global_load_lds((const unsigned*)(_gb + (long)K * 128 + voff0), (LAS unsigned*)(_lp + 8192), 16, 0, 0); } while (0)
#define LDA(dst, PI) do { unsigned _o = sw_ + a_uni; asm volatile("" : "+v"(_o)); _o &= 0x23F0u; \
    _Pragma("unroll") for (int m = 0; m < 4; ++m) _Pragma("unroll") for (int k = 0; k < 2; ++k) \
      dst[m][k] = *reinterpret_cast<const bf16x8*>((const char*)shm + (PI) * (HT * 2) + m * 2048 + k * 1024 + _o); } while (0)
#define LDB(dst, PI) do { unsigned _o = sw_ + b_uni; asm volatile("" : "+v"(_o)); _o &= 0x33F0u; \
    _Pragma("unroll") for (int n = 0; n < 2; ++n) _Pragma("unroll") for (int k = 0; k < 2; ++k) \
      dst[n][k] = *reinterpret_cast<const bf16x8*>((const char*)shm + (PI) * (HT * 2) + n * 2048 + k * 1024 + _o); } while (0)
#define MMA(ai, bj, At_, Bt_) do { __builtin_amdgcn_s_setprio(1); \
    _Pragma("unroll") for (int m = 0; m < 4; ++m) _Pragma("unroll") for (int n = 0; n < 2; ++n) _Pragma("unroll") for (int k = 0; k < 2; ++k) \
      acc[ai][bj][m][n] = __builtin_amdgcn_mfma_f32_16x16x32_bf16(At_[m][k], Bt_[n][k], acc[ai][bj][m][n], 0, 0, 0); \
    __builtin_amdgcn_s_setprio(0); } while (0)
#define WAIT_V(n) asm volatile("s_waitcnt vmcnt(" #n ")" ::: "memory")
#define WAIT_L(n) asm volatile("s_waitcnt lgkmcnt(" #n ")" ::: "memory")
#define BAR __builtin_amdgcn_s_barrier()
#define SCHED __builtin_amdgcn_sched_barrier(0)
  const int wid = __builtin_amdgcn_readfirstlane(tid >> 6), lane = tid & 63, wr = wid >> 2, wc = wid & 3, fr = lane & 15, fq = lane >> 4;
  const int wave_lds = (wid & 7) * 1024;
  unsigned voff0;
  { int r_, c_; stage_rc(tid * 16, r_, c_); voff0 = (unsigned)(r_ * K + c_) * 2u; }
  const unsigned sw_ = (unsigned)((fr * 64 + fq * 16) ^ ((((fr * 64 + fq * 16) >> 9) & 1) << 5));
  const unsigned a_uni = (unsigned)(wr * 8192), b_uni = (unsigned)(wc * 4096);
  f32x4 acc[2][2][4][2];
#pragma unroll
  for (int a = 0; a < 2; ++a)
#pragma unroll
    for (int b = 0; b < 2; ++b)
#pragma unroll
      for (int m = 0; m < 4; ++m)
#pragma unroll
        for (int n = 0; n < 2; ++n) acc[a][b][m][n] = (f32x4){0.f, 0.f, 0.f, 0.f};
  bf16x8 At[4][2], B0[2][2], B1[2][2];
  const int nt = K / BK;
  WAIT_V(0);
  __syncthreads();
  STAGE(SBI(0, 0), Bt, bcol, 0); STAGE(SAI(0, 0), A, brow, 0);
  STAGE(SBI(0, 1), Bt, bcol + HALF, 0); STAGE(SAI(0, 1), A, brow + HALF, 0);
  if (wr == 1) BAR;
  WAIT_V(4); BAR;
  STAGE(SBI(1, 0), Bt, bcol, 1); STAGE(SAI(1, 0), A, brow, 1); STAGE(SBI(1, 1), Bt, bcol + HALF, 1);
  WAIT_V(6); BAR;
  for (int t = 0; t < nt - 2; t += 2) {
    LDB(B0, SBI(0, 0)); SCHED; LDA(At, SAI(0, 0)); STAGE(SAI(1, 1), A, brow + HALF, t + 1);
    WAIT_L(8); BAR; WAIT_L(0); MMA(0, 0, At, B0); BAR; SCHED;
    LDB(B1, SBI(0, 1)); STAGE(SBI(0, 0), Bt, bcol, t + 2);
    BAR; WAIT_L(0); MMA(0, 1, At, B1); BAR;
    LDA(At, SAI(0, 1)); STAGE(SAI(0, 0), A, brow, t + 2);
    BAR; WAIT_L(0); MMA(1, 0, At, B0); BAR; SCHED;
    STAGE(SBI(0, 1), Bt, bcol + HALF, t + 2);
    WAIT_V(6); BAR; MMA(1, 1, At, B1); BAR;
    LDB(B0, SBI(1, 0)); SCHED; LDA(At, SAI(1, 0)); STAGE(SAI(0, 1), A, brow + HALF, t + 2);
    WAIT_L(8); BAR; WAIT_L(0); MMA(0, 0, At, B0); BAR; SCHED;
    LDB(B1, SBI(1, 1)); STAGE(SBI(1, 0), Bt, bcol, t + 3);
    BAR; WAIT_L(0); MMA(0, 1, At, B1); BAR;
    LDA(At, SAI(1, 1)); STAGE(SAI(1, 0), A, brow, t + 3);
    BAR; WAIT_L(0); MMA(1, 0, At, B0); BAR; SCHED;
    STAGE(SBI(1, 1), Bt, bcol + HALF, t + 3);
    WAIT_V(6); BAR; MMA(1, 1, At, B1); BAR;
  }
  { LDB(B0, SBI(0, 0)); LDA(At, SAI(0, 0)); STAGE(SAI(1, 1), A, brow + HALF, nt - 1);
    BAR; WAIT_L(0); MMA(0, 0, At, B0); BAR;
    LDB(B1, SBI(0, 1)); BAR; WAIT_L(0); MMA(0, 1, At, B1); BAR;
    LDA(At, SAI(0, 1)); WAIT_V(4); BAR; WAIT_L(0); MMA(1, 0, At, B0); MMA(1, 1, At, B1); BAR; }
  { LDB(B0, SBI(1, 0)); LDA(At, SAI(1, 0)); WAIT_V(2); BAR; WAIT_L(0); MMA(0, 0, At, B0); BAR;
    LDB(B1, SBI(1, 1)); WAIT_V(0); BAR; WAIT_L(0); MMA(0, 1, At, B1); BAR;
    LDA(At, SAI(1, 1)); BAR; WAIT_L(0); MMA(1, 0, At, B0); MMA(1, 1, At, B1); BAR; }
  if (wr == 0) BAR;
#undef SAI
#undef SBI
#undef STAGE
#undef LDA
#undef LDB
#undef MMA
#undef WAIT_V
#undef WAIT_L
#undef BAR
#undef SCHED
  if (EPI == EPI_SWIGLU) {
    u16* H = (u16*)(p->ws + OFF_HP);
    const int hc0 = (bcol >> 1) + wc * 32 + fr;
#pragma unroll
    for (int ai = 0; ai < 2; ++ai)
#pragma unroll
      for (int m = 0; m < 4; ++m)
#pragma unroll
        for (int j = 0; j < 4; ++j) {
          int row = brow + ai * 128 + wr * 64 + m * 16 + fq * 4 + j;
#pragma unroll
          for (int n = 0; n < 2; ++n) {
            float g = acc[ai][0][m][n][j], u = acc[ai][1][m][n][j];
            float h = g / (1.f + __expf(-g)) * u;
            H[(size_t)row * DFF + hc0 + n * 16] = f2bf(h);
          }
        }
  } else if (EPI == EPI_RESID) {
    float* x = p->out + O_X;
    const float* mod = (const float*)(p->ws + OFF_MOD);
#pragma unroll
    for (int ai = 0; ai < 2; ++ai)
#pragma unroll
      for (int m = 0; m < 4; ++m)
#pragma unroll
        for (int j = 0; j < 4; ++j) {
          int row = brow + ai * 128 + wr * 64 + m * 16 + fq * 4 + j;
          const float* gp = mod + (l * 3 + cond_of(row)) * 9216 + gchunk * 1024;
#pragma unroll
          for (int bj = 0; bj < 2; ++bj)
#pragma unroll
            for (int n = 0; n < 2; ++n) {
              int col = bcol + bj * 128 + wc * 32 + n * 16 + fr;
              size_t idx = (size_t)row * D + col;
              x[idx] = x[idx] + coef * gp[col] * acc[ai][bj][m][n][j];
            }
        }
  } else {
    u16* proj = (u16*)(p->ws + OFF_HP);
    const bool isctx = brow < NCTX;
    const int c0 = bcol + wc * 64;
    const float* rc = (const float*)(p->ws + OFF_ROPE);
    bool do_norm = false, do_rope = false;
    const float* ng = nullptr;
    float* o32 = nullptr; int ostr = 0;
    bool elementwise = false;
    if (EPI == EPI_MIX0) {
      if (c0 < 512) { do_norm = true; ng = p->in[I_L0 + L_X0]; do_rope = !isctx; }
      else if (c0 < 640) { do_norm = true; ng = p->in[I_L0 + L_X0] + 64; do_rope = !isctx; if (isctx) { o32 = p->out + O_K0 + (c0 - 512); ostr = 128; } }
      else if (c0 < 768) { if (isctx) { o32 = p->out + O_V0 + (c0 - 640); ostr = 128; } }
      else if (c0 >= 2304) elementwise = true;
    } else {
      if (c0 < 512) {}
      else if (c0 < 1024) { if (isctx) { o32 = p->out + O_KC1 + (c0 - 512); ostr = 512; } }
      else if (c0 < 1536) { if (isctx) { o32 = p->out + O_VC1 + (c0 - 1024); ostr = 512; } }
      else if (c0 < 2048) { do_rope = !isctx; }
      else if (c0 < 2176) { do_rope = !isctx; if (isctx) { o32 = p->out + O_KD1 + (c0 - 2048); ostr = 128; } }
      else { if (isctx) { o32 = p->out + O_VD1 + (c0 - 2176); ostr = 128; } }
    }
    if (elementwise) {
      float* gates = (float*)(p->ws + OFF_GATES);
      const float* gb = p->in[I_L0 + L_X1];
#pragma unroll
      for (int ai = 0; ai < 2; ++ai)
#pragma unroll
        for (int m = 0; m < 4; ++m)
#pragma unroll
          for (int j = 0; j < 4; ++j) {
            int row = brow + ai * 128 + wr * 64 + m * 16 + fq * 4 + j;
#pragma unroll
            for (int bj = 0; bj < 2; ++bj)
#pragma unroll
              for (int n = 0; n < 2; ++n) {
                int col = c0 + bj * 32 + n * 16 + fr;
                float v = acc[ai][bj][m][n][j];
                if (col < 2336) gates[(size_t)row * 32 + (col - 2304)] = v + gb[col - 2304];
                else if (col < P0N) proj[(size_t)row * PSTR + col] = f2bf(v);
              }
          }
    } else {
#pragma unroll
      for (int ai = 0; ai < 2; ++ai)
#pragma unroll
        for (int m = 0; m < 4; ++m)
#pragma unroll
          for (int j = 0; j < 4; ++j) {
            int row = brow + ai * 128 + wr * 64 + m * 16 + fq * 4 + j;
            float v0 = acc[ai][0][m][0][j], v1 = acc[ai][0][m][1][j], v2 = acc[ai][1][m][0][j], v3 = acc[ai][1][m][1][j];
            if (do_norm) {
              float ss = v0 * v0 + v1 * v1 + v2 * v2 + v3 * v3;
              ss = grp16_sum(ss);
              float rstd = rsqrtf(ss * (1.f / 64.f) + EPS);
              v0 = v0 * rstd * ng[fr]; v1 = v1 * rstd * ng[16 + fr]; v2 = v2 * rstd * ng[32 + fr]; v3 = v3 * rstd * ng[48 + fr];
            }
            if (do_rope) {
              int tk = (row - NCTX) & 1023;
              float ca = rc[tk * 32 + fr], sa = rc[32768 + tk * 32 + fr];
              float cb = rc[tk * 32 + 16 + fr], sb = rc[32768 + tk * 32 + 16 + fr];
              float a0 = v0 * ca - v2 * sa, a2 = v2 * ca + v0 * sa;
              float a1 = v1 * cb - v3 * sb, a3 = v3 * cb + v1 * sb;
              v0 = a0; v1 = a1; v2 = a2; v3 = a3;
            }
            u16* pr = proj + (size_t)row * PSTR + c0 + fr;
            pr[0] = f2bf(v0); pr[16] = f2bf(v1); pr[32] = f2bf(v2); pr[48] = f2bf(v3);
            if (o32) {
              float* o = o32 + (size_t)row * ostr + fr;
              o[0] = v0; o[16] = v1; o[32] = v2; o[48] = v3;
            }
          }
    }
  }
}

template <int EPI>
__device__ __forceinline__ void gemm_phase(CP p, const u16* A, const u16* Bt, int K, int nN, int l, int gchunk, float coef, u16* smem) {
  const int tid = get_tid();
  const int nM = MTOK / BM, nwg = nM * nN;
  for (int t = blockIdx.x; t < nwg; t += gridDim.x) {
    int wgid = t;
    { int q = nwg / NXCD, r = nwg % NXCD, xcd = wgid % NXCD, off = wgid / NXCD;
      wgid = (xcd < r ? xcd * (q + 1) : r * (q + 1) + (xcd - r) * q) + off; }
    int nig = WGM * nN, gid = wgid / nig, fm = gid * WGM, gsz = min(nM - fm, WGM);
    int pm = fm + ((wgid % nig) % gsz), pn = (wgid % nig) / gsz;
    gemm256_tile<EPI>(p, A, Bt, K, pm * BM, pn * BM, l, gchunk, coef, smem, tid);
  }
}

__device__ __forceinline__ void load_tile_bf16(float* dst, const u16* src, long rstride, float scale, int tid) {
  int r = tid >> 2, part = tid & 3;
  const uint4* s = (const uint4*)(src + (long)r * rstride + part * 16);
  uint4 a = s[0], b = s[1];
  float4* d = (float4*)(dst + r * TS + part * 16);
  d[0] = make_float4(bflo(a.x) * scale, bfhi(a.x) * scale, bflo(a.y) * scale, bfhi(a.y) * scale);
  d[1] = make_float4(bflo(a.z) * scale, bfhi(a.z) * scale, bflo(a.w) * scale, bfhi(a.w) * scale);
  d[2] = make_float4(bflo(b.x) * scale, bfhi(b.x) * scale, bflo(b.y) * scale, bfhi(b.y) * scale);
  d[3] = make_float4(bflo(b.z) * scale, bfhi(b.z) * scale, bflo(b.w) * scale, bfhi(b.w) * scale);
}
__device__ __forceinline__ void load_tile_f32(float* dst, const float* src, long rstride, int tid) {
  int r = tid >> 2, part = tid & 3;
  const float4* s = (const float4*)(src + (long)r * rstride + part * 16);
  float4* d = (float4*)(dst + r * TS + part * 16);
  d[0] = s[0]; d[1] = s[1]; d[2] = s[2]; d[3] = s[3];
}
__device__ __forceinline__ void qk_micro(const float* Qs, const float* Ks, int ty, int tx, float s[4][4]) {
#pragma unroll
  for (int i = 0; i < 4; ++i)
#pragma unroll
    for (int j = 0; j < 4; ++j) s[i][j] = 0.f;
#pragma unroll 2
  for (int d4 = 0; d4 < 16; ++d4) {
    float4 q[4], k[4];
#pragma unroll
    for (int i = 0; i < 4; ++i) q[i] = *(const float4*)(Qs + (ty * 4 + i) * TS + d4 * 4);
#pragma unroll
    for (int j = 0; j < 4; ++j) k[j] = *(const float4*)(Ks + (tx + 16 * j) * TS + d4 * 4);
#pragma unroll
    for (int i = 0; i < 4; ++i)
#pragma unroll
      for (int j = 0; j < 4; ++j)
        s[i][j] += q[i].x * k[j].x + q[i].y * k[j].y + q[i].z * k[j].z + q[i].w * k[j].w;
  }
}
__device__ __forceinline__ void pv_micro(const float* Ps, const float* Vs, int ty, int tx, float o[4][4]) {
#pragma unroll 2
  for (int s4 = 0; s4 < 16; ++s4) {
    float4 pp[4], v[4];
#pragma unroll
    for (int i = 0; i < 4; ++i) pp[i] = *(const float4*)(Ps + (ty * 4 + i) * TS + s4 * 4);
#pragma unroll
    for (int q = 0; q < 4; ++q) v[q] = *(const float4*)(Vs + (s4 * 4 + q) * TS + tx * 4);
#pragma unroll
    for (int i = 0; i < 4; ++i) {
      o[i][0] += pp[i].x * v[0].x + pp[i].y * v[1].x + pp[i].z * v[2].x + pp[i].w * v[3].x;
      o[i][1] += pp[i].x * v[0].y + pp[i].y * v[1].y + pp[i].z * v[2].y + pp[i].w * v[3].y;
      o[i][2] += pp[i].x * v[0].z + pp[i].y * v[1].z + pp[i].z * v[2].z + pp[i].w * v[3].z;
      o[i][3] += pp[i].x * v[0].w + pp[i].y * v[1].w + pp[i].z * v[2].w + pp[i].w * v[3].w;
    }
  }
}

struct AttnDesc {
  int qrow0, qcol, ocol;
  const float* ck; const float* cv; int cstride; int nctx;
  int krow0, nloc, kcol, vcol;
  int mode;
  int a0;
  int r0;
  const float* rpb;
  float sink; int has_sink;
};

constexpr int AS_ = 72;
__device__ __forceinline__ void attn_item(CP p, const AttnDesc& d, float* sm) {
  const int tid = get_tid(), w = tid >> 6, lane = tid & 63, fr = lane & 15, fq = lane >> 4, half = w >> 2;
  const u16* proj = (const u16*)(p->ws + OFF_HP);
  u16* Ks = (u16*)sm;
  u16* Vt = Ks + 64 * AS_;
  u16* Ps = Vt + 64 * AS_ + w * (16 * AS_);
  bf16x8 qf[2];
  {
    const u16* qp = proj + (size_t)(d.qrow0 + w * 16 + fr) * PSTR + d.qcol + fq * 8;
    qf[0] = *(const bf16x8*)(qp);
    qf[1] = *(const bf16x8*)(qp + 32);
  }
  float m_i[4], l_i[4];
  f32x4 o[4];
#pragma unroll
  for (int j = 0; j < 4; ++j) {
    m_i[j] = d.has_sink ? d.sink : -1e30f;
    l_i[j] = (d.has_sink && fr == 0) ? 1.f : 0.f;
  }
#pragma unroll
  for (int n = 0; n < 4; ++n) o[n] = (f32x4){0.f, 0.f, 0.f, 0.f};
  const int ntiles = d.nctx + d.nloc;
  const int lrow = tid >> 3, lc8 = tid & 7;
  float4 kf0, kf1, vf0, vf1;
  u32x4 kq, vq;
  auto issue = [&](int tile) {
    if (tile < d.nctx) {
      const size_t off = (size_t)(tile * 64 + lrow) * d.cstride + lc8 * 8;
      kf0 = *(const float4*)(d.ck + off); kf1 = *(const float4*)(d.ck + off + 4);
      vf0 = *(const float4*)(d.cv + off); vf1 = *(const float4*)(d.cv + off + 4);
    } else {
      const u16* base = proj + (size_t)(d.krow0 + (tile - d.nctx) * 64 + lrow) * PSTR + lc8 * 8;
      kq = *(const u32x4*)(base + d.kcol);
      vq = *(const u32x4*)(base + d.vcol);
    }
  };
  issue(0);
  for (int tile = 0; tile < ntiles; ++tile) {
    __syncthreads();
    if (tile < d.nctx) {
      kq = (u32x4){pack2(kf0.x, kf0.y), pack2(kf0.z, kf0.w), pack2(kf1.x, kf1.y), pack2(kf1.z, kf1.w)};
      vq = (u32x4){pack2(vf0.x, vf0.y), pack2(vf0.z, vf0.w), pack2(vf1.x, vf1.y), pack2(vf1.z, vf1.w)};
    }
    *(u32x4*)(Ks + lrow * AS_ + lc8 * 8) = kq;
    {
      u16* vt = Vt + (lc8 * 8) * AS_ + lrow;
      vt[0 * AS_] = (u16)(vq.x & 0xffff); vt[1 * AS_] = (u16)(vq.x >> 16);
      vt[2 * AS_] = (u16)(vq.y & 0xffff); vt[3 * AS_] = (u16)(vq.y >> 16);
      vt[4 * AS_] = (u16)(vq.z & 0xffff); vt[5 * AS_] = (u16)(vq.z >> 16);
      vt[6 * AS_] = (u16)(vq.w & 0xffff); vt[7 * AS_] = (u16)(vq.w >> 16);
    }
    __syncthreads();
    if (tile + 1 < ntiles) issue(tile + 1);
    const int lt = tile - d.nctx;
    f32x4 sacc[4];
#pragma unroll
    for (int n = 0; n < 4; ++n) sacc[n] = (f32x4){0.f, 0.f, 0.f, 0.f};
#pragma unroll
    for (int ks = 0; ks < 2; ++ks)
#pragma unroll
      for (int n = 0; n < 4; ++n) {
        bf16x8 kb = *(const bf16x8*)(Ks + (n * 16 + fr) * AS_ + ks * 32 + fq * 8);
        sacc[n] = __builtin_amdgcn_mfma_f32_16x16x32_bf16(qf[ks], kb, sacc[n], 0, 0, 0);
      }
    float sv[4][4];
#pragma unroll
    for (int n = 0; n < 4; ++n)
#pragma unroll
      for (int j = 0; j < 4; ++j) sv[j][n] = sacc[n][j] * 0.125f;
    if (lt >= 0 && d.mode == 1) {
      const int rq = d.a0 + half;
      const int kr = d.r0 + lt;
      const int rq0 = min(max(rq - 4, 0), 8);
      const bool rowok = (kr >= rq0) && (kr < rq0 + 8);
      const int dy = min(max(kr - rq + 7, 0), 14);
      const float* rp = d.rpb + dy * 31;
#pragma unroll
      for (int j = 0; j < 4; ++j) {
        int qc = (w & 3) * 16 + fq * 4 + j;
        int ws = min(max(qc - 8, 0), 48);
#pragma unroll
        for (int n = 0; n < 4; ++n) {
          int kc = n * 16 + fr;
          bool ok = rowok && (kc >= ws) && (kc < ws + 16);
          int dx = min(max(kc - qc + 15, 0), 30);
          sv[j][n] = ok ? sv[j][n] + rp[dx] : -1e30f;
        }
      }
    } else if (lt >= 0 && d.mode == 2) {
      const int off = d.a0 + lt * 64 - half * 64;
#pragma unroll
      for (int j = 0; j < 4; ++j)
#pragma unroll
        for (int n = 0; n < 4; ++n) {
          int dd = off + (n * 16 + fr) - ((w & 3) * 16 + fq * 4 + j);
          bool ok = (dd <= 128) && (dd >= -128);
          sv[j][n] = ok ? sv[j][n] : -1e30f;
        }
    }
#pragma unroll
    for (int j = 0; j < 4; ++j) {
      float mx = fmaxf(fmaxf(sv[j][0], sv[j][1]), fmaxf(sv[j][2], sv[j][3]));
      mx = grp16_max(mx);
      float mn = fmaxf(m_i[j], mx);
      float alpha = __expf(m_i[j] - mn);
      float rs = 0.f;
#pragma unroll
      for (int n = 0; n < 4; ++n) {
        float pj = __expf(sv[j][n] - mn);
        rs += pj;
        Ps[(fq * 4 + j) * AS_ + n * 16 + fr] = f2bf(pj);
      }
      l_i[j] = l_i[j] * alpha + rs;
      m_i[j] = mn;
#pragma unroll
      for (int n = 0; n < 4; ++n) o[n][j] *= alpha;
    }
    __builtin_amdgcn_wave_barrier();
#pragma unroll
    for (int ks = 0; ks < 2; ++ks) {
      bf16x8 pa = *(const bf16x8*)(Ps + fr * AS_ + ks * 32 + fq * 8);
#pragma unroll
      for (int n = 0; n < 4; ++n) {
        bf16x8 vb = *(const bf16x8*)(Vt + (n * 16 + fr) * AS_ + ks * 32 + fq * 8);
        o[n] = __builtin_amdgcn_mfma_f32_16x16x32_bf16(pa, vb, o[n], 0, 0, 0);
      }
    }
    __builtin_amdgcn_wave_barrier();
  }
  u16* ymix = (u16*)(p->ws + OFF_YMIX);
#pragma unroll
  for (int j = 0; j < 4; ++j) {
    float inv = 1.f / grp16_sum(l_i[j]);
    u16* yp = ymix + (size_t)(d.qrow0 + w * 16 + fq * 4 + j) * D + d.ocol + fr;
#pragma unroll
    for (int n = 0; n < 4; ++n) yp[n * 16] = f2bf(o[n][j] * inv);
  }
}

__device__ __forceinline__ int st_slot(int isctx, int b, int dir, int head, int cc) {
  int ch = (b * 2 + dir) * 8 + head;
  return isctx ? (ch * 4 + cc) : (2048 + ch * 16 + cc);
}

__device__ __forceinline__ void mlstm_state_item(CP p, int isctx, int b, int head, float* sm) {
  const int tid = get_tid(), dir = tid >> 8, t = tid & 255, ty = t >> 4, tx = t & 15, lane = t & 63;
  const u16* proj = (const u16*)(p->ws + OFF_HP);
  const float* gates = (const float*)(p->ws + OFF_GATES);
  float* stC = (float*)(p->ws + OFF_STC);
  float* stn = (float*)(p->ws + OFF_STN);
  float* stm = (float*)(p->ws + OFF_STM);
  float* Ks = sm + (dir * 2) * TILE_F; float* Vs = sm + (dir * 2 + 1) * TILE_F;
  float* sws = sm + 8 * TILE_F + dir * 256;
  float* sn = sws + 64;
  float* ssc = sn + 64;
  const int nc = isctx ? 4 : 16, L = isctx ? 256 : 1024;
  const int seq0 = isctx ? b * 256 : NCTX + b * 1024;
  float c[4][4];
  float m;
  __syncthreads();
  if (isctx) {
#pragma unroll
    for (int i = 0; i < 4; ++i)
#pragma unroll
      for (int j = 0; j < 4; ++j) c[i][j] = 0.f;
    if (t < 64) sn[t] = 0.f;
    m = 0.f;
  } else {
    int ch = (b * 2 + dir) * 8 + head;
    const float* C0 = p->in[I_SC] + (size_t)ch * 4096;
#pragma unroll
    for (int i = 0; i < 4; ++i) {
      float4 v = *(const float4*)(C0 + (ty * 4 + i) * 64 + tx * 4);
      c[i][0] = v.x; c[i][1] = v.y; c[i][2] = v.z; c[i][3] = v.w;
    }
    if (t < 64) sn[t] = p->in[I_SN][ch * 64 + t];
    m = p->in[I_SM][ch];
  }
  for (int cc = 0; cc < nc; ++cc) {
    __syncthreads();
    const int slot = st_slot(isctx, b, dir, head, cc);
#pragma unroll
    for (int i = 0; i < 4; ++i)
      *(float4*)(stC + (size_t)slot * 4096 + (ty * 4 + i) * 64 + tx * 4) = make_float4(c[i][0], c[i][1], c[i][2], c[i][3]);
    if (t < 64) stn[slot * 64 + t] = sn[t];
    if (t == 0) stm[slot] = m;
    const int tok0 = dir ? (L - 1 - cc * 64) : cc * 64;
    const long rs = dir ? -(long)PSTR : (long)PSTR;
    const u16* base = proj + (size_t)(seq0 + tok0) * PSTR;
    load_tile_bf16(Ks, base + 1280 + head * 64, rs, 0.125f, t);
    load_tile_bf16(Vs, base + 1792 + head * 64, rs, 1.f, t);
    if (t < 64) {
      int tr = seq0 + (dir ? tok0 - lane : tok0 + lane);
      float li = gates[(size_t)tr * 32 + (dir * 2) * 8 + head];
      float fp = gates[(size_t)tr * 32 + (dir * 2 + 1) * 8 + head];
      float lf = logsigmoidf_(fp);
      float bb = wave_scan_add(lf, lane);
      float a = li - bb;
      float amax = wave_max(a);
      float blast = __shfl(bb, 63);
      float mnew = blast + fmaxf(m, amax);
      sws[lane] = expf(blast + a - mnew);
      if (lane == 0) { ssc[0] = expf(blast + m - mnew); ssc[1] = mnew; }
    }
    __syncthreads();
    const float wc = ssc[0];
    m = ssc[1];
#pragma unroll
    for (int i = 0; i < 4; ++i)
#pragma unroll
      for (int j = 0; j < 4; ++j) c[i][j] *= wc;
    float nacc = 0.f;
#pragma unroll 4
    for (int s = 0; s < 64; ++s) {
      float w = sws[s];
      float4 kk = *(const float4*)(Ks + s * TS + ty * 4);
      float4 vv = *(const float4*)(Vs + s * TS + tx * 4);
      float k0 = kk.x * w, k1 = kk.y * w, k2 = kk.z * w, k3 = kk.w * w;
      c[0][0] += k0 * vv.x; c[0][1] += k0 * vv.y; c[0][2] += k0 * vv.z; c[0][3] += k0 * vv.w;
      c[1][0] += k1 * vv.x; c[1][1] += k1 * vv.y; c[1][2] += k1 * vv.z; c[1][3] += k1 * vv.w;
      c[2][0] += k2 * vv.x; c[2][1] += k2 * vv.y; c[2][2] += k2 * vv.z; c[2][3] += k2 * vv.w;
      c[3][0] += k3 * vv.x; c[3][1] += k3 * vv.y; c[3][2] += k3 * vv.z; c[3][3] += k3 * vv.w;
      if (t < 64) nacc += w * Ks[s * TS + t];
    }
    if (t < 64) sn[t] = wc * sn[t] + nacc;
  }
  __syncthreads();
  if (isctx) {
    int ch = (b * 2 + dir) * 8 + head;
    float* Co = p->out + O_C + (size_t)ch * 4096;
#pragma unroll
    for (int i = 0; i < 4; ++i)
      *(float4*)(Co + (ty * 4 + i) * 64 + tx * 4) = make_float4(c[i][0], c[i][1], c[i][2], c[i][3]);
    if (t < 64) p->out[O_N + ch * 64 + t] = sn[t];
    if (t == 0) p->out[O_M + ch] = m;
  }
}

__device__ __forceinline__ void mlstm_out_item(CP p, int isctx, int b, int head, int c, float* sm) {
  const int tid = get_tid(), dir = tid >> 8, t = tid & 255, ty = t >> 4, tx = t & 15, lane = t & 63;
  const u16* proj = (const u16*)(p->ws + OFF_HP);
  const float* gates = (const float*)(p->ws + OFF_GATES);
  const float* stC = (const float*)(p->ws + OFF_STC);
  const float* stn = (const float*)(p->ws + OFF_STN);
  const float* stm = (const float*)(p->ws + OFF_STM);
  float* Qs = sm + (dir * 4) * TILE_F; float* KCs = Qs + TILE_F; float* Vs = Qs + 2 * TILE_F; float* Ws = Qs + 3 * TILE_F;
  float* Ws1 = sm + 7 * TILE_F;
  float* sa = sm + 8 * TILE_F + dir * 256;
  float* sM = sa + 64;
  float* sb = sM + 64;
  float* sn = sb + 64;
  const int nc = isctx ? 4 : 16;
  const int mb = (isctx ? b * 256 : NCTX + b * 1024) + c * 64;
  const int cc = dir ? nc - 1 - c : c;
  const int slot = st_slot(isctx, b, dir, head, cc);
  const float m0 = stm[slot];
  __syncthreads();
  const long rs = dir ? -(long)PSTR : (long)PSTR;
  const u16* base = proj + (size_t)(mb + (dir ? 63 : 0)) * PSTR;
  load_tile_bf16(Qs, base + 768 + head * 64, rs, 1.f, t);
  load_tile_bf16(KCs, base + 1280 + head * 64, rs, 0.125f, t);
  load_tile_bf16(Vs, base + 1792 + head * 64, rs, 1.f, t);
  if (t < 64) {
    int tr = mb + (dir ? 63 - lane : lane);
    float li = gates[(size_t)tr * 32 + (dir * 2) * 8 + head];
    float fp = gates[(size_t)tr * 32 + (dir * 2 + 1) * 8 + head];
    float lf = logsigmoidf_(fp);
    float bb = wave_scan_add(lf, lane);
    float a = li - bb;
    float pm = wave_scan_max(a, lane);
    sa[lane] = a; sM[lane] = fmaxf(m0, pm); sb[lane] = bb;
    sn[lane] = stn[slot * 64 + lane];
  }
  __syncthreads();
  float hd[4][4];
  {
    float s[4][4];
    qk_micro(Qs, KCs, ty, tx, s);
    float rsum[4];
#pragma unroll
    for (int i = 0; i < 4; ++i) {
      int tq = ty * 4 + i;
      float Mt = sM[tq];
      float r = 0.f;
#pragma unroll
      for (int j = 0; j < 4; ++j) {
        int sidx = tx + 16 * j;
        float w = (sidx <= tq) ? expf(sa[sidx] - Mt) * s[i][j] : 0.f;
        Ws[tq * TS + sidx] = w;
        r += w;
      }
      rsum[i] = grp16_sum(r);
    }
    __syncthreads();
    load_tile_f32(KCs, stC + (size_t)slot * 4096, 64, t);
    __syncthreads();
    float num[4][4], qc[4][4];
#pragma unroll
    for (int i = 0; i < 4; ++i)
#pragma unroll
      for (int j = 0; j < 4; ++j) { num[i][j] = 0.f; qc[i][j] = 0.f; }
    pv_micro(Ws, Vs, ty, tx, num);
    pv_micro(Qs, KCs, ty, tx, qc);
#pragma unroll
    for (int i = 0; i < 4; ++i) {
      int tq = ty * 4 + i;
      float4 q4 = *(const float4*)(Qs + tq * TS + tx * 4);
      float4 n4 = *(const float4*)(sn + tx * 4);
      float qn = q4.x * n4.x + q4.y * n4.y + q4.z * n4.z + q4.w * n4.w;
      qn = grp16_sum(qn);
      float Mt = sM[tq];
      float wi = expf(m0 - Mt);
      float den = rsum[i] + wi * qn;
      float mt = sb[tq] + Mt;
      float dn = fmaxf(fabsf(den), expf(-mt));
      float inv = 1.f / dn;
#pragma unroll
      for (int j = 0; j < 4; ++j) hd[i][j] = (num[i][j] + wi * qc[i][j]) * inv;
    }
  }
  __syncthreads();
  if (dir == 1) {
#pragma unroll
    for (int i = 0; i < 4; ++i)
      *(float4*)(Ws1 + (63 - (ty * 4 + i)) * TS + tx * 4) = make_float4(hd[i][0], hd[i][1], hd[i][2], hd[i][3]);
  }
  __syncthreads();
  if (dir == 0) {
    const float* hg = p->in[I_L0 + L_X2] + head * 64 + tx * 4;
    u16* ymix = (u16*)(p->ws + OFF_YMIX);
#pragma unroll
    for (int i = 0; i < 4; ++i) {
      float4 v = *(const float4*)(Ws1 + (ty * 4 + i) * TS + tx * 4);
      float h0 = hd[i][0] + v.x, h1 = hd[i][1] + v.y, h2 = hd[i][2] + v.z, h3 = hd[i][3] + v.w;
      float ss = h0 * h0 + h1 * h1 + h2 * h2 + h3 * h3;
      ss = grp16_sum(ss);
      float rstd = rsqrtf(ss * (1.f / 64.f) + EPS);
      int tr = mb + ty * 4 + i;
      uint2 ob = *(const uint2*)(proj + (size_t)tr * PSTR + 2336 + head * 64 + tx * 4);
      float y0 = sigmoidf_(bflo(ob.x)) * (h0 * rstd * hg[0]);
      float y1 = sigmoidf_(bfhi(ob.x)) * (h1 * rstd * hg[1]);
      float y2 = sigmoidf_(bflo(ob.y)) * (h2 * rstd * hg[2]);
      float y3 = sigmoidf_(bfhi(ob.y)) * (h3 * rstd * hg[3]);
      *(uint2*)(ymix + (size_t)tr * D + 512 + head * 64 + tx * 4) = make_uint2(pack2(y0, y1), pack2(y2, y3));
    }
  }
}

__device__ __forceinline__ int next_item(int* ctr, int* s_item) {
  __syncthreads();
  if (get_tid() == 0) *s_item = atomicAdd(ctr, 1);
  __syncthreads();
  return *s_item;
}

__device__ __forceinline__ void mix0_phase_a(CP p, float* sm, int* s_item, int coff) {
  int* ctr = (int*)(p->ws + OFF_CTR) + 0 + coff;
  for (;;) {
    int it = next_item(ctr, s_item);
    if (it >= 912) break;
    if (it >= 128 && it < 144) {
      int v = it - 128; int b = v >> 3, head = v & 7;
      mlstm_state_item(p, 0, b, head, sm);
    } else if (it >= 656) {
      int v = it - 656; int b = v >> 3, head = v & 7;
      mlstm_state_item(p, 1, b, head, sm);
    } else {
      AttnDesc d;
      d.mode = 0; d.a0 = 0; d.r0 = 0; d.rpb = nullptr; d.sink = 0.f; d.has_sink = 0;
      if (it < 128) {
        int b = it >> 6, h = (it >> 3) & 7, qb = it & 7;
        d.qrow0 = NCTX + b * 1024 + qb * 128; d.qcol = h * 64; d.ocol = h * 64;
        d.ck = p->in[I_C0K] + (size_t)b * 256 * 128 + (h >> 2) * 64; d.cv = p->in[I_C0V] + (size_t)b * 256 * 128 + (h >> 2) * 64;
        d.cstride = 128; d.nctx = 4;
        d.krow0 = NCTX + b * 1024; d.nloc = 16; d.kcol = 512 + (h >> 2) * 64; d.vcol = 640 + (h >> 2) * 64;
      } else {
        int v = it - 144; int b = v >> 4, h = (v >> 1) & 7, qb = v & 1;
        d.qrow0 = b * 256 + qb * 128; d.qcol = h * 64; d.ocol = h * 64;
        d.ck = nullptr; d.cv = nullptr; d.cstride = 0; d.nctx = 0;
        d.krow0 = b * 256; d.nloc = 4; d.kcol = 512 + (h >> 2) * 64; d.vcol = 640 + (h >> 2) * 64;
      }
      attn_item(p, d, sm);
    }
  }
}

__device__ __forceinline__ void mix0_phase_b(CP p, float* sm, int* s_item, int coff) {
  int* ctr = (int*)(p->ws + OFF_CTR) + 1 + coff;
  for (;;) {
    int it = next_item(ctr, s_item);
    if (it >= 1280) break;
    if (it < 256) {
      int b = it >> 7, head = (it >> 4) & 7, c = it & 15;
      mlstm_out_item(p, 0, b, head, c, sm);
    } else {
      int v = it - 256; int b = v >> 5, head = (v >> 2) & 7, c = v & 3;
      mlstm_out_item(p, 1, b, head, c, sm);
    }
  }
}

__device__ __forceinline__ void mix1_phase(CP p, float* sm, int* s_item, int coff) {
  int* ctr = (int*)(p->ws + OFF_CTR) + 2 + coff;
  const float* sink = p->in[I_L1 + L_X1];
  for (;;) {
    int it = next_item(ctr, s_item);
    if (it >= 1280) break;
    AttnDesc d;
    d.mode = 0; d.a0 = 0; d.r0 = 0; d.rpb = nullptr; d.sink = 0.f; d.has_sink = 0;
    if (it < 128) {
      int b = it >> 6, h = (it >> 3) & 7, r = (it & 7) * 2;
      int r0 = min(max(r - 4, 0), 8);
      int r1 = min(max(r + 1 - 4, 0), 8) + 8;
      d.qrow0 = NCTX + b * 1024 + r * 64; d.qcol = h * 64; d.ocol = h * 64;
      d.ck = p->in[I_NAK] + (size_t)b * 256 * 512 + h * 64; d.cv = p->in[I_NAV] + (size_t)b * 256 * 512 + h * 64;
      d.cstride = 512; d.nctx = 4;
      d.krow0 = NCTX + b * 1024 + r0 * 64; d.nloc = r1 - r0; d.kcol = 512 + h * 64; d.vcol = 1024 + h * 64;
      d.mode = 1; d.a0 = r; d.r0 = r0; d.rpb = p->in[I_L1 + L_X0] + h * 15 * 31;
    } else if (it < 256) {
      int v = it - 128; int b = v >> 6, h = (v >> 3) & 7, qb = v & 7;
      int t0 = qb * 128;
      int s0 = max(t0 - 128, 0);
      int s1 = min(t0 + 256, 1024);
      d.qrow0 = NCTX + b * 1024 + t0; d.qcol = 1536 + h * 64; d.ocol = 512 + h * 64;
      d.ck = p->in[I_SWK] + (size_t)b * 256 * 128 + (h >> 2) * 64; d.cv = p->in[I_SWV] + (size_t)b * 256 * 128 + (h >> 2) * 64;
      d.cstride = 128; d.nctx = 4;
      d.krow0 = NCTX + b * 1024 + s0; d.nloc = (s1 - s0) >> 6; d.kcol = 2048 + (h >> 2) * 64; d.vcol = 2176 + (h >> 2) * 64;
      d.mode = 2; d.a0 = s0 - t0;
      d.sink = sink[h]; d.has_sink = 1;
    } else if (it < 768) {
      int v = it - 256; int b = v >> 4, h = (v >> 1) & 7, qb = v & 1;
      d.qrow0 = b * 256 + qb * 128; d.qcol = h * 64; d.ocol = h * 64;
      d.ck = nullptr; d.cv = nullptr; d.cstride = 0; d.nctx = 0;
      d.krow0 = b * 256; d.nloc = 4; d.kcol = 512 + h * 64; d.vcol = 1024 + h * 64;
    } else {
      int v = it - 768; int b = v >> 4, h = (v >> 1) & 7, qb = v & 1;
      d.qrow0 = b * 256 + qb * 128; d.qcol = 1536 + h * 64; d.ocol = 512 + h * 64;
      d.ck = nullptr; d.cv = nullptr; d.cstride = 0; d.nctx = 0;
      d.krow0 = b * 256; d.nloc = 4; d.kcol = 2048 + (h >> 2) * 64; d.vcol = 2176 + (h >> 2) * 64;
      d.sink = sink[h]; d.has_sink = 1;
    }
    attn_item(p, d, sm);
  }
}

#define XB_TMO      128
#define XB_XCNT(j)  (256  + 64 * (j))
#define XB_XSUB(j)  (1280 + 64 * (j))
#define XB_XGEN(j)  (2304 + 64 * (j))
#define XB_TOP      3328
#define XB_TOPGEN   3392
#define XCD_BAR_WORDS 3456
#define XB_SPIN_CAP (1u << 22)
__device__ __forceinline__ unsigned xb_ld(unsigned* p) { return __hip_atomic_load(p, __ATOMIC_RELAXED, __HIP_MEMORY_SCOPE_AGENT); }
__device__ __forceinline__ unsigned xb_add(unsigned* p, unsigned v) { return __hip_atomic_fetch_add(p, v, __ATOMIC_RELAXED, __HIP_MEMORY_SCOPE_AGENT); }
__device__ __forceinline__ unsigned xb_xcc_id() { return (unsigned)__builtin_amdgcn_s_getreg((3 << 11) | 20) & 0xFu; }
#define XB_SPIN(cond, bar) do { unsigned _sp = 0; while (cond) { __builtin_amdgcn_s_sleep(1); \
    if ((++_sp & 255u) == 0u) { if (xb_ld(&(bar)[XB_TMO])) break; if (_sp > XB_SPIN_CAP) { atomicAdd(&(bar)[XB_TMO], 1u); break; } } } } while (0)
struct XcdBarrier { unsigned* bar; unsigned x; volatile LAS unsigned* st; };
__device__ __forceinline__ XcdBarrier xcd_barrier_post(unsigned* bar, volatile LAS unsigned* st) {
  XcdBarrier b; b.bar = bar; b.x = xb_xcc_id(); b.st = st;
  if (threadIdx.x == 0) (void)xb_add(&bar[XB_XCNT(b.x)], 1u);
  return b;
}
__device__ __forceinline__ void xcd_barrier_complete(unsigned* bar, unsigned x, unsigned& nloc, unsigned& nx) {
  const unsigned G = gridDim.x * gridDim.y * gridDim.z;
  unsigned sum, cnt, mine, sp = 0u;
  for (;;) {
    sum = 0u; cnt = 0u; mine = 0u;
#pragma unroll
    for (unsigned j = 0; j < 16; ++j) { const unsigned c = xb_ld(&bar[XB_XCNT(j)]); sum += c; cnt += (c > 0u) ? 1u : 0u; mine = (j == x) ? c : mine; }
    if (sum == G) break;
    __builtin_amdgcn_s_sleep(1);
    if ((++sp & 255u) == 0u) { if (xb_ld(&bar[XB_TMO])) break; if (sp > XB_SPIN_CAP) { atomicAdd(&bar[XB_TMO], 1u); break; } }
  }
  nloc = mine > 0u ? mine : 1u; nx = cnt > 0u ? cnt : 1u;
}
__device__ __forceinline__ void xcd_barrier(const XcdBarrier& b) {
  asm volatile("s_waitcnt vmcnt(0)" ::: "memory");
  __syncthreads();
  if (threadIdx.x == 0) {
    unsigned* bar = b.bar;
    __builtin_amdgcn_s_waitcnt(0);
    unsigned nloc = b.st[0], nx = b.st[1];
    if (nloc == 0u) { xcd_barrier_complete(bar, b.x, nloc, nx); b.st[0] = nloc; b.st[1] = nx; }
    const unsigned old = xb_add(&bar[XB_XSUB(b.x)], 1u);
    const unsigned gen = old / nloc;
    if (old + 1u == (gen + 1u) * nloc) {
      __builtin_amdgcn_fence(__ATOMIC_RELEASE, "agent");
      asm volatile("s_waitcnt vmcnt(0)" ::: "memory");
      const unsigned og = xb_add(&bar[XB_TOP], 1u);
      const unsigned tg = og / nx;
      if (og + 1u == (tg + 1u) * nx) xb_add(&bar[XB_TOPGEN], 1u);
      else XB_SPIN(xb_ld(&bar[XB_TOPGEN]) == tg, bar);
      __builtin_amdgcn_fence(__ATOMIC_ACQUIRE, "agent");
      xb_add(&bar[XB_XGEN(b.x)], 1u);
      asm volatile("s_waitcnt vmcnt(0)" ::: "memory");
    } else {
      XB_SPIN(xb_ld(&bar[XB_XGEN(b.x)]) == gen, bar);
      __builtin_amdgcn_fence(__ATOMIC_ACQUIRE, "agent");
      asm volatile("s_waitcnt vmcnt(0)" ::: "memory");
    }
  }
  __syncthreads();
}

constexpr int NPHASE = 23;

__device__ __forceinline__ void run_phase(CP p, int ph, char* smem, int* s_item, const int dry) {
  float* smf = (float*)smem;
  u16* smh = (u16*)smem;
  const u16* xn = (const u16*)(p->ws + OFF_XN);
  const u16* hp = (const u16*)(p->ws + OFF_HP);
  const u16* ymix = (const u16*)(p->ws + OFF_YMIX);
  if (ph == 0) { prep_phase(p, smf); return; }
  if (ph == 22) { norm_phase(p, 0, 3); return; }
  int l = (ph - 1) / 11, q = (ph - 1) % 11;
  if (l == 1 && q >= 6) q += 1;
  if (q == 0 || q == 3 || q == 8) { norm_phase(p, l, q == 0 ? 0 : (q == 3 ? 1 : 2)); return; }
  if (q == 1 || q == 9) {
    const int f = (q == 9) ? 1 : 0;
    gemm_phase<EPI_SWIGLU>(p, xn, (const u16*)(p->ws + OFF_WIN + (l * 2 + f) * SZ_WIN), 1024, 22, l, 0, 0.f, smh);
    return;
  }
  if (q == 2 || q == 7 || q == 10) {
    const u16* A = (q == 7) ? ymix : hp;
    const u16* Bt = (q == 7) ? (const u16*)(p->ws + OFF_WMO + (size_t)l * D * D * 2)
                             : (const u16*)(p->ws + OFF_WOUT + (l * 2 + (q == 10 ? 1 : 0)) * SZ_WOUT);
    const int K = (q == 7) ? 1024 : DFF;
    const int gch = (q == 2) ? 2 : (q == 7 ? 5 : 8);
    const float coef = dry ? 0.f : ((q == 7) ? 1.f : 0.5f);
    gemm_phase<EPI_RESID>(p, A, Bt, K, 4, l, gch, coef, smh);
    return;
  }
  if (q == 4) {
    if (l == 0) gemm_phase<EPI_MIX0>(p, xn, (const u16*)(p->ws + OFF_WMI0), 1024, 12, l, 0, 0.f, smh);
    else gemm_phase<EPI_MIX1>(p, xn, (const u16*)(p->ws + OFF_WMI1), 1024, 9, l, 0, 0.f, smh);
    return;
  }
  if (q == 5) { if (l == 0) mix0_phase_a(p, smf, s_item, dry * 3); else mix1_phase(p, smf, s_item, dry * 3); return; }
  if (q == 6) { mix0_phase_b(p, smf, s_item, dry * 3); return; }
}

__global__ void __launch_bounds__(512, 2) mega(Params kp, int ph0, int ph1, int dry) {
  extern __shared__ __attribute__((aligned(16))) char smem[];
  int* s_item_p = (int*)(smem + SMEM_BYTES);
  uint4* xb_words_p = (uint4*)(smem + SMEM_BYTES + 16);
  if (threadIdx.x == 0) *xb_words_p = make_uint4(0u, 0u, 0u, 0u);
  __syncthreads();
  XcdBarrier xb = xcd_barrier_post((unsigned*)(kp.ws + OFF_BAR), (volatile LAS unsigned*)xb_words_p);
  if (ph1 < 0) cg::this_grid().sync();
  for (int ph = ph0; ph < ph1; ++ph) {
    if (ph > ph0) xcd_barrier(xb);
    CP p = (CP)__builtin_amdgcn_kernarg_segment_ptr();
    asm volatile("" : "+s"(p));
    run_phase(p, ph, smem, s_item_p, dry);
  }
}

extern "C" void kernel_launch(void* const* d_in, const int* in_sizes, int n_in, void* d_out, int out_size, void* d_ws,
                              size_t ws_size, hipStream_t stream) {
  static int grid_blocks = 0;
  if (!grid_blocks) {
    int dev = 0, cus = 0, per_cu = 0;
    hipGetDevice(&dev);
    hipDeviceGetAttribute(&cus, hipDeviceAttributeMultiprocessorCount, dev);
    hipFuncSetAttribute((const void*)mega, hipFuncAttributeMaxDynamicSharedMemorySize, DYN_LDS);
    hipOccupancyMaxActiveBlocksPerMultiprocessor(&per_cu, mega, NTH, DYN_LDS);
    if (per_cu > 1) per_cu = 1;
    if (per_cu < 1) per_cu = 1;
    grid_blocks = cus * per_cu;
  }
  if (ws_size < WS_TOTAL) fprintf(stderr, "workspace too small: %zu < %zu\n", ws_size, (size_t)WS_TOTAL);
  Params p{};
  for (int i = 0; i < 37; ++i) p.in[i] = (const float*)d_in[i];
  p.out = (float*)d_out;
  p.ws = (char*)d_ws;
  hipMemsetAsync((char*)d_ws + OFF_CTR, 0, 16384, stream);
#if SINGLE_LAUNCH
  int ph0 = 0, ph1 = NPHASE, dry = 0;
  void* args[] = {&p, &ph0, &ph1, &dry};
  hipError_t e = hipLaunchCooperativeKernel((void*)mega, dim3(grid_blocks), dim3(NTH), args, DYN_LDS, stream);
  if (e != hipSuccess) fprintf(stderr, "cooperative launch failed: %s (grid %d)\n", hipGetErrorString(e), grid_blocks);
#else
  for (int ph = 0; ph < NPHASE; ++ph) {
    mega<<<grid_blocks, NTH, DYN_LDS, stream>>>(p, ph, ph + 1, 0);
    int q = (ph - 1) % 11; const int l = (ph - 1) / 11; if (l == 1 && q >= 6) q += 1;
    const bool mid = ph > 0 && ph < 22;
    const bool is_gemm1 = mid && (q == 1 || q == 9), is_gemm2 = mid && (q == 2 || q == 10), is_gmix = mid && (q == 4 || q == 7);
    const bool is_mix = mid && (q == 5 || q == 6), is_norm = mid && (q == 0 || q == 3 || q == 8);
    if (((REP_MASK & 1) && is_gemm1) || ((REP_MASK & 2) && is_gemm2) || ((REP_MASK & 4) && is_gmix) || ((REP_MASK & 8) && is_mix) ||
        ((REP_MASK & 16) && ph == 0) || ((REP_MASK & 32) && is_norm))
      mega<<<grid_blocks, NTH, DYN_LDS, stream>>>(p, ph, ph + 1, 1);
  }
#endif
}
```

```cpp
#include <hip/hip_runtime.h>
#include <hip/hip_cooperative_groups.h>
#include <cstdio>
namespace cg = cooperative_groups;

#ifndef REP_MASK
#define REP_MASK 0
#endif
#ifndef SINGLE_LAUNCH
#define SINGLE_LAUNCH 1
#endif

typedef unsigned short u16;
typedef __attribute__((ext_vector_type(8))) short bf16x8;
typedef __attribute__((ext_vector_type(4))) float f32x4;
typedef __attribute__((ext_vector_type(4))) unsigned u32x4;
#define LAS __attribute__((address_space(3)))

constexpr int D = 1024, NCTX = 8192, MTOK = 10240;
constexpr int DFF = 2816, NFF = 5632;
constexpr int P0N = 2848, P0P = 3072, P1N = 2304;
constexpr int PSTR = 2944;
constexpr float EPS = 1e-6f;

enum { I_XP = 0, I_XS, I_C0K, I_C0V, I_SC, I_SN, I_SM, I_NAK, I_NAV, I_SWK, I_SWV, I_C, I_CCTX, I_NF,
       I_L0 = 14, I_L1 = 26 };
enum { L_ADAW = 0, L_ADAB, L_NORM, L_F1I, L_F1O, L_F2I, L_F2O, L_MI, L_MO, L_X0, L_X1, L_X2 };

constexpr size_t O_X = 0, O_K0 = 10485760, O_V0 = 11534336, O_C = 12582912, O_N = 14680064, O_M = 14712832,
                 O_KC1 = 14713344, O_VC1 = 18907648, O_KD1 = 23101952, O_VD1 = 24150528;

constexpr size_t SZ_WIN = (size_t)NFF * D * 2;
constexpr size_t SZ_WOUT = (size_t)D * DFF * 2;
constexpr size_t OFF_WIN = 0;
constexpr size_t OFF_WOUT = OFF_WIN + 4 * SZ_WIN;
constexpr size_t OFF_WMI0 = OFF_WOUT + 4 * SZ_WOUT;
constexpr size_t OFF_WMI1 = OFF_WMI0 + (size_t)P0P * D * 2;
constexpr size_t OFF_WMO = OFF_WMI1 + (size_t)P1N * D * 2;
constexpr size_t OFF_MOD = OFF_WMO + 2 * (size_t)D * D * 2;
constexpr size_t OFF_ROPE = OFF_MOD + 2 * 3 * 9216 * 4;
constexpr size_t OFF_CTR = OFF_ROPE + 2 * 1024 * 32 * 4;
constexpr size_t OFF_BAR = OFF_CTR + 256;
constexpr size_t OFF_ROWSS = OFF_CTR + 16384;
constexpr size_t OFF_BIAS = OFF_ROWSS + (size_t)7 * MTOK * 4;
constexpr size_t ZERO_BYTES = 16384 + (size_t)7 * MTOK * 4 + (size_t)2 * 3 * 3 * NFF * 4;
constexpr size_t OFF_XN = OFF_CTR + ZERO_BYTES;
constexpr size_t OFF_YMIX = OFF_XN + (size_t)MTOK * D * 2;
constexpr size_t OFF_HP = OFF_YMIX + (size_t)MTOK * D * 2;
constexpr size_t OFF_GATES = OFF_HP + (size_t)MTOK * PSTR * 2;
constexpr size_t OFF_STC = OFF_GATES + (size_t)MTOK * 32 * 4;
constexpr size_t OFF_STN = OFF_STC + (size_t)2560 * 4096 * 4;
constexpr size_t OFF_STM = OFF_STN + (size_t)2560 * 64 * 4;
constexpr size_t WS_TOTAL = OFF_STM + 2560 * 4;

constexpr int TS = 68;
constexpr int TILE_F = 64 * TS;
constexpr int SMEM_BYTES = 8 * TILE_F * 4 + 4096;
constexpr int NTH = 512;
constexpr int DYN_LDS = SMEM_BYTES + 32;

struct Params {
  const float* in[37];
  float* out;
  char* ws;
};
typedef const __attribute__((address_space(4))) Params* CP;

__device__ __forceinline__ int get_tid() { int t = threadIdx.x; asm volatile("" : "+v"(t)); return t; }
__device__ __forceinline__ u16 f2bf(float f) {
  unsigned u = __float_as_uint(f);
  u += 0x7fffu + ((u >> 16) & 1u);
  return (u16)(u >> 16);
}
__device__ __forceinline__ unsigned pack2(float a, float b) { return (unsigned)f2bf(a) | ((unsigned)f2bf(b) << 16); }
__device__ __forceinline__ float bflo(unsigned x) { return __uint_as_float(x << 16); }
__device__ __forceinline__ float bfhi(unsigned x) { return __uint_as_float(x & 0xffff0000u); }
__device__ __forceinline__ float grp16_sum(float v) {
  v += __shfl_xor(v, 1); v += __shfl_xor(v, 2); v += __shfl_xor(v, 4); v += __shfl_xor(v, 8); return v;
}
__device__ __forceinline__ float grp16_max(float v) {
  v = fmaxf(v, __shfl_xor(v, 1)); v = fmaxf(v, __shfl_xor(v, 2)); v = fmaxf(v, __shfl_xor(v, 4)); v = fmaxf(v, __shfl_xor(v, 8)); return v;
}
__device__ __forceinline__ float wave_sum(float v) {
  for (int o = 32; o; o >>= 1) v += __shfl_xor(v, o);
  return v;
}
__device__ __forceinline__ float wave_max(float v) {
  for (int o = 32; o; o >>= 1) v = fmaxf(v, __shfl_xor(v, o));
  return v;
}
__device__ __forceinline__ float wave_scan_add(float v, int lane) {
  for (int o = 1; o < 64; o <<= 1) { float t = __shfl_up(v, o); if (lane >= o) v += t; }
  return v;
}
__device__ __forceinline__ float wave_scan_max(float v, int lane) {
  for (int o = 1; o < 64; o <<= 1) { float t = __shfl_up(v, o); if (lane >= o) v = fmaxf(v, t); }
  return v;
}
__device__ __forceinline__ int cond_of(int row) { return row < NCTX ? 0 : 1 + ((row - NCTX) >> 10); }
__device__ __forceinline__ float sigmoidf_(float x) { return 1.f / (1.f + expf(-x)); }
__device__ __forceinline__ float logsigmoidf_(float x) { return fminf(x, 0.f) - log1pf(expf(-fabsf(x))); }

__device__ void conv_tile(const float* __restrict__ W, int K, int N, u16* __restrict__ Wt, int perm, int kt, int nt, float* T, int t, bool valid,
                          const float* shp, float* biasp) {
  {
    int r = t >> 4, c4 = t & 15;
    int c = c4 * 4;
    int src;
    if (perm == 1) src = ((nt & 3) < 2 ? 0 : DFF) + (nt >> 2) * 128 + (nt & 1) * 64 + c;
    else if (perm == 2) {
      int bj = (nt & 3) >> 1, wc = (nt & 1) * 2 + (c >> 5), w = c & 31;
      src = (nt >> 2) * 256 + wc * 64 + bj * 32 + w;
    } else src = nt * 64 + c;
    bool ok = valid && (src < N);
#pragma unroll
    for (int ps = 0; ps < 4; ++ps) {
      int k = r + ps * 16;
      float4 v = make_float4(0.f, 0.f, 0.f, 0.f);
      if (ok) v = *(const float4*)(W + (size_t)(kt * 64 + k) * N + src);
      float* tt = T + k * 65 + c;
      tt[0] = v.x; tt[1] = v.y; tt[2] = v.z; tt[3] = v.w;
    }
  }
  if (biasp && t < 192) T[4224 + t] = shp[(t >> 6) * 9216 + kt * 64 + (t & 63)];
  __syncthreads();
  if (valid && biasp && t < 192) {
    int a = t >> 6, c = t & 63;
    int src;
    if (perm == 1) src = ((nt & 3) < 2 ? 0 : DFF) + (nt >> 2) * 128 + (nt & 1) * 64 + c;
    else { int bj = (nt & 3) >> 1, wc = (nt & 1) * 2 + (c >> 5), w = c & 31; src = (nt >> 2) * 256 + wc * 64 + bj * 32 + w; }
    if (src < N) {
      const float* sh = T + 4224 + a * 64;
      float acc = 0.f;
#pragma unroll 16
      for (int k = 0; k < 64; ++k) acc += sh[k] * T[k * 65 + c];
      unsafeAtomicAdd(biasp + a * NFF + src, acc);
    }
  }
  if (valid) {
    int n = t >> 2, kp = t & 3;
    unsigned o[8];
#pragma unroll
    for (int i = 0; i < 8; ++i) {
      float a = T[(kp * 16 + 2 * i) * 65 + n], b = T[(kp * 16 + 2 * i + 1) * 65 + n];
      o[i] = pack2(a, b);
    }
    uint4* dst = (uint4*)(Wt + (size_t)(nt * 64 + n) * K + kt * 64 + kp * 16);
    dst[0] = make_uint4(o[0], o[1], o[2], o[3]);
    dst[1] = make_uint4(o[4], o[5], o[6], o[7]);
  }
  __syncthreads();
}

__device__ void adaln_unit(CP p, int u, float* sm, int t, bool valid) {
  int l = u / 144, cg_ = u % 144;
  if (!valid) { l = 0; cg_ = 0; }
  const float* W = p->in[(l ? I_L1 : I_L0) + L_ADAW];
  const float* B = p->in[(l ? I_L1 : I_L0) + L_ADAB];
  float* sc = sm;
  float* red = sm + 3072;
  for (int i = t; i < 3072; i += 256) {
    int cnd = i >> 10, k = i & 1023;
    float v = (cnd == 0) ? p->in[I_CCTX][k] : p->in[I_C][(cnd - 1) * 1024 + k];
    sc[i] = v / (1.f + expf(-v));
  }
  __syncthreads();
  int kp = t >> 4, c4 = t & 15;
  float acc[3][4];
#pragma unroll
  for (int a = 0; a < 3; ++a)
#pragma unroll
    for (int e = 0; e < 4; ++e) acc[a][e] = 0.f;
  for (int kk = 0; kk < 64; ++kk) {
    int k = kp * 64 + kk;
    float4 w = *(const float4*)(W + (size_t)k * 9216 + cg_ * 64 + c4 * 4);
#pragma unroll
    for (int a = 0; a < 3; ++a) {
      float s = sc[a * 1024 + k];
      acc[a][0] += s * w.x; acc[a][1] += s * w.y; acc[a][2] += s * w.z; acc[a][3] += s * w.w;
    }
  }
#pragma unroll
  for (int a = 0; a < 3; ++a)
#pragma unroll
    for (int e = 0; e < 4; ++e) red[(kp * 3 + a) * 64 + c4 * 4 + e] = acc[a][e];
  __syncthreads();
  if (valid && t < 192) {
    int a = t >> 6, col = t & 63;
    float s = 0.f;
    for (int q = 0; q < 16; ++q) s += red[(q * 3 + a) * 64 + col];
    s += B[cg_ * 64 + col];
    float* mod = (float*)(p->ws + OFF_MOD);
    mod[(l * 3 + a) * 9216 + cg_ * 64 + col] = s;
  }
  __syncthreads();
}

__device__ __forceinline__ void prep_a_phase(CP p, float* sm) {
  const int tid = get_tid(), half = tid >> 8, t = tid & 255;
  float* smh = sm + half * 8192;
  constexpr int U_CONV = 3328, U_ADA = 288, U_ROPE = 64;
  for (int ub = blockIdx.x * 2; ub < U_ADA; ub += gridDim.x * 2) {
    int u = ub + half;
    adaln_unit(p, u, smh, t, u < U_ADA);
  }
  for (int ub = blockIdx.x * 2; ub < U_CONV; ub += gridDim.x * 2) {
    int u = ub + half;
    bool valid = u < U_CONV;
    if (!valid) u = 0;
    const float* W; u16* Wt; int K, tt;
    if (u < 2816) {
      int mi = u / 704; tt = u % 704;
      int l = mi >> 1, f = mi & 1;
      W = p->in[(l ? I_L1 : I_L0) + (f ? L_F2O : L_F1O)];
      Wt = (u16*)(p->ws + OFF_WOUT + mi * SZ_WOUT);
      K = DFF;
    } else {
      int v = u - 2816; int l = v / 256; tt = v % 256;
      W = p->in[(l ? I_L1 : I_L0) + L_MO]; Wt = (u16*)(p->ws + OFF_WMO + (size_t)l * D * D * 2); K = 1024;
    }
    int nt = tt % 16, kt = tt / 16;
    conv_tile(W, K, 1024, Wt, 0, kt, nt, smh, t, valid, nullptr, nullptr);
  }
  for (int u = blockIdx.x; u < U_ROPE; u += gridDim.x) {
    int e = u * 512 + tid;
    int tk = e >> 5, i = e & 31;
    float pos = (i < 16) ? (float)(tk >> 6) : (float)(tk & 63);
    float fr = powf(10000.f, -(float)(i & 15) / 16.f);
    float ang = pos * fr;
    float* rc = (float*)(p->ws + OFF_ROPE);
    rc[e] = cosf(ang);
    rc[32768 + e] = sinf(ang);
  }
}

__device__ __forceinline__ void prep_b_phase(CP p, float* sm, const int dry) {
  const int tid = get_tid(), half = tid >> 8, t = tid & 255, lane = tid & 63, w = tid >> 6;
  float* smh = sm + half * 8192;
  const float* mod = (const float*)(p->ws + OFF_MOD);
  float* bias = (float*)(p->ws + OFF_BIAS);
  constexpr int U_CONV = 6976;
  for (int ub = blockIdx.x * 2; ub < U_CONV; ub += gridDim.x * 2) {
    int u = ub + half;
    bool valid = u < U_CONV;
    if (!valid) u = 0;
    const float* W; u16* Wt; int N, perm, tt, ntn, l, which;
    if (u < 5632) {
      int mi = u / 1408; tt = u % 1408;
      l = mi >> 1; int f = mi & 1; which = f ? 2 : 0;
      W = p->in[(l ? I_L1 : I_L0) + (f ? L_F2I : L_F1I)];
      Wt = (u16*)(p->ws + OFF_WIN + mi * SZ_WIN);
      N = NFF; perm = 1; ntn = 88;
    } else if (u < 6400) {
      tt = u - 5632; l = 0; which = 1; W = p->in[I_L0 + L_MI]; Wt = (u16*)(p->ws + OFF_WMI0); N = P0N; perm = 2; ntn = 48;
    } else {
      tt = u - 6400; l = 1; which = 1; W = p->in[I_L1 + L_MI]; Wt = (u16*)(p->ws + OFF_WMI1); N = P1N; perm = 2; ntn = 36;
    }
    int nt = tt % ntn, kt = tt / ntn;
    conv_tile(W, 1024, N, Wt, perm, kt, nt, smh, t, valid, mod + (l * 3) * 9216 + (3 * which) * 1024, dry ? nullptr : bias + (size_t)((l * 3 + which) * 3) * NFF);
  }
  {
    float* x = p->out + O_X;
    u16* xn = (u16*)(p->ws + OFF_XN);
    float* rowss = (float*)(p->ws + OFF_ROWSS);
    const float4* g = (const float4*)(p->in[I_L0 + L_NORM]);
    for (int row = blockIdx.x * 8 + w; row < MTOK; row += gridDim.x * 8) {
      const float4* src = (row < NCTX) ? (const float4*)(p->in[I_XP] + (size_t)row * D) : (const float4*)(p->in[I_XS] + (size_t)(row - NCTX) * D);
      float4* xr = (float4*)(x + (size_t)row * D);
      const float4* sc = (const float4*)(mod + (size_t)cond_of(row) * 9216 + 1024);
      float ss = 0.f;
#pragma unroll
      for (int i = 0; i < 4; ++i) {
        int q = lane + i * 64;
        float4 v = src[q];
        ss += v.x * v.x + v.y * v.y + v.z * v.z + v.w * v.w;
        xr[q] = v;
        float4 gg = g[q], s2 = sc[q];
        uint2 o = make_uint2(pack2(v.x * (gg.x * (1.f + s2.x)), v.y * (gg.y * (1.f + s2.y))), pack2(v.z * (gg.z * (1.f + s2.z)), v.w * (gg.w * (1.f + s2.w))));
        *(uint2*)(xn + (size_t)row * D + q * 4) = o;
      }
      ss = wave_sum(ss);
      if (lane == 0) rowss[row] = ss;
    }
  }
}

__device__ __forceinline__ void final_phase(CP p) {
  const int tid = get_tid(), lane = tid & 63, w = tid >> 6;
  float* x = p->out + O_X;
  const float* rowss = (const float*)(p->ws + OFF_ROWSS) + 6 * MTOK;
  const float4* g = (const float4*)p->in[I_NF];
  for (int row = blockIdx.x * 8 + w; row < MTOK; row += gridDim.x * 8) {
    float4* xr = (float4*)(x + (size_t)row * D);
    const float rstd = rsqrtf(rowss[row] * (1.f / 1024.f) + EPS);
#pragma unroll
    for (int i = 0; i < 4; ++i) {
      int q = lane + i * 64;
      float4 v = xr[q], gg = g[q];
      xr[q] = make_float4(v.x * rstd * gg.x, v.y * rstd * gg.y, v.z * rstd * gg.z, v.w * rstd * gg.w);
    }
  }
}

enum { EPI_SWIGLU = 0, EPI_RESID = 1, EPI_MIX0 = 2, EPI_MIX1 = 3 };
constexpr int BM = 256, BK = 64, HALF = 128, HT = HALF * BK, NXCD = 8, WGM = 8;

__device__ __forceinline__ int lds_byte(int r, int c) {
  int st = (r >> 4) * 2 + (c >> 5), rr = r & 15, cc = c & 31, ob = rr * 64 + cc * 2;
  return st * 1024 + (ob ^ (((ob >> 9) & 1) << 5));
}
__device__ __forceinline__ void stage_rc(int b, int& R, int& C) {
  int st = b / 1024, sb = b % 1024, swz = sb ^ (((sb >> 9) & 1) << 5);
  R = (st >> 1) * 16 + swz / 64; C = (st & 1) * 32 + (swz % 64) / 2;
}

template <int EPI>
__device__ __forceinline__ void gemm256_tile(CP p, const u16* A, const u16* Bt, const int K,
                                             const int brow, const int bcol, int l, int gchunk, float coef, int nid, u16* shm, const int tid) {
#define SAI(b, h) ((b) * 2 + (h))
#define SBI(b, h) (4 + (b) * 2 + (h))
#define STAGE(PI, BASE, br, kt) do { \
    const char* _gb = (const char*)(BASE) + ((long)(br) * K + (long)(kt) * BK) * 2; \
    char* _lp = (char*)shm + (PI) * (HT * 2) + wave_lds; \
    __builtin_amdgcn_global_load_lds((const unsigned*)(_gb + voff0), (LAS unsigned*)(_lp), 16, 0, 0); \
    __builtin_amdgcn_global_load_lds((const unsigned*)(_gb + (long)K * 128 + voff0), (LAS unsigned*)(_lp + 8192), 16, 0, 0); } while (0)
#define LDA(dst, PI) do { unsigned _o = sw_ + a_uni; asm volatile("" : "+v"(_o)); _o &= 0x23F0u; \
    _Pragma("unroll") for (int m = 0; m < 4; ++m) _Pragma("unroll") for (int k = 0; k < 2; ++k) \
      dst[m][k] = *reinterpret_cast<const bf16x8*>((const char*)shm + (PI) * (HT * 2) + m * 2048 + k * 1024 + _o); } while (0)
#define LDB(dst, PI) do { unsigned _o = sw_ + b_uni; asm volatile("" : "+v"(_o)); _o &= 0x33F0u; \
    _Pragma("unroll") for (int n = 0; n < 2; ++n) _Pragma("unroll") for (int k = 0; k < 2; ++k) \
      dst[n][k] = *reinterpret_cast<const bf16x8*>((const char*)shm + (PI) * (HT * 2) + n * 2048 + k * 1024 + _o); } while (0)
#define MMA(ai, bj, At_, Bt_) do { __builtin_amdgcn_s_setprio(1); \
    _Pragma("unroll") for (int m = 0; m < 4; ++m) _Pragma("unroll") for (int n = 0; n < 2; ++n) _Pragma("unroll") for (int k = 0; k < 2; ++k) \
      acc[ai][bj][m][n] = __builtin_amdgcn_mfma_f32_16x16x32_bf16(At_[m][k], Bt_[n][k], acc[ai][bj][m][n], 0, 0, 0); \
    __builtin_amdgcn_s_setprio(0); } while (0)
#define WAIT_V(n) asm volatile("s_waitcnt vmcnt(" #n ")" ::: "memory")
#define WAIT_L(n) asm volatile("s_waitcnt lgkmcnt(" #n ")" ::: "memory")
#define BAR __builtin_amdgcn_s_barrier()
#define SCHED __builtin_amdgcn_sched_barrier(0)
  const int wid = __builtin_amdgcn_readfirstlane(tid >> 6), lane = tid & 63, wr = wid >> 2, wc = wid & 3, fr = lane & 15, fq = lane >> 4;
  const int wave_lds = (wid & 7) * 1024;
  unsigned voff0;
  { int r_, c_; stage_rc(tid * 16, r_, c_); voff0 = (unsigned)(r_ * K + c_) * 2u; }
  const unsigned sw_ = (unsigned)((fr * 64 + fq * 16) ^ ((((fr * 64 + fq * 16) >> 9) & 1) << 5));
  const unsigned a_uni = (unsigned)(wr * 8192), b_uni = (unsigned)(wc * 4096);
  f32x4 acc[2][2][4][2];
#pragma unroll
  for (int a = 0; a < 2; ++a)
#pragma unroll
    for (int b = 0; b < 2; ++b)
#pragma unroll
      for (int m = 0; m < 4; ++m)
#pragma unroll
        for (int n = 0; n < 2; ++n) acc[a][b][m][n] = (f32x4){0.f, 0.f, 0.f, 0.f};
  bf16x8 At[4][2], B0[2][2], B1[2][2];
  const int nt = K / BK;
  WAIT_V(0);
  __syncthreads();
  STAGE(SBI(0, 0), Bt, bcol, 0); STAGE(SAI(0, 0), A, brow, 0);
  STAGE(SBI(0, 1), Bt, bcol + HALF, 0); STAGE(SAI(0, 1), A, brow + HALF, 0);
  if (wr == 1) BAR;
  WAIT_V(4); BAR;
  STAGE(SBI(1, 0), Bt, bcol, 1); STAGE(SAI(1, 0), A, brow, 1); STAGE(SBI(1, 1), Bt, bcol + HALF, 1);
  WAIT_V(6); BAR;
  for (int t = 0; t < nt - 2; t += 2) {
    LDB(B0, SBI(0, 0)); SCHED; LDA(At, SAI(0, 0)); STAGE(SAI(1, 1), A, brow + HALF, t + 1);
    WAIT_L(8); BAR; WAIT_L(0); MMA(0, 0, At, B0); BAR; SCHED;
    LDB(B1, SBI(0, 1)); STAGE(SBI(0, 0), Bt, bcol, t + 2);
    BAR; WAIT_L(0); MMA(0, 1, At, B1); BAR;
    LDA(At, SAI(0, 1)); STAGE(SAI(0, 0), A, brow, t + 2);
    BAR; WAIT_L(0); MMA(1, 0, At, B0); BAR; SCHED;
    STAGE(SBI(0, 1), Bt, bcol + HALF, t + 2);
    WAIT_V(6); BAR; MMA(1, 1, At, B1); BAR;
    LDB(B0, SBI(1, 0)); SCHED; LDA(At, SAI(1, 0)); STAGE(SAI(0, 1), A, brow + HALF, t + 2);
    WAIT_L(8); BAR; WAIT_L(0); MMA(0, 0, At, B0); BAR; SCHED;
    LDB(B1, SBI(1, 1)); STAGE(SBI(1, 0), Bt, bcol, t + 3);
    BAR; WAIT_L(0); MMA(0, 1, At, B1); BAR;
    LDA(At, SAI(1, 1)); STAGE(SAI(1, 0), A, brow, t + 3);
    BAR; WAIT_L(0); MMA(1, 0, At, B0); BAR; SCHED;
    STAGE(SBI(1, 1), Bt, bcol + HALF, t + 3);
    WAIT_V(6); BAR; MMA(1, 1, At, B1); BAR;
  }
  { LDB(B0, SBI(0, 0)); LDA(At, SAI(0, 0)); STAGE(SAI(1, 1), A, brow + HALF, nt - 1);
    BAR; WAIT_L(0); MMA(0, 0, At, B0); BAR;
    LDB(B1, SBI(0, 1)); BAR; WAIT_L(0); MMA(0, 1, At, B1); BAR;
    LDA(At, SAI(0, 1)); WAIT_V(4); BAR; WAIT_L(0); MMA(1, 0, At, B0); MMA(1, 1, At, B1); BAR; }
  { LDB(B0, SBI(1, 0)); LDA(At, SAI(1, 0)); WAIT_V(2); BAR; WAIT_L(0); MMA(0, 0, At, B0); BAR;
    LDB(B1, SBI(1, 1)); WAIT_V(0); BAR; WAIT_L(0); MMA(0, 1, At, B1); BAR;
    LDA(At, SAI(1, 1)); BAR; WAIT_L(0); MMA(1, 0, At, B0); MMA(1, 1, At, B1); BAR; }
  if (wr == 0) BAR;
#undef SAI
#undef SBI
#undef STAGE
#undef LDA
#undef LDB
#undef MMA
#undef WAIT_V
#undef WAIT_L
#undef BAR
#undef SCHED
  if (EPI == EPI_SWIGLU) {
    u16* H = (u16*)(p->ws + OFF_HP);
    const int hc0 = (bcol >> 1) + wc * 32 + fr;
    const float* rowss = (const float*)(p->ws + OFF_ROWSS) + (size_t)nid * MTOK;
    const float* bias = (const float*)(p->ws + OFF_BIAS) + (size_t)(nid * 3 + cond_of(brow)) * NFF;
    float bg[2], bu[2];
#pragma unroll
    for (int n = 0; n < 2; ++n) { bg[n] = bias[hc0 + n * 16]; bu[n] = bias[DFF + hc0 + n * 16]; }
#pragma unroll
    for (int ai = 0; ai < 2; ++ai)
#pragma unroll
      for (int m = 0; m < 4; ++m)
#pragma unroll
        for (int j = 0; j < 4; ++j) {
          int row = brow + ai * 128 + wr * 64 + m * 16 + fq * 4 + j;
          const float rstd = rsqrtf(rowss[row] * (1.f / 1024.f) + EPS);
#pragma unroll
          for (int n = 0; n < 2; ++n) {
            float g = acc[ai][0][m][n][j] * rstd + bg[n], u = acc[ai][1][m][n][j] * rstd + bu[n];
            float h = g / (1.f + __expf(-g)) * u;
            H[(size_t)row * DFF + hc0 + n * 16] = f2bf(h);
          }
        }
  } else if (EPI == EPI_RESID) {
    float* x = p->out + O_X;
    const float* mod = (const float*)(p->ws + OFF_MOD);
    u16* xn = (u16*)(p->ws + OFF_XN);
    float* rowss = (float*)(p->ws + OFF_ROWSS) + (size_t)nid * MTOK;
    const int cnd = cond_of(brow);
    const float* gp = mod + (l * 3 + cnd) * 9216 + gchunk * 1024;
    const bool has_next = nid < 6;
    const int ln = (nid % 6) / 3, wn = nid % 3;
    const float* ngp = p->in[(ln ? I_L1 : I_L0) + L_NORM] + wn * 1024;
    const float* scp = mod + (ln * 3 + cnd) * 9216 + (3 * wn + 1) * 1024;
    float gt[2][2], gs[2][2];
#pragma unroll
    for (int bj = 0; bj < 2; ++bj)
#pragma unroll
      for (int n = 0; n < 2; ++n) {
        int col = bcol + bj * 128 + wc * 32 + n * 16 + fr;
        gt[bj][n] = coef * gp[col];
        gs[bj][n] = has_next ? ngp[col] * (1.f + scp[col]) : 0.f;
      }
#pragma unroll
    for (int ai = 0; ai < 2; ++ai)
#pragma unroll
      for (int m = 0; m < 4; ++m)
#pragma unroll
        for (int j = 0; j < 4; ++j) {
          int row = brow + ai * 128 + wr * 64 + m * 16 + fq * 4 + j;
          float ss = 0.f;
#pragma unroll
          for (int bj = 0; bj < 2; ++bj)
#pragma unroll
            for (int n = 0; n < 2; ++n) {
              int col = bcol + bj * 128 + wc * 32 + n * 16 + fr;
              size_t idx = (size_t)row * D + col;
              float xv = x[idx] + gt[bj][n] * acc[ai][bj][m][n][j];
              x[idx] = xv;
              ss += xv * xv;
              if (has_next) xn[idx] = f2bf(xv * gs[bj][n]);
            }
          ss = grp16_sum(ss);
          if (fr == 0 && nid < 7) unsafeAtomicAdd(rowss + row, ss);
        }
  } else {
    u16* proj = (u16*)(p->ws + OFF_HP);
    const bool isctx = brow < NCTX;
    const int c0 = bcol + wc * 64;
    const float* rc = (const float*)(p->ws + OFF_ROPE);
    const float* rowss = (const float*)(p->ws + OFF_ROWSS) + (size_t)nid * MTOK;
    const float* bias = (const float*)(p->ws + OFF_BIAS) + (size_t)(nid * 3 + cond_of(brow)) * NFF;
    float bz[2][2];
#pragma unroll
    for (int bj = 0; bj < 2; ++bj)
#pragma unroll
      for (int n = 0; n < 2; ++n) { int col = c0 + bj * 32 + n * 16 + fr; bz[bj][n] = (col < ((EPI == EPI_MIX0) ? P0N : P1N)) ? bias[col] : 0.f; }
    bool do_norm = false, do_rope = false;
    const float* ng = nullptr;
    float* o32 = nullptr; int ostr = 0;
    bool elementwise = false;
    if (EPI == EPI_MIX0) {
      if (c0 < 512) { do_norm = true; ng = p->in[I_L0 + L_X0]; do_rope = !isctx; }
      else if (c0 < 640) { do_norm = true; ng = p->in[I_L0 + L_X0] + 64; do_rope = !isctx; if (isctx) { o32 = p->out + O_K0 + (c0 - 512); ostr = 128; } }
      else if (c0 < 768) { if (isctx) { o32 = p->out + O_V0 + (c0 - 640); ostr = 128; } }
      else if (c0 >= 2304) elementwise = true;
    } else {
      if (c0 < 512) {}
      else if (c0 < 1024) { if (isctx) { o32 = p->out + O_KC1 + (c0 - 512); ostr = 512; } }
      else if (c0 < 1536) { if (isctx) { o32 = p->out + O_VC1 + (c0 - 1024); ostr = 512; } }
      else if (c0 < 2048) { do_rope = !isctx; }
      else if (c0 < 2176) { do_rope = !isctx; if (isctx) { o32 = p->out + O_KD1 + (c0 - 2048); ostr = 128; } }
      else { if (isctx) { o32 = p->out + O_VD1 + (c0 - 2176); ostr = 128; } }
    }
    if (elementwise) {
      float* gates = (float*)(p->ws + OFF_GATES);
      const float* gb = p->in[I_L0 + L_X1];
#pragma unroll
      for (int ai = 0; ai < 2; ++ai)
#pragma unroll
        for (int m = 0; m < 4; ++m)
#pragma unroll
          for (int j = 0; j < 4; ++j) {
            int row = brow + ai * 128 + wr * 64 + m * 16 + fq * 4 + j;
            const float rstd = rsqrtf(rowss[row] * (1.f / 1024.f) + EPS);
#pragma unroll
            for (int bj = 0; bj < 2; ++bj)
#pragma unroll
              for (int n = 0; n < 2; ++n) {
                int col = c0 + bj * 32 + n * 16 + fr;
                float v = acc[ai][bj][m][n][j] * rstd + bz[bj][n];
                if (col < 2336) gates[(size_t)row * 32 + (col - 2304)] = v + gb[col - 2304];
                else if (col < P0N) proj[(size_t)row * PSTR + col] = f2bf(v);
              }
          }
    } else {
#pragma unroll
      for (int ai = 0; ai < 2; ++ai)
#pragma unroll
        for (int m = 0; m < 4; ++m)
#pragma unroll
          for (int j = 0; j < 4; ++j) {
            int row = brow + ai * 128 + wr * 64 + m * 16 + fq * 4 + j;
            const float rstd0 = rsqrtf(rowss[row] * (1.f / 1024.f) + EPS);
            float v0 = acc[ai][0][m][0][j] * rstd0 + bz[0][0], v1 = acc[ai][0][m][1][j] * rstd0 + bz[0][1];
            float v2 = acc[ai][1][m][0][j] * rstd0 + bz[1][0], v3 = acc[ai][1][m][1][j] * rstd0 + bz[1][1];
            if (do_norm) {
              float ss = v0 * v0 + v1 * v1 + v2 * v2 + v3 * v3;
              ss = grp16_sum(ss);
              float rstd = rsqrtf(ss * (1.f / 64.f) + EPS);
              v0 = v0 * rstd * ng[fr]; v1 = v1 * rstd * ng[16 + fr]; v2 = v2 * rstd * ng[32 + fr]; v3 = v3 * rstd * ng[48 + fr];
            }
            if (do_rope) {
              int tk = (row - NCTX) & 1023;
              float ca = rc[tk * 32 + fr], sa = rc[32768 + tk * 32 + fr];
              float cb = rc[tk * 32 + 16 + fr], sb = rc[32768 + tk * 32 + 16 + fr];
              float a0 = v0 * ca - v2 * sa, a2 = v2 * ca + v0 * sa;
              float a1 = v1 * cb - v3 * sb, a3 = v3 * cb + v1 * sb;
              v0 = a0; v1 = a1; v2 = a2; v3 = a3;
            }
            u16* pr = proj + (size_t)row * PSTR + c0 + fr;
            pr[0] = f2bf(v0); pr[16] = f2bf(v1); pr[32] = f2bf(v2); pr[48] = f2bf(v3);
            if (o32) {
              float* o = o32 + (size_t)row * ostr + fr;
              o[0] = v0; o[16] = v1; o[32] = v2; o[48] = v3;
            }
          }
    }
  }
}

template <int EPI>
__device__ __forceinline__ void gemm_phase(CP p, const u16* A, const u16* Bt, int K, int nN, int l, int gchunk, float coef, int nid, u16* smem) {
  const int tid = get_tid();
  const int nM = MTOK / BM, nwg = nM * nN;
  for (int t = blockIdx.x; t < nwg; t += gridDim.x) {
    int wgid = t;
    { int q = nwg / NXCD, r = nwg % NXCD, xcd = wgid % NXCD, off = wgid / NXCD;
      wgid = (xcd < r ? xcd * (q + 1) : r * (q + 1) + (xcd - r) * q) + off; }
    int nig = WGM * nN, gid = wgid / nig, fm = gid * WGM, gsz = min(nM - fm, WGM);
    int pm = fm + ((wgid % nig) % gsz), pn = (wgid % nig) / gsz;
    gemm256_tile<EPI>(p, A, Bt, K, pm * BM, pn * BM, l, gchunk, coef, nid, smem, tid);
  }
}

__device__ __forceinline__ void load_tile_bf16(float* dst, const u16* src, long rstride, float scale, int tid) {
  int r = tid >> 2, part = tid & 3;
  const uint4* s = (const uint4*)(src + (long)r * rstride + part * 16);
  uint4 a = s[0], b = s[1];
  float4* d = (float4*)(dst + r * TS + part * 16);
  d[0] = make_float4(bflo(a.x) * scale, bfhi(a.x) * scale, bflo(a.y) * scale, bfhi(a.y) * scale);
  d[1] = make_float4(bflo(a.z) * scale, bfhi(a.z) * scale, bflo(a.w) * scale, bfhi(a.w) * scale);
  d[2] = make_float4(bflo(b.x) * scale, bfhi(b.x) * scale, bflo(b.y) * scale, bfhi(b.y) * scale);
  d[3] = make_float4(bflo(b.z) * scale, bfhi(b.z) * scale, bflo(b.w) * scale, bfhi(b.w) * scale);
}
__device__ __forceinline__ void tile_ld_regs(const u16* src, long rstride, int tid, uint4& a, uint4& b) {
  int r = tid >> 2, part = tid & 3;
  const uint4* s = (const uint4*)(src + (long)r * rstride + part * 16);
  a = s[0]; b = s[1];
}
__device__ __forceinline__ void tile_st_regs(float* dst, int tid, const uint4& a, const uint4& b, float scale) {
  int r = tid >> 2, part = tid & 3;
  float4* d = (float4*)(dst + r * TS + part * 16);
  d[0] = make_float4(bflo(a.x) * scale, bfhi(a.x) * scale, bflo(a.y) * scale, bfhi(a.y) * scale);
  d[1] = make_float4(bflo(a.z) * scale, bfhi(a.z) * scale, bflo(a.w) * scale, bfhi(a.w) * scale);
  d[2] = make_float4(bflo(b.x) * scale, bfhi(b.x) * scale, bflo(b.y) * scale, bfhi(b.y) * scale);
  d[3] = make_float4(bflo(b.z) * scale, bfhi(b.z) * scale, bflo(b.w) * scale, bfhi(b.w) * scale);
}
__device__ __forceinline__ void load_tile_f32(float* dst, const float* src, long rstride, int tid) {
  int r = tid >> 2, part = tid & 3;
  const float4* s = (const float4*)(src + (long)r * rstride + part * 16);
  float4* d = (float4*)(dst + r * TS + part * 16);
  d[0] = s[0]; d[1] = s[1]; d[2] = s[2]; d[3] = s[3];
}
typedef __attribute__((ext_vector_type(2))) float f32x2;
__device__ __forceinline__ void qk_micro(const float* Qs, const float* Ks, int ty, int tx, float s[4][4]) {
  f32x2 s2[4][4];
#pragma unroll
  for (int i = 0; i < 4; ++i)
#pragma unroll
    for (int j = 0; j < 4; ++j) s2[i][j] = (f32x2){0.f, 0.f};
#pragma unroll 2
  for (int d4 = 0; d4 < 16; ++d4) {
    f32x4 q[4], k[4];
#pragma unroll
    for (int i = 0; i < 4; ++i) q[i] = *(const f32x4*)(Qs + (ty * 4 + i) * TS + d4 * 4);
#pragma unroll
    for (int j = 0; j < 4; ++j) k[j] = *(const f32x4*)(Ks + (tx + 16 * j) * TS + d4 * 4);
#pragma unroll
    for (int i = 0; i < 4; ++i)
#pragma unroll
      for (int j = 0; j < 4; ++j) {
        s2[i][j] += q[i].xy * k[j].xy;
        s2[i][j] += q[i].zw * k[j].zw;
      }
  }
#pragma unroll
  for (int i = 0; i < 4; ++i)
#pragma unroll
    for (int j = 0; j < 4; ++j) s[i][j] = s2[i][j].x + s2[i][j].y;
}
__device__ __forceinline__ void pv_micro(const float* Ps, const float* Vs, int ty, int tx, float o[4][4]) {
  f32x2 oa[4], ob[4];
#pragma unroll
  for (int i = 0; i < 4; ++i) { oa[i] = (f32x2){o[i][0], o[i][1]}; ob[i] = (f32x2){o[i][2], o[i][3]}; }
#pragma unroll 2
  for (int s4 = 0; s4 < 16; ++s4) {
    f32x4 pp[4], v[4];
#pragma unroll
    for (int i = 0; i < 4; ++i) pp[i] = *(const f32x4*)(Ps + (ty * 4 + i) * TS + s4 * 4);
#pragma unroll
    for (int q = 0; q < 4; ++q) v[q] = *(const f32x4*)(Vs + (s4 * 4 + q) * TS + tx * 4);
#pragma unroll
    for (int i = 0; i < 4; ++i)
#pragma unroll
      for (int q = 0; q < 4; ++q) {
        const float ps = pp[i][q];
        const f32x2 p2 = (f32x2){ps, ps};
        oa[i] += p2 * v[q].xy;
        ob[i] += p2 * v[q].zw;
      }
  }
#pragma unroll
  for (int i = 0; i < 4; ++i) { o[i][0] = oa[i].x; o[i][1] = oa[i].y; o[i][2] = ob[i].x; o[i][3] = ob[i].y; }
}

struct AttnDesc {
  int qrow0, qcol, ocol;
  const float* ck; const float* cv; int cstride; int nctx;
  int krow0, nloc, kcol, vcol;
  int mode;
  int a0;
  int r0;
  const float* rpb;
  float sink; int has_sink;
};

constexpr int AS_ = 72;
__device__ __forceinline__ void attn_item(CP p, const AttnDesc& d, float* sm) {
  const int tid = get_tid(), w = tid >> 6, lane = tid & 63, fr = lane & 15, fq = lane >> 4, half = w >> 2;
  const u16* proj = (const u16*)(p->ws + OFF_HP);
  u16* Ks = (u16*)sm;
  u16* Vt = Ks + 64 * AS_;
  u16* Ps = Vt + 64 * AS_ + w * (16 * AS_);
  bf16x8 qf[2];
  {
    const u16* qp = proj + (size_t)(d.qrow0 + w * 16 + fr) * PSTR + d.qcol + fq * 8;
    qf[0] = *(const bf16x8*)(qp);
    qf[1] = *(const bf16x8*)(qp + 32);
  }
  float m_i[4], l_i[4];
  f32x4 o[4];
#pragma unroll
  for (int j = 0; j < 4; ++j) {
    m_i[j] = d.has_sink ? d.sink : -1e30f;
    l_i[j] = (d.has_sink && fr == 0) ? 1.f : 0.f;
  }
#pragma unroll
  for (int n = 0; n < 4; ++n) o[n] = (f32x4){0.f, 0.f, 0.f, 0.f};
  const int ntiles = d.nctx + d.nloc;
  const int lrow = tid >> 3, lc8 = tid & 7;
  float4 kf0, kf1, vf0, vf1;
  u32x4 kq, vq;
  auto issue = [&](int tile) {
    if (tile < d.nctx) {
      const size_t off = (size_t)(tile * 64 + lrow) * d.cstride + lc8 * 8;
      kf0 = *(const float4*)(d.ck + off); kf1 = *(const float4*)(d.ck + off + 4);
      vf0 = *(const float4*)(d.cv + off); vf1 = *(const float4*)(d.cv + off + 4);
    } else {
      const u16* base = proj + (size_t)(d.krow0 + (tile - d.nctx) * 64 + lrow) * PSTR + lc8 * 8;
      kq = *(const u32x4*)(base + d.kcol);
      vq = *(const u32x4*)(base + d.vcol);
    }
  };
  issue(0);
  for (int tile = 0; tile < ntiles; ++tile) {
    __syncthreads();
    if (tile < d.nctx) {
      kq = (u32x4){pack2(kf0.x, kf0.y), pack2(kf0.z, kf0.w), pack2(kf1.x, kf1.y), pack2(kf1.z, kf1.w)};
      vq = (u32x4){pack2(vf0.x, vf0.y), pack2(vf0.z, vf0.w), pack2(vf1.x, vf1.y), pack2(vf1.z, vf1.w)};
    }
    *(u32x4*)(Ks + lrow * AS_ + lc8 * 8) = kq;
    {
      u16* vt = Vt + (lc8 * 8) * AS_ + lrow;
      vt[0 * AS_] = (u16)(vq.x & 0xffff); vt[1 * AS_] = (u16)(vq.x >> 16);
      vt[2 * AS_] = (u16)(vq.y & 0xffff); vt[3 * AS_] = (u16)(vq.y >> 16);
      vt[4 * AS_] = (u16)(vq.z & 0xffff); vt[5 * AS_] = (u16)(vq.z >> 16);
      vt[6 * AS_] = (u16)(vq.w & 0xffff); vt[7 * AS_] = (u16)(vq.w >> 16);
    }
    __syncthreads();
    if (tile + 1 < ntiles) issue(tile + 1);
    const int lt = tile - d.nctx;
    f32x4 sacc[4];
#pragma unroll
    for (int n = 0; n < 4; ++n) sacc[n] = (f32x4){0.f, 0.f, 0.f, 0.f};
#pragma unroll
    for (int ks = 0; ks < 2; ++ks)
#pragma unroll
      for (int n = 0; n < 4; ++n) {
        bf16x8 kb = *(const bf16x8*)(Ks + (n * 16 + fr) * AS_ + ks * 32 + fq * 8);
        sacc[n] = __builtin_amdgcn_mfma_f32_16x16x32_bf16(qf[ks], kb, sacc[n], 0, 0, 0);
      }
    float sv[4][4];
#pragma unroll
    for (int n = 0; n < 4; ++n)
#pragma unroll
      for (int j = 0; j < 4; ++j) sv[j][n] = sacc[n][j] * 0.125f;
    if (lt >= 0 && d.mode == 1) {
      const int rq = d.a0 + half;
      const int kr = d.r0 + lt;
      const int rq0 = min(max(rq - 4, 0), 8);
      const bool rowok = (kr >= rq0) && (kr < rq0 + 8);
      const int dy = min(max(kr - rq + 7, 0), 14);
      const float* rp = d.rpb + dy * 31;
#pragma unroll
      for (int j = 0; j < 4; ++j) {
        int qc = (w & 3) * 16 + fq * 4 + j;
        int ws = min(max(qc - 8, 0), 48);
#pragma unroll
        for (int n = 0; n < 4; ++n) {
          int kc = n * 16 + fr;
          bool ok = rowok && (kc >= ws) && (kc < ws + 16);
          int dx = min(max(kc - qc + 15, 0), 30);
          sv[j][n] = ok ? sv[j][n] + rp[dx] : -1e30f;
        }
      }
    } else if (lt >= 0 && d.mode == 2) {
      const int off = d.a0 + lt * 64 - half * 64;
#pragma unroll
      for (int j = 0; j < 4; ++j)
#pragma unroll
        for (int n = 0; n < 4; ++n) {
          int dd = off + (n * 16 + fr) - ((w & 3) * 16 + fq * 4 + j);
          bool ok = (dd <= 128) && (dd >= -128);
          sv[j][n] = ok ? sv[j][n] : -1e30f;
        }
    }
#pragma unroll
    for (int j = 0; j < 4; ++j) {
      float mx = fmaxf(fmaxf(sv[j][0], sv[j][1]), fmaxf(sv[j][2], sv[j][3]));
      mx = grp16_max(mx);
      float mn = fmaxf(m_i[j], mx);
      float alpha = __expf(m_i[j] - mn);
      float rs = 0.f;
#pragma unroll
      for (int n = 0; n < 4; ++n) {
        float pj = __expf(sv[j][n] - mn);
        rs += pj;
        Ps[(fq * 4 + j) * AS_ + n * 16 + fr] = f2bf(pj);
      }
      l_i[j] = l_i[j] * alpha + rs;
      m_i[j] = mn;
#pragma unroll
      for (int n = 0; n < 4; ++n) o[n][j] *= alpha;
    }
    __builtin_amdgcn_wave_barrier();
#pragma unroll
    for (int ks = 0; ks < 2; ++ks) {
      bf16x8 pa = *(const bf16x8*)(Ps + fr * AS_ + ks * 32 + fq * 8);
#pragma unroll
      for (int n = 0; n < 4; ++n) {
        bf16x8 vb = *(const bf16x8*)(Vt + (n * 16 + fr) * AS_ + ks * 32 + fq * 8);
        o[n] = __builtin_amdgcn_mfma_f32_16x16x32_bf16(pa, vb, o[n], 0, 0, 0);
      }
    }
    __builtin_amdgcn_wave_barrier();
  }
  u16* ymix = (u16*)(p->ws + OFF_YMIX);
#pragma unroll
  for (int j = 0; j < 4; ++j) {
    float inv = 1.f / grp16_sum(l_i[j]);
    u16* yp = ymix + (size_t)(d.qrow0 + w * 16 + fq * 4 + j) * D + d.ocol + fr;
#pragma unroll
    for (int n = 0; n < 4; ++n) yp[n * 16] = f2bf(o[n][j] * inv);
  }
}

__device__ __forceinline__ int st_slot(int isctx, int b, int dir, int head, int cc) {
  int ch = (b * 2 + dir) * 8 + head;
  return isctx ? (ch * 4 + cc) : (2048 + ch * 16 + cc);
}

__device__ __forceinline__ void mlstm_state_item(CP p, int isctx, int b, int head, float* sm) {
  const int tid = get_tid(), dir = tid >> 8, t = tid & 255, ty = t >> 4, tx = t & 15, lane = t & 63;
  const u16* proj = (const u16*)(p->ws + OFF_HP);
  const float* gates = (const float*)(p->ws + OFF_GATES);
  float* stC = (float*)(p->ws + OFF_STC);
  float* stn = (float*)(p->ws + OFF_STN);
  float* stm = (float*)(p->ws + OFF_STM);
  float* Ks = sm + (dir * 2) * TILE_F; float* Vs = sm + (dir * 2 + 1) * TILE_F;
  float* sws = sm + 8 * TILE_F + dir * 256;
  float* sn = sws + 64;
  float* ssc = sn + 64;
  const int nc = isctx ? 4 : 16, L = isctx ? 256 : 1024;
  const int seq0 = isctx ? b * 256 : NCTX + b * 1024;
  float c[4][4];
  float m;
  __syncthreads();
  if (isctx) {
#pragma unroll
    for (int i = 0; i < 4; ++i)
#pragma unroll
      for (int j = 0; j < 4; ++j) c[i][j] = 0.f;
    if (t < 64) sn[t] = 0.f;
    m = 0.f;
  } else {
    int ch = (b * 2 + dir) * 8 + head;
    const float* C0 = p->in[I_SC] + (size_t)ch * 4096;
#pragma unroll
    for (int i = 0; i < 4; ++i) {
      float4 v = *(const float4*)(C0 + (ty * 4 + i) * 64 + tx * 4);
      c[i][0] = v.x; c[i][1] = v.y; c[i][2] = v.z; c[i][3] = v.w;
    }
    if (t < 64) sn[t] = p->in[I_SN][ch * 64 + t];
    m = p->in[I_SM][ch];
  }
  uint4 ka, kb, va, vb;
  float g_li = 0.f, g_fp = 0.f;
  auto prefetch = [&](int cc) {
    const int tok0 = dir ? (L - 1 - cc * 64) : cc * 64;
    const long rs = dir ? -(long)PSTR : (long)PSTR;
    const u16* base = proj + (size_t)(seq0 + tok0) * PSTR;
    tile_ld_regs(base + 1280 + head * 64, rs, t, ka, kb);
    tile_ld_regs(base + 1792 + head * 64, rs, t, va, vb);
    if (t < 64) {
      int tr = seq0 + (dir ? tok0 - lane : tok0 + lane);
      g_li = gates[(size_t)tr * 32 + (dir * 2) * 8 + head];
      g_fp = gates[(size_t)tr * 32 + (dir * 2 + 1) * 8 + head];
    }
  };
  prefetch(0);
  for (int cc = 0; cc < nc; ++cc) {
    __syncthreads();
    const int slot = st_slot(isctx, b, dir, head, cc);
#pragma unroll
    for (int i = 0; i < 4; ++i)
      *(float4*)(stC + (size_t)slot * 4096 + (ty * 4 + i) * 64 + tx * 4) = make_float4(c[i][0], c[i][1], c[i][2], c[i][3]);
    if (t < 64) stn[slot * 64 + t] = sn[t];
    if (t == 0) stm[slot] = m;
    tile_st_regs(Ks, t, ka, kb, 0.125f);
    tile_st_regs(Vs, t, va, vb, 1.f);
    if (t < 64) {
      float li = g_li, fp = g_fp;
      float lf = logsigmoidf_(fp);
      float bb = wave_scan_add(lf, lane);
      float a = li - bb;
      float amax = wave_max(a);
      float blast = __shfl(bb, 63);
      float mnew = blast + fmaxf(m, amax);
      sws[lane] = expf(blast + a - mnew);
      if (lane == 0) { ssc[0] = expf(blast + m - mnew); ssc[1] = mnew; }
    }
    if (cc + 1 < nc) prefetch(cc + 1);
    __syncthreads();
    const float wc = ssc[0];
    m = ssc[1];
#pragma unroll
    for (int i = 0; i < 4; ++i)
#pragma unroll
      for (int j = 0; j < 4; ++j) c[i][j] *= wc;
    float nacc = 0.f;
    {
      f32x2 ca[4], cb[4];
#pragma unroll
      for (int i = 0; i < 4; ++i) { ca[i] = (f32x2){c[i][0], c[i][1]}; cb[i] = (f32x2){c[i][2], c[i][3]}; }
#pragma unroll 4
      for (int s = 0; s < 64; ++s) {
        const float w = sws[s];
        const f32x4 kk = *(const f32x4*)(Ks + s * TS + ty * 4);
        const f32x4 vv = *(const f32x4*)(Vs + s * TS + tx * 4);
#pragma unroll
        for (int i = 0; i < 4; ++i) {
          const float kw = kk[i] * w;
          const f32x2 k2 = (f32x2){kw, kw};
          ca[i] += k2 * vv.xy;
          cb[i] += k2 * vv.zw;
        }
        if (t < 64) nacc += w * Ks[s * TS + t];
      }
#pragma unroll
      for (int i = 0; i < 4; ++i) { c[i][0] = ca[i].x; c[i][1] = ca[i].y; c[i][2] = cb[i].x; c[i][3] = cb[i].y; }
    }
    if (t < 64) sn[t] = wc * sn[t] + nacc;
  }
  __syncthreads();
  if (isctx) {
    int ch = (b * 2 + dir) * 8 + head;
    float* Co = p->out + O_C + (size_t)ch * 4096;
#pragma unroll
    for (int i = 0; i < 4; ++i)
      *(float4*)(Co + (ty * 4 + i) * 64 + tx * 4) = make_float4(c[i][0], c[i][1], c[i][2], c[i][3]);
    if (t < 64) p->out[O_N + ch * 64 + t] = sn[t];
    if (t == 0) p->out[O_M + ch] = m;
  }
}

__device__ __forceinline__ void mlstm_out_item(CP p, int isctx, int b, int head, int c, float* sm) {
  const int tid = get_tid(), dir = tid >> 8, t = tid & 255, ty = t >> 4, tx = t & 15, lane = t & 63;
  const u16* proj = (const u16*)(p->ws + OFF_HP);
  const float* gates = (const float*)(p->ws + OFF_GATES);
  const float* stC = (const float*)(p->ws + OFF_STC);
  const float* stn = (const float*)(p->ws + OFF_STN);
  const float* stm = (const float*)(p->ws + OFF_STM);
  float* Qs = sm + (dir * 4) * TILE_F; float* KCs = Qs + TILE_F; float* Vs = Qs + 2 * TILE_F; float* Ws = Qs + 3 * TILE_F;
  float* Ws1 = sm + 7 * TILE_F;
  float* sa = sm + 8 * TILE_F + dir * 256;
  float* sM = sa + 64;
  float* sb = sM + 64;
  float* sn = sb + 64;
  const int nc = isctx ? 4 : 16;
  const int mb = (isctx ? b * 256 : NCTX + b * 1024) + c * 64;
  const int cc = dir ? nc - 1 - c : c;
  const int slot = st_slot(isctx, b, dir, head, cc);
  const float m0 = stm[slot];
  __syncthreads();
  const long rs = dir ? -(long)PSTR : (long)PSTR;
  const u16* base = proj + (size_t)(mb + (dir ? 63 : 0)) * PSTR;
  load_tile_bf16(Qs, base + 768 + head * 64, rs, 1.f, t);
  load_tile_bf16(KCs, base + 1280 + head * 64, rs, 0.125f, t);
  load_tile_bf16(Vs, base + 1792 + head * 64, rs, 1.f, t);
  if (t < 64) {
    int tr = mb + (dir ? 63 - lane : lane);
    float li = gates[(size_t)tr * 32 + (dir * 2) * 8 + head];
    float fp = gates[(size_t)tr * 32 + (dir * 2 + 1) * 8 + head];
    float lf = logsigmoidf_(fp);
    float bb = wave_scan_add(lf, lane);
    float a = li - bb;
    float pm = wave_scan_max(a, lane);
    sa[lane] = a; sM[lane] = fmaxf(m0, pm); sb[lane] = bb;
    sn[lane] = stn[slot * 64 + lane];
  }
  __syncthreads();
  float hd[4][4];
  {
    float s[4][4];
    qk_micro(Qs, KCs, ty, tx, s);
    float rsum[4];
#pragma unroll
    for (int i = 0; i < 4; ++i) {
      int tq = ty * 4 + i;
      float Mt = sM[tq];
      float r = 0.f;
#pragma unroll
      for (int j = 0; j < 4; ++j) {
        int sidx = tx + 16 * j;
        float w = (sidx <= tq) ? expf(sa[sidx] - Mt) * s[i][j] : 0.f;
        Ws[tq * TS + sidx] = w;
        r += w;
      }
      rsum[i] = grp16_sum(r);
    }
    __syncthreads();
    load_tile_f32(KCs, stC + (size_t)slot * 4096, 64, t);
    __syncthreads();
    float num[4][4], qc[4][4];
#pragma unroll
    for (int i = 0; i < 4; ++i)
#pragma unroll
      for (int j = 0; j < 4; ++j) { num[i][j] = 0.f; qc[i][j] = 0.f; }
    pv_micro(Ws, Vs, ty, tx, num);
    pv_micro(Qs, KCs, ty, tx, qc);
#pragma unroll
    for (int i = 0; i < 4; ++i) {
      int tq = ty * 4 + i;
      float4 q4 = *(const float4*)(Qs + tq * TS + tx * 4);
      float4 n4 = *(const float4*)(sn + tx * 4);
      float qn = q4.x * n4.x + q4.y * n4.y + q4.z * n4.z + q4.w * n4.w;
      qn = grp16_sum(qn);
      float Mt = sM[tq];
      float wi = expf(m0 - Mt);
      float den = rsum[i] + wi * qn;
      float mt = sb[tq] + Mt;
      float dn = fmaxf(fabsf(den), expf(-mt));
      float inv = 1.f / dn;
#pragma unroll
      for (int j = 0; j < 4; ++j) hd[i][j] = (num[i][j] + wi * qc[i][j]) * inv;
    }
  }
  __syncthreads();
  if (dir == 1) {
#pragma unroll
    for (int i = 0; i < 4; ++i)
      *(float4*)(Ws1 + (63 - (ty * 4 + i)) * TS + tx * 4) = make_float4(hd[i][0], hd[i][1], hd[i][2], hd[i][3]);
  }
  __syncthreads();
  if (dir == 0) {
    const float* hg = p->in[I_L0 + L_X2] + head * 64 + tx * 4;
    u16* ymix = (u16*)(p->ws + OFF_YMIX);
#pragma unroll
    for (int i = 0; i < 4; ++i) {
      float4 v = *(const float4*)(Ws1 + (ty * 4 + i) * TS + tx * 4);
      float h0 = hd[i][0] + v.x, h1 = hd[i][1] + v.y, h2 = hd[i][2] + v.z, h3 = hd[i][3] + v.w;
      float ss = h0 * h0 + h1 * h1 + h2 * h2 + h3 * h3;
      ss = grp16_sum(ss);
      float rstd = rsqrtf(ss * (1.f / 64.f) + EPS);
      int tr = mb + ty * 4 + i;
      uint2 ob = *(const uint2*)(proj + (size_t)tr * PSTR + 2336 + head * 64 + tx * 4);
      float y0 = sigmoidf_(bflo(ob.x)) * (h0 * rstd * hg[0]);
      float y1 = sigmoidf_(bfhi(ob.x)) * (h1 * rstd * hg[1]);
      float y2 = sigmoidf_(bflo(ob.y)) * (h2 * rstd * hg[2]);
      float y3 = sigmoidf_(bfhi(ob.y)) * (h3 * rstd * hg[3]);
      *(uint2*)(ymix + (size_t)tr * D + 512 + head * 64 + tx * 4) = make_uint2(pack2(y0, y1), pack2(y2, y3));
    }
  }
}

__device__ __forceinline__ int next_item(int* ctr, int* s_item) {
  __syncthreads();
  if (get_tid() == 0) *s_item = atomicAdd(ctr, 1);
  __syncthreads();
  return *s_item;
}

__device__ __forceinline__ void mix0_phase_a(CP p, float* sm, int* s_item, int coff) {
  int* ctr = (int*)(p->ws + OFF_CTR) + 0 + coff;
  for (;;) {
    int it = next_item(ctr, s_item);
    if (it >= 912) break;
    if (it >= 128 && it < 144) {
      int v = it - 128; int b = v >> 3, head = v & 7;
      mlstm_state_item(p, 0, b, head, sm);
    } else if (it >= 656) {
      int v = it - 656; int b = v >> 3, head = v & 7;
      mlstm_state_item(p, 1, b, head, sm);
    } else {
      AttnDesc d;
      d.mode = 0; d.a0 = 0; d.r0 = 0; d.rpb = nullptr; d.sink = 0.f; d.has_sink = 0;
      if (it < 128) {
        int b = it >> 6, h = (it >> 3) & 7, qb = it & 7;
        d.qrow0 = NCTX + b * 1024 + qb * 128; d.qcol = h * 64; d.ocol = h * 64;
        d.ck = p->in[I_C0K] + (size_t)b * 256 * 128 + (h >> 2) * 64; d.cv = p->in[I_C0V] + (size_t)b * 256 * 128 + (h >> 2) * 64;
        d.cstride = 128; d.nctx = 4;
        d.krow0 = NCTX + b * 1024; d.nloc = 16; d.kcol = 512 + (h >> 2) * 64; d.vcol = 640 + (h >> 2) * 64;
      } else {
        int v = it - 144; int b = v >> 4, h = (v >> 1) & 7, qb = v & 1;
        d.qrow0 = b * 256 + qb * 128; d.qcol = h * 64; d.ocol = h * 64;
        d.ck = nullptr; d.cv = nullptr; d.cstride = 0; d.nctx = 0;
        d.krow0 = b * 256; d.nloc = 4; d.kcol = 512 + (h >> 2) * 64; d.vcol = 640 + (h >> 2) * 64;
      }
      attn_item(p, d, sm);
    }
  }
}

__device__ __forceinline__ void mix0_phase_b(CP p, float* sm, int* s_item, int coff) {
  int* ctr = (int*)(p->ws + OFF_CTR) + 1 + coff;
  for (;;) {
    int it = next_item(ctr, s_item);
    if (it >= 1280) break;
    if (it < 256) {
      int b = it >> 7, head = (it >> 4) & 7, c = it & 15;
      mlstm_out_item(p, 0, b, head, c, sm);
    } else {
      int v = it - 256; int b = v >> 5, head = (v >> 2) & 7, c = v & 3;
      mlstm_out_item(p, 1, b, head, c, sm);
    }
  }
}

__device__ __forceinline__ void mix1_phase(CP p, float* sm, int* s_item, int coff) {
  int* ctr = (int*)(p->ws + OFF_CTR) + 2 + coff;
  const float* sink = p->in[I_L1 + L_X1];
  for (;;) {
    int it = next_item(ctr, s_item);
    if (it >= 1280) break;
    AttnDesc d;
    d.mode = 0; d.a0 = 0; d.r0 = 0; d.rpb = nullptr; d.sink = 0.f; d.has_sink = 0;
    if (it < 128) {
      int b = it >> 6, h = (it >> 3) & 7, r = (it & 7) * 2;
      int r0 = min(max(r - 4, 0), 8);
      int r1 = min(max(r + 1 - 4, 0), 8) + 8;
      d.qrow0 = NCTX + b * 1024 + r * 64; d.qcol = h * 64; d.ocol = h * 64;
      d.ck = p->in[I_NAK] + (size_t)b * 256 * 512 + h * 64; d.cv = p->in[I_NAV] + (size_t)b * 256 * 512 + h * 64;
      d.cstride = 512; d.nctx = 4;
      d.krow0 = NCTX + b * 1024 + r0 * 64; d.nloc = r1 - r0; d.kcol = 512 + h * 64; d.vcol = 1024 + h * 64;
      d.mode = 1; d.a0 = r; d.r0 = r0; d.rpb = p->in[I_L1 + L_X0] + h * 15 * 31;
    } else if (it < 256) {
      int v = it - 128; int b = v >> 6, h = (v >> 3) & 7, qb = v & 7;
      int t0 = qb * 128;
      int s0 = max(t0 - 128, 0);
      int s1 = min(t0 + 256, 1024);
      d.qrow0 = NCTX + b * 1024 + t0; d.qcol = 1536 + h * 64; d.ocol = 512 + h * 64;
      d.ck = p->in[I_SWK] + (size_t)b * 256 * 128 + (h >> 2) * 64; d.cv = p->in[I_SWV] + (size_t)b * 256 * 128 + (h >> 2) * 64;
      d.cstride = 128; d.nctx = 4;
      d.krow0 = NCTX + b * 1024 + s0; d.nloc = (s1 - s0) >> 6; d.kcol = 2048 + (h >> 2) * 64; d.vcol = 2176 + (h >> 2) * 64;
      d.mode = 2; d.a0 = s0 - t0;
      d.sink = sink[h]; d.has_sink = 1;
    } else if (it < 768) {
      int v = it - 256; int b = v >> 4, h = (v >> 1) & 7, qb = v & 1;
      d.qrow0 = b * 256 + qb * 128; d.qcol = h * 64; d.ocol = h * 64;
      d.ck = nullptr; d.cv = nullptr; d.cstride = 0; d.nctx = 0;
      d.krow0 = b * 256; d.nloc = 4; d.kcol = 512 + h * 64; d.vcol = 1024 + h * 64;
    } else {
      int v = it - 768; int b = v >> 4, h = (v >> 1) & 7, qb = v & 1;
      d.qrow0 = b * 256 + qb * 128; d.qcol = 1536 + h * 64; d.ocol = 512 + h * 64;
      d.ck = nullptr; d.cv = nullptr; d.cstride = 0; d.nctx = 0;
      d.krow0 = b * 256; d.nloc = 4; d.kcol = 2048 + (h >> 2) * 64; d.vcol = 2176 + (h >> 2) * 64;
      d.sink = sink[h]; d.has_sink = 1;
    }
    attn_item(p, d, sm);
  }
}

#define XB_TMO      128
#define XB_XCNT(j)  (256  + 64 * (j))
#define XB_XSUB(j)  (1280 + 64 * (j))
#define XB_XGEN(j)  (2304 + 64 * (j))
#define XB_TOP      3328
#define XB_TOPGEN   3392
#define XCD_BAR_WORDS 3456
#define XB_SPIN_CAP (1u << 22)
__device__ __forceinline__ unsigned xb_ld(unsigned* p) { return __hip_atomic_load(p, __ATOMIC_RELAXED, __HIP_MEMORY_SCOPE_AGENT); }
__device__ __forceinline__ unsigned xb_add(unsigned* p, unsigned v) { return __hip_atomic_fetch_add(p, v, __ATOMIC_RELAXED, __HIP_MEMORY_SCOPE_AGENT); }
__device__ __forceinline__ unsigned xb_xcc_id() { return (unsigned)__builtin_amdgcn_s_getreg((3 << 11) | 20) & 0xFu; }
#define XB_SPIN(cond, bar) do { unsigned _sp = 0; while (cond) { __builtin_amdgcn_s_sleep(1); \
    if ((++_sp & 255u) == 0u) { if (xb_ld(&(bar)[XB_TMO])) break; if (_sp > XB_SPIN_CAP) { atomicAdd(&(bar)[XB_TMO], 1u); break; } } } } while (0)
struct XcdBarrier { unsigned* bar; unsigned x; volatile LAS unsigned* st; };
__device__ __forceinline__ XcdBarrier xcd_barrier_post(unsigned* bar, volatile LAS unsigned* st) {
  XcdBarrier b; b.bar = bar; b.x = xb_xcc_id(); b.st = st;
  if (threadIdx.x == 0) (void)xb_add(&bar[XB_XCNT(b.x)], 1u);
  return b;
}
__device__ __forceinline__ void xcd_barrier_complete(unsigned* bar, unsigned x, unsigned& nloc, unsigned& nx) {
  const unsigned G = gridDim.x * gridDim.y * gridDim.z;
  unsigned sum, cnt, mine, sp = 0u;
  for (;;) {
    sum = 0u; cnt = 0u; mine = 0u;
#pragma unroll
    for (unsigned j = 0; j < 16; ++j) { const unsigned c = xb_ld(&bar[XB_XCNT(j)]); sum += c; cnt += (c > 0u) ? 1u : 0u; mine = (j == x) ? c : mine; }
    if (sum == G) break;
    __builtin_amdgcn_s_sleep(1);
    if ((++sp & 255u) == 0u) { if (xb_ld(&bar[XB_TMO])) break; if (sp > XB_SPIN_CAP) { atomicAdd(&bar[XB_TMO], 1u); break; } }
  }
  nloc = mine > 0u ? mine : 1u; nx = cnt > 0u ? cnt : 1u;
}
__device__ __forceinline__ void xcd_barrier(const XcdBarrier& b) {
  asm volatile("s_waitcnt vmcnt(0)" ::: "memory");
  __syncthreads();
  if (threadIdx.x == 0) {
    unsigned* bar = b.bar;
    __builtin_amdgcn_s_waitcnt(0);
    unsigned nloc = b.st[0], nx = b.st[1];
    if (nloc == 0u) { xcd_barrier_complete(bar, b.x, nloc, nx); b.st[0] = nloc; b.st[1] = nx; }
    const unsigned old = xb_add(&bar[XB_XSUB(b.x)], 1u);
    const unsigned gen = old / nloc;
    if (old + 1u == (gen + 1u) * nloc) {
      __builtin_amdgcn_fence(__ATOMIC_RELEASE, "agent");
      asm volatile("s_waitcnt vmcnt(0)" ::: "memory");
      const unsigned og = xb_add(&bar[XB_TOP], 1u);
      const unsigned tg = og / nx;
      if (og + 1u == (tg + 1u) * nx) xb_add(&bar[XB_TOPGEN], 1u);
      else XB_SPIN(xb_ld(&bar[XB_TOPGEN]) == tg, bar);
      __builtin_amdgcn_fence(__ATOMIC_ACQUIRE, "agent");
      xb_add(&bar[XB_XGEN(b.x)], 1u);
      asm volatile("s_waitcnt vmcnt(0)" ::: "memory");
    } else {
      XB_SPIN(xb_ld(&bar[XB_XGEN(b.x)]) == gen, bar);
      __builtin_amdgcn_fence(__ATOMIC_ACQUIRE, "agent");
      asm volatile("s_waitcnt vmcnt(0)" ::: "memory");
    }
  }
  __syncthreads();
}

constexpr int NPHASE = 18;
__device__ __forceinline__ void run_phase(CP p, int ph, char* smem, int* s_item, const int dry) {
  float* smf = (float*)smem;
  u16* smh = (u16*)smem;
  const u16* xn = (const u16*)(p->ws + OFF_XN);
  const u16* hp = (const u16*)(p->ws + OFF_HP);
  const u16* ymix = (const u16*)(p->ws + OFF_YMIX);
  if (ph == 0) { prep_a_phase(p, smf); return; }
  if (ph == 1) { prep_b_phase(p, smf, dry); return; }
  if (ph == 17) { final_phase(p); return; }
  const int l = (ph >= 10) ? 1 : 0;
  int q = ph - (l ? 10 : 2);
  if (l == 1 && q >= 4) q += 1;
  if (q == 0 || q == 6) {
    const int f = (q == 6) ? 1 : 0;
    gemm_phase<EPI_SWIGLU>(p, xn, (const u16*)(p->ws + OFF_WIN + (l * 2 + f) * SZ_WIN), 1024, 22, l, 0, 0.f, l * 3 + (f ? 2 : 0), smh);
    return;
  }
  if (q == 1 || q == 5 || q == 7) {
    const u16* A = (q == 5) ? ymix : hp;
    const u16* Bt = (q == 5) ? (const u16*)(p->ws + OFF_WMO + (size_t)l * D * D * 2)
                             : (const u16*)(p->ws + OFF_WOUT + (l * 2 + (q == 7 ? 1 : 0)) * SZ_WOUT);
    const int K = (q == 5) ? 1024 : DFF;
    const int gch = (q == 1) ? 2 : (q == 5 ? 5 : 8);
    const float coef = dry ? 0.f : ((q == 5) ? 1.f : 0.5f);
    const int nid_next = l * 3 + ((q == 1) ? 1 : (q == 5 ? 2 : 3));
    gemm_phase<EPI_RESID>(p, A, Bt, K, 4, l, gch, coef, dry ? 7 : nid_next, smh);
    return;
  }
  if (q == 2) {
    if (l == 0) gemm_phase<EPI_MIX0>(p, xn, (const u16*)(p->ws + OFF_WMI0), 1024, 12, l, 0, 0.f, 1, smh);
    else gemm_phase<EPI_MIX1>(p, xn, (const u16*)(p->ws + OFF_WMI1), 1024, 9, l, 0, 0.f, 4, smh);
    return;
  }
  if (q == 3) { if (l == 0) mix0_phase_a(p, smf, s_item, dry * 3); else mix1_phase(p, smf, s_item, dry * 3); return; }
  if (q == 4) { mix0_phase_b(p, smf, s_item, dry * 3); return; }
}

__global__ void __launch_bounds__(512, 2) mega(Params kp, int ph0, int ph1, int dry) {
  extern __shared__ __attribute__((aligned(16))) char smem[];
  int* s_item_p = (int*)(smem + SMEM_BYTES);
  uint4* xb_words_p = (uint4*)(smem + SMEM_BYTES + 16);
  if (threadIdx.x == 0) *xb_words_p = make_uint4(0u, 0u, 0u, 0u);
  __syncthreads();
  XcdBarrier xb = xcd_barrier_post((unsigned*)(kp.ws + OFF_BAR), (volatile LAS unsigned*)xb_words_p);
  if (ph1 < 0) cg::this_grid().sync();
  for (int ph = ph0; ph < ph1; ++ph) {
    if (ph > ph0) xcd_barrier(xb);
    CP p = (CP)__builtin_amdgcn_kernarg_segment_ptr();
    asm volatile("" : "+s"(p));
    run_phase(p, ph, smem, s_item_p, dry);
  }
}

extern "C" void kernel_launch(void* const* d_in, const int* in_sizes, int n_in, void* d_out, int out_size, void* d_ws,
                              size_t ws_size, hipStream_t stream) {
  static int grid_blocks = 0;
  if (!grid_blocks) {
    int dev = 0, cus = 0, per_cu = 0;
    hipGetDevice(&dev);
    hipDeviceGetAttribute(&cus, hipDeviceAttributeMultiprocessorCount, dev);
    hipFuncSetAttribute((const void*)mega, hipFuncAttributeMaxDynamicSharedMemorySize, DYN_LDS);
    hipOccupancyMaxActiveBlocksPerMultiprocessor(&per_cu, mega, NTH, DYN_LDS);
    if (per_cu > 1) per_cu = 1;
    if (per_cu < 1) per_cu = 1;
    grid_blocks = cus * per_cu;
  }
  if (ws_size < WS_TOTAL) fprintf(stderr, "workspace too small: %zu < %zu\n", ws_size, (size_t)WS_TOTAL);
  Params p{};
  for (int i = 0; i < 37; ++i) p.in[i] = (const float*)d_in[i];
  p.out = (float*)d_out;
  p.ws = (char*)d_ws;
  hipMemsetAsync((char*)d_ws + OFF_CTR, 0, ZERO_BYTES, stream);
#if SINGLE_LAUNCH
  int ph0 = 0, ph1 = NPHASE, dry = 0;
  void* args[] = {&p, &ph0, &ph1, &dry};
  hipError_t e = hipLaunchCooperativeKernel((void*)mega, dim3(grid_blocks), dim3(NTH), args, DYN_LDS, stream);
  if (e != hipSuccess) fprintf(stderr, "cooperative launch failed: %s (grid %d)\n", hipGetErrorString(e), grid_blocks);
#else
  for (int ph = 0; ph < NPHASE; ++ph) {
    mega<<<grid_blocks, NTH, DYN_LDS, stream>>>(p, ph, ph + 1, 0);
    const bool g1 = (ph == 2 || ph == 8 || ph == 10 || ph == 15), g2 = (ph == 3 || ph == 9 || ph == 11 || ph == 16);
    const bool mi = (ph == 4 || ph == 12), mo = (ph == 7 || ph == 14), mx = (ph == 5 || ph == 6 || ph == 13);
    if (((REP_MASK & 1) && g1) || ((REP_MASK & 2) && g2) || ((REP_MASK & 4) && (mi || mo)) || ((REP_MASK & 8) && mx) ||
        ((REP_MASK & 16) && ph == 0) || ((REP_MASK & 32) && ph == 1))
      mega<<<grid_blocks, NTH, DYN_LDS, stream>>>(p, ph, ph + 1, 1);
  }
#endif
}
```

```cpp
#include <hip/hip_runtime.h>
#include <hip/hip_cooperative_groups.h>
#include <cstdio>
namespace cg = cooperative_groups;

#ifndef REP_MASK
#define REP_MASK 0
#endif
#ifndef SINGLE_LAUNCH
#define SINGLE_LAUNCH 1
#endif

typedef unsigned short u16;
typedef __attribute__((ext_vector_type(8))) short bf16x8;
typedef __attribute__((ext_vector_type(4))) float f32x4;
typedef __attribute__((ext_vector_type(4))) unsigned u32x4;
#define LAS __attribute__((address_space(3)))

constexpr int D = 1024, NCTX = 8192, MTOK = 10240;
constexpr int DFF = 2816, NFF = 5632;
constexpr int P0N = 2848, P0P = 3072, P1N = 2304;
constexpr int PSTR = 2944;
constexpr float EPS = 1e-6f;

enum { I_XP = 0, I_XS, I_C0K, I_C0V, I_SC, I_SN, I_SM, I_NAK, I_NAV, I_SWK, I_SWV, I_C, I_CCTX, I_NF,
       I_L0 = 14, I_L1 = 26 };
enum { L_ADAW = 0, L_ADAB, L_NORM, L_F1I, L_F1O, L_F2I, L_F2O, L_MI, L_MO, L_X0, L_X1, L_X2 };

constexpr size_t O_X = 0, O_K0 = 10485760, O_V0 = 11534336, O_C = 12582912, O_N = 14680064, O_M = 14712832,
                 O_KC1 = 14713344, O_VC1 = 18907648, O_KD1 = 23101952, O_VD1 = 24150528;

constexpr size_t SZ_WIN = (size_t)NFF * D * 2;
constexpr size_t SZ_WOUT = (size_t)D * DFF * 2;
constexpr size_t OFF_WIN = 0;
constexpr size_t OFF_WOUT = OFF_WIN + 4 * SZ_WIN;
constexpr size_t OFF_WMI0 = OFF_WOUT + 4 * SZ_WOUT;
constexpr size_t OFF_WMI1 = OFF_WMI0 + (size_t)P0P * D * 2;
constexpr size_t OFF_WMO = OFF_WMI1 + (size_t)P1N * D * 2;
constexpr size_t OFF_MOD = OFF_WMO + 2 * (size_t)D * D * 2;
constexpr size_t OFF_ROPE = OFF_MOD + 2 * 3 * 9216 * 4;
constexpr size_t OFF_CTR = OFF_ROPE + 2 * 1024 * 32 * 4;
constexpr size_t OFF_BAR = OFF_CTR + 256;
constexpr size_t OFF_ROWSS = OFF_CTR + 16384;
constexpr size_t OFF_BIAS = OFF_ROWSS + (size_t)7 * MTOK * 4;
constexpr size_t ZERO_BYTES = 16384 + (size_t)7 * MTOK * 4 + (size_t)2 * 3 * 3 * NFF * 4;
constexpr size_t OFF_XN = OFF_CTR + ZERO_BYTES;
constexpr size_t OFF_YMIX = OFF_XN + (size_t)MTOK * D * 2;
constexpr size_t OFF_HP = OFF_YMIX + (size_t)MTOK * D * 2;
constexpr size_t OFF_GATES = OFF_HP + (size_t)MTOK * PSTR * 2;
constexpr size_t OFF_STC = OFF_GATES + (size_t)MTOK * 32 * 4;
constexpr size_t OFF_STN = OFF_STC + (size_t)2560 * 4096 * 4;
constexpr size_t OFF_STM = OFF_STN + (size_t)2560 * 64 * 4;
constexpr size_t WS_TOTAL = OFF_STM + 2560 * 4;

constexpr int TS = 68;
constexpr int TILE_F = 64 * TS;
constexpr int SMEM_BYTES = 8 * TILE_F * 4 + 4096;
constexpr int NTH = 512;
constexpr int DYN_LDS = SMEM_BYTES + 32;

struct Params {
  const float* in[37];
  float* out;
  char* ws;
};
typedef const __attribute__((address_space(4))) Params* CP;

__device__ __forceinline__ int get_tid() { int t = threadIdx.x; asm volatile("" : "+v"(t)); return t; }
__device__ __forceinline__ u16 f2bf(float f) {
  unsigned u = __float_as_uint(f);
  u += 0x7fffu + ((u >> 16) & 1u);
  return (u16)(u >> 16);
}
__device__ __forceinline__ unsigned pack2(float a, float b) { return (unsigned)f2bf(a) | ((unsigned)f2bf(b) << 16); }
__device__ __forceinline__ float bflo(unsigned x) { return __uint_as_float(x << 16); }
__device__ __forceinline__ float bfhi(unsigned x) { return __uint_as_float(x & 0xffff0000u); }
__device__ __forceinline__ float grp16_sum(float v) {
  v += __shfl_xor(v, 1); v += __shfl_xor(v, 2); v += __shfl_xor(v, 4); v += __shfl_xor(v, 8); return v;
}
__device__ __forceinline__ float grp16_max(float v) {
  v = fmaxf(v, __shfl_xor(v, 1)); v = fmaxf(v, __shfl_xor(v, 2)); v = fmaxf(v, __shfl_xor(v, 4)); v = fmaxf(v, __shfl_xor(v, 8)); return v;
}
__device__ __forceinline__ float wave_sum(float v) {
  for (int o = 32; o; o >>= 1) v += __shfl_xor(v, o);
  return v;
}
__device__ __forceinline__ float wave_max(float v) {
  for (int o = 32; o; o >>= 1) v = fmaxf(v, __shfl_xor(v, o));
  return v;
}
__device__ __forceinline__ float wave_scan_add(float v, int lane) {
  for (int o = 1; o < 64; o <<= 1) { float t = __shfl_up(v, o); if (lane >= o) v += t; }
  return v;
}
__device__ __forceinline__ float wave_scan_max(float v, int lane) {
  for (int o = 1; o < 64; o <<= 1) { float t = __shfl_up(v, o); if (lane >= o) v = fmaxf(v, t); }
  return v;
}
__device__ __forceinline__ int cond_of(int row) { return row < NCTX ? 0 : 1 + ((row - NCTX) >> 10); }
__device__ __forceinline__ float sigmoidf_(float x) { return 1.f / (1.f + expf(-x)); }
__device__ __forceinline__ float logsigmoidf_(float x) { return fminf(x, 0.f) - log1pf(expf(-fabsf(x))); }

__device__ void conv_tile(const float* __restrict__ W, int K, int N, u16* __restrict__ Wt, int perm, int kt, int nt, float* T, int t, bool valid,
                          const float* shp, float* biasp) {
  {
    int r = t >> 4, c4 = t & 15;
    int c = c4 * 4;
    int src;
    if (perm == 1) src = ((nt & 3) < 2 ? 0 : DFF) + (nt >> 2) * 128 + (nt & 1) * 64 + c;
    else if (perm == 2) {
      int bj = (nt & 3) >> 1, wc = (nt & 1) * 2 + (c >> 5), w = c & 31;
      src = (nt >> 2) * 256 + wc * 64 + bj * 32 + w;
    } else src = nt * 64 + c;
    bool ok = valid && (src < N);
#pragma unroll
    for (int ps = 0; ps < 4; ++ps) {
      int k = r + ps * 16;
      float4 v = make_float4(0.f, 0.f, 0.f, 0.f);
      if (ok) v = *(const float4*)(W + (size_t)(kt * 64 + k) * N + src);
      float* tt = T + k * 65 + c;
      tt[0] = v.x; tt[1] = v.y; tt[2] = v.z; tt[3] = v.w;
    }
  }
  if (biasp && t < 192) T[4224 + t] = shp[(t >> 6) * 9216 + kt * 64 + (t & 63)];
  __syncthreads();
  if (valid && biasp && t < 192) {
    int a = t >> 6, c = t & 63;
    int src;
    if (perm == 1) src = ((nt & 3) < 2 ? 0 : DFF) + (nt >> 2) * 128 + (nt & 1) * 64 + c;
    else { int bj = (nt & 3) >> 1, wc = (nt & 1) * 2 + (c >> 5), w = c & 31; src = (nt >> 2) * 256 + wc * 64 + bj * 32 + w; }
    if (src < N) {
      const float* sh = T + 4224 + a * 64;
      float acc = 0.f;
#pragma unroll 16
      for (int k = 0; k < 64; ++k) acc += sh[k] * T[k * 65 + c];
      unsafeAtomicAdd(biasp + a * NFF + src, acc);
    }
  }
  if (valid) {
    int n = t >> 2, kp = t & 3;
    unsigned o[8];
#pragma unroll
    for (int i = 0; i < 8; ++i) {
      float a = T[(kp * 16 + 2 * i) * 65 + n], b = T[(kp * 16 + 2 * i + 1) * 65 + n];
      o[i] = pack2(a, b);
    }
    uint4* dst = (uint4*)(Wt + (size_t)(nt * 64 + n) * K + kt * 64 + kp * 16);
    dst[0] = make_uint4(o[0], o[1], o[2], o[3]);
    dst[1] = make_uint4(o[4], o[5], o[6], o[7]);
  }
  __syncthreads();
}

__device__ void adaln_unit(CP p, int u, float* sm, int t, bool valid) {
  int l = u / 144, cg_ = u % 144;
  if (!valid) { l = 0; cg_ = 0; }
  const float* W = p->in[(l ? I_L1 : I_L0) + L_ADAW];
  const float* B = p->in[(l ? I_L1 : I_L0) + L_ADAB];
  float* sc = sm;
  float* red = sm + 3072;
  for (int i = t; i < 3072; i += 256) {
    int cnd = i >> 10, k = i & 1023;
    float v = (cnd == 0) ? p->in[I_CCTX][k] : p->in[I_C][(cnd - 1) * 1024 + k];
    sc[i] = v / (1.f + expf(-v));
  }
  __syncthreads();
  int kp = t >> 4, c4 = t & 15;
  float acc[3][4];
#pragma unroll
  for (int a = 0; a < 3; ++a)
#pragma unroll
    for (int e = 0; e < 4; ++e) acc[a][e] = 0.f;
  for (int kk = 0; kk < 64; ++kk) {
    int k = kp * 64 + kk;
    float4 w = *(const float4*)(W + (size_t)k * 9216 + cg_ * 64 + c4 * 4);
#pragma unroll
    for (int a = 0; a < 3; ++a) {
      float s = sc[a * 1024 + k];
      acc[a][0] += s * w.x; acc[a][1] += s * w.y; acc[a][2] += s * w.z; acc[a][3] += s * w.w;
    }
  }
#pragma unroll
  for (int a = 0; a < 3; ++a)
#pragma unroll
    for (int e = 0; e < 4; ++e) red[(kp * 3 + a) * 64 + c4 * 4 + e] = acc[a][e];
  __syncthreads();
  if (valid && t < 192) {
    int a = t >> 6, col = t & 63;
    float s = 0.f;
    for (int q = 0; q < 16; ++q) s += red[(q * 3 + a) * 64 + col];
    s += B[cg_ * 64 + col];
    float* mod = (float*)(p->ws + OFF_MOD);
    mod[(l * 3 + a) * 9216 + cg_ * 64 + col] = s;
  }
  __syncthreads();
}

__device__ __forceinline__ int conv_units_of(int l, int kind) {
  return (kind == 0 || kind == 4) ? 1408 : ((kind == 1 || kind == 5) ? 704 : (kind == 3 ? 256 : (l ? 576 : 768)));
}
__device__ __forceinline__ void conv_job(CP p, int l, int kind, int tt, float* smh, int t, bool valid) {
  const float* mod = (const float*)(p->ws + OFF_MOD);
  float* bias = (float*)(p->ws + OFF_BIAS);
  const float* W; u16* Wt; int K, N, perm, ntn, which = -1;
  const int lb = l ? I_L1 : I_L0;
  if (kind == 0 || kind == 4) {
    const int f = kind == 4;
    W = p->in[lb + (f ? L_F2I : L_F1I)]; Wt = (u16*)(p->ws + OFF_WIN + (l * 2 + f) * SZ_WIN);
    K = 1024; N = NFF; perm = 1; ntn = 88; which = f ? 2 : 0;
  } else if (kind == 1 || kind == 5) {
    const int f = kind == 5;
    W = p->in[lb + (f ? L_F2O : L_F1O)]; Wt = (u16*)(p->ws + OFF_WOUT + (l * 2 + f) * SZ_WOUT);
    K = DFF; N = 1024; perm = 0; ntn = 16;
  } else if (kind == 2) {
    W = p->in[lb + L_MI]; Wt = (u16*)(p->ws + (l ? OFF_WMI1 : OFF_WMI0));
    K = 1024; N = l ? P1N : P0N; perm = 2; ntn = l ? 36 : 48; which = 1;
  } else {
    W = p->in[lb + L_MO]; Wt = (u16*)(p->ws + OFF_WMO + (size_t)l * D * D * 2);
    K = 1024; N = 1024; perm = 0; ntn = 16;
  }
  const int nt = tt % ntn, kt = tt / ntn;
  const bool wb = which >= 0;
  conv_tile(W, K, N, Wt, perm, kt, nt, smh, t, valid, wb ? mod + (l * 3) * 9216 + (3 * which) * 1024 : nullptr,
            wb ? bias + (size_t)((l * 3 + which) * 3) * NFF : nullptr);
}

__device__ __forceinline__ void conv_side_job(CP p, int side, int nwg, float* sm) {
  const int tid = get_tid(), half = tid >> 8, t = tid & 255;
  float* smh = sm + half * 8192;
  const int first = ((int)gridDim.x >= nwg + 32) ? nwg : 0;
  const int nb = (int)gridDim.x - first;
  if ((int)blockIdx.x < first) return;
  const int U = (side == 1) ? 3136 : 5056;
  for (int ub = ((int)blockIdx.x - first) * 2; ub < U; ub += nb * 2) {
    int u = ub + half;
    const bool valid = u < U;
    if (!valid) u = 0;
    int l, kind, tt;
    if (side == 1) {
      l = 0;
      if (u < 768) { kind = 2; tt = u; } else if (u < 1024) { kind = 3; tt = u - 768; }
      else if (u < 2432) { kind = 4; tt = u - 1024; } else { kind = 5; tt = u - 2432; }
    } else {
      l = 1;
      if (u < 1408) { kind = 0; tt = u; } else if (u < 2112) { kind = 1; tt = u - 1408; }
      else if (u < 2688) { kind = 2; tt = u - 2112; } else if (u < 2944) { kind = 3; tt = u - 2688; }
      else if (u < 4352) { kind = 4; tt = u - 2944; } else { kind = 5; tt = u - 4352; }
    }
    conv_job(p, l, kind, tt, smh, t, valid);
  }
}

__device__ __forceinline__ void prep_a_phase(CP p, float* sm) {
  const int tid = get_tid(), half = tid >> 8, t = tid & 255;
  float* smh = sm + half * 8192;
  constexpr int U_CONV = 704, U_ADA = 288, U_ROPE = 64;
  for (int ub = blockIdx.x * 2; ub < U_ADA; ub += gridDim.x * 2) {
    int u = ub + half;
    adaln_unit(p, u, smh, t, u < U_ADA);
  }
  for (int ub = blockIdx.x * 2; ub < U_CONV; ub += gridDim.x * 2) {
    int u = ub + half;
    bool valid = u < U_CONV;
    if (!valid) u = 0;
    conv_job(p, 0, 1, u, smh, t, valid);
  }
  for (int u = blockIdx.x; u < U_ROPE; u += gridDim.x) {
    int e = u * 512 + tid;
    int tk = e >> 5, i = e & 31;
    float pos = (i < 16) ? (float)(tk >> 6) : (float)(tk & 63);
    float fr = powf(10000.f, -(float)(i & 15) / 16.f);
    float ang = pos * fr;
    float* rc = (float*)(p->ws + OFF_ROPE);
    rc[e] = cosf(ang);
    rc[32768 + e] = sinf(ang);
  }
}

__device__ __forceinline__ void prep_b_phase(CP p, float* sm, const int dry) {
  const int tid = get_tid(), half = tid >> 8, t = tid & 255, lane = tid & 63, w = tid >> 6;
  float* smh = sm + half * 8192;
  const float* mod = (const float*)(p->ws + OFF_MOD);
  constexpr int U_CONV = 1408;
  for (int ub = blockIdx.x * 2; ub < U_CONV; ub += gridDim.x * 2) {
    int u = ub + half;
    bool valid = u < U_CONV;
    if (!valid) u = 0;
    conv_job(p, 0, 0, u, smh, t, valid);
  }
  {
    float* x = p->out + O_X;
    u16* xn = (u16*)(p->ws + OFF_XN);
    float* rowss = (float*)(p->ws + OFF_ROWSS);
    const float4* g = (const float4*)(p->in[I_L0 + L_NORM]);
    for (int row = blockIdx.x * 8 + w; row < MTOK; row += gridDim.x * 8) {
      const float4* src = (row < NCTX) ? (const float4*)(p->in[I_XP] + (size_t)row * D) : (const float4*)(p->in[I_XS] + (size_t)(row - NCTX) * D);
      float4* xr = (float4*)(x + (size_t)row * D);
      const float4* sc = (const float4*)(mod + (size_t)cond_of(row) * 9216 + 1024);
      float ss = 0.f;
#pragma unroll
      for (int i = 0; i < 4; ++i) {
        int q = lane + i * 64;
        float4 v = src[q];
        ss += v.x * v.x + v.y * v.y + v.z * v.z + v.w * v.w;
        xr[q] = v;
        float4 gg = g[q], s2 = sc[q];
        uint2 o = make_uint2(pack2(v.x * (gg.x * (1.f + s2.x)), v.y * (gg.y * (1.f + s2.y))), pack2(v.z * (gg.z * (1.f + s2.z)), v.w * (gg.w * (1.f + s2.w))));
        *(uint2*)(xn + (size_t)row * D + q * 4) = o;
      }
      ss = wave_sum(ss);
      if (lane == 0) rowss[row] = ss;
    }
  }
}

__device__ __forceinline__ void final_phase(CP p) {
  const int tid = get_tid(), lane = tid & 63, w = tid >> 6;
  float* x = p->out + O_X;
  const float* rowss = (const float*)(p->ws + OFF_ROWSS) + 6 * MTOK;
  const float4* g = (const float4*)p->in[I_NF];
  for (int row = blockIdx.x * 8 + w; row < MTOK; row += gridDim.x * 8) {
    float4* xr = (float4*)(x + (size_t)row * D);
    const float rstd = rsqrtf(rowss[row] * (1.f / 1024.f) + EPS);
#pragma unroll
    for (int i = 0; i < 4; ++i) {
      int q = lane + i * 64;
      float4 v = xr[q], gg = g[q];
      xr[q] = make_float4(v.x * rstd * gg.x, v.y * rstd * gg.y, v.z * rstd * gg.z, v.w * rstd * gg.w);
    }
  }
}

enum { EPI_SWIGLU = 0, EPI_RESID = 1, EPI_MIX0 = 2, EPI_MIX1 = 3 };
constexpr int BM = 256, BK = 64, HALF = 128, HT = HALF * BK, NXCD = 8, WGM = 8;

__device__ __forceinline__ int lds_byte(int r, int c) {
  int st = (r >> 4) * 2 + (c >> 5), rr = r & 15, cc = c & 31, ob = rr * 64 + cc * 2;
  return st * 1024 + (ob ^ (((ob >> 9) & 1) << 5));
}
__device__ __forceinline__ void stage_rc(int b, int& R, int& C) {
  int st = b / 1024, sb = b % 1024, swz = sb ^ (((sb >> 9) & 1) << 5);
  R = (st >> 1) * 16 + swz / 64; C = (st & 1) * 32 + (swz % 64) / 2;
}

template <int EPI>
__device__ __forceinline__ void gemm256_tile(CP p, const u16* A, const u16* Bt, const int K,
                                             const int brow, const int bcol, int l, int gchunk, float coef, int nid, u16* shm, const int tid) {
#define SAI(b, h) ((b) * 2 + (h))
#define SBI(b, h) (4 + (b) * 2 + (h))
#define STAGE(PI, BASE, br, kt) do { \
    const char* _gb = (const char*)(BASE) + ((long)(br) * K + (long)(kt) * BK) * 2; \
    char* _lp = (char*)shm + (PI) * (HT * 2) + wave_lds; \
    __builtin_amdgcn_global_load_lds((const unsigned*)(_gb + voff0), (LAS unsigned*)(_lp), 16, 0, 0); \
    __builtin_amdgcn_global_load_lds((const unsigned*)(_gb + (long)K * 128 + voff0), (LAS unsigned*)(_lp + 8192), 16, 0, 0); } while (0)
#define LDA(dst, PI) do { unsigned _o = sw_ + a_uni; asm volatile("" : "+v"(_o)); _o &= 0x23F0u; \
    _Pragma("unroll") for (int m = 0; m < 4; ++m) _Pragma("unroll") for (int k = 0; k < 2; ++k) \
      dst[m][k] = *reinterpret_cast<const bf16x8*>((const char*)shm + (PI) * (HT * 2) + m * 2048 + k * 1024 + _o); } while (0)
#define LDB(dst, PI) do { unsigned _o = sw_ + b_uni; asm volatile("" : "+v"(_o)); _o &= 0x33F0u; \
    _Pragma("unroll") for (int n = 0; n < 2; ++n) _Pragma("unroll") for (int k = 0; k < 2; ++k) \
      dst[n][k] = *reinterpret_cast<const bf16x8*>((const char*)shm + (PI) * (HT * 2) + n * 2048 + k * 1024 + _o); } while (0)
#define MMA(ai, bj, At_, Bt_) do { __builtin_amdgcn_s_setprio(1); \
    _Pragma("unroll") for (int m = 0; m < 4; ++m) _Pragma("unroll") for (int n = 0; n < 2; ++n) _Pragma("unroll") for (int k = 0; k < 2; ++k) \
      acc[ai][bj][m][n] = __builtin_amdgcn_mfma_f32_16x16x32_bf16(At_[m][k], Bt_[n][k], acc[ai][bj][m][n], 0, 0, 0); \
    __builtin_amdgcn_s_setprio(0); } while (0)
#define WAIT_V(n) asm volatile("s_waitcnt vmcnt(" #n ")" ::: "memory")
#define WAIT_L(n) asm volatile("s_waitcnt lgkmcnt(" #n ")" ::: "memory")
#define BAR __builtin_amdgcn_s_barrier()
#define SCHED __builtin_amdgcn_sched_barrier(0)
  const int wid = __builtin_amdgcn_readfirstlane(tid >> 6), lane = tid & 63, wr = wid >> 2, wc = wid & 3, fr = lane & 15, fq = lane >> 4;
  const int wave_lds = (wid & 7) * 1024;
  unsigned voff0;
  { int r_, c_; stage_rc(tid * 16, r_, c_); voff0 = (unsigned)(r_ * K + c_) * 2u; }
  const unsigned sw_ = (unsigned)((fr * 64 + fq * 16) ^ ((((fr * 64 + fq * 16) >> 9) & 1) << 5));
  const unsigned a_uni = (unsigned)(wr * 8192), b_uni = (unsigned)(wc * 4096);
  f32x4 acc[2][2][4][2];
#pragma unroll
  for (int a = 0; a < 2; ++a)
#pragma unroll
    for (int b = 0; b < 2; ++b)
#pragma unroll
      for (int m = 0; m < 4; ++m)
#pragma unroll
        for (int n = 0; n < 2; ++n) acc[a][b][m][n] = (f32x4){0.f, 0.f, 0.f, 0.f};
  bf16x8 At[4][2], B0[2][2], B1[2][2];
  const int nt = K / BK;
  WAIT_V(0);
  __syncthreads();
  STAGE(SBI(0, 0), Bt, bcol, 0); STAGE(SAI(0, 0), A, brow, 0);
  STAGE(SBI(0, 1), Bt, bcol + HALF, 0); STAGE(SAI(0, 1), A, brow + HALF, 0);
  if (wr == 1) BAR;
  WAIT_V(4); BAR;
  STAGE(SBI(1, 0), Bt, bcol, 1); STAGE(SAI(1, 0), A, brow, 1); STAGE(SBI(1, 1), Bt, bcol + HALF, 1);
  WAIT_V(6); BAR;
  for (int t = 0; t < nt - 2; t += 2) {
    LDB(B0, SBI(0, 0)); SCHED; LDA(At, SAI(0, 0)); STAGE(SAI(1, 1), A, brow + HALF, t + 1);
    WAIT_L(8); BAR; WAIT_L(0); MMA(0, 0, At, B0); BAR; SCHED;
    LDB(B1, SBI(0, 1)); STAGE(SBI(0, 0), Bt, bcol, t + 2);
    BAR; WAIT_L(0); MMA(0, 1, At, B1); BAR;
    LDA(At, SAI(0, 1)); STAGE(SAI(0, 0), A, brow, t + 2);
    BAR; WAIT_L(0); MMA(1, 0, At, B0); BAR; SCHED;
    STAGE(SBI(0, 1), Bt, bcol + HALF, t + 2);
    WAIT_V(6); BAR; MMA(1, 1, At, B1); BAR;
    LDB(B0, SBI(1, 0)); SCHED; LDA(At, SAI(1, 0)); STAGE(SAI(0, 1), A, brow + HALF, t + 2);
    WAIT_L(8); BAR; WAIT_L(0); MMA(0, 0, At, B0); BAR; SCHED;
    LDB(B1, SBI(1, 1)); STAGE(SBI(1, 0), Bt, bcol, t + 3);
    BAR; WAIT_L(0); MMA(0, 1, At, B1); BAR;
    LDA(At, SAI(1, 1)); STAGE(SAI(1, 0), A, brow, t + 3);
    BAR; WAIT_L(0); MMA(1, 0, At, B0); BAR; SCHED;
    STAGE(SBI(1, 1), Bt, bcol + HALF, t + 3);
    WAIT_V(6); BAR; MMA(1, 1, At, B1); BAR;
  }
  { LDB(B0, SBI(0, 0)); LDA(At, SAI(0, 0)); STAGE(SAI(1, 1), A, brow + HALF, nt - 1);
    BAR; WAIT_L(0); MMA(0, 0, At, B0); BAR;
    LDB(B1, SBI(0, 1)); BAR; WAIT_L(0); MMA(0, 1, At, B1); BAR;
    LDA(At, SAI(0, 1)); WAIT_V(4); BAR; WAIT_L(0); MMA(1, 0, At, B0); MMA(1, 1, At, B1); BAR; }
  { LDB(B0, SBI(1, 0)); LDA(At, SAI(1, 0)); WAIT_V(2); BAR; WAIT_L(0); MMA(0, 0, At, B0); BAR;
    LDB(B1, SBI(1, 1)); WAIT_V(0); BAR; WAIT_L(0); MMA(0, 1, At, B1); BAR;
    LDA(At, SAI(1, 1)); BAR; WAIT_L(0); MMA(1, 0, At, B0); MMA(1, 1, At, B1); BAR; }
  if (wr == 0) BAR;
#undef SAI
#undef SBI
#undef STAGE
#undef LDA
#undef LDB
#undef MMA
#undef WAIT_V
#undef WAIT_L
#undef BAR
#undef SCHED
  if (EPI == EPI_SWIGLU) {
    u16* H = (u16*)(p->ws + OFF_HP);
    const int hc0 = (bcol >> 1) + wc * 32 + fr;
    const float* rowss = (const float*)(p->ws + OFF_ROWSS) + (size_t)nid * MTOK;
    const float* bias = (const float*)(p->ws + OFF_BIAS) + (size_t)(nid * 3 + cond_of(brow)) * NFF;
    float bg[2], bu[2];
#pragma unroll
    for (int n = 0; n < 2; ++n) { bg[n] = bias[hc0 + n * 16]; bu[n] = bias[DFF + hc0 + n * 16]; }
#pragma unroll
    for (int ai = 0; ai < 2; ++ai)
#pragma unroll
      for (int m = 0; m < 4; ++m)
#pragma unroll
        for (int j = 0; j < 4; ++j) {
          int row = brow + ai * 128 + wr * 64 + m * 16 + fq * 4 + j;
          const float rstd = rsqrtf(rowss[row] * (1.f / 1024.f) + EPS);
#pragma unroll
          for (int n = 0; n < 2; ++n) {
            float g = acc[ai][0][m][n][j] * rstd + bg[n], u = acc[ai][1][m][n][j] * rstd + bu[n];
            float h = g / (1.f + __expf(-g)) * u;
            H[(size_t)row * DFF + hc0 + n * 16] = f2bf(h);
          }
        }
  } else if (EPI == EPI_RESID) {
    float* x = p->out + O_X;
    const float* mod = (const float*)(p->ws + OFF_MOD);
    u16* xn = (u16*)(p->ws + OFF_XN);
    float* rowss = (float*)(p->ws + OFF_ROWSS) + (size_t)nid * MTOK;
    const int cnd = cond_of(brow);
    const float* gp = mod + (l * 3 + cnd) * 9216 + gchunk * 1024;
    const bool has_next = nid < 6;
    const int ln = (nid % 6) / 3, wn = nid % 3;
    const float* ngp = p->in[(ln ? I_L1 : I_L0) + L_NORM] + wn * 1024;
    const float* scp = mod + (ln * 3 + cnd) * 9216 + (3 * wn + 1) * 1024;
    float gt[2][2], gs[2][2];
#pragma unroll
    for (int bj = 0; bj < 2; ++bj)
#pragma unroll
      for (int n = 0; n < 2; ++n) {
        int col = bcol + bj * 128 + wc * 32 + n * 16 + fr;
        gt[bj][n] = coef * gp[col];
        gs[bj][n] = has_next ? ngp[col] * (1.f + scp[col]) : 0.f;
      }
#pragma unroll
    for (int ai = 0; ai < 2; ++ai)
#pragma unroll
      for (int m = 0; m < 4; ++m)
#pragma unroll
        for (int j = 0; j < 4; ++j) {
          int row = brow + ai * 128 + wr * 64 + m * 16 + fq * 4 + j;
          float ss = 0.f;
#pragma unroll
          for (int bj = 0; bj < 2; ++bj)
#pragma unroll
            for (int n = 0; n < 2; ++n) {
              int col = bcol + bj * 128 + wc * 32 + n * 16 + fr;
              size_t idx = (size_t)row * D + col;
              float xv = x[idx] + gt[bj][n] * acc[ai][bj][m][n][j];
              x[idx] = xv;
              ss += xv * xv;
              if (has_next) xn[idx] = f2bf(xv * gs[bj][n]);
            }
          ss = grp16_sum(ss);
          if (fr == 0 && nid < 7) unsafeAtomicAdd(rowss + row, ss);
        }
  } else {
    u16* proj = (u16*)(p->ws + OFF_HP);
    const bool isctx = brow < NCTX;
    const int c0 = bcol + wc * 64;
    const float* rc = (const float*)(p->ws + OFF_ROPE);
    const float* rowss = (const float*)(p->ws + OFF_ROWSS) + (size_t)nid * MTOK;
    const float* bias = (const float*)(p->ws + OFF_BIAS) + (size_t)(nid * 3 + cond_of(brow)) * NFF;
    float bz[2][2];
#pragma unroll
    for (int bj = 0; bj < 2; ++bj)
#pragma unroll
      for (int n = 0; n < 2; ++n) { int col = c0 + bj * 32 + n * 16 + fr; bz[bj][n] = (col < ((EPI == EPI_MIX0) ? P0N : P1N)) ? bias[col] : 0.f; }
    bool do_norm = false, do_rope = false;
    const float* ng = nullptr;
    float* o32 = nullptr; int ostr = 0;
    bool elementwise = false;
    if (EPI == EPI_MIX0) {
      if (c0 < 512) { do_norm = true; ng = p->in[I_L0 + L_X0]; do_rope = !isctx; }
      else if (c0 < 640) { do_norm = true; ng = p->in[I_L0 + L_X0] + 64; do_rope = !isctx; if (isctx) { o32 = p->out + O_K0 + (c0 - 512); ostr = 128; } }
      else if (c0 < 768) { if (isctx) { o32 = p->out + O_V0 + (c0 - 640); ostr = 128; } }
      else if (c0 >= 2304) elementwise = true;
    } else {
      if (c0 < 512) {}
      else if (c0 < 1024) { if (isctx) { o32 = p->out + O_KC1 + (c0 - 512); ostr = 512; } }
      else if (c0 < 1536) { if (isctx) { o32 = p->out + O_VC1 + (c0 - 1024); ostr = 512; } }
      else if (c0 < 2048) { do_rope = !isctx; }
      else if (c0 < 2176) { do_rope = !isctx; if (isctx) { o32 = p->out + O_KD1 + (c0 - 2048); ostr = 128; } }
      else { if (isctx) { o32 = p->out + O_VD1 + (c0 - 2176); ostr = 128; } }
    }
    if (elementwise) {
      float* gates = (float*)(p->ws + OFF_GATES);
      const float* gb = p->in[I_L0 + L_X1];
#pragma unroll
      for (int ai = 0; ai < 2; ++ai)
#pragma unroll
        for (int m = 0; m < 4; ++m)
#pragma unroll
          for (int j = 0; j < 4; ++j) {
            int row = brow + ai * 128 + wr * 64 + m * 16 + fq * 4 + j;
            const float rstd = rsqrtf(rowss[row] * (1.f / 1024.f) + EPS);
#pragma unroll
            for (int bj = 0; bj < 2; ++bj)
#pragma unroll
              for (int n = 0; n < 2; ++n) {
                int col = c0 + bj * 32 + n * 16 + fr;
                float v = acc[ai][bj][m][n][j] * rstd + bz[bj][n];
                if (col < 2336) gates[(size_t)row * 32 + (col - 2304)] = v + gb[col - 2304];
                else if (col < P0N) proj[(size_t)row * PSTR + col] = f2bf(v);
              }
          }
    } else {
#pragma unroll
      for (int ai = 0; ai < 2; ++ai)
#pragma unroll
        for (int m = 0; m < 4; ++m)
#pragma unroll
          for (int j = 0; j < 4; ++j) {
            int row = brow + ai * 128 + wr * 64 + m * 16 + fq * 4 + j;
            const float rstd0 = rsqrtf(rowss[row] * (1.f / 1024.f) + EPS);
            float v0 = acc[ai][0][m][0][j] * rstd0 + bz[0][0], v1 = acc[ai][0][m][1][j] * rstd0 + bz[0][1];
            float v2 = acc[ai][1][m][0][j] * rstd0 + bz[1][0], v3 = acc[ai][1][m][1][j] * rstd0 + bz[1][1];
            if (do_norm) {
              float ss = v0 * v0 + v1 * v1 + v2 * v2 + v3 * v3;
              ss = grp16_sum(ss);
              float rstd = rsqrtf(ss * (1.f / 64.f) + EPS);
              v0 = v0 * rstd * ng[fr]; v1 = v1 * rstd * ng[16 + fr]; v2 = v2 * rstd * ng[32 + fr]; v3 = v3 * rstd * ng[48 + fr];
            }
            if (do_rope) {
              int tk = (row - NCTX) & 1023;
              float ca = rc[tk * 32 + fr], sa = rc[32768 + tk * 32 + fr];
              float cb = rc[tk * 32 + 16 + fr], sb = rc[32768 + tk * 32 + 16 + fr];
              float a0 = v0 * ca - v2 * sa, a2 = v2 * ca + v0 * sa;
              float a1 = v1 * cb - v3 * sb, a3 = v3 * cb + v1 * sb;
              v0 = a0; v1 = a1; v2 = a2; v3 = a3;
            }
            u16* pr = proj + (size_t)row * PSTR + c0 + fr;
            pr[0] = f2bf(v0); pr[16] = f2bf(v1); pr[32] = f2bf(v2); pr[48] = f2bf(v3);
            if (o32) {
              float* o = o32 + (size_t)row * ostr + fr;
              o[0] = v0; o[16] = v1; o[32] = v2; o[48] = v3;
            }
          }
    }
  }
}

template <int EPI>
__device__ __forceinline__ void gemm_phase(CP p, const u16* A, const u16* Bt, int K, int nN, int l, int gchunk, float coef, int nid, u16* smem, int side = 0) {
  const int tid = get_tid();
  const int nM = MTOK / BM, nwg = nM * nN;
  for (int t = blockIdx.x; t < nwg; t += gridDim.x) {
    int wgid = t;
    { int q = nwg / NXCD, r = nwg % NXCD, xcd = wgid % NXCD, off = wgid / NXCD;
      wgid = (xcd < r ? xcd * (q + 1) : r * (q + 1) + (xcd - r) * q) + off; }
    int nig = WGM * nN, gid = wgid / nig, fm = gid * WGM, gsz = min(nM - fm, WGM);
    int pm = fm + ((wgid % nig) % gsz), pn = (wgid % nig) / gsz;
    gemm256_tile<EPI>(p, A, Bt, K, pm * BM, pn * BM, l, gchunk, coef, nid, smem, tid);
  }
  if (EPI == EPI_RESID && side) { __syncthreads(); conv_side_job(p, side, nwg, (float*)smem); }
}

__device__ __forceinline__ void load_tile_bf16(float* dst, const u16* src, long rstride, float scale, int tid) {
  int r = tid >> 2, part = tid & 3;
  const uint4* s = (const uint4*)(src + (long)r * rstride + part * 16);
  uint4 a = s[0], b = s[1];
  float4* d = (float4*)(dst + r * TS + part * 16);
  d[0] = make_float4(bflo(a.x) * scale, bfhi(a.x) * scale, bflo(a.y) * scale, bfhi(a.y) * scale);
  d[1] = make_float4(bflo(a.z) * scale, bfhi(a.z) * scale, bflo(a.w) * scale, bfhi(a.w) * scale);
  d[2] = make_float4(bflo(b.x) * scale, bfhi(b.x) * scale, bflo(b.y) * scale, bfhi(b.y) * scale);
  d[3] = make_float4(bflo(b.z) * scale, bfhi(b.z) * scale, bflo(b.w) * scale, bfhi(b.w) * scale);
}
__device__ __forceinline__ void tile_ld_regs(const u16* src, long rstride, int tid, uint4& a, uint4& b) {
  int r = tid >> 2, part = tid & 3;
  const uint4* s = (const uint4*)(src + (long)r * rstride + part * 16);
  a = s[0]; b = s[1];
}
__device__ __forceinline__ void tile_st_regs(float* dst, int tid, const uint4& a, const uint4& b, float scale) {
  int r = tid >> 2, part = tid & 3;
  float4* d = (float4*)(dst + r * TS + part * 16);
  d[0] = make_float4(bflo(a.x) * scale, bfhi(a.x) * scale, bflo(a.y) * scale, bfhi(a.y) * scale);
  d[1] = make_float4(bflo(a.z) * scale, bfhi(a.z) * scale, bflo(a.w) * scale, bfhi(a.w) * scale);
  d[2] = make_float4(bflo(b.x) * scale, bfhi(b.x) * scale, bflo(b.y) * scale, bfhi(b.y) * scale);
  d[3] = make_float4(bflo(b.z) * scale, bfhi(b.z) * scale, bflo(b.w) * scale, bfhi(b.w) * scale);
}
__device__ __forceinline__ void load_tile_f32(float* dst, const float* src, long rstride, int tid) {
  int r = tid >> 2, part = tid & 3;
  const float4* s = (const float4*)(src + (long)r * rstride + part * 16);
  float4* d = (float4*)(dst + r * TS + part * 16);
  d[0] = s[0]; d[1] = s[1]; d[2] = s[2]; d[3] = s[3];
}
typedef __attribute__((ext_vector_type(2))) float f32x2;
__device__ __forceinline__ void qk_micro(const float* Qs, const float* Ks, int ty, int tx, float s[4][4]) {
  f32x2 s2[4][4];
#pragma unroll
  for (int i = 0; i < 4; ++i)
#pragma unroll
    for (int j = 0; j < 4; ++j) s2[i][j] = (f32x2){0.f, 0.f};
#pragma unroll 2
  for (int d4 = 0; d4 < 16; ++d4) {
    f32x4 q[4], k[4];
#pragma unroll
    for (int i = 0; i < 4; ++i) q[i] = *(const f32x4*)(Qs + (ty * 4 + i) * TS + d4 * 4);
#pragma unroll
    for (int j = 0; j < 4; ++j) k[j] = *(const f32x4*)(Ks + (tx + 16 * j) * TS + d4 * 4);
#pragma unroll
    for (int i = 0; i < 4; ++i)
#pragma unroll
      for (int j = 0; j < 4; ++j) {
        s2[i][j] += q[i].xy * k[j].xy;
        s2[i][j] += q[i].zw * k[j].zw;
      }
  }
#pragma unroll
  for (int i = 0; i < 4; ++i)
#pragma unroll
    for (int j = 0; j < 4; ++j) s[i][j] = s2[i][j].x + s2[i][j].y;
}
__device__ __forceinline__ void pv_micro(const float* Ps, const float* Vs, int ty, int tx, float o[4][4]) {
  f32x2 oa[4], ob[4];
#pragma unroll
  for (int i = 0; i < 4; ++i) { oa[i] = (f32x2){o[i][0], o[i][1]}; ob[i] = (f32x2){o[i][2], o[i][3]}; }
#pragma unroll 2
  for (int s4 = 0; s4 < 16; ++s4) {
    f32x4 pp[4], v[4];
#pragma unroll
    for (int i = 0; i < 4; ++i) pp[i] = *(const f32x4*)(Ps + (ty * 4 + i) * TS + s4 * 4);
#pragma unroll
    for (int q = 0; q < 4; ++q) v[q] = *(const f32x4*)(Vs + (s4 * 4 + q) * TS + tx * 4);
#pragma unroll
    for (int i = 0; i < 4; ++i)
#pragma unroll
      for (int q = 0; q < 4; ++q) {
        const float ps = pp[i][q];
        const f32x2 p2 = (f32x2){ps, ps};
        oa[i] += p2 * v[q].xy;
        ob[i] += p2 * v[q].zw;
      }
  }
#pragma unroll
  for (int i = 0; i < 4; ++i) { o[i][0] = oa[i].x; o[i][1] = oa[i].y; o[i][2] = ob[i].x; o[i][3] = ob[i].y; }
}

struct AttnDesc {
  int qrow0, qcol, ocol;
  const float* ck; const float* cv; int cstride; int nctx;
  int krow0, nloc, kcol, vcol;
  int mode;
  int a0;
  int r0;
  const float* rpb;
  float sink; int has_sink;
};

constexpr int AS_ = 72;
__device__ __forceinline__ void attn_item(CP p, const AttnDesc& d, float* sm) {
  const int tid = get_tid(), w = tid >> 6, lane = tid & 63, fr = lane & 15, fq = lane >> 4, half = w >> 2;
  const u16* proj = (const u16*)(p->ws + OFF_HP);
  u16* Ks = (u16*)sm;
  u16* Vt = Ks + 64 * AS_;
  u16* Ps = Vt + 64 * AS_ + w * (16 * AS_);
  bf16x8 qf[2];
  {
    const u16* qp = proj + (size_t)(d.qrow0 + w * 16 + fr) * PSTR + d.qcol + fq * 8;
    qf[0] = *(const bf16x8*)(qp);
    qf[1] = *(const bf16x8*)(qp + 32);
  }
  float m_i[4], l_i[4];
  f32x4 o[4];
#pragma unroll
  for (int j = 0; j < 4; ++j) {
    m_i[j] = d.has_sink ? d.sink : -1e30f;
    l_i[j] = (d.has_sink && fr == 0) ? 1.f : 0.f;
  }
#pragma unroll
  for (int n = 0; n < 4; ++n) o[n] = (f32x4){0.f, 0.f, 0.f, 0.f};
  const int ntiles = d.nctx + d.nloc;
  const int lrow = tid >> 3, lc8 = tid & 7;
  float4 kf0, kf1, vf0, vf1;
  u32x4 kq, vq;
  auto issue = [&](int tile) {
    if (tile < d.nctx) {
      const size_t off = (size_t)(tile * 64 + lrow) * d.cstride + lc8 * 8;
      kf0 = *(const float4*)(d.ck + off); kf1 = *(const float4*)(d.ck + off + 4);
      vf0 = *(const float4*)(d.cv + off); vf1 = *(const float4*)(d.cv + off + 4);
    } else {
      const u16* base = proj + (size_t)(d.krow0 + (tile - d.nctx) * 64 + lrow) * PSTR + lc8 * 8;
      kq = *(const u32x4*)(base + d.kcol);
      vq = *(const u32x4*)(base + d.vcol);
    }
  };
  issue(0);
  for (int tile = 0; tile < ntiles; ++tile) {
    __syncthreads();
    if (tile < d.nctx) {
      kq = (u32x4){pack2(kf0.x, kf0.y), pack2(kf0.z, kf0.w), pack2(kf1.x, kf1.y), pack2(kf1.z, kf1.w)};
      vq = (u32x4){pack2(vf0.x, vf0.y), pack2(vf0.z, vf0.w), pack2(vf1.x, vf1.y), pack2(vf1.z, vf1.w)};
    }
    *(u32x4*)(Ks + lrow * AS_ + lc8 * 8) = kq;
    {
      u16* vt = Vt + (lc8 * 8) * AS_ + lrow;
      vt[0 * AS_] = (u16)(vq.x & 0xffff); vt[1 * AS_] = (u16)(vq.x >> 16);
      vt[2 * AS_] = (u16)(vq.y & 0xffff); vt[3 * AS_] = (u16)(vq.y >> 16);
      vt[4 * AS_] = (u16)(vq.z & 0xffff); vt[5 * AS_] = (u16)(vq.z >> 16);
      vt[6 * AS_] = (u16)(vq.w & 0xffff); vt[7 * AS_] = (u16)(vq.w >> 16);
    }
    __syncthreads();
    if (tile + 1 < ntiles) issue(tile + 1);
    const int lt = tile - d.nctx;
    f32x4 sacc[4];
#pragma unroll
    for (int n = 0; n < 4; ++n) sacc[n] = (f32x4){0.f, 0.f, 0.f, 0.f};
#pragma unroll
    for (int ks = 0; ks < 2; ++ks)
#pragma unroll
      for (int n = 0; n < 4; ++n) {
        bf16x8 kb = *(const bf16x8*)(Ks + (n * 16 + fr) * AS_ + ks * 32 + fq * 8);
        sacc[n] = __builtin_amdgcn_mfma_f32_16x16x32_bf16(qf[ks], kb, sacc[n], 0, 0, 0);
      }
    float sv[4][4];
#pragma unroll
    for (int n = 0; n < 4; ++n)
#pragma unroll
      for (int j = 0; j < 4; ++j) sv[j][n] = sacc[n][j] * 0.125f;
    if (lt >= 0 && d.mode == 1) {
      const int rq = d.a0 + half;
      const int kr = d.r0 + lt;
      const int rq0 = min(max(rq - 4, 0), 8);
      const bool rowok = (kr >= rq0) && (kr < rq0 + 8);
      const int dy = min(max(kr - rq + 7, 0), 14);
      const float* rp = d.rpb + dy * 31;
#pragma unroll
      for (int j = 0; j < 4; ++j) {
        int qc = (w & 3) * 16 + fq * 4 + j;
        int ws = min(max(qc - 8, 0), 48);
#pragma unroll
        for (int n = 0; n < 4; ++n) {
          int kc = n * 16 + fr;
          bool ok = rowok && (kc >= ws) && (kc < ws + 16);
          int dx = min(max(kc - qc + 15, 0), 30);
          sv[j][n] = ok ? sv[j][n] + rp[dx] : -1e30f;
        }
      }
    } else if (lt >= 0 && d.mode == 2) {
      const int off = d.a0 + lt * 64 - half * 64;
#pragma unroll
      for (int j = 0; j < 4; ++j)
#pragma unroll
        for (int n = 0; n < 4; ++n) {
          int dd = off + (n * 16 + fr) - ((w & 3) * 16 + fq * 4 + j);
          bool ok = (dd <= 128) && (dd >= -128);
          sv[j][n] = ok ? sv[j][n] : -1e30f;
        }
    }
#pragma unroll
    for (int j = 0; j < 4; ++j) {
      float mx = fmaxf(fmaxf(sv[j][0], sv[j][1]), fmaxf(sv[j][2], sv[j][3]));
      mx = grp16_max(mx);
      float mn = fmaxf(m_i[j], mx);
      float alpha = __expf(m_i[j] - mn);
      float rs = 0.f;
#pragma unroll
      for (int n = 0; n < 4; ++n) {
        float pj = __expf(sv[j][n] - mn);
        rs += pj;
        Ps[(fq * 4 + j) * AS_ + n * 16 + fr] = f2bf(pj);
      }
      l_i[j] = l_i[j] * alpha + rs;
      m_i[j] = mn;
#pragma unroll
      for (int n = 0; n < 4; ++n) o[n][j] *= alpha;
    }
    __builtin_amdgcn_wave_barrier();
#pragma unroll
    for (int ks = 0; ks < 2; ++ks) {
      bf16x8 pa = *(const bf16x8*)(Ps + fr * AS_ + ks * 32 + fq * 8);
#pragma unroll
      for (int n = 0; n < 4; ++n) {
        bf16x8 vb = *(const bf16x8*)(Vt + (n * 16 + fr) * AS_ + ks * 32 + fq * 8);
        o[n] = __builtin_amdgcn_mfma_f32_16x16x32_bf16(pa, vb, o[n], 0, 0, 0);
      }
    }
    __builtin_amdgcn_wave_barrier();
  }
  u16* ymix = (u16*)(p->ws + OFF_YMIX);
#pragma unroll
  for (int j = 0; j < 4; ++j) {
    float inv = 1.f / grp16_sum(l_i[j]);
    u16* yp = ymix + (size_t)(d.qrow0 + w * 16 + fq * 4 + j) * D + d.ocol + fr;
#pragma unroll
    for (int n = 0; n < 4; ++n) yp[n * 16] = f2bf(o[n][j] * inv);
  }
}

__device__ __forceinline__ int st_slot(int isctx, int b, int dir, int head, int cc) {
  int ch = (b * 2 + dir) * 8 + head;
  return isctx ? (ch * 4 + cc) : (2048 + ch * 16 + cc);
}

__device__ __forceinline__ void mlstm_state_item(CP p, int isctx, int b, int head, float* sm) {
  const int tid = get_tid(), dir = tid >> 8, t = tid & 255, ty = t >> 4, tx = t & 15, lane = t & 63;
  const u16* proj = (const u16*)(p->ws + OFF_HP);
  const float* gates = (const float*)(p->ws + OFF_GATES);
  float* stC = (float*)(p->ws + OFF_STC);
  float* stn = (float*)(p->ws + OFF_STN);
  float* stm = (float*)(p->ws + OFF_STM);
  float* Ks = sm + (dir * 2) * TILE_F; float* Vs = sm + (dir * 2 + 1) * TILE_F;
  float* sws = sm + 8 * TILE_F + dir * 256;
  float* sn = sws + 64;
  float* ssc = sn + 64;
  const int nc = isctx ? 4 : 16, L = isctx ? 256 : 1024;
  const int seq0 = isctx ? b * 256 : NCTX + b * 1024;
  float c[4][4];
  float m;
  __syncthreads();
  if (isctx) {
#pragma unroll
    for (int i = 0; i < 4; ++i)
#pragma unroll
      for (int j = 0; j < 4; ++j) c[i][j] = 0.f;
    if (t < 64) sn[t] = 0.f;
    m = 0.f;
  } else {
    int ch = (b * 2 + dir) * 8 + head;
    const float* C0 = p->in[I_SC] + (size_t)ch * 4096;
#pragma unroll
    for (int i = 0; i < 4; ++i) {
      float4 v = *(const float4*)(C0 + (ty * 4 + i) * 64 + tx * 4);
      c[i][0] = v.x; c[i][1] = v.y; c[i][2] = v.z; c[i][3] = v.w;
    }
    if (t < 64) sn[t] = p->in[I_SN][ch * 64 + t];
    m = p->in[I_SM][ch];
  }
  uint4 ka, kb, va, vb;
  float g_li = 0.f, g_fp = 0.f;
  auto prefetch = [&](int cc) {
    const int tok0 = dir ? (L - 1 - cc * 64) : cc * 64;
    const long rs = dir ? -(long)PSTR : (long)PSTR;
    const u16* base = proj + (size_t)(seq0 + tok0) * PSTR;
    tile_ld_regs(base + 1280 + head * 64, rs, t, ka, kb);
    tile_ld_regs(base + 1792 + head * 64, rs, t, va, vb);
    if (t < 64) {
      int tr = seq0 + (dir ? tok0 - lane : tok0 + lane);
      g_li = gates[(size_t)tr * 32 + (dir * 2) * 8 + head];
      g_fp = gates[(size_t)tr * 32 + (dir * 2 + 1) * 8 + head];
    }
  };
  prefetch(0);
  for (int cc = 0; cc < nc; ++cc) {
    __syncthreads();
    const int slot = st_slot(isctx, b, dir, head, cc);
#pragma unroll
    for (int i = 0; i < 4; ++i)
      *(float4*)(stC + (size_t)slot * 4096 + (ty * 4 + i) * 64 + tx * 4) = make_float4(c[i][0], c[i][1], c[i][2], c[i][3]);
    if (t < 64) stn[slot * 64 + t] = sn[t];
    if (t == 0) stm[slot] = m;
    tile_st_regs(Ks, t, ka, kb, 0.125f);
    tile_st_regs(Vs, t, va, vb, 1.f);
    if (t < 64) {
      float li = g_li, fp = g_fp;
      float lf = logsigmoidf_(fp);
      float bb = wave_scan_add(lf, lane);
      float a = li - bb;
      float amax = wave_max(a);
      float blast = __shfl(bb, 63);
      float mnew = blast + fmaxf(m, amax);
      sws[lane] = expf(blast + a - mnew);
      if (lane == 0) { ssc[0] = expf(blast + m - mnew); ssc[1] = mnew; }
    }
    if (cc + 1 < nc) prefetch(cc + 1);
    __syncthreads();
    const float wc = ssc[0];
    m = ssc[1];
#pragma unroll
    for (int i = 0; i < 4; ++i)
#pragma unroll
      for (int j = 0; j < 4; ++j) c[i][j] *= wc;
    float nacc = 0.f;
    {
      f32x2 ca[4], cb[4];
#pragma unroll
      for (int i = 0; i < 4; ++i) { ca[i] = (f32x2){c[i][0], c[i][1]}; cb[i] = (f32x2){c[i][2], c[i][3]}; }
#pragma unroll 4
      for (int s = 0; s < 64; ++s) {
        const float w = sws[s];
        const f32x4 kk = *(const f32x4*)(Ks + s * TS + ty * 4);
        const f32x4 vv = *(const f32x4*)(Vs + s * TS + tx * 4);
#pragma unroll
        for (int i = 0; i < 4; ++i) {
          const float kw = kk[i] * w;
          const f32x2 k2 = (f32x2){kw, kw};
          ca[i] += k2 * vv.xy;
          cb[i] += k2 * vv.zw;
        }
        if (t < 64) nacc += w * Ks[s * TS + t];
      }
#pragma unroll
      for (int i = 0; i < 4; ++i) { c[i][0] = ca[i].x; c[i][1] = ca[i].y; c[i][2] = cb[i].x; c[i][3] = cb[i].y; }
    }
    if (t < 64) sn[t] = wc * sn[t] + nacc;
  }
  __syncthreads();
  if (isctx) {
    int ch = (b * 2 + dir) * 8 + head;
    float* Co = p->out + O_C + (size_t)ch * 4096;
#pragma unroll
    for (int i = 0; i < 4; ++i)
      *(float4*)(Co + (ty * 4 + i) * 64 + tx * 4) = make_float4(c[i][0], c[i][1], c[i][2], c[i][3]);
    if (t < 64) p->out[O_N + ch * 64 + t] = sn[t];
    if (t == 0) p->out[O_M + ch] = m;
  }
}

__device__ __forceinline__ void mlstm_out_item(CP p, int isctx, int b, int head, int c, float* sm) {
  const int tid = get_tid(), dir = tid >> 8, t = tid & 255, ty = t >> 4, tx = t & 15, lane = t & 63;
  const u16* proj = (const u16*)(p->ws + OFF_HP);
  const float* gates = (const float*)(p->ws + OFF_GATES);
  const float* stC = (const float*)(p->ws + OFF_STC);
  const float* stn = (const float*)(p->ws + OFF_STN);
  const float* stm = (const float*)(p->ws + OFF_STM);
  float* Qs = sm + (dir * 4) * TILE_F; float* KCs = Qs + TILE_F; float* Vs = Qs + 2 * TILE_F; float* Ws = Qs + 3 * TILE_F;
  float* Ws1 = sm + 7 * TILE_F;
  float* sa = sm + 8 * TILE_F + dir * 256;
  float* sM = sa + 64;
  float* sb = sM + 64;
  float* sn = sb + 64;
  const int nc = isctx ? 4 : 16;
  const int mb = (isctx ? b * 256 : NCTX + b * 1024) + c * 64;
  const int cc = dir ? nc - 1 - c : c;
  const int slot = st_slot(isctx, b, dir, head, cc);
  const float m0 = stm[slot];
  __syncthreads();
  const long rs = dir ? -(long)PSTR : (long)PSTR;
  const u16* base = proj + (size_t)(mb + (dir ? 63 : 0)) * PSTR;
  load_tile_bf16(Qs, base + 768 + head * 64, rs, 1.f, t);
  load_tile_bf16(KCs, base + 1280 + head * 64, rs, 0.125f, t);
  load_tile_bf16(Vs, base + 1792 + head * 64, rs, 1.f, t);
  if (t < 64) {
    int tr = mb + (dir ? 63 - lane : lane);
    float li = gates[(size_t)tr * 32 + (dir * 2) * 8 + head];
    float fp = gates[(size_t)tr * 32 + (dir * 2 + 1) * 8 + head];
    float lf = logsigmoidf_(fp);
    float bb = wave_scan_add(lf, lane);
    float a = li - bb;
    float pm = wave_scan_max(a, lane);
    sa[lane] = a; sM[lane] = fmaxf(m0, pm); sb[lane] = bb;
    sn[lane] = stn[slot * 64 + lane];
  }
  __syncthreads();
  float hd[4][4];
  {
    float s[4][4];
    qk_micro(Qs, KCs, ty, tx, s);
    float rsum[4];
#pragma unroll
    for (int i = 0; i < 4; ++i) {
      int tq = ty * 4 + i;
      float Mt = sM[tq];
      float r = 0.f;
#pragma unroll
      for (int j = 0; j < 4; ++j) {
        int sidx = tx + 16 * j;
        float w = (sidx <= tq) ? expf(sa[sidx] - Mt) * s[i][j] : 0.f;
        Ws[tq * TS + sidx] = w;
        r += w;
      }
      rsum[i] = grp16_sum(r);
    }
    __syncthreads();
    load_tile_f32(KCs, stC + (size_t)slot * 4096, 64, t);
    __syncthreads();
    float num[4][4], qc[4][4];
#pragma unroll
    for (int i = 0; i < 4; ++i)
#pragma unroll
      for (int j = 0; j < 4; ++j) { num[i][j] = 0.f; qc[i][j] = 0.f; }
    pv_micro(Ws, Vs, ty, tx, num);
    pv_micro(Qs, KCs, ty, tx, qc);
#pragma unroll
    for (int i = 0; i < 4; ++i) {
      int tq = ty * 4 + i;
      float4 q4 = *(const float4*)(Qs + tq * TS + tx * 4);
      float4 n4 = *(const float4*)(sn + tx * 4);
      float qn = q4.x * n4.x + q4.y * n4.y + q4.z * n4.z + q4.w * n4.w;
      qn = grp16_sum(qn);
      float Mt = sM[tq];
      float wi = expf(m0 - Mt);
      float den = rsum[i] + wi * qn;
      float mt = sb[tq] + Mt;
      float dn = fmaxf(fabsf(den), expf(-mt));
      float inv = 1.f / dn;
#pragma unroll
      for (int j = 0; j < 4; ++j) hd[i][j] = (num[i][j] + wi * qc[i][j]) * inv;
    }
  }
  __syncthreads();
  if (dir == 1) {
#pragma unroll
    for (int i = 0; i < 4; ++i)
      *(float4*)(Ws1 + (63 - (ty * 4 + i)) * TS + tx * 4) = make_float4(hd[i][0], hd[i][1], hd[i][2], hd[i][3]);
  }
  __syncthreads();
  if (dir == 0) {
    const float* hg = p->in[I_L0 + L_X2] + head * 64 + tx * 4;
    u16* ymix = (u16*)(p->ws + OFF_YMIX);
#pragma unroll
    for (int i = 0; i < 4; ++i) {
      float4 v = *(const float4*)(Ws1 + (ty * 4 + i) * TS + tx * 4);
      float h0 = hd[i][0] + v.x, h1 = hd[i][1] + v.y, h2 = hd[i][2] + v.z, h3 = hd[i][3] + v.w;
      float ss = h0 * h0 + h1 * h1 + h2 * h2 + h3 * h3;
      ss = grp16_sum(ss);
      float rstd = rsqrtf(ss * (1.f / 64.f) + EPS);
      int tr = mb + ty * 4 + i;
      uint2 ob = *(const uint2*)(proj + (size_t)tr * PSTR + 2336 + head * 64 + tx * 4);
      float y0 = sigmoidf_(bflo(ob.x)) * (h0 * rstd * hg[0]);
      float y1 = sigmoidf_(bfhi(ob.x)) * (h1 * rstd * hg[1]);
      float y2 = sigmoidf_(bflo(ob.y)) * (h2 * rstd * hg[2]);
      float y3 = sigmoidf_(bfhi(ob.y)) * (h3 * rstd * hg[3]);
      *(uint2*)(ymix + (size_t)tr * D + 512 + head * 64 + tx * 4) = make_uint2(pack2(y0, y1), pack2(y2, y3));
    }
  }
}

__device__ __forceinline__ int next_item(int* ctr, int* s_item) {
  __syncthreads();
  if (get_tid() == 0) *s_item = atomicAdd(ctr, 1);
  __syncthreads();
  return *s_item;
}

__device__ __forceinline__ void mix0_phase_a(CP p, float* sm, int* s_item, int coff) {
  int* ctr = (int*)(p->ws + OFF_CTR) + 0 + coff;
  for (;;) {
    int it = next_item(ctr, s_item);
    if (it >= 912) break;
    if (it >= 128 && it < 144) {
      int v = it - 128; int b = v >> 3, head = v & 7;
      mlstm_state_item(p, 0, b, head, sm);
    } else if (it >= 656) {
      int v = it - 656; int b = v >> 3, head = v & 7;
      mlstm_state_item(p, 1, b, head, sm);
    } else {
      AttnDesc d;
      d.mode = 0; d.a0 = 0; d.r0 = 0; d.rpb = nullptr; d.sink = 0.f; d.has_sink = 0;
      if (it < 128) {
        int b = it >> 6, h = (it >> 3) & 7, qb = it & 7;
        d.qrow0 = NCTX + b * 1024 + qb * 128; d.qcol = h * 64; d.ocol = h * 64;
        d.ck = p->in[I_C0K] + (size_t)b * 256 * 128 + (h >> 2) * 64; d.cv = p->in[I_C0V] + (size_t)b * 256 * 128 + (h >> 2) * 64;
        d.cstride = 128; d.nctx = 4;
        d.krow0 = NCTX + b * 1024; d.nloc = 16; d.kcol = 512 + (h >> 2) * 64; d.vcol = 640 + (h >> 2) * 64;
      } else {
        int v = it - 144; int b = v >> 4, h = (v >> 1) & 7, qb = v & 1;
        d.qrow0 = b * 256 + qb * 128; d.qcol = h * 64; d.ocol = h * 64;
        d.ck = nullptr; d.cv = nullptr; d.cstride = 0; d.nctx = 0;
        d.krow0 = b * 256; d.nloc = 4; d.kcol = 512 + (h >> 2) * 64; d.vcol = 640 + (h >> 2) * 64;
      }
      attn_item(p, d, sm);
    }
  }
}

__device__ __forceinline__ void mix0_phase_b(CP p, float* sm, int* s_item, int coff) {
  int* ctr = (int*)(p->ws + OFF_CTR) + 1 + coff;
  for (;;) {
    int it = next_item(ctr, s_item);
    if (it >= 1280) break;
    if (it < 256) {
      int b = it >> 7, head = (it >> 4) & 7, c = it & 15;
      mlstm_out_item(p, 0, b, head, c, sm);
    } else {
      int v = it - 256; int b = v >> 5, head = (v >> 2) & 7, c = v & 3;
      mlstm_out_item(p, 1, b, head, c, sm);
    }
  }
}

__device__ __forceinline__ void mix1_phase(CP p, float* sm, int* s_item, int coff) {
  int* ctr = (int*)(p->ws + OFF_CTR) + 2 + coff;
  const float* sink = p->in[I_L1 + L_X1];
  for (;;) {
    int it = next_item(ctr, s_item);
    if (it >= 1280) break;
    AttnDesc d;
    d.mode = 0; d.a0 = 0; d.r0 = 0; d.rpb = nullptr; d.sink = 0.f; d.has_sink = 0;
    if (it < 128) {
      int b = it >> 6, h = (it >> 3) & 7, r = (it & 7) * 2;
      int r0 = min(max(r - 4, 0), 8);
      int r1 = min(max(r + 1 - 4, 0), 8) + 8;
      d.qrow0 = NCTX + b * 1024 + r * 64; d.qcol = h * 64; d.ocol = h * 64;
      d.ck = p->in[I_NAK] + (size_t)b * 256 * 512 + h * 64; d.cv = p->in[I_NAV] + (size_t)b * 256 * 512 + h * 64;
      d.cstride = 512; d.nctx = 4;
      d.krow0 = NCTX + b * 1024 + r0 * 64; d.nloc = r1 - r0; d.kcol = 512 + h * 64; d.vcol = 1024 + h * 64;
      d.mode = 1; d.a0 = r; d.r0 = r0; d.rpb = p->in[I_L1 + L_X0] + h * 15 * 31;
    } else if (it < 256) {
      int v = it - 128; int b = v >> 6, h = (v >> 3) & 7, qb = v & 7;
      int t0 = qb * 128;
      int s0 = max(t0 - 128, 0);
      int s1 = min(t0 + 256, 1024);
      d.qrow0 = NCTX + b * 1024 + t0; d.qcol = 1536 + h * 64; d.ocol = 512 + h * 64;
      d.ck = p->in[I_SWK] + (size_t)b * 256 * 128 + (h >> 2) * 64; d.cv = p->in[I_SWV] + (size_t)b * 256 * 128 + (h >> 2) * 64;
      d.cstride = 128; d.nctx = 4;
      d.krow0 = NCTX + b * 1024 + s0; d.nloc = (s1 - s0) >> 6; d.kcol = 2048 + (h >> 2) * 64; d.vcol = 2176 + (h >> 2) * 64;
      d.mode = 2; d.a0 = s0 - t0;
      d.sink = sink[h]; d.has_sink = 1;
    } else if (it < 768) {
      int v = it - 256; int b = v >> 4, h = (v >> 1) & 7, qb = v & 1;
      d.qrow0 = b * 256 + qb * 128; d.qcol = h * 64; d.ocol = h * 64;
      d.ck = nullptr; d.cv = nullptr; d.cstride = 0; d.nctx = 0;
      d.krow0 = b * 256; d.nloc = 4; d.kcol = 512 + h * 64; d.vcol = 1024 + h * 64;
    } else {
      int v = it - 768; int b = v >> 4, h = (v >> 1) & 7, qb = v & 1;
      d.qrow0 = b * 256 + qb * 128; d.qcol = 1536 + h * 64; d.ocol = 512 + h * 64;
      d.ck = nullptr; d.cv = nullptr; d.cstride = 0; d.nctx = 0;
      d.krow0 = b * 256; d.nloc = 4; d.kcol = 2048 + (h >> 2) * 64; d.vcol = 2176 + (h >> 2) * 64;
      d.sink = sink[h]; d.has_sink = 1;
    }
    attn_item(p, d, sm);
  }
}

#define XB_TMO      128
#define XB_XCNT(j)  (256  + 64 * (j))
#define XB_XSUB(j)  (1280 + 64 * (j))
#define XB_XGEN(j)  (2304 + 64 * (j))
#define XB_TOP      3328
#define XB_TOPGEN   3392
#define XCD_BAR_WORDS 3456
#define XB_SPIN_CAP (1u << 22)
__device__ __forceinline__ unsigned xb_ld(unsigned* p) { return __hip_atomic_load(p, __ATOMIC_RELAXED, __HIP_MEMORY_SCOPE_AGENT); }
__device__ __forceinline__ unsigned xb_add(unsigned* p, unsigned v) { return __hip_atomic_fetch_add(p, v, __ATOMIC_RELAXED, __HIP_MEMORY_SCOPE_AGENT); }
__device__ __forceinline__ unsigned xb_xcc_id() { return (unsigned)__builtin_amdgcn_s_getreg((3 << 11) | 20) & 0xFu; }
#define XB_SPIN(cond, bar) do { unsigned _sp = 0; while (cond) { __builtin_amdgcn_s_sleep(1); \
    if ((++_sp & 255u) == 0u) { if (xb_ld(&(bar)[XB_TMO])) break; if (_sp > XB_SPIN_CAP) { atomicAdd(&(bar)[XB_TMO], 1u); break; } } } } while (0)
struct XcdBarrier { unsigned* bar; unsigned x; volatile LAS unsigned* st; };
__device__ __forceinline__ XcdBarrier xcd_barrier_post(unsigned* bar, volatile LAS unsigned* st) {
  XcdBarrier b; b.bar = bar; b.x = xb_xcc_id(); b.st = st;
  if (threadIdx.x == 0) (void)xb_add(&bar[XB_XCNT(b.x)], 1u);
  return b;
}
__device__ __forceinline__ void xcd_barrier_complete(unsigned* bar, unsigned x, unsigned& nloc, unsigned& nx) {
  const unsigned G = gridDim.x * gridDim.y * gridDim.z;
  unsigned sum, cnt, mine, sp = 0u;
  for (;;) {
    sum = 0u; cnt = 0u; mine = 0u;
#pragma unroll
    for (unsigned j = 0; j < 16; ++j) { const unsigned c = xb_ld(&bar[XB_XCNT(j)]); sum += c; cnt += (c > 0u) ? 1u : 0u; mine = (j == x) ? c : mine; }
    if (sum == G) break;
    __builtin_amdgcn_s_sleep(1);
    if ((++sp & 255u) == 0u) { if (xb_ld(&bar[XB_TMO])) break; if (sp > XB_SPIN_CAP) { atomicAdd(&bar[XB_TMO], 1u); break; } }
  }
  nloc = mine > 0u ? mine : 1u; nx = cnt > 0u ? cnt : 1u;
}
__device__ __forceinline__ void xcd_barrier(const XcdBarrier& b) {
  asm volatile("s_waitcnt vmcnt(0)" ::: "memory");
  __syncthreads();
  if (threadIdx.x == 0) {
    unsigned* bar = b.bar;
    __builtin_amdgcn_s_waitcnt(0);
    unsigned nloc = b.st[0], nx = b.st[1];
    if (nloc == 0u) { xcd_barrier_complete(bar, b.x, nloc, nx); b.st[0] = nloc; b.st[1] = nx; }
    const unsigned old = xb_add(&bar[XB_XSUB(b.x)], 1u);
    const unsigned gen = old / nloc;
    if (old + 1u == (gen + 1u) * nloc) {
      __builtin_amdgcn_fence(__ATOMIC_RELEASE, "agent");
      asm volatile("s_waitcnt vmcnt(0)" ::: "memory");
      const unsigned og = xb_add(&bar[XB_TOP], 1u);
      const unsigned tg = og / nx;
      if (og + 1u == (tg + 1u) * nx) xb_add(&bar[XB_TOPGEN], 1u);
      else XB_SPIN(xb_ld(&bar[XB_TOPGEN]) == tg, bar);
      __builtin_amdgcn_fence(__ATOMIC_ACQUIRE, "agent");
      xb_add(&bar[XB_XGEN(b.x)], 1u);
      asm volatile("s_waitcnt vmcnt(0)" ::: "memory");
    } else {
      XB_SPIN(xb_ld(&bar[XB_XGEN(b.x)]) == gen, bar);
      __builtin_amdgcn_fence(__ATOMIC_ACQUIRE, "agent");
      asm volatile("s_waitcnt vmcnt(0)" ::: "memory");
    }
  }
  __syncthreads();
}

constexpr int NPHASE = 18;
__device__ __forceinline__ void run_phase(CP p, int ph, char* smem, int* s_item, const int dry) {
  float* smf = (float*)smem;
  u16* smh = (u16*)smem;
  const u16* xn = (const u16*)(p->ws + OFF_XN);
  const u16* hp = (const u16*)(p->ws + OFF_HP);
  const u16* ymix = (const u16*)(p->ws + OFF_YMIX);
  if (ph == 0) { prep_a_phase(p, smf); return; }
  if (ph == 1) { prep_b_phase(p, smf, dry); return; }
  if (ph == 17) { final_phase(p); return; }
  const int l = (ph >= 10) ? 1 : 0;
  int q = ph - (l ? 10 : 2);
  if (l == 1 && q >= 4) q += 1;
  if (q == 0 || q == 6) {
    const int f = (q == 6) ? 1 : 0;
    gemm_phase<EPI_SWIGLU>(p, xn, (const u16*)(p->ws + OFF_WIN + (l * 2 + f) * SZ_WIN), 1024, 22, l, 0, 0.f, l * 3 + (f ? 2 : 0), smh);
    return;
  }
  if (q == 1 || q == 5 || q == 7) {
    const u16* A = (q == 5) ? ymix : hp;
    const u16* Bt = (q == 5) ? (const u16*)(p->ws + OFF_WMO + (size_t)l * D * D * 2)
                             : (const u16*)(p->ws + OFF_WOUT + (l * 2 + (q == 7 ? 1 : 0)) * SZ_WOUT);
    const int K = (q == 5) ? 1024 : DFF;
    const int gch = (q == 1) ? 2 : (q == 5 ? 5 : 8);
    const float coef = dry ? 0.f : ((q == 5) ? 1.f : 0.5f);
    const int nid_next = l * 3 + ((q == 1) ? 1 : (q == 5 ? 2 : 3));
    gemm_phase<EPI_RESID>(p, A, Bt, K, 4, l, gch, coef, dry ? 7 : nid_next, smh, (dry || l) ? 0 : (q == 1 ? 1 : (q == 7 ? 2 : 0)));
    return;
  }
  if (q == 2) {
    if (l == 0) gemm_phase<EPI_MIX0>(p, xn, (const u16*)(p->ws + OFF_WMI0), 1024, 12, l, 0, 0.f, 1, smh);
    else gemm_phase<EPI_MIX1>(p, xn, (const u16*)(p->ws + OFF_WMI1), 1024, 9, l, 0, 0.f, 4, smh);
    return;
  }
  if (q == 3) { if (l == 0) mix0_phase_a(p, smf, s_item, dry * 3); else mix1_phase(p, smf, s_item, dry * 3); return; }
  if (q == 4) { mix0_phase_b(p, smf, s_item, dry * 3); return; }
}

__global__ void __launch_bounds__(512, 2) mega(Params kp, int ph0, int ph1, int dry) {
  extern __shared__ __attribute__((aligned(16))) char smem[];
  int* s_item_p = (int*)(smem + SMEM_BYTES);
  uint4* xb_words_p = (uint4*)(smem + SMEM_BYTES + 16);
  if (threadIdx.x == 0) *xb_words_p = make_uint4(0u, 0u, 0u, 0u);
  __syncthreads();
  XcdBarrier xb = xcd_barrier_post((unsigned*)(kp.ws + OFF_BAR), (volatile LAS unsigned*)xb_words_p);
  if (ph1 < 0) cg::this_grid().sync();
  for (int ph = ph0; ph < ph1; ++ph) {
    if (ph > ph0) xcd_barrier(xb);
    CP p = (CP)__builtin_amdgcn_kernarg_segment_ptr();
    asm volatile("" : "+s"(p));
    run_phase(p, ph, smem, s_item_p, dry);
  }
}

extern "C" void kernel_launch(void* const* d_in, const int* in_sizes, int n_in, void* d_out, int out_size, void* d_ws,
                              size_t ws_size, hipStream_t stream) {
  static int grid_blocks = 0;
  if (!grid_blocks) {
    int dev = 0, cus = 0, per_cu = 0;
    hipGetDevice(&dev);
    hipDeviceGetAttribute(&cus, hipDeviceAttributeMultiprocessorCount, dev);
    hipFuncSetAttribute((const void*)mega, hipFuncAttributeMaxDynamicSharedMemorySize, DYN_LDS);
    hipOccupancyMaxActiveBlocksPerMultiprocessor(&per_cu, mega, NTH, DYN_LDS);
    if (per_cu > 1) per_cu = 1;
    if (per_cu < 1) per_cu = 1;
    grid_blocks = cus * per_cu;
  }
  if (ws_size < WS_TOTAL) fprintf(stderr, "workspace too small: %zu < %zu\n", ws_size, (size_t)WS_TOTAL);
  Params p{};
  for (int i = 0; i < 37; ++i) p.in[i] = (const float*)d_in[i];
  p.out = (float*)d_out;
  p.ws = (char*)d_ws;
  hipMemsetAsync((char*)d_ws + OFF_CTR, 0, ZERO_BYTES, stream);
#if SINGLE_LAUNCH
  int ph0 = 0, ph1 = NPHASE, dry = 0;
  void* args[] = {&p, &ph0, &ph1, &dry};
  hipError_t e = hipLaunchCooperativeKernel((void*)mega, dim3(grid_blocks), dim3(NTH), args, DYN_LDS, stream);
  if (e != hipSuccess) fprintf(stderr, "cooperative launch failed: %s (grid %d)\n", hipGetErrorString(e), grid_blocks);
#else
  for (int ph = 0; ph < NPHASE; ++ph) {
    mega<<<grid_blocks, NTH, DYN_LDS, stream>>>(p, ph, ph + 1, 0);
    const bool g1 = (ph == 2 || ph == 8 || ph == 10 || ph == 15), g2 = (ph == 3 || ph == 9 || ph == 11 || ph == 16);
    const bool mi = (ph == 4 || ph == 12), mo = (ph == 7 || ph == 14), mx = (ph == 5 || ph == 6 || ph == 13);
    if (((REP_MASK & 1) && g1) || ((REP_MASK & 2) && g2) || ((REP_MASK & 4) && (mi || mo)) || ((REP_MASK & 8) && mx) ||
        ((REP_MASK & 16) && ph == 0) || ((REP_MASK & 32) && ph == 1))
      mega<<<grid_blocks, NTH, DYN_LDS, stream>>>(p, ph, ph + 1, 1);
  }
#endif
}
```

```cpp
#include <hip/hip_runtime.h>
#include <hip/hip_cooperative_groups.h>
#include <cstdio>
namespace cg = cooperative_groups;

#ifndef REP_MASK
#define REP_MASK 0
#endif
#ifndef SINGLE_LAUNCH
#define SINGLE_LAUNCH 1
#endif

typedef unsigned short u16;
typedef __attribute__((ext_vector_type(8))) short bf16x8;
typedef __attribute__((ext_vector_type(4))) float f32x4;
typedef __attribute__((ext_vector_type(4))) unsigned u32x4;
#define LAS __attribute__((address_space(3)))

constexpr int D = 1024, NCTX = 8192, MTOK = 10240;
constexpr int DFF = 2816, NFF = 5632;
constexpr int P0N = 2848, P0P = 3072, P1N = 2304;
constexpr int PSTR = 2944;
constexpr float EPS = 1e-6f;

enum { I_XP = 0, I_XS, I_C0K, I_C0V, I_SC, I_SN, I_SM, I_NAK, I_NAV, I_SWK, I_SWV, I_C, I_CCTX, I_NF,
       I_L0 = 14, I_L1 = 26 };
enum { L_ADAW = 0, L_ADAB, L_NORM, L_F1I, L_F1O, L_F2I, L_F2O, L_MI, L_MO, L_X0, L_X1, L_X2 };

constexpr size_t O_X = 0, O_K0 = 10485760, O_V0 = 11534336, O_C = 12582912, O_N = 14680064, O_M = 14712832,
                 O_KC1 = 14713344, O_VC1 = 18907648, O_KD1 = 23101952, O_VD1 = 24150528;

constexpr size_t SZ_WIN = (size_t)NFF * D * 2;
constexpr size_t SZ_WOUT = (size_t)D * DFF * 2;
constexpr size_t OFF_WIN = 0;
constexpr size_t OFF_WOUT = OFF_WIN + 4 * SZ_WIN;
constexpr size_t OFF_WMI0 = OFF_WOUT + 4 * SZ_WOUT;
constexpr size_t OFF_WMI1 = OFF_WMI0 + (size_t)P0P * D * 2;
constexpr size_t OFF_WMO = OFF_WMI1 + (size_t)P1N * D * 2;
constexpr size_t OFF_MOD = OFF_WMO + 2 * (size_t)D * D * 2;
constexpr size_t OFF_ROPE = OFF_MOD + 2 * 3 * 9216 * 4;
constexpr size_t OFF_CTR = OFF_ROPE + 2 * 1024 * 32 * 4;
constexpr size_t OFF_BAR = OFF_CTR + 256;
constexpr size_t OFF_ROWSS = OFF_CTR + 16384;
constexpr size_t OFF_BIAS = OFF_ROWSS + (size_t)7 * MTOK * 4;
constexpr size_t ZERO_BYTES = 16384 + (size_t)7 * MTOK * 4 + (size_t)2 * 3 * 3 * NFF * 4;
constexpr size_t OFF_XN = OFF_CTR + ZERO_BYTES;
constexpr size_t OFF_YMIX = OFF_XN + (size_t)MTOK * D * 2;
constexpr size_t OFF_HP = OFF_YMIX + (size_t)MTOK * D * 2;
constexpr size_t OFF_GATES = OFF_HP + (size_t)MTOK * PSTR * 2;
constexpr size_t OFF_STC = OFF_GATES + (size_t)MTOK * 32 * 4;
constexpr size_t OFF_STN = OFF_STC + (size_t)2560 * 4096 * 4;
constexpr size_t OFF_STM = OFF_STN + (size_t)2560 * 64 * 4;
constexpr size_t WS_TOTAL = OFF_STM + 2560 * 4;

constexpr int TS = 68;
constexpr int TILE_F = 64 * TS;
constexpr int SMEM_BYTES = 8 * TILE_F * 4 + 4096;
constexpr int NTH = 512;
constexpr int DYN_LDS = SMEM_BYTES + 32;

struct Params {
  const float* in[37];
  float* out;
  char* ws;
};
typedef const __attribute__((address_space(4))) Params* CP;

__device__ __forceinline__ int get_tid() { int t = threadIdx.x; asm volatile("" : "+v"(t)); return t; }
__device__ __forceinline__ u16 f2bf(float f) {
  unsigned u = __float_as_uint(f);
  u += 0x7fffu + ((u >> 16) & 1u);
  return (u16)(u >> 16);
}
__device__ __forceinline__ unsigned pack2(float a, float b) { return (unsigned)f2bf(a) | ((unsigned)f2bf(b) << 16); }
__device__ __forceinline__ float bflo(unsigned x) { return __uint_as_float(x << 16); }
__device__ __forceinline__ float bfhi(unsigned x) { return __uint_as_float(x & 0xffff0000u); }
__device__ __forceinline__ float grp16_sum(float v) {
  v += __shfl_xor(v, 1); v += __shfl_xor(v, 2); v += __shfl_xor(v, 4); v += __shfl_xor(v, 8); return v;
}
__device__ __forceinline__ float grp16_max(float v) {
  v = fmaxf(v, __shfl_xor(v, 1)); v = fmaxf(v, __shfl_xor(v, 2)); v = fmaxf(v, __shfl_xor(v, 4)); v = fmaxf(v, __shfl_xor(v, 8)); return v;
}
__device__ __forceinline__ float wave_sum(float v) {
  for (int o = 32; o; o >>= 1) v += __shfl_xor(v, o);
  return v;
}
__device__ __forceinline__ float wave_max(float v) {
  for (int o = 32; o; o >>= 1) v = fmaxf(v, __shfl_xor(v, o));
  return v;
}
__device__ __forceinline__ float wave_scan_add(float v, int lane) {
  for (int o = 1; o < 64; o <<= 1) { float t = __shfl_up(v, o); if (lane >= o) v += t; }
  return v;
}
__device__ __forceinline__ float wave_scan_max(float v, int lane) {
  for (int o = 1; o < 64; o <<= 1) { float t = __shfl_up(v, o); if (lane >= o) v = fmaxf(v, t); }
  return v;
}
__device__ __forceinline__ int cond_of(int row) { return row < NCTX ? 0 : 1 + ((row - NCTX) >> 10); }
__device__ __forceinline__ float sigmoidf_(float x) { return 1.f / (1.f + expf(-x)); }
__device__ __forceinline__ float logsigmoidf_(float x) { return fminf(x, 0.f) - log1pf(expf(-fabsf(x))); }

__device__ void conv_tile(const float* __restrict__ W, int K, int N, u16* __restrict__ Wt, int perm, int kt, int nt, float* T, int t, bool valid,
                          const float* shp, float* biasp) {
  {
    int r = t >> 4, c4 = t & 15;
    int c = c4 * 4;
    int src;
    if (perm == 1) src = ((nt & 3) < 2 ? 0 : DFF) + (nt >> 2) * 128 + (nt & 1) * 64 + c;
    else if (perm == 2) {
      int bj = (nt & 3) >> 1, wc = (nt & 1) * 2 + (c >> 5), w = c & 31;
      src = (nt >> 2) * 256 + wc * 64 + bj * 32 + w;
    } else src = nt * 64 + c;
    bool ok = valid && (src < N);
#pragma unroll
    for (int ps = 0; ps < 4; ++ps) {
      int k = r + ps * 16;
      float4 v = make_float4(0.f, 0.f, 0.f, 0.f);
      if (ok) v = *(const float4*)(W + (size_t)(kt * 64 + k) * N + src);
      float* tt = T + k * 65 + c;
      tt[0] = v.x; tt[1] = v.y; tt[2] = v.z; tt[3] = v.w;
    }
  }
  if (biasp && t < 192) T[4224 + t] = shp[(t >> 6) * 9216 + kt * 64 + (t & 63)];
  __syncthreads();
  if (valid && biasp && t < 192) {
    int a = t >> 6, c = t & 63;
    int src;
    if (perm == 1) src = ((nt & 3) < 2 ? 0 : DFF) + (nt >> 2) * 128 + (nt & 1) * 64 + c;
    else { int bj = (nt & 3) >> 1, wc = (nt & 1) * 2 + (c >> 5), w = c & 31; src = (nt >> 2) * 256 + wc * 64 + bj * 32 + w; }
    if (src < N) {
      const float* sh = T + 4224 + a * 64;
      float acc = 0.f;
#pragma unroll 16
      for (int k = 0; k < 64; ++k) acc += sh[k] * T[k * 65 + c];
      unsafeAtomicAdd(biasp + a * NFF + src, acc);
    }
  }
  if (valid) {
    int n = t >> 2, kp = t & 3;
    unsigned o[8];
#pragma unroll
    for (int i = 0; i < 8; ++i) {
      float a = T[(kp * 16 + 2 * i) * 65 + n], b = T[(kp * 16 + 2 * i + 1) * 65 + n];
      o[i] = pack2(a, b);
    }
    uint4* dst = (uint4*)(Wt + (size_t)(nt * 64 + n) * K + kt * 64 + kp * 16);
    dst[0] = make_uint4(o[0], o[1], o[2], o[3]);
    dst[1] = make_uint4(o[4], o[5], o[6], o[7]);
  }
  __syncthreads();
}

__device__ void adaln_unit(CP p, int u, float* sm, int t, bool valid) {
  int l = u / 144, cg_ = u % 144;
  if (!valid) { l = 0; cg_ = 0; }
  const float* W = p->in[(l ? I_L1 : I_L0) + L_ADAW];
  const float* B = p->in[(l ? I_L1 : I_L0) + L_ADAB];
  float* sc = sm;
  float* red = sm + 3072;
  for (int i = t; i < 3072; i += 256) {
    int cnd = i >> 10, k = i & 1023;
    float v = (cnd == 0) ? p->in[I_CCTX][k] : p->in[I_C][(cnd - 1) * 1024 + k];
    sc[i] = v / (1.f + expf(-v));
  }
  __syncthreads();
  int kp = t >> 4, c4 = t & 15;
  float acc[3][4];
#pragma unroll
  for (int a = 0; a < 3; ++a)
#pragma unroll
    for (int e = 0; e < 4; ++e) acc[a][e] = 0.f;
  for (int kk = 0; kk < 64; ++kk) {
    int k = kp * 64 + kk;
    float4 w = *(const float4*)(W + (size_t)k * 9216 + cg_ * 64 + c4 * 4);
#pragma unroll
    for (int a = 0; a < 3; ++a) {
      float s = sc[a * 1024 + k];
      acc[a][0] += s * w.x; acc[a][1] += s * w.y; acc[a][2] += s * w.z; acc[a][3] += s * w.w;
    }
  }
#pragma unroll
  for (int a = 0; a < 3; ++a)
#pragma unroll
    for (int e = 0; e < 4; ++e) red[(kp * 3 + a) * 64 + c4 * 4 + e] = acc[a][e];
  __syncthreads();
  if (valid && t < 192) {
    int a = t >> 6, col = t & 63;
    float s = 0.f;
    for (int q = 0; q < 16; ++q) s += red[(q * 3 + a) * 64 + col];
    s += B[cg_ * 64 + col];
    float* mod = (float*)(p->ws + OFF_MOD);
    mod[(l * 3 + a) * 9216 + cg_ * 64 + col] = s;
  }
  __syncthreads();
}

__device__ __forceinline__ int conv_units_of(int l, int kind) {
  return (kind == 0 || kind == 4) ? 1408 : ((kind == 1 || kind == 5) ? 704 : (kind == 3 ? 256 : (l ? 576 : 768)));
}
__device__ __forceinline__ void conv_job(CP p, int l, int kind, int tt, float* smh, int t, bool valid) {
  const float* mod = (const float*)(p->ws + OFF_MOD);
  float* bias = (float*)(p->ws + OFF_BIAS);
  const float* W; u16* Wt; int K, N, perm, ntn, which = -1;
  const int lb = l ? I_L1 : I_L0;
  if (kind == 0 || kind == 4) {
    const int f = kind == 4;
    W = p->in[lb + (f ? L_F2I : L_F1I)]; Wt = (u16*)(p->ws + OFF_WIN + (l * 2 + f) * SZ_WIN);
    K = 1024; N = NFF; perm = 1; ntn = 88; which = f ? 2 : 0;
  } else if (kind == 1 || kind == 5) {
    const int f = kind == 5;
    W = p->in[lb + (f ? L_F2O : L_F1O)]; Wt = (u16*)(p->ws + OFF_WOUT + (l * 2 + f) * SZ_WOUT);
    K = DFF; N = 1024; perm = 0; ntn = 16;
  } else if (kind == 2) {
    W = p->in[lb + L_MI]; Wt = (u16*)(p->ws + (l ? OFF_WMI1 : OFF_WMI0));
    K = 1024; N = l ? P1N : P0N; perm = 2; ntn = l ? 36 : 48; which = 1;
  } else {
    W = p->in[lb + L_MO]; Wt = (u16*)(p->ws + OFF_WMO + (size_t)l * D * D * 2);
    K = 1024; N = 1024; perm = 0; ntn = 16;
  }
  const int nt = tt % ntn, kt = tt / ntn;
  const bool wb = which >= 0;
  conv_tile(W, K, N, Wt, perm, kt, nt, smh, t, valid, wb ? mod + (l * 3) * 9216 + (3 * which) * 1024 : nullptr,
            wb ? bias + (size_t)((l * 3 + which) * 3) * NFF : nullptr);
}

__device__ __forceinline__ void conv_side_job(CP p, int side, int nwg, float* sm) {
  const int tid = get_tid(), half = tid >> 8, t = tid & 255;
  float* smh = sm + half * 8192;
  const int first = ((int)gridDim.x >= nwg + 32) ? nwg : 0;
  const int nb = (int)gridDim.x - first;
  if ((int)blockIdx.x < first) return;
  const int U = (side == 1) ? 3136 : 5056;
  for (int ub = ((int)blockIdx.x - first) * 2; ub < U; ub += nb * 2) {
    int u = ub + half;
    const bool valid = u < U;
    if (!valid) u = 0;
    int l, kind, tt;
    if (side == 1) {
      l = 0;
      if (u < 768) { kind = 2; tt = u; } else if (u < 1024) { kind = 3; tt = u - 768; }
      else if (u < 2432) { kind = 4; tt = u - 1024; } else { kind = 5; tt = u - 2432; }
    } else {
      l = 1;
      if (u < 1408) { kind = 0; tt = u; } else if (u < 2112) { kind = 1; tt = u - 1408; }
      else if (u < 2688) { kind = 2; tt = u - 2112; } else if (u < 2944) { kind = 3; tt = u - 2688; }
      else if (u < 4352) { kind = 4; tt = u - 2944; } else { kind = 5; tt = u - 4352; }
    }
    conv_job(p, l, kind, tt, smh, t, valid);
  }
}

__device__ __forceinline__ void prep_a_phase(CP p, float* sm) {
  const int tid = get_tid(), half = tid >> 8, t = tid & 255;
  float* smh = sm + half * 8192;
  constexpr int U_CONV = 704, U_ADA = 288, U_ROPE = 64;
  for (int ub = blockIdx.x * 2; ub < U_ADA; ub += gridDim.x * 2) {
    int u = ub + half;
    adaln_unit(p, u, smh, t, u < U_ADA);
  }
  for (int ub = blockIdx.x * 2; ub < U_CONV; ub += gridDim.x * 2) {
    int u = ub + half;
    bool valid = u < U_CONV;
    if (!valid) u = 0;
    conv_job(p, 0, 1, u, smh, t, valid);
  }
  for (int u = blockIdx.x; u < U_ROPE; u += gridDim.x) {
    int e = u * 512 + tid;
    int tk = e >> 5, i = e & 31;
    float pos = (i < 16) ? (float)(tk >> 6) : (float)(tk & 63);
    float fr = powf(10000.f, -(float)(i & 15) / 16.f);
    float ang = pos * fr;
    float* rc = (float*)(p->ws + OFF_ROPE);
    rc[e] = cosf(ang);
    rc[32768 + e] = sinf(ang);
  }
}

__device__ __forceinline__ void prep_b_phase(CP p, float* sm, const int dry) {
  const int tid = get_tid(), half = tid >> 8, t = tid & 255, lane = tid & 63, w = tid >> 6;
  float* smh = sm + half * 8192;
  const float* mod = (const float*)(p->ws + OFF_MOD);
  constexpr int U_CONV = 1408;
  for (int ub = blockIdx.x * 2; ub < U_CONV; ub += gridDim.x * 2) {
    int u = ub + half;
    bool valid = u < U_CONV;
    if (!valid) u = 0;
    conv_job(p, 0, 0, u, smh, t, valid);
  }
  {
    float* x = p->out + O_X;
    u16* xn = (u16*)(p->ws + OFF_XN);
    float* rowss = (float*)(p->ws + OFF_ROWSS);
    const float4* g = (const float4*)(p->in[I_L0 + L_NORM]);
    for (int row = blockIdx.x * 8 + w; row < MTOK; row += gridDim.x * 8) {
      const float4* src = (row < NCTX) ? (const float4*)(p->in[I_XP] + (size_t)row * D) : (const float4*)(p->in[I_XS] + (size_t)(row - NCTX) * D);
      float4* xr = (float4*)(x + (size_t)row * D);
      const float4* sc = (const float4*)(mod + (size_t)cond_of(row) * 9216 + 1024);
      float ss = 0.f;
#pragma unroll
      for (int i = 0; i < 4; ++i) {
        int q = lane + i * 64;
        float4 v = src[q];
        ss += v.x * v.x + v.y * v.y + v.z * v.z + v.w * v.w;
        xr[q] = v;
        float4 gg = g[q], s2 = sc[q];
        uint2 o = make_uint2(pack2(v.x * (gg.x * (1.f + s2.x)), v.y * (gg.y * (1.f + s2.y))), pack2(v.z * (gg.z * (1.f + s2.z)), v.w * (gg.w * (1.f + s2.w))));
        *(uint2*)(xn + (size_t)row * D + q * 4) = o;
      }
      ss = wave_sum(ss);
      if (lane == 0) rowss[row] = ss;
    }
  }
}

__device__ __forceinline__ void final_phase(CP p) {
  const int tid = get_tid(), lane = tid & 63, w = tid >> 6;
  float* x = p->out + O_X;
  const float* rowss = (const float*)(p->ws + OFF_ROWSS) + 6 * MTOK;
  const float4* g = (const float4*)p->in[I_NF];
  for (int row = blockIdx.x * 8 + w; row < MTOK; row += gridDim.x * 8) {
    float4* xr = (float4*)(x + (size_t)row * D);
    const float rstd = rsqrtf(rowss[row] * (1.f / 1024.f) + EPS);
#pragma unroll
    for (int i = 0; i < 4; ++i) {
      int q = lane + i * 64;
      float4 v = xr[q], gg = g[q];
      xr[q] = make_float4(v.x * rstd * gg.x, v.y * rstd * gg.y, v.z * rstd * gg.z, v.w * rstd * gg.w);
    }
  }
}

enum { EPI_SWIGLU = 0, EPI_RESID = 1, EPI_MIX0 = 2, EPI_MIX1 = 3 };
constexpr int BM = 256, BK = 64, HALF = 128, HT = HALF * BK, NXCD = 8, WGM = 8;

__device__ __forceinline__ int lds_byte(int r, int c) {
  int st = (r >> 4) * 2 + (c >> 5), rr = r & 15, cc = c & 31, ob = rr * 64 + cc * 2;
  return st * 1024 + (ob ^ (((ob >> 9) & 1) << 5));
}
__device__ __forceinline__ void stage_rc(int b, int& R, int& C) {
  int st = b / 1024, sb = b % 1024, swz = sb ^ (((sb >> 9) & 1) << 5);
  R = (st >> 1) * 16 + swz / 64; C = (st & 1) * 32 + (swz % 64) / 2;
}

template <int EPI>
__device__ __forceinline__ void gemm256_tile(CP p, const u16* A, const u16* Bt, const int K,
                                             const int brow, const int bcol, int l, int gchunk, float coef, int nid, u16* shm, const int tid) {
#define SWZ_LANE() ([]() { unsigned ln = __builtin_amdgcn_mbcnt_hi(~0u, __builtin_amdgcn_mbcnt_lo(~0u, 0u)); asm volatile("" : "+v"(ln)); \
    unsigned ob = (ln & 15u) * 64u + (ln >> 4) * 16u; return ob ^ (((ob >> 9) & 1u) << 5); }())
#define SAI(b, h) ((b) * 2 + (h))
#define SBI(b, h) (4 + (b) * 2 + (h))
#define STAGE(PI, BASE, br, kt) do { \
    const char* _gb = (const char*)(BASE) + ((long)(br) * K + (long)(kt) * BK) * 2; \
    char* _lp = (char*)shm + (PI) * (HT * 2) + wave_lds; \
    __builtin_amdgcn_global_load_lds((const unsigned*)(_gb + voff0), (LAS unsigned*)(_lp), 16, 0, 0); \
    __builtin_amdgcn_global_load_lds((const unsigned*)(_gb + (long)K * 128 + voff0), (LAS unsigned*)(_lp + 8192), 16, 0, 0); } while (0)
#define LDA(dst, PI) do { unsigned _o = SWZ_LANE() + a_uni; asm volatile("" : "+v"(_o)); _o &= 0x23F0u; \
    _Pragma("unroll") for (int m = 0; m < 4; ++m) _Pragma("unroll") for (int k = 0; k < 2; ++k) \
      dst[m][k] = *reinterpret_cast<const bf16x8*>((const char*)shm + (PI) * (HT * 2) + m * 2048 + k * 1024 + _o); } while (0)
#define LDB(dst, PI) do { unsigned _o = SWZ_LANE() + b_uni; asm volatile("" : "+v"(_o)); _o &= 0x33F0u; \
    _Pragma("unroll") for (int n = 0; n < 2; ++n) _Pragma("unroll") for (int k = 0; k < 2; ++k) \
      dst[n][k] = *reinterpret_cast<const bf16x8*>((const char*)shm + (PI) * (HT * 2) + n * 2048 + k * 1024 + _o); } while (0)
#define MMA(ai, bj, At_, Bt_) do { __builtin_amdgcn_s_setprio(1); \
    _Pragma("unroll") for (int m = 0; m < 4; ++m) _Pragma("unroll") for (int n = 0; n < 2; ++n) _Pragma("unroll") for (int k = 0; k < 2; ++k) \
      acc[ai][bj][m][n] = __builtin_amdgcn_mfma_f32_16x16x32_bf16(At_[m][k], Bt_[n][k], acc[ai][bj][m][n], 0, 0, 0); \
    __builtin_amdgcn_s_setprio(0); } while (0)
#define WAIT_V(n) asm volatile("s_waitcnt vmcnt(" #n ")" ::: "memory")
#define WAIT_L(n) asm volatile("s_waitcnt lgkmcnt(" #n ")" ::: "memory")
#define BAR __builtin_amdgcn_s_barrier()
#define SCHED __builtin_amdgcn_sched_barrier(0)
  const int wid = __builtin_amdgcn_readfirstlane(tid >> 6), lane = tid & 63, wr = wid >> 2, wc = wid & 3, fr = lane & 15, fq = lane >> 4;
  const int wave_lds = (wid & 7) * 1024;
  unsigned voff0;
  { int r_, c_; stage_rc(tid * 16, r_, c_); voff0 = (unsigned)(r_ * K + c_) * 2u; }
  const unsigned a_uni = (unsigned)(wr * 8192), b_uni = (unsigned)(wc * 4096);
  f32x4 acc[2][2][4][2];
#pragma unroll
  for (int a = 0; a < 2; ++a)
#pragma unroll
    for (int b = 0; b < 2; ++b)
#pragma unroll
      for (int m = 0; m < 4; ++m)
#pragma unroll
        for (int n = 0; n < 2; ++n) acc[a][b][m][n] = (f32x4){0.f, 0.f, 0.f, 0.f};
  bf16x8 At[4][2], B0[2][2], B1[2][2];
  const int nt = K / BK;
  WAIT_V(0);
  __syncthreads();
  STAGE(SBI(0, 0), Bt, bcol, 0); STAGE(SAI(0, 0), A, brow, 0);
  STAGE(SBI(0, 1), Bt, bcol + HALF, 0); STAGE(SAI(0, 1), A, brow + HALF, 0);
  if (wr == 1) BAR;
  WAIT_V(4); BAR;
  STAGE(SBI(1, 0), Bt, bcol, 1); STAGE(SAI(1, 0), A, brow, 1); STAGE(SBI(1, 1), Bt, bcol + HALF, 1);
  WAIT_V(6); BAR;
  for (int t = 0; t < nt - 2; t += 2) {
    LDB(B0, SBI(0, 0)); SCHED; LDA(At, SAI(0, 0)); STAGE(SAI(1, 1), A, brow + HALF, t + 1);
    WAIT_L(8); BAR; WAIT_L(0); MMA(0, 0, At, B0); BAR; SCHED;
    LDB(B1, SBI(0, 1)); STAGE(SBI(0, 0), Bt, bcol, t + 2);
    BAR; WAIT_L(0); MMA(0, 1, At, B1); BAR;
    LDA(At, SAI(0, 1)); STAGE(SAI(0, 0), A, brow, t + 2);
    BAR; WAIT_L(0); MMA(1, 0, At, B0); BAR; SCHED;
    STAGE(SBI(0, 1), Bt, bcol + HALF, t + 2);
    WAIT_V(6); BAR; MMA(1, 1, At, B1); BAR;
    LDB(B0, SBI(1, 0)); SCHED; LDA(At, SAI(1, 0)); STAGE(SAI(0, 1), A, brow + HALF, t + 2);
    WAIT_L(8); BAR; WAIT_L(0); MMA(0, 0, At, B0); BAR; SCHED;
    LDB(B1, SBI(1, 1)); STAGE(SBI(1, 0), Bt, bcol, t + 3);
    BAR; WAIT_L(0); MMA(0, 1, At, B1); BAR;
    LDA(At, SAI(1, 1)); STAGE(SAI(1, 0), A, brow, t + 3);
    BAR; WAIT_L(0); MMA(1, 0, At, B0); BAR; SCHED;
    STAGE(SBI(1, 1), Bt, bcol + HALF, t + 3);
    WAIT_V(6); BAR; MMA(1, 1, At, B1); BAR;
  }
  { LDB(B0, SBI(0, 0)); LDA(At, SAI(0, 0)); STAGE(SAI(1, 1), A, brow + HALF, nt - 1);
    BAR; WAIT_L(0); MMA(0, 0, At, B0); BAR;
    LDB(B1, SBI(0, 1)); BAR; WAIT_L(0); MMA(0, 1, At, B1); BAR;
    LDA(At, SAI(0, 1)); WAIT_V(4); BAR; WAIT_L(0); MMA(1, 0, At, B0); MMA(1, 1, At, B1); BAR; }
  { LDB(B0, SBI(1, 0)); LDA(At, SAI(1, 0)); WAIT_V(2); BAR; WAIT_L(0); MMA(0, 0, At, B0); BAR;
    LDB(B1, SBI(1, 1)); WAIT_V(0); BAR; WAIT_L(0); MMA(0, 1, At, B1); BAR;
    LDA(At, SAI(1, 1)); BAR; WAIT_L(0); MMA(1, 0, At, B0); MMA(1, 1, At, B1); BAR; }
  if (wr == 0) BAR;
#undef SAI
#undef SWZ_LANE
#undef SBI
#undef STAGE
#undef LDA
#undef LDB
#undef MMA
#undef WAIT_V
#undef WAIT_L
#undef BAR
#undef SCHED
  if (EPI == EPI_SWIGLU) {
    u16* H = (u16*)(p->ws + OFF_HP);
    const int hcl = wc * 32 + fr;
    const int hc0 = (bcol >> 1) + hcl;
    const float* rowss = (const float*)(p->ws + OFF_ROWSS) + (size_t)nid * MTOK;
    const float* bias = (const float*)(p->ws + OFF_BIAS) + (size_t)(nid * 3 + cond_of(brow)) * NFF;
    float bg[2], bu[2];
#pragma unroll
    for (int n = 0; n < 2; ++n) { bg[n] = bias[hc0 + n * 16]; bu[n] = bias[DFF + hc0 + n * 16]; }
    u16* Hs = shm;
#pragma unroll
    for (int ai = 0; ai < 2; ++ai)
#pragma unroll
      for (int m = 0; m < 4; ++m)
#pragma unroll
        for (int j = 0; j < 4; ++j) {
          const int rl = ai * 128 + wr * 64 + m * 16 + fq * 4 + j;
          const float rstd = rsqrtf(rowss[brow + rl] * (1.f / 1024.f) + EPS);
#pragma unroll
          for (int n = 0; n < 2; ++n) {
            float g = acc[ai][0][m][n][j] * rstd + bg[n], u = acc[ai][1][m][n][j] * rstd + bu[n];
            float h = g / (1.f + __expf(-g)) * u;
            Hs[rl * 136 + hcl + n * 16] = f2bf(h);
          }
        }
    __syncthreads();
#pragma unroll
    for (int i = 0; i < 8; ++i) {
      const int q = tid + 512 * i, r = q >> 4, c = q & 15;
      const u32x4 v = *(const u32x4*)(Hs + r * 136 + c * 8);
      *(u32x4*)(H + (size_t)(brow + r) * DFF + (bcol >> 1) + c * 8) = v;
    }
  } else if (EPI == EPI_RESID) {
    float* x = p->out + O_X;
    const float* mod = (const float*)(p->ws + OFF_MOD);
    u16* xn = (u16*)(p->ws + OFF_XN);
    float* rowss = (float*)(p->ws + OFF_ROWSS) + (size_t)nid * MTOK;
    const int cnd = cond_of(brow);
    const bool has_next = nid < 6;
    const int ln = (nid % 6) / 3, wn = nid % 3;
    const int col4 = bcol + lane * 4;
    float4 gt4 = *(const float4*)(mod + (l * 3 + cnd) * 9216 + gchunk * 1024 + col4);
    gt4.x *= coef; gt4.y *= coef; gt4.z *= coef; gt4.w *= coef;
    float4 gs4 = make_float4(0.f, 0.f, 0.f, 0.f);
    if (has_next) {
      const float4 ng = *(const float4*)(p->in[(ln ? I_L1 : I_L0) + L_NORM] + wn * 1024 + col4);
      const float4 sc = *(const float4*)(mod + (ln * 3 + cnd) * 9216 + (3 * wn + 1) * 1024 + col4);
      gs4 = make_float4(ng.x * (1.f + sc.x), ng.y * (1.f + sc.y), ng.z * (1.f + sc.z), ng.w * (1.f + sc.w));
    }
    float* Cs = (float*)shm;
    float4 xv0[16], xv1[16];
#pragma unroll
    for (int i = 0; i < 16; ++i) xv0[i] = *(const float4*)(x + (size_t)(brow + wid + 8 * i) * D + col4);
#pragma unroll
    for (int bj = 0; bj < 2; ++bj)
#pragma unroll
      for (int m = 0; m < 4; ++m)
#pragma unroll
        for (int n = 0; n < 2; ++n)
#pragma unroll
          for (int j = 0; j < 4; ++j)
            Cs[(wr * 64 + m * 16 + fq * 4 + j) * 260 + bj * 128 + wc * 32 + n * 16 + fr] = acc[0][bj][m][n][j];
    __syncthreads();
#pragma unroll
    for (int ai = 0; ai < 2; ++ai) {
      if (ai) {
#pragma unroll
        for (int i = 0; i < 16; ++i) xv1[i] = *(const float4*)(x + (size_t)(brow + 128 + wid + 8 * i) * D + col4);
        __syncthreads();
#pragma unroll
        for (int bj = 0; bj < 2; ++bj)
#pragma unroll
          for (int m = 0; m < 4; ++m)
#pragma unroll
            for (int n = 0; n < 2; ++n)
#pragma unroll
              for (int j = 0; j < 4; ++j)
                Cs[(wr * 64 + m * 16 + fq * 4 + j) * 260 + bj * 128 + wc * 32 + n * 16 + fr] = acc[1][bj][m][n][j];
        __syncthreads();
      }
#pragma unroll
      for (int i = 0; i < 16; ++i) {
        const int r = wid + 8 * i;
        const int row = brow + ai * 128 + r;
        const float4 a = *(const float4*)(Cs + r * 260 + lane * 4);
        float4 xv = ai ? xv1[i] : xv0[i];
        xv.x += gt4.x * a.x; xv.y += gt4.y * a.y; xv.z += gt4.z * a.z; xv.w += gt4.w * a.w;
        *(float4*)(x + (size_t)row * D + col4) = xv;
        float ss = xv.x * xv.x + xv.y * xv.y + xv.z * xv.z + xv.w * xv.w;
        if (has_next) *(uint2*)(xn + (size_t)row * D + col4) = make_uint2(pack2(xv.x * gs4.x, xv.y * gs4.y), pack2(xv.z * gs4.z, xv.w * gs4.w));
        ss = wave_sum(ss);
        if (lane == 0 && nid < 7) unsafeAtomicAdd(rowss + row, ss);
      }
    }
  } else {
    u16* proj = (u16*)(p->ws + OFF_HP);
    u16* Pst = shm;
    const bool isctx = brow < NCTX;
    const int c0 = bcol + wc * 64;
    const float* rc = (const float*)(p->ws + OFF_ROPE);
    const float* rowss = (const float*)(p->ws + OFF_ROWSS) + (size_t)nid * MTOK;
    const float* bias = (const float*)(p->ws + OFF_BIAS) + (size_t)(nid * 3 + cond_of(brow)) * NFF;
    float bz[2][2];
#pragma unroll
    for (int bj = 0; bj < 2; ++bj)
#pragma unroll
      for (int n = 0; n < 2; ++n) { int col = c0 + bj * 32 + n * 16 + fr; bz[bj][n] = (col < ((EPI == EPI_MIX0) ? P0N : P1N)) ? bias[col] : 0.f; }
    bool do_norm = false, do_rope = false;
    const float* ng = nullptr;
    float* o32 = nullptr; int ostr = 0;
    bool elementwise = false;
    if (EPI == EPI_MIX0) {
      if (c0 < 512) { do_norm = true; ng = p->in[I_L0 + L_X0]; do_rope = !isctx; }
      else if (c0 < 640) { do_norm = true; ng = p->in[I_L0 + L_X0] + 64; do_rope = !isctx; if (isctx) { o32 = p->out + O_K0 + (c0 - 512); ostr = 128; } }
      else if (c0 < 768) { if (isctx) { o32 = p->out + O_V0 + (c0 - 640); ostr = 128; } }
      else if (c0 >= 2304) elementwise = true;
    } else {
      if (c0 < 512) {}
      else if (c0 < 1024) { if (isctx) { o32 = p->out + O_KC1 + (c0 - 512); ostr = 512; } }
      else if (c0 < 1536) { if (isctx) { o32 = p->out + O_VC1 + (c0 - 1024); ostr = 512; } }
      else if (c0 < 2048) { do_rope = !isctx; }
      else if (c0 < 2176) { do_rope = !isctx; if (isctx) { o32 = p->out + O_KD1 + (c0 - 2048); ostr = 128; } }
      else { if (isctx) { o32 = p->out + O_VD1 + (c0 - 2176); ostr = 128; } }
    }
    if (elementwise) {
      float* gates = (float*)(p->ws + OFF_GATES);
      const float* gb = p->in[I_L0 + L_X1];
#pragma unroll
      for (int ai = 0; ai < 2; ++ai)
#pragma unroll
        for (int m = 0; m < 4; ++m)
#pragma unroll
          for (int j = 0; j < 4; ++j) {
            int row = brow + ai * 128 + wr * 64 + m * 16 + fq * 4 + j;
            const float rstd = rsqrtf(rowss[row] * (1.f / 1024.f) + EPS);
#pragma unroll
            for (int bj = 0; bj < 2; ++bj)
#pragma unroll
              for (int n = 0; n < 2; ++n) {
                int col = c0 + bj * 32 + n * 16 + fr;
                float v = acc[ai][bj][m][n][j] * rstd + bz[bj][n];
                if (col < 2336) gates[(size_t)row * 32 + (col - 2304)] = v + gb[col - 2304];
                else if (col < P0N) Pst[(row - brow) * 264 + (col - bcol)] = f2bf(v);
              }
          }
    } else {
#pragma unroll
      for (int ai = 0; ai < 2; ++ai)
#pragma unroll
        for (int m = 0; m < 4; ++m)
#pragma unroll
          for (int j = 0; j < 4; ++j) {
            int row = brow + ai * 128 + wr * 64 + m * 16 + fq * 4 + j;
            const float rstd0 = rsqrtf(rowss[row] * (1.f / 1024.f) + EPS);
            float v0 = acc[ai][0][m][0][j] * rstd0 + bz[0][0], v1 = acc[ai][0][m][1][j] * rstd0 + bz[0][1];
            float v2 = acc[ai][1][m][0][j] * rstd0 + bz[1][0], v3 = acc[ai][1][m][1][j] * rstd0 + bz[1][1];
            if (do_norm) {
              float ss = v0 * v0 + v1 * v1 + v2 * v2 + v3 * v3;
              ss = grp16_sum(ss);
              float rstd = rsqrtf(ss * (1.f / 64.f) + EPS);
              v0 = v0 * rstd * ng[fr]; v1 = v1 * rstd * ng[16 + fr]; v2 = v2 * rstd * ng[32 + fr]; v3 = v3 * rstd * ng[48 + fr];
            }
            if (do_rope) {
              int tk = (row - NCTX) & 1023;
              float ca = rc[tk * 32 + fr], sa = rc[32768 + tk * 32 + fr];
              float cb = rc[tk * 32 + 16 + fr], sb = rc[32768 + tk * 32 + 16 + fr];
              float a0 = v0 * ca - v2 * sa, a2 = v2 * ca + v0 * sa;
              float a1 = v1 * cb - v3 * sb, a3 = v3 * cb + v1 * sb;
              v0 = a0; v1 = a1; v2 = a2; v3 = a3;
            }
            u16* pr = Pst + (row - brow) * 264 + (c0 - bcol) + fr;
            pr[0] = f2bf(v0); pr[16] = f2bf(v1); pr[32] = f2bf(v2); pr[48] = f2bf(v3);
            if (o32) {
              float* o = o32 + (size_t)row * ostr + fr;
              o[0] = v0; o[16] = v1; o[32] = v2; o[48] = v3;
            }
          }
    }
    __syncthreads();
#pragma unroll 1
    for (int i = 0; i < 16; ++i) {
      const int q = tid + 512 * i, r = q >> 5, c = q & 31;
      const int col = bcol + c * 8;
      if (col < PSTR) *(u32x4*)(proj + (size_t)(brow + r) * PSTR + col) = *(const u32x4*)(Pst + r * 264 + c * 8);
    }
  }
}

template <int EPI>
__device__ __forceinline__ void gemm_phase(CP p, const u16* A, const u16* Bt, int K, int nN, int l, int gchunk, float coef, int nid, u16* smem, int side = 0) {
  const int tid = get_tid();
  const int nM = MTOK / BM, nwg = nM * nN;
  for (int t = blockIdx.x; t < nwg; t += gridDim.x) {
    int wgid = t;
    { int q = nwg / NXCD, r = nwg % NXCD, xcd = wgid % NXCD, off = wgid / NXCD;
      wgid = (xcd < r ? xcd * (q + 1) : r * (q + 1) + (xcd - r) * q) + off; }
    int nig = WGM * nN, gid = wgid / nig, fm = gid * WGM, gsz = min(nM - fm, WGM);
    int pm = fm + ((wgid % nig) % gsz), pn = (wgid % nig) / gsz;
    gemm256_tile<EPI>(p, A, Bt, K, pm * BM, pn * BM, l, gchunk, coef, nid, smem, tid);
  }
  if (EPI == EPI_RESID && side) { __syncthreads(); conv_side_job(p, side, nwg, (float*)smem); }
}

__device__ __forceinline__ void load_tile_bf16(float* dst, const u16* src, long rstride, float scale, int tid) {
  int r = tid >> 2, part = tid & 3;
  const uint4* s = (const uint4*)(src + (long)r * rstride + part * 16);
  uint4 a = s[0], b = s[1];
  float4* d = (float4*)(dst + r * TS + part * 16);
  d[0] = make_float4(bflo(a.x) * scale, bfhi(a.x) * scale, bflo(a.y) * scale, bfhi(a.y) * scale);
  d[1] = make_float4(bflo(a.z) * scale, bfhi(a.z) * scale, bflo(a.w) * scale, bfhi(a.w) * scale);
  d[2] = make_float4(bflo(b.x) * scale, bfhi(b.x) * scale, bflo(b.y) * scale, bfhi(b.y) * scale);
  d[3] = make_float4(bflo(b.z) * scale, bfhi(b.z) * scale, bflo(b.w) * scale, bfhi(b.w) * scale);
}
__device__ __forceinline__ void tile_ld_regs(const u16* src, long rstride, int tid, uint4& a, uint4& b) {
  int r = tid >> 2, part = tid & 3;
  const uint4* s = (const uint4*)(src + (long)r * rstride + part * 16);
  a = s[0]; b = s[1];
}
__device__ __forceinline__ void tile_st_regs(float* dst, int tid, const uint4& a, const uint4& b, float scale) {
  int r = tid >> 2, part = tid & 3;
  float4* d = (float4*)(dst + r * TS + part * 16);
  d[0] = make_float4(bflo(a.x) * scale, bfhi(a.x) * scale, bflo(a.y) * scale, bfhi(a.y) * scale);
  d[1] = make_float4(bflo(a.z) * scale, bfhi(a.z) * scale, bflo(a.w) * scale, bfhi(a.w) * scale);
  d[2] = make_float4(bflo(b.x) * scale, bfhi(b.x) * scale, bflo(b.y) * scale, bfhi(b.y) * scale);
  d[3] = make_float4(bflo(b.z) * scale, bfhi(b.z) * scale, bflo(b.w) * scale, bfhi(b.w) * scale);
}
__device__ __forceinline__ void load_tile_f32(float* dst, const float* src, long rstride, int tid) {
  int r = tid >> 2, part = tid & 3;
  const float4* s = (const float4*)(src + (long)r * rstride + part * 16);
  float4* d = (float4*)(dst + r * TS + part * 16);
  d[0] = s[0]; d[1] = s[1]; d[2] = s[2]; d[3] = s[3];
}
typedef __attribute__((ext_vector_type(2))) float f32x2;
__device__ __forceinline__ void qk_micro(const float* Qs, const float* Ks, int ty, int tx, float s[4][4]) {
  f32x2 s2[4][4];
#pragma unroll
  for (int i = 0; i < 4; ++i)
#pragma unroll
    for (int j = 0; j < 4; ++j) s2[i][j] = (f32x2){0.f, 0.f};
#pragma unroll 2
  for (int d4 = 0; d4 < 16; ++d4) {
    f32x4 q[4], k[4];
#pragma unroll
    for (int i = 0; i < 4; ++i) q[i] = *(const f32x4*)(Qs + (ty * 4 + i) * TS + d4 * 4);
#pragma unroll
    for (int j = 0; j < 4; ++j) k[j] = *(const f32x4*)(Ks + (tx + 16 * j) * TS + d4 * 4);
#pragma unroll
    for (int i = 0; i < 4; ++i)
#pragma unroll
      for (int j = 0; j < 4; ++j) {
        s2[i][j] += q[i].xy * k[j].xy;
        s2[i][j] += q[i].zw * k[j].zw;
      }
  }
#pragma unroll
  for (int i = 0; i < 4; ++i)
#pragma unroll
    for (int j = 0; j < 4; ++j) s[i][j] = s2[i][j].x + s2[i][j].y;
}
__device__ __forceinline__ void pv_micro(const float* Ps, const float* Vs, int ty, int tx, float o[4][4]) {
  f32x2 oa[4], ob[4];
#pragma unroll
  for (int i = 0; i < 4; ++i) { oa[i] = (f32x2){o[i][0], o[i][1]}; ob[i] = (f32x2){o[i][2], o[i][3]}; }
#pragma unroll 2
  for (int s4 = 0; s4 < 16; ++s4) {
    f32x4 pp[4], v[4];
#pragma unroll
    for (int i = 0; i < 4; ++i) pp[i] = *(const f32x4*)(Ps + (ty * 4 + i) * TS + s4 * 4);
#pragma unroll
    for (int q = 0; q < 4; ++q) v[q] = *(const f32x4*)(Vs + (s4 * 4 + q) * TS + tx * 4);
#pragma unroll
    for (int i = 0; i < 4; ++i)
#pragma unroll
      for (int q = 0; q < 4; ++q) {
        const float ps = pp[i][q];
        const f32x2 p2 = (f32x2){ps, ps};
        oa[i] += p2 * v[q].xy;
        ob[i] += p2 * v[q].zw;
      }
  }
#pragma unroll
  for (int i = 0; i < 4; ++i) { o[i][0] = oa[i].x; o[i][1] = oa[i].y; o[i][2] = ob[i].x; o[i][3] = ob[i].y; }
}

struct AttnDesc {
  int qrow0, qcol, ocol;
  const float* ck; const float* cv; int cstride; int nctx;
  int krow0, nloc, kcol, vcol;
  int mode;
  int a0;
  int r0;
  const float* rpb;
  float sink; int has_sink;
};

constexpr int AS_ = 72;
__device__ __forceinline__ void attn_item(CP p, const AttnDesc& d, float* sm) {
  const int tid = get_tid(), w = tid >> 6, lane = tid & 63, fr = lane & 15, fq = lane >> 4, half = w >> 2;
  const u16* proj = (const u16*)(p->ws + OFF_HP);
  u16* Ks = (u16*)sm;
  u16* Vt = Ks + 64 * AS_;
  u16* Ps = Vt + 64 * AS_ + w * (16 * AS_);
  bf16x8 qf[2];
  {
    const u16* qp = proj + (size_t)(d.qrow0 + w * 16 + fr) * PSTR + d.qcol + fq * 8;
    qf[0] = *(const bf16x8*)(qp);
    qf[1] = *(const bf16x8*)(qp + 32);
  }
  float m_i[4], l_i[4];
  f32x4 o[4];
#pragma unroll
  for (int j = 0; j < 4; ++j) {
    m_i[j] = d.has_sink ? d.sink : -1e30f;
    l_i[j] = (d.has_sink && fr == 0) ? 1.f : 0.f;
  }
#pragma unroll
  for (int n = 0; n < 4; ++n) o[n] = (f32x4){0.f, 0.f, 0.f, 0.f};
  const int ntiles = d.nctx + d.nloc;
  const int lrow = tid >> 3, lc8 = tid & 7;
  float4 kf0, kf1, vf0, vf1;
  u32x4 kq, vq;
  auto issue = [&](int tile) {
    if (tile < d.nctx) {
      const size_t off = (size_t)(tile * 64 + lrow) * d.cstride + lc8 * 8;
      kf0 = *(const float4*)(d.ck + off); kf1 = *(const float4*)(d.ck + off + 4);
      vf0 = *(const float4*)(d.cv + off); vf1 = *(const float4*)(d.cv + off + 4);
    } else {
      const u16* base = proj + (size_t)(d.krow0 + (tile - d.nctx) * 64 + lrow) * PSTR + lc8 * 8;
      kq = *(const u32x4*)(base + d.kcol);
      vq = *(const u32x4*)(base + d.vcol);
    }
  };
  issue(0);
  for (int tile = 0; tile < ntiles; ++tile) {
    __syncthreads();
    if (tile < d.nctx) {
      kq = (u32x4){pack2(kf0.x, kf0.y), pack2(kf0.z, kf0.w), pack2(kf1.x, kf1.y), pack2(kf1.z, kf1.w)};
      vq = (u32x4){pack2(vf0.x, vf0.y), pack2(vf0.z, vf0.w), pack2(vf1.x, vf1.y), pack2(vf1.z, vf1.w)};
    }
    *(u32x4*)(Ks + lrow * AS_ + lc8 * 8) = kq;
    {
      u16* vt = Vt + (lc8 * 8) * AS_ + lrow;
      vt[0 * AS_] = (u16)(vq.x & 0xffff); vt[1 * AS_] = (u16)(vq.x >> 16);
      vt[2 * AS_] = (u16)(vq.y & 0xffff); vt[3 * AS_] = (u16)(vq.y >> 16);
      vt[4 * AS_] = (u16)(vq.z & 0xffff); vt[5 * AS_] = (u16)(vq.z >> 16);
      vt[6 * AS_] = (u16)(vq.w & 0xffff); vt[7 * AS_] = (u16)(vq.w >> 16);
    }
    __syncthreads();
    if (tile + 1 < ntiles) issue(tile + 1);
    const int lt = tile - d.nctx;
    f32x4 sacc[4];
#pragma unroll
    for (int n = 0; n < 4; ++n) sacc[n] = (f32x4){0.f, 0.f, 0.f, 0.f};
#pragma unroll
    for (int ks = 0; ks < 2; ++ks)
#pragma unroll
      for (int n = 0; n < 4; ++n) {
        bf16x8 kb = *(const bf16x8*)(Ks + (n * 16 + fr) * AS_ + ks * 32 + fq * 8);
        sacc[n] = __builtin_amdgcn_mfma_f32_16x16x32_bf16(qf[ks], kb, sacc[n], 0, 0, 0);
      }
    float sv[4][4];
#pragma unroll
    for (int n = 0; n < 4; ++n)
#pragma unroll
      for (int j = 0; j < 4; ++j) sv[j][n] = sacc[n][j] * 0.125f;
    if (lt >= 0 && d.mode == 1) {
      const int rq = d.a0 + half;
      const int kr = d.r0 + lt;
      const int rq0 = min(max(rq - 4, 0), 8);
      const bool rowok = (kr >= rq0) && (kr < rq0 + 8);
      const int dy = min(max(kr - rq + 7, 0), 14);
      const float* rp = d.rpb + dy * 31;
#pragma unroll
      for (int j = 0; j < 4; ++j) {
        int qc = (w & 3) * 16 + fq * 4 + j;
        int ws = min(max(qc - 8, 0), 48);
#pragma unroll
        for (int n = 0; n < 4; ++n) {
          int kc = n * 16 + fr;
          bool ok = rowok && (kc >= ws) && (kc < ws + 16);
          int dx = min(max(kc - qc + 15, 0), 30);
          sv[j][n] = ok ? sv[j][n] + rp[dx] : -1e30f;
        }
      }
    } else if (lt >= 0 && d.mode == 2) {
      const int off = d.a0 + lt * 64 - half * 64;
#pragma unroll
      for (int j = 0; j < 4; ++j)
#pragma unroll
        for (int n = 0; n < 4; ++n) {
          int dd = off + (n * 16 + fr) - ((w & 3) * 16 + fq * 4 + j);
          bool ok = (dd <= 128) && (dd >= -128);
          sv[j][n] = ok ? sv[j][n] : -1e30f;
        }
    }
#pragma unroll
    for (int j = 0; j < 4; ++j) {
      float mx = fmaxf(fmaxf(sv[j][0], sv[j][1]), fmaxf(sv[j][2], sv[j][3]));
      mx = grp16_max(mx);
      float mn = fmaxf(m_i[j], mx);
      float alpha = __expf(m_i[j] - mn);
      float rs = 0.f;
#pragma unroll
      for (int n = 0; n < 4; ++n) {
        float pj = __expf(sv[j][n] - mn);
        rs += pj;
        Ps[(fq * 4 + j) * AS_ + n * 16 + fr] = f2bf(pj);
      }
      l_i[j] = l_i[j] * alpha + rs;
      m_i[j] = mn;
#pragma unroll
      for (int n = 0; n < 4; ++n) o[n][j] *= alpha;
    }
    __builtin_amdgcn_wave_barrier();
#pragma unroll
    for (int ks = 0; ks < 2; ++ks) {
      bf16x8 pa = *(const bf16x8*)(Ps + fr * AS_ + ks * 32 + fq * 8);
#pragma unroll
      for (int n = 0; n < 4; ++n) {
        bf16x8 vb = *(const bf16x8*)(Vt + (n * 16 + fr) * AS_ + ks * 32 + fq * 8);
        o[n] = __builtin_amdgcn_mfma_f32_16x16x32_bf16(pa, vb, o[n], 0, 0, 0);
      }
    }
    __builtin_amdgcn_wave_barrier();
  }
  u16* ymix = (u16*)(p->ws + OFF_YMIX);
#pragma unroll
  for (int j = 0; j < 4; ++j) {
    float inv = 1.f / grp16_sum(l_i[j]);
    u16* yp = ymix + (size_t)(d.qrow0 + w * 16 + fq * 4 + j) * D + d.ocol + fr;
#pragma unroll
    for (int n = 0; n < 4; ++n) yp[n * 16] = f2bf(o[n][j] * inv);
  }
}

__device__ __forceinline__ int st_slot(int isctx, int b, int dir, int head, int cc) {
  int ch = (b * 2 + dir) * 8 + head;
  return isctx ? (ch * 4 + cc) : (2048 + ch * 16 + cc);
}

__device__ __forceinline__ void mlstm_state_item(CP p, int isctx, int b, int head, float* sm) {
  const int tid = get_tid(), dir = tid >> 8, t = tid & 255, ty = t >> 4, tx = t & 15, lane = t & 63;
  const u16* proj = (const u16*)(p->ws + OFF_HP);
  const float* gates = (const float*)(p->ws + OFF_GATES);
  float* stC = (float*)(p->ws + OFF_STC);
  float* stn = (float*)(p->ws + OFF_STN);
  float* stm = (float*)(p->ws + OFF_STM);
  float* Ks = sm + (dir * 2) * TILE_F; float* Vs = sm + (dir * 2 + 1) * TILE_F;
  float* sws = sm + 8 * TILE_F + dir * 256;
  float* sn = sws + 64;
  float* ssc = sn + 64;
  const int nc = isctx ? 4 : 16, L = isctx ? 256 : 1024;
  const int seq0 = isctx ? b * 256 : NCTX + b * 1024;
  float c[4][4];
  float m;
  __syncthreads();
  if (isctx) {
#pragma unroll
    for (int i = 0; i < 4; ++i)
#pragma unroll
      for (int j = 0; j < 4; ++j) c[i][j] = 0.f;
    if (t < 64) sn[t] = 0.f;
    m = 0.f;
  } else {
    int ch = (b * 2 + dir) * 8 + head;
    const float* C0 = p->in[I_SC] + (size_t)ch * 4096;
#pragma unroll
    for (int i = 0; i < 4; ++i) {
      float4 v = *(const float4*)(C0 + (ty * 4 + i) * 64 + tx * 4);
      c[i][0] = v.x; c[i][1] = v.y; c[i][2] = v.z; c[i][3] = v.w;
    }
    if (t < 64) sn[t] = p->in[I_SN][ch * 64 + t];
    m = p->in[I_SM][ch];
  }
  uint4 ka, kb, va, vb;
  float g_li = 0.f, g_fp = 0.f;
  auto prefetch = [&](int cc) {
    const int tok0 = dir ? (L - 1 - cc * 64) : cc * 64;
    const long rs = dir ? -(long)PSTR : (long)PSTR;
    const u16* base = proj + (size_t)(seq0 + tok0) * PSTR;
    tile_ld_regs(base + 1280 + head * 64, rs, t, ka, kb);
    tile_ld_regs(base + 1792 + head * 64, rs, t, va, vb);
    if (t < 64) {
      int tr = seq0 + (dir ? tok0 - lane : tok0 + lane);
      g_li = gates[(size_t)tr * 32 + (dir * 2) * 8 + head];
      g_fp = gates[(size_t)tr * 32 + (dir * 2 + 1) * 8 + head];
    }
  };
  prefetch(0);
  for (int cc = 0; cc < nc; ++cc) {
    __syncthreads();
    const int slot = st_slot(isctx, b, dir, head, cc);
#pragma unroll
    for (int i = 0; i < 4; ++i)
      *(float4*)(stC + (size_t)slot * 4096 + (ty * 4 + i) * 64 + tx * 4) = make_float4(c[i][0], c[i][1], c[i][2], c[i][3]);
    if (t < 64) stn[slot * 64 + t] = sn[t];
    if (t == 0) stm[slot] = m;
    tile_st_regs(Ks, t, ka, kb, 0.125f);
    tile_st_regs(Vs, t, va, vb, 1.f);
    if (t < 64) {
      float li = g_li, fp = g_fp;
      float lf = logsigmoidf_(fp);
      float bb = wave_scan_add(lf, lane);
      float a = li - bb;
      float amax = wave_max(a);
      float blast = __shfl(bb, 63);
      float mnew = blast + fmaxf(m, amax);
      sws[lane] = expf(blast + a - mnew);
      if (lane == 0) { ssc[0] = expf(blast + m - mnew); ssc[1] = mnew; }
    }
    if (cc + 1 < nc) prefetch(cc + 1);
    __syncthreads();
    const float wc = ssc[0];
    m = ssc[1];
#pragma unroll
    for (int i = 0; i < 4; ++i)
#pragma unroll
      for (int j = 0; j < 4; ++j) c[i][j] *= wc;
    float nacc = 0.f;
    {
      f32x2 ca[4], cb[4];
#pragma unroll
      for (int i = 0; i < 4; ++i) { ca[i] = (f32x2){c[i][0], c[i][1]}; cb[i] = (f32x2){c[i][2], c[i][3]}; }
#pragma unroll 4
      for (int s = 0; s < 64; ++s) {
        const float w = sws[s];
        const f32x4 kk = *(const f32x4*)(Ks + s * TS + ty * 4);
        const f32x4 vv = *(const f32x4*)(Vs + s * TS + tx * 4);
#pragma unroll
        for (int i = 0; i < 4; ++i) {
          const float kw = kk[i] * w;
          const f32x2 k2 = (f32x2){kw, kw};
          ca[i] += k2 * vv.xy;
          cb[i] += k2 * vv.zw;
        }
        if (t < 64) nacc += w * Ks[s * TS + t];
      }
#pragma unroll
      for (int i = 0; i < 4; ++i) { c[i][0] = ca[i].x; c[i][1] = ca[i].y; c[i][2] = cb[i].x; c[i][3] = cb[i].y; }
    }
    if (t < 64) sn[t] = wc * sn[t] + nacc;
  }
  __syncthreads();
  if (isctx) {
    int ch = (b * 2 + dir) * 8 + head;
    float* Co = p->out + O_C + (size_t)ch * 4096;
#pragma unroll
    for (int i = 0; i < 4; ++i)
      *(float4*)(Co + (ty * 4 + i) * 64 + tx * 4) = make_float4(c[i][0], c[i][1], c[i][2], c[i][3]);
    if (t < 64) p->out[O_N + ch * 64 + t] = sn[t];
    if (t == 0) p->out[O_M + ch] = m;
  }
}

__device__ __forceinline__ void mlstm_out_item(CP p, int isctx, int b, int head, int c, float* sm) {
  const int tid = get_tid(), dir = tid >> 8, t = tid & 255, ty = t >> 4, tx = t & 15, lane = t & 63;
  const u16* proj = (const u16*)(p->ws + OFF_HP);
  const float* gates = (const float*)(p->ws + OFF_GATES);
  const float* stC = (const float*)(p->ws + OFF_STC);
  const float* stn = (const float*)(p->ws + OFF_STN);
  const float* stm = (const float*)(p->ws + OFF_STM);
  float* Qs = sm + (dir * 4) * TILE_F; float* KCs = Qs + TILE_F; float* Vs = Qs + 2 * TILE_F; float* Ws = Qs + 3 * TILE_F;
  float* Ws1 = sm + 7 * TILE_F;
  float* sa = sm + 8 * TILE_F + dir * 256;
  float* sM = sa + 64;
  float* sb = sM + 64;
  float* sn = sb + 64;
  const int nc = isctx ? 4 : 16;
  const int mb = (isctx ? b * 256 : NCTX + b * 1024) + c * 64;
  const int cc = dir ? nc - 1 - c : c;
  const int slot = st_slot(isctx, b, dir, head, cc);
  const float m0 = stm[slot];
  __syncthreads();
  const long rs = dir ? -(long)PSTR : (long)PSTR;
  const u16* base = proj + (size_t)(mb + (dir ? 63 : 0)) * PSTR;
  load_tile_bf16(Qs, base + 768 + head * 64, rs, 1.f, t);
  load_tile_bf16(KCs, base + 1280 + head * 64, rs, 0.125f, t);
  load_tile_bf16(Vs, base + 1792 + head * 64, rs, 1.f, t);
  if (t < 64) {
    int tr = mb + (dir ? 63 - lane : lane);
    float li = gates[(size_t)tr * 32 + (dir * 2) * 8 + head];
    float fp = gates[(size_t)tr * 32 + (dir * 2 + 1) * 8 + head];
    float lf = logsigmoidf_(fp);
    float bb = wave_scan_add(lf, lane);
    float a = li - bb;
    float pm = wave_scan_max(a, lane);
    sa[lane] = a; sM[lane] = fmaxf(m0, pm); sb[lane] = bb;
    sn[lane] = stn[slot * 64 + lane];
  }
  __syncthreads();
  float hd[4][4];
  {
    float s[4][4];
    qk_micro(Qs, KCs, ty, tx, s);
    float rsum[4];
#pragma unroll
    for (int i = 0; i < 4; ++i) {
      int tq = ty * 4 + i;
      float Mt = sM[tq];
      float r = 0.f;
#pragma unroll
      for (int j = 0; j < 4; ++j) {
        int sidx = tx + 16 * j;
        float w = (sidx <= tq) ? expf(sa[sidx] - Mt) * s[i][j] : 0.f;
        Ws[tq * TS + sidx] = w;
        r += w;
      }
      rsum[i] = grp16_sum(r);
    }
    __syncthreads();
    load_tile_f32(KCs, stC + (size_t)slot * 4096, 64, t);
    __syncthreads();
    float num[4][4], qc[4][4];
#pragma unroll
    for (int i = 0; i < 4; ++i)
#pragma unroll
      for (int j = 0; j < 4; ++j) { num[i][j] = 0.f; qc[i][j] = 0.f; }
    pv_micro(Ws, Vs, ty, tx, num);
    pv_micro(Qs, KCs, ty, tx, qc);
#pragma unroll
    for (int i = 0; i < 4; ++i) {
      int tq = ty * 4 + i;
      float4 q4 = *(const float4*)(Qs + tq * TS + tx * 4);
      float4 n4 = *(const float4*)(sn + tx * 4);
      float qn = q4.x * n4.x + q4.y * n4.y + q4.z * n4.z + q4.w * n4.w;
      qn = grp16_sum(qn);
      float Mt = sM[tq];
      float wi = expf(m0 - Mt);
      float den = rsum[i] + wi * qn;
      float mt = sb[tq] + Mt;
      float dn = fmaxf(fabsf(den), expf(-mt));
      float inv = 1.f / dn;
#pragma unroll
      for (int j = 0; j < 4; ++j) hd[i][j] = (num[i][j] + wi * qc[i][j]) * inv;
    }
  }
  __syncthreads();
  if (dir == 1) {
#pragma unroll
    for (int i = 0; i < 4; ++i)
      *(float4*)(Ws1 + (63 - (ty * 4 + i)) * TS + tx * 4) = make_float4(hd[i][0], hd[i][1], hd[i][2], hd[i][3]);
  }
  __syncthreads();
  if (dir == 0) {
    const float* hg = p->in[I_L0 + L_X2] + head * 64 + tx * 4;
    u16* ymix = (u16*)(p->ws + OFF_YMIX);
#pragma unroll
    for (int i = 0; i < 4; ++i) {
      float4 v = *(const float4*)(Ws1 + (ty * 4 + i) * TS + tx * 4);
      float h0 = hd[i][0] + v.x, h1 = hd[i][1] + v.y, h2 = hd[i][2] + v.z, h3 = hd[i][3] + v.w;
      float ss = h0 * h0 + h1 * h1 + h2 * h2 + h3 * h3;
      ss = grp16_sum(ss);
      float rstd = rsqrtf(ss * (1.f / 64.f) + EPS);
      int tr = mb + ty * 4 + i;
      uint2 ob = *(const uint2*)(proj + (size_t)tr * PSTR + 2336 + head * 64 + tx * 4);
      float y0 = sigmoidf_(bflo(ob.x)) * (h0 * rstd * hg[0]);
      float y1 = sigmoidf_(bfhi(ob.x)) * (h1 * rstd * hg[1]);
      float y2 = sigmoidf_(bflo(ob.y)) * (h2 * rstd * hg[2]);
      float y3 = sigmoidf_(bfhi(ob.y)) * (h3 * rstd * hg[3]);
      *(uint2*)(ymix + (size_t)tr * D + 512 + head * 64 + tx * 4) = make_uint2(pack2(y0, y1), pack2(y2, y3));
    }
  }
}

__device__ __forceinline__ int next_item(int* ctr, int* s_item) {
  __syncthreads();
  if (get_tid() == 0) *s_item = atomicAdd(ctr, 1);
  __syncthreads();
  return *s_item;
}

__device__ __forceinline__ void mix0_phase_a(CP p, float* sm, int* s_item, int coff) {
  int* ctr = (int*)(p->ws + OFF_CTR) + 0 + coff;
  for (;;) {
    int it = next_item(ctr, s_item);
    if (it >= 912) break;
    if (it >= 128 && it < 144) {
      int v = it - 128; int b = v >> 3, head = v & 7;
      mlstm_state_item(p, 0, b, head, sm);
    } else if (it >= 656) {
      int v = it - 656; int b = v >> 3, head = v & 7;
      mlstm_state_item(p, 1, b, head, sm);
    } else {
      AttnDesc d;
      d.mode = 0; d.a0 = 0; d.r0 = 0; d.rpb = nullptr; d.sink = 0.f; d.has_sink = 0;
      if (it < 128) {
        int b = it >> 6, h = (it >> 3) & 7, qb = it & 7;
        d.qrow0 = NCTX + b * 1024 + qb * 128; d.qcol = h * 64; d.ocol = h * 64;
        d.ck = p->in[I_C0K] + (size_t)b * 256 * 128 + (h >> 2) * 64; d.cv = p->in[I_C0V] + (size_t)b * 256 * 128 + (h >> 2) * 64;
        d.cstride = 128; d.nctx = 4;
        d.krow0 = NCTX + b * 1024; d.nloc = 16; d.kcol = 512 + (h >> 2) * 64; d.vcol = 640 + (h >> 2) * 64;
      } else {
        int v = it - 144; int b = v >> 4, h = (v >> 1) & 7, qb = v & 1;
        d.qrow0 = b * 256 + qb * 128; d.qcol = h * 64; d.ocol = h * 64;
        d.ck = nullptr; d.cv = nullptr; d.cstride = 0; d.nctx = 0;
        d.krow0 = b * 256; d.nloc = 4; d.kcol = 512 + (h >> 2) * 64; d.vcol = 640 + (h >> 2) * 64;
      }
      attn_item(p, d, sm);
    }
  }
}

__device__ __forceinline__ void mix0_phase_b(CP p, float* sm, int* s_item, int coff) {
  int* ctr = (int*)(p->ws + OFF_CTR) + 1 + coff;
  for (;;) {
    int it = next_item(ctr, s_item);
    if (it >= 1280) break;
    if (it < 256) {
      int b = it >> 7, head = (it >> 4) & 7, c = it & 15;
      mlstm_out_item(p, 0, b, head, c, sm);
    } else {
      int v = it - 256; int b = v >> 5, head = (v >> 2) & 7, c = v & 3;
      mlstm_out_item(p, 1, b, head, c, sm);
    }
  }
}

__device__ __forceinline__ void mix1_phase(CP p, float* sm, int* s_item, int coff) {
  int* ctr = (int*)(p->ws + OFF_CTR) + 2 + coff;
  const float* sink = p->in[I_L1 + L_X1];
  for (;;) {
    int it = next_item(ctr, s_item);
    if (it >= 1280) break;
    AttnDesc d;
    d.mode = 0; d.a0 = 0; d.r0 = 0; d.rpb = nullptr; d.sink = 0.f; d.has_sink = 0;
    if (it < 128) {
      int b = it >> 6, h = (it >> 3) & 7, r = (it & 7) * 2;
      int r0 = min(max(r - 4, 0), 8);
      int r1 = min(max(r + 1 - 4, 0), 8) + 8;
      d.qrow0 = NCTX + b * 1024 + r * 64; d.qcol = h * 64; d.ocol = h * 64;
      d.ck = p->in[I_NAK] + (size_t)b * 256 * 512 + h * 64; d.cv = p->in[I_NAV] + (size_t)b * 256 * 512 + h * 64;
      d.cstride = 512; d.nctx = 4;
      d.krow0 = NCTX + b * 1024 + r0 * 64; d.nloc = r1 - r0; d.kcol = 512 + h * 64; d.vcol = 1024 + h * 64;
      d.mode = 1; d.a0 = r; d.r0 = r0; d.rpb = p->in[I_L1 + L_X0] + h * 15 * 31;
    } else if (it < 256) {
      int v = it - 128; int b = v >> 6, h = (v >> 3) & 7, qb = v & 7;
      int t0 = qb * 128;
      int s0 = max(t0 - 128, 0);
      int s1 = min(t0 + 256, 1024);
      d.qrow0 = NCTX + b * 1024 + t0; d.qcol = 1536 + h * 64; d.ocol = 512 + h * 64;
      d.ck = p->in[I_SWK] + (size_t)b * 256 * 128 + (h >> 2) * 64; d.cv = p->in[I_SWV] + (size_t)b * 256 * 128 + (h >> 2) * 64;
      d.cstride = 128; d.nctx = 4;
      d.krow0 = NCTX + b * 1024 + s0; d.nloc = (s1 - s0) >> 6; d.kcol = 2048 + (h >> 2) * 64; d.vcol = 2176 + (h >> 2) * 64;
      d.mode = 2; d.a0 = s0 - t0;
      d.sink = sink[h]; d.has_sink = 1;
    } else if (it < 768) {
      int v = it - 256; int b = v >> 4, h = (v >> 1) & 7, qb = v & 1;
      d.qrow0 = b * 256 + qb * 128; d.qcol = h * 64; d.ocol = h * 64;
      d.ck = nullptr; d.cv = nullptr; d.cstride = 0; d.nctx = 0;
      d.krow0 = b * 256; d.nloc = 4; d.kcol = 512 + h * 64; d.vcol = 1024 + h * 64;
    } else {
      int v = it - 768; int b = v >> 4, h = (v >> 1) & 7, qb = v & 1;
      d.qrow0 = b * 256 + qb * 128; d.qcol = 1536 + h * 64; d.ocol = 512 + h * 64;
      d.ck = nullptr; d.cv = nullptr; d.cstride = 0; d.nctx = 0;
      d.krow0 = b * 256; d.nloc = 4; d.kcol = 2048 + (h >> 2) * 64; d.vcol = 2176 + (h >> 2) * 64;
      d.sink = sink[h]; d.has_sink = 1;
    }
    attn_item(p, d, sm);
  }
}

#define XB_TMO      128
#define XB_XCNT(j)  (256  + 64 * (j))
#define XB_XSUB(j)  (1280 + 64 * (j))
#define XB_XGEN(j)  (2304 + 64 * (j))
#define XB_TOP      3328
#define XB_TOPGEN   3392
#define XCD_BAR_WORDS 3456
#define XB_SPIN_CAP (1u << 22)
__device__ __forceinline__ unsigned xb_ld(unsigned* p) { return __hip_atomic_load(p, __ATOMIC_RELAXED, __HIP_MEMORY_SCOPE_AGENT); }
__device__ __forceinline__ unsigned xb_add(unsigned* p, unsigned v) { return __hip_atomic_fetch_add(p, v, __ATOMIC_RELAXED, __HIP_MEMORY_SCOPE_AGENT); }
__device__ __forceinline__ unsigned xb_xcc_id() { return (unsigned)__builtin_amdgcn_s_getreg((3 << 11) | 20) & 0xFu; }
#define XB_SPIN(cond, bar) do { unsigned _sp = 0; while (cond) { __builtin_amdgcn_s_sleep(1); \
    if ((++_sp & 255u) == 0u) { if (xb_ld(&(bar)[XB_TMO])) break; if (_sp > XB_SPIN_CAP) { atomicAdd(&(bar)[XB_TMO], 1u); break; } } } } while (0)
struct XcdBarrier { unsigned* bar; unsigned x; volatile LAS unsigned* st; };
__device__ __forceinline__ XcdBarrier xcd_barrier_post(unsigned* bar, volatile LAS unsigned* st) {
  XcdBarrier b; b.bar = bar; b.x = xb_xcc_id(); b.st = st;
  if (threadIdx.x == 0) (void)xb_add(&bar[XB_XCNT(b.x)], 1u);
  return b;
}
__device__ __forceinline__ void xcd_barrier_complete(unsigned* bar, unsigned x, unsigned& nloc, unsigned& nx) {
  const unsigned G = gridDim.x * gridDim.y * gridDim.z;
  unsigned sum, cnt, mine, sp = 0u;
  for (;;) {
    sum = 0u; cnt = 0u; mine = 0u;
#pragma unroll
    for (unsigned j = 0; j < 16; ++j) { const unsigned c = xb_ld(&bar[XB_XCNT(j)]); sum += c; cnt += (c > 0u) ? 1u : 0u; mine = (j == x) ? c : mine; }
    if (sum == G) break;
    __builtin_amdgcn_s_sleep(1);
    if ((++sp & 255u) == 0u) { if (xb_ld(&bar[XB_TMO])) break; if (sp > XB_SPIN_CAP) { atomicAdd(&bar[XB_TMO], 1u); break; } }
  }
  nloc = mine > 0u ? mine : 1u; nx = cnt > 0u ? cnt : 1u;
}
__device__ __forceinline__ void xcd_barrier(const XcdBarrier& b) {
  asm volatile("s_waitcnt vmcnt(0)" ::: "memory");
  __syncthreads();
  if (threadIdx.x == 0) {
    unsigned* bar = b.bar;
    __builtin_amdgcn_s_waitcnt(0);
    unsigned nloc = b.st[0], nx = b.st[1];
    if (nloc == 0u) { xcd_barrier_complete(bar, b.x, nloc, nx); b.st[0] = nloc; b.st[1] = nx; }
    const unsigned old = xb_add(&bar[XB_XSUB(b.x)], 1u);
    const unsigned gen = old / nloc;
    if (old + 1u == (gen + 1u) * nloc) {
      __builtin_amdgcn_fence(__ATOMIC_RELEASE, "agent");
      asm volatile("s_waitcnt vmcnt(0)" ::: "memory");
      const unsigned og = xb_add(&bar[XB_TOP], 1u);
      const unsigned tg = og / nx;
      if (og + 1u == (tg + 1u) * nx) xb_add(&bar[XB_TOPGEN], 1u);
      else XB_SPIN(xb_ld(&bar[XB_TOPGEN]) == tg, bar);
      __builtin_amdgcn_fence(__ATOMIC_ACQUIRE, "agent");
      xb_add(&bar[XB_XGEN(b.x)], 1u);
      asm volatile("s_waitcnt vmcnt(0)" ::: "memory");
    } else {
      XB_SPIN(xb_ld(&bar[XB_XGEN(b.x)]) == gen, bar);
      __builtin_amdgcn_fence(__ATOMIC_ACQUIRE, "agent");
      asm volatile("s_waitcnt vmcnt(0)" ::: "memory");
    }
  }
  __syncthreads();
}

constexpr int NPHASE = 18;
__device__ __forceinline__ void run_phase(CP p, int ph, char* smem, int* s_item, const int dry) {
  float* smf = (float*)smem;
  u16* smh = (u16*)smem;
  const u16* xn = (const u16*)(p->ws + OFF_XN);
  const u16* hp = (const u16*)(p->ws + OFF_HP);
  const u16* ymix = (const u16*)(p->ws + OFF_YMIX);
  if (ph == 0) { prep_a_phase(p, smf); return; }
  if (ph == 1) { prep_b_phase(p, smf, dry); return; }
  if (ph == 17) { final_phase(p); return; }
  const int l = (ph >= 10) ? 1 : 0;
  int q = ph - (l ? 10 : 2);
  if (l == 1 && q >= 4) q += 1;
  if (q == 0 || q == 6) {
    const int f = (q == 6) ? 1 : 0;
    gemm_phase<EPI_SWIGLU>(p, xn, (const u16*)(p->ws + OFF_WIN + (l * 2 + f) * SZ_WIN), 1024, 22, l, 0, 0.f, l * 3 + (f ? 2 : 0), smh);
    return;
  }
  if (q == 1 || q == 5 || q == 7) {
    const u16* A = (q == 5) ? ymix : hp;
    const u16* Bt = (q == 5) ? (const u16*)(p->ws + OFF_WMO + (size_t)l * D * D * 2)
                             : (const u16*)(p->ws + OFF_WOUT + (l * 2 + (q == 7 ? 1 : 0)) * SZ_WOUT);
    const int K = (q == 5) ? 1024 : DFF;
    const int gch = (q == 1) ? 2 : (q == 5 ? 5 : 8);
    const float coef = dry ? 0.f : ((q == 5) ? 1.f : 0.5f);
    const int nid_next = l * 3 + ((q == 1) ? 1 : (q == 5 ? 2 : 3));
    gemm_phase<EPI_RESID>(p, A, Bt, K, 4, l, gch, coef, dry ? 7 : nid_next, smh, (dry || l) ? 0 : (q == 1 ? 1 : (q == 7 ? 2 : 0)));
    return;
  }
  if (q == 2) {
    if (l == 0) gemm_phase<EPI_MIX0>(p, xn, (const u16*)(p->ws + OFF_WMI0), 1024, 12, l, 0, 0.f, 1, smh);
    else gemm_phase<EPI_MIX1>(p, xn, (const u16*)(p->ws + OFF_WMI1), 1024, 9, l, 0, 0.f, 4, smh);
    return;
  }
  if (q == 3) { if (l == 0) mix0_phase_a(p, smf, s_item, dry * 3); else mix1_phase(p, smf, s_item, dry * 3); return; }
  if (q == 4) { mix0_phase_b(p, smf, s_item, dry * 3); return; }
}

__global__ void __launch_bounds__(512, 2) mega(Params kp, int ph0, int ph1, int dry) {
  extern __shared__ __attribute__((aligned(16))) char smem[];
  int* s_item_p = (int*)(smem + SMEM_BYTES);
  uint4* xb_words_p = (uint4*)(smem + SMEM_BYTES + 16);
  if (threadIdx.x == 0) *xb_words_p = make_uint4(0u, 0u, 0u, 0u);
  __syncthreads();
  XcdBarrier xb = xcd_barrier_post((unsigned*)(kp.ws + OFF_BAR), (volatile LAS unsigned*)xb_words_p);
  if (ph1 < 0) cg::this_grid().sync();
  for (int ph = ph0; ph < ph1; ++ph) {
    if (ph > ph0) xcd_barrier(xb);
    CP p = (CP)__builtin_amdgcn_kernarg_segment_ptr();
    asm volatile("" : "+s"(p));
    run_phase(p, ph, smem, s_item_p, dry);
  }
}

extern "C" void kernel_launch(void* const* d_in, const int* in_sizes, int n_in, void* d_out, int out_size, void* d_ws,
                              size_t ws_size, hipStream_t stream) {
  static int grid_blocks = 0;
  if (!grid_blocks) {
    int dev = 0, cus = 0, per_cu = 0;
    hipGetDevice(&dev);
    hipDeviceGetAttribute(&cus, hipDeviceAttributeMultiprocessorCount, dev);
    hipFuncSetAttribute((const void*)mega, hipFuncAttributeMaxDynamicSharedMemorySize, DYN_LDS);
    hipOccupancyMaxActiveBlocksPerMultiprocessor(&per_cu, mega, NTH, DYN_LDS);
    if (per_cu > 1) per_cu = 1;
    if (per_cu < 1) per_cu = 1;
    grid_blocks = cus * per_cu;
  }
  if (ws_size < WS_TOTAL) fprintf(stderr, "workspace too small: %zu < %zu\n", ws_size, (size_t)WS_TOTAL);
  Params p{};
  for (int i = 0; i < 37; ++i) p.in[i] = (const float*)d_in[i];
  p.out = (float*)d_out;
  p.ws = (char*)d_ws;
  hipMemsetAsync((char*)d_ws + OFF_CTR, 0, ZERO_BYTES, stream);
#if SINGLE_LAUNCH
  int ph0 = 0, ph1 = NPHASE, dry = 0;
  void* args[] = {&p, &ph0, &ph1, &dry};
  hipError_t e = hipLaunchCooperativeKernel((void*)mega, dim3(grid_blocks), dim3(NTH), args, DYN_LDS, stream);
  if (e != hipSuccess) fprintf(stderr, "cooperative launch failed: %s (grid %d)\n", hipGetErrorString(e), grid_blocks);
#else
  for (int ph = 0; ph < NPHASE; ++ph) {
    mega<<<grid_blocks, NTH, DYN_LDS, stream>>>(p, ph, ph + 1, 0);
    const bool g1 = (ph == 2 || ph == 8 || ph == 10 || ph == 15), g2 = (ph == 3 || ph == 9 || ph == 11 || ph == 16);
    const bool mi = (ph == 4 || ph == 12), mo = (ph == 7 || ph == 14), mx = (ph == 5 || ph == 6 || ph == 13);
    if (((REP_MASK & 1) && g1) || ((REP_MASK & 2) && g2) || ((REP_MASK & 4) && (mi || mo)) || ((REP_MASK & 8) && mx) ||
        ((REP_MASK & 16) && ph == 0) || ((REP_MASK & 32) && ph == 1))
      mega<<<grid_blocks, NTH, DYN_LDS, stream>>>(p, ph, ph + 1, 1);
  }
#endif
}
```

```cpp
#include <hip/hip_runtime.h>
#include <hip/hip_cooperative_groups.h>
#include <cstdio>
namespace cg = cooperative_groups;

#ifndef REP_MASK
#define REP_MASK 0
#endif
#ifndef SINGLE_LAUNCH
#define SINGLE_LAUNCH 1
#endif

typedef unsigned short u16;
typedef __attribute__((ext_vector_type(8))) short bf16x8;
typedef __attribute__((ext_vector_type(4))) float f32x4;
typedef __attribute__((ext_vector_type(4))) unsigned u32x4;
#define LAS __attribute__((address_space(3)))

constexpr int D = 1024, NCTX = 8192, MTOK = 10240;
constexpr int DFF = 2816, NFF = 5632;
constexpr int P0N = 2848, P0P = 3072, P1N = 2304;
constexpr int PSTR = 2944;
constexpr float EPS = 1e-6f;

enum { I_XP = 0, I_XS, I_C0K, I_C0V, I_SC, I_SN, I_SM, I_NAK, I_NAV, I_SWK, I_SWV, I_C, I_CCTX, I_NF,
       I_L0 = 14, I_L1 = 26 };
enum { L_ADAW = 0, L_ADAB, L_NORM, L_F1I, L_F1O, L_F2I, L_F2O, L_MI, L_MO, L_X0, L_X1, L_X2 };

constexpr size_t O_X = 0, O_K0 = 10485760, O_V0 = 11534336, O_C = 12582912, O_N = 14680064, O_M = 14712832,
                 O_KC1 = 14713344, O_VC1 = 18907648, O_KD1 = 23101952, O_VD1 = 24150528;

constexpr size_t SZ_WIN = (size_t)NFF * D * 2;
constexpr size_t SZ_WOUT = (size_t)D * DFF * 2;
constexpr size_t OFF_WIN = 0;
constexpr size_t OFF_WOUT = OFF_WIN + 4 * SZ_WIN;
constexpr size_t OFF_WMI0 = OFF_WOUT + 4 * SZ_WOUT;
constexpr size_t OFF_WMI1 = OFF_WMI0 + (size_t)P0P * D * 2;
constexpr size_t OFF_WMO = OFF_WMI1 + (size_t)P1N * D * 2;
constexpr size_t OFF_MOD = OFF_WMO + 2 * (size_t)D * D * 2;
constexpr size_t OFF_ROPE = OFF_MOD + 2 * 3 * 9216 * 4;
constexpr size_t OFF_CTR = OFF_ROPE + 2 * 1024 * 32 * 4;
constexpr size_t OFF_BAR = OFF_CTR + 256;
constexpr size_t OFF_ROWSS = OFF_CTR + 16384;
constexpr size_t OFF_BIAS = OFF_ROWSS + (size_t)7 * MTOK * 4;
constexpr size_t ZERO_BYTES = 16384 + (size_t)7 * MTOK * 4 + (size_t)2 * 3 * 3 * NFF * 4;
constexpr size_t OFF_XN = OFF_CTR + ZERO_BYTES;
constexpr size_t OFF_YMIX = OFF_XN + (size_t)MTOK * D * 2;
constexpr size_t OFF_HP = OFF_YMIX + (size_t)MTOK * D * 2;
constexpr size_t OFF_GATES = OFF_HP + (size_t)MTOK * PSTR * 2;
constexpr size_t OFF_STC = OFF_GATES + (size_t)MTOK * 32 * 4;
constexpr size_t OFF_STN = OFF_STC + (size_t)2560 * 4096 * 4;
constexpr size_t OFF_STM = OFF_STN + (size_t)2560 * 64 * 4;
constexpr size_t WS_TOTAL = OFF_STM + 2560 * 4;

constexpr int TS = 68;
constexpr int TILE_F = 64 * TS;
constexpr int SMEM_BYTES = 8 * TILE_F * 4 + 4096;
constexpr int NTH = 512;
constexpr int DYN_LDS = SMEM_BYTES + 32;

struct Params {
  const float* in[37];
  float* out;
  char* ws;
};
typedef const __attribute__((address_space(4))) Params* CP;

__device__ __forceinline__ int get_tid() { int t = threadIdx.x; asm volatile("" : "+v"(t)); return t; }
__device__ __forceinline__ u16 f2bf(float f) {
  unsigned u = __float_as_uint(f);
  u += 0x7fffu + ((u >> 16) & 1u);
  return (u16)(u >> 16);
}
__device__ __forceinline__ unsigned pack2(float a, float b) { return (unsigned)f2bf(a) | ((unsigned)f2bf(b) << 16); }
__device__ __forceinline__ float bflo(unsigned x) { return __uint_as_float(x << 16); }
__device__ __forceinline__ float bfhi(unsigned x) { return __uint_as_float(x & 0xffff0000u); }
__device__ __forceinline__ float grp16_sum(float v) {
  v += __shfl_xor(v, 1); v += __shfl_xor(v, 2); v += __shfl_xor(v, 4); v += __shfl_xor(v, 8); return v;
}
__device__ __forceinline__ float grp16_max(float v) {
  v = fmaxf(v, __shfl_xor(v, 1)); v = fmaxf(v, __shfl_xor(v, 2)); v = fmaxf(v, __shfl_xor(v, 4)); v = fmaxf(v, __shfl_xor(v, 8)); return v;
}
__device__ __forceinline__ float wave_sum(float v) {
  for (int o = 32; o; o >>= 1) v += __shfl_xor(v, o);
  return v;
}
__device__ __forceinline__ float wave_max(float v) {
  for (int o = 32; o; o >>= 1) v = fmaxf(v, __shfl_xor(v, o));
  return v;
}
__device__ __forceinline__ float wave_scan_add(float v, int lane) {
  for (int o = 1; o < 64; o <<= 1) { float t = __shfl_up(v, o); if (lane >= o) v += t; }
  return v;
}
__device__ __forceinline__ float wave_scan_max(float v, int lane) {
  for (int o = 1; o < 64; o <<= 1) { float t = __shfl_up(v, o); if (lane >= o) v = fmaxf(v, t); }
  return v;
}
__device__ __forceinline__ int cond_of(int row) { return row < NCTX ? 0 : 1 + ((row - NCTX) >> 10); }
__device__ __forceinline__ float sigmoidf_(float x) { return 1.f / (1.f + expf(-x)); }
__device__ __forceinline__ float logsigmoidf_(float x) { return fminf(x, 0.f) - log1pf(expf(-fabsf(x))); }

__device__ void conv_tile(const float* __restrict__ W, int K, int N, u16* __restrict__ Wt, int perm, int kt, int nt, float* T, int t, bool valid,
                          const float* shp, float* biasp) {
  {
    int r = t >> 4, c4 = t & 15;
    int c = c4 * 4;
    int src;
    if (perm == 1) src = ((nt & 3) < 2 ? 0 : DFF) + (nt >> 2) * 128 + (nt & 1) * 64 + c;
    else if (perm == 2) {
      int bj = (nt & 3) >> 1, wc = (nt & 1) * 2 + (c >> 5), w = c & 31;
      src = (nt >> 2) * 256 + wc * 64 + bj * 32 + w;
    } else src = nt * 64 + c;
    bool ok = valid && (src < N);
#pragma unroll
    for (int ps = 0; ps < 4; ++ps) {
      int k = r + ps * 16;
      float4 v = make_float4(0.f, 0.f, 0.f, 0.f);
      if (ok) v = *(const float4*)(W + (size_t)(kt * 64 + k) * N + src);
      float* tt = T + k * 65 + c;
      tt[0] = v.x; tt[1] = v.y; tt[2] = v.z; tt[3] = v.w;
    }
  }
  if (biasp && t < 192) T[4224 + t] = shp[(t >> 6) * 9216 + kt * 64 + (t & 63)];
  __syncthreads();
  if (valid && biasp && t < 192) {
    int a = t >> 6, c = t & 63;
    int src;
    if (perm == 1) src = ((nt & 3) < 2 ? 0 : DFF) + (nt >> 2) * 128 + (nt & 1) * 64 + c;
    else { int bj = (nt & 3) >> 1, wc = (nt & 1) * 2 + (c >> 5), w = c & 31; src = (nt >> 2) * 256 + wc * 64 + bj * 32 + w; }
    if (src < N) {
      const float* sh = T + 4224 + a * 64;
      float acc = 0.f;
#pragma unroll 16
      for (int k = 0; k < 64; ++k) acc += sh[k] * T[k * 65 + c];
      unsafeAtomicAdd(biasp + a * NFF + src, acc);
    }
  }
  if (valid) {
    int n = t >> 2, kp = t & 3;
    unsigned o[8];
#pragma unroll
    for (int i = 0; i < 8; ++i) {
      float a = T[(kp * 16 + 2 * i) * 65 + n], b = T[(kp * 16 + 2 * i + 1) * 65 + n];
      o[i] = pack2(a, b);
    }
    uint4* dst = (uint4*)(Wt + (size_t)(nt * 64 + n) * K + kt * 64 + kp * 16);
    dst[0] = make_uint4(o[0], o[1], o[2], o[3]);
    dst[1] = make_uint4(o[4], o[5], o[6], o[7]);
  }
  __syncthreads();
}

__device__ void adaln_unit(CP p, int u, float* sm, int t, bool valid) {
  int l = u / 144, cg_ = u % 144;
  if (!valid) { l = 0; cg_ = 0; }
  const float* W = p->in[(l ? I_L1 : I_L0) + L_ADAW];
  const float* B = p->in[(l ? I_L1 : I_L0) + L_ADAB];
  float* sc = sm;
  float* red = sm + 3072;
  for (int i = t; i < 3072; i += 256) {
    int cnd = i >> 10, k = i & 1023;
    float v = (cnd == 0) ? p->in[I_CCTX][k] : p->in[I_C][(cnd - 1) * 1024 + k];
    sc[i] = v / (1.f + expf(-v));
  }
  __syncthreads();
  int kp = t >> 4, c4 = t & 15;
  float acc[3][4];
#pragma unroll
  for (int a = 0; a < 3; ++a)
#pragma unroll
    for (int e = 0; e < 4; ++e) acc[a][e] = 0.f;
  for (int kk = 0; kk < 64; ++kk) {
    int k = kp * 64 + kk;
    float4 w = *(const float4*)(W + (size_t)k * 9216 + cg_ * 64 + c4 * 4);
#pragma unroll
    for (int a = 0; a < 3; ++a) {
      float s = sc[a * 1024 + k];
      acc[a][0] += s * w.x; acc[a][1] += s * w.y; acc[a][2] += s * w.z; acc[a][3] += s * w.w;
    }
  }
#pragma unroll
  for (int a = 0; a < 3; ++a)
#pragma unroll
    for (int e = 0; e < 4; ++e) red[(kp * 3 + a) * 64 + c4 * 4 + e] = acc[a][e];
  __syncthreads();
  if (valid && t < 192) {
    int a = t >> 6, col = t & 63;
    float s = 0.f;
    for (int q = 0; q < 16; ++q) s += red[(q * 3 + a) * 64 + col];
    s += B[cg_ * 64 + col];
    float* mod = (float*)(p->ws + OFF_MOD);
    mod[(l * 3 + a) * 9216 + cg_ * 64 + col] = s;
  }
  __syncthreads();
}

__device__ __forceinline__ int conv_units_of(int l, int kind) {
  return (kind == 0 || kind == 4) ? 1408 : ((kind == 1 || kind == 5) ? 704 : (kind == 3 ? 256 : (l ? 576 : 768)));
}
__device__ __forceinline__ void conv_job(CP p, int l, int kind, int tt, float* smh, int t, bool valid) {
  const float* mod = (const float*)(p->ws + OFF_MOD);
  float* bias = (float*)(p->ws + OFF_BIAS);
  const float* W; u16* Wt; int K, N, perm, ntn, which = -1;
  const int lb = l ? I_L1 : I_L0;
  if (kind == 0 || kind == 4) {
    const int f = kind == 4;
    W = p->in[lb + (f ? L_F2I : L_F1I)]; Wt = (u16*)(p->ws + OFF_WIN + (l * 2 + f) * SZ_WIN);
    K = 1024; N = NFF; perm = 1; ntn = 88; which = f ? 2 : 0;
  } else if (kind == 1 || kind == 5) {
    const int f = kind == 5;
    W = p->in[lb + (f ? L_F2O : L_F1O)]; Wt = (u16*)(p->ws + OFF_WOUT + (l * 2 + f) * SZ_WOUT);
    K = DFF; N = 1024; perm = 0; ntn = 16;
  } else if (kind == 2) {
    W = p->in[lb + L_MI]; Wt = (u16*)(p->ws + (l ? OFF_WMI1 : OFF_WMI0));
    K = 1024; N = l ? P1N : P0N; perm = 2; ntn = l ? 36 : 48; which = 1;
  } else {
    W = p->in[lb + L_MO]; Wt = (u16*)(p->ws + OFF_WMO + (size_t)l * D * D * 2);
    K = 1024; N = 1024; perm = 0; ntn = 16;
  }
  const int nt = tt % ntn, kt = tt / ntn;
  const bool wb = which >= 0;
  conv_tile(W, K, N, Wt, perm, kt, nt, smh, t, valid, wb ? mod + (l * 3) * 9216 + (3 * which) * 1024 : nullptr,
            wb ? bias + (size_t)((l * 3 + which) * 3) * NFF : nullptr);
}

__device__ __forceinline__ void conv_side_job(CP p, int side, int nwg, float* sm) {
  const int tid = get_tid(), half = tid >> 8, t = tid & 255;
  float* smh = sm + half * 8192;
  const int first = ((int)gridDim.x >= nwg + 32) ? nwg : 0;
  const int nb = (int)gridDim.x - first;
  if ((int)blockIdx.x < first) return;
  const int U = (side == 1) ? 3136 : 5056;
  for (int ub = ((int)blockIdx.x - first) * 2; ub < U; ub += nb * 2) {
    int u = ub + half;
    const bool valid = u < U;
    if (!valid) u = 0;
    int l, kind, tt;
    if (side == 1) {
      l = 0;
      if (u < 768) { kind = 2; tt = u; } else if (u < 1024) { kind = 3; tt = u - 768; }
      else if (u < 2432) { kind = 4; tt = u - 1024; } else { kind = 5; tt = u - 2432; }
    } else {
      l = 1;
      if (u < 1408) { kind = 0; tt = u; } else if (u < 2112) { kind = 1; tt = u - 1408; }
      else if (u < 2688) { kind = 2; tt = u - 2112; } else if (u < 2944) { kind = 3; tt = u - 2688; }
      else if (u < 4352) { kind = 4; tt = u - 2944; } else { kind = 5; tt = u - 4352; }
    }
    conv_job(p, l, kind, tt, smh, t, valid);
  }
}

__device__ __forceinline__ void prep_a_phase(CP p, float* sm) {
  const int tid = get_tid(), half = tid >> 8, t = tid & 255;
  float* smh = sm + half * 8192;
  constexpr int U_CONV = 704, U_ADA = 288, U_ROPE = 64;
  for (int ub = blockIdx.x * 2; ub < U_ADA; ub += gridDim.x * 2) {
    int u = ub + half;
    adaln_unit(p, u, smh, t, u < U_ADA);
  }
  for (int ub = blockIdx.x * 2; ub < U_CONV; ub += gridDim.x * 2) {
    int u = ub + half;
    bool valid = u < U_CONV;
    if (!valid) u = 0;
    conv_job(p, 0, 1, u, smh, t, valid);
  }
  for (int u = blockIdx.x; u < U_ROPE; u += gridDim.x) {
    int e = u * 512 + tid;
    int tk = e >> 5, i = e & 31;
    float pos = (i < 16) ? (float)(tk >> 6) : (float)(tk & 63);
    float fr = powf(10000.f, -(float)(i & 15) / 16.f);
    float ang = pos * fr;
    float* rc = (float*)(p->ws + OFF_ROPE);
    rc[e] = cosf(ang);
    rc[32768 + e] = sinf(ang);
  }
}

__device__ __forceinline__ void prep_b_phase(CP p, float* sm, const int dry) {
  const int tid = get_tid(), half = tid >> 8, t = tid & 255, lane = tid & 63, w = tid >> 6;
  float* smh = sm + half * 8192;
  const float* mod = (const float*)(p->ws + OFF_MOD);
  constexpr int U_CONV = 1408;
  for (int ub = blockIdx.x * 2; ub < U_CONV; ub += gridDim.x * 2) {
    int u = ub + half;
    bool valid = u < U_CONV;
    if (!valid) u = 0;
    conv_job(p, 0, 0, u, smh, t, valid);
  }
  {
    float* x = p->out + O_X;
    u16* xn = (u16*)(p->ws + OFF_XN);
    float* rowss = (float*)(p->ws + OFF_ROWSS);
    const float4* g = (const float4*)(p->in[I_L0 + L_NORM]);
    for (int row = blockIdx.x * 8 + w; row < MTOK; row += gridDim.x * 8) {
      const float4* src = (row < NCTX) ? (const float4*)(p->in[I_XP] + (size_t)row * D) : (const float4*)(p->in[I_XS] + (size_t)(row - NCTX) * D);
      float4* xr = (float4*)(x + (size_t)row * D);
      const float4* sc = (const float4*)(mod + (size_t)cond_of(row) * 9216 + 1024);
      float ss = 0.f;
#pragma unroll
      for (int i = 0; i < 4; ++i) {
        int q = lane + i * 64;
        float4 v = src[q];
        ss += v.x * v.x + v.y * v.y + v.z * v.z + v.w * v.w;
        xr[q] = v;
        float4 gg = g[q], s2 = sc[q];
        uint2 o = make_uint2(pack2(v.x * (gg.x * (1.f + s2.x)), v.y * (gg.y * (1.f + s2.y))), pack2(v.z * (gg.z * (1.f + s2.z)), v.w * (gg.w * (1.f + s2.w))));
        *(uint2*)(xn + (size_t)row * D + q * 4) = o;
      }
      ss = wave_sum(ss);
      if (lane == 0) rowss[row] = ss;
    }
  }
}

__device__ __forceinline__ void final_phase(CP p) {
  const int tid = get_tid(), lane = tid & 63, w = tid >> 6;
  float* x = p->out + O_X;
  const float* rowss = (const float*)(p->ws + OFF_ROWSS) + 6 * MTOK;
  const float4* g = (const float4*)p->in[I_NF];
  for (int row = blockIdx.x * 8 + w; row < MTOK; row += gridDim.x * 8) {
    float4* xr = (float4*)(x + (size_t)row * D);
    const float rstd = rsqrtf(rowss[row] * (1.f / 1024.f) + EPS);
#pragma unroll
    for (int i = 0; i < 4; ++i) {
      int q = lane + i * 64;
      float4 v = xr[q], gg = g[q];
      xr[q] = make_float4(v.x * rstd * gg.x, v.y * rstd * gg.y, v.z * rstd * gg.z, v.w * rstd * gg.w);
    }
  }
}

enum { EPI_SWIGLU = 0, EPI_RESID = 1, EPI_MIX0 = 2, EPI_MIX1 = 3 };
constexpr int BM = 256, BK = 64, HALF = 128, HT = HALF * BK, NXCD = 8, WGM = 8;

__device__ __forceinline__ int lds_byte(int r, int c) {
  int st = (r >> 4) * 2 + (c >> 5), rr = r & 15, cc = c & 31, ob = rr * 64 + cc * 2;
  return st * 1024 + (ob ^ (((ob >> 9) & 1) << 5));
}
__device__ __forceinline__ void stage_rc(int b, int& R, int& C) {
  int st = b / 1024, sb = b % 1024, swz = sb ^ (((sb >> 9) & 1) << 5);
  R = (st >> 1) * 16 + swz / 64; C = (st & 1) * 32 + (swz % 64) / 2;
}

template <int EPI>
__device__ __forceinline__ void gemm256_tile(CP p, const u16* A, const u16* Bt, const int K,
                                             const int brow, const int bcol, int l, int gchunk, float coef, int nid, u16* shm, const int tid0) {
#define SWZ_LANE() ([]() { unsigned ln = __builtin_amdgcn_mbcnt_hi(~0u, __builtin_amdgcn_mbcnt_lo(~0u, 0u)); asm volatile("" : "+v"(ln)); \
    unsigned ob = (ln & 15u) * 64u + (ln >> 4) * 16u; return ob ^ (((ob >> 9) & 1u) << 5); }())
#define SAI(b, h) ((b) * 2 + (h))
#define SBI(b, h) (4 + (b) * 2 + (h))
#define STAGE(PI, BASE, br, kt) do { \
    const char* _gb = (const char*)(BASE) + ((long)(br) * K + (long)(kt) * BK) * 2; \
    char* _lp = (char*)shm + (PI) * (HT * 2) + wave_lds; \
    __builtin_amdgcn_global_load_lds((const unsigned*)(_gb + voff0), (LAS unsigned*)(_lp), 16, 0, 0); \
    __builtin_amdgcn_global_load_lds((const unsigned*)(_gb + (long)K * 128 + voff0), (LAS unsigned*)(_lp + 8192), 16, 0, 0); } while (0)
#define LDA(dst, PI) do { unsigned _o = SWZ_LANE() + a_uni; asm volatile("" : "+v"(_o)); _o &= 0x23F0u; \
    _Pragma("unroll") for (int m = 0; m < 4; ++m) _Pragma("unroll") for (int k = 0; k < 2; ++k) \
      dst[m][k] = *reinterpret_cast<const bf16x8*>((const char*)shm + (PI) * (HT * 2) + m * 2048 + k * 1024 + _o); } while (0)
#define LDB(dst, PI) do { unsigned _o = SWZ_LANE() + b_uni; asm volatile("" : "+v"(_o)); _o &= 0x33F0u; \
    _Pragma("unroll") for (int n = 0; n < 2; ++n) _Pragma("unroll") for (int k = 0; k < 2; ++k) \
      dst[n][k] = *reinterpret_cast<const bf16x8*>((const char*)shm + (PI) * (HT * 2) + n * 2048 + k * 1024 + _o); } while (0)
#define MMA(ai, bj, At_, Bt_) do { __builtin_amdgcn_s_setprio(1); \
    _Pragma("unroll") for (int m = 0; m < 4; ++m) _Pragma("unroll") for (int n = 0; n < 2; ++n) _Pragma("unroll") for (int k = 0; k < 2; ++k) \
      acc[ai][bj][m][n] = __builtin_amdgcn_mfma_f32_16x16x32_bf16(At_[m][k], Bt_[n][k], acc[ai][bj][m][n], 0, 0, 0); \
    __builtin_amdgcn_s_setprio(0); } while (0)
#define WAIT_V(n) asm volatile("s_waitcnt vmcnt(" #n ")" ::: "memory")
#define WAIT_L(n) asm volatile("s_waitcnt lgkmcnt(" #n ")" ::: "memory")
#define BAR __builtin_amdgcn_s_barrier()
#define SCHED __builtin_amdgcn_sched_barrier(0)
  const int wid = __builtin_amdgcn_readfirstlane(tid0 >> 6), wr = wid >> 2, wc = wid & 3;
  const int wave_lds = (wid & 7) * 1024;
  unsigned voff0;
  { int r_, c_; stage_rc(tid0 * 16, r_, c_); voff0 = (unsigned)(r_ * K + c_) * 2u; }
  const unsigned a_uni = (unsigned)(wr * 8192), b_uni = (unsigned)(wc * 4096);
  f32x4 acc[2][2][4][2];
#pragma unroll
  for (int a = 0; a < 2; ++a)
#pragma unroll
    for (int b = 0; b < 2; ++b)
#pragma unroll
      for (int m = 0; m < 4; ++m)
#pragma unroll
        for (int n = 0; n < 2; ++n) acc[a][b][m][n] = (f32x4){0.f, 0.f, 0.f, 0.f};
  bf16x8 At[4][2], B0[2][2], B1[2][2];
  const int nt = K / BK;
  WAIT_V(0);
  __syncthreads();
  STAGE(SBI(0, 0), Bt, bcol, 0); STAGE(SAI(0, 0), A, brow, 0);
  STAGE(SBI(0, 1), Bt, bcol + HALF, 0); STAGE(SAI(0, 1), A, brow + HALF, 0);
  if (wr == 1) BAR;
  WAIT_V(4); BAR;
  STAGE(SBI(1, 0), Bt, bcol, 1); STAGE(SAI(1, 0), A, brow, 1); STAGE(SBI(1, 1), Bt, bcol + HALF, 1);
  WAIT_V(6); BAR;
  for (int t = 0; t < nt - 2; t += 2) {
    LDB(B0, SBI(0, 0)); SCHED; LDA(At, SAI(0, 0)); STAGE(SAI(1, 1), A, brow + HALF, t + 1);
    WAIT_L(8); BAR; WAIT_L(0); MMA(0, 0, At, B0); BAR; SCHED;
    LDB(B1, SBI(0, 1)); STAGE(SBI(0, 0), Bt, bcol, t + 2);
    BAR; WAIT_L(0); MMA(0, 1, At, B1); BAR;
    LDA(At, SAI(0, 1)); STAGE(SAI(0, 0), A, brow, t + 2);
    BAR; WAIT_L(0); MMA(1, 0, At, B0); BAR; SCHED;
    STAGE(SBI(0, 1), Bt, bcol + HALF, t + 2);
    WAIT_V(6); BAR; MMA(1, 1, At, B1); BAR;
    LDB(B0, SBI(1, 0)); SCHED; LDA(At, SAI(1, 0)); STAGE(SAI(0, 1), A, brow + HALF, t + 2);
    WAIT_L(8); BAR; WAIT_L(0); MMA(0, 0, At, B0); BAR; SCHED;
    LDB(B1, SBI(1, 1)); STAGE(SBI(1, 0), Bt, bcol, t + 3);
    BAR; WAIT_L(0); MMA(0, 1, At, B1); BAR;
    LDA(At, SAI(1, 1)); STAGE(SAI(1, 0), A, brow, t + 3);
    BAR; WAIT_L(0); MMA(1, 0, At, B0); BAR; SCHED;
    STAGE(SBI(1, 1), Bt, bcol + HALF, t + 3);
    WAIT_V(6); BAR; MMA(1, 1, At, B1); BAR;
  }
  { LDB(B0, SBI(0, 0)); LDA(At, SAI(0, 0)); STAGE(SAI(1, 1), A, brow + HALF, nt - 1);
    BAR; WAIT_L(0); MMA(0, 0, At, B0); BAR;
    LDB(B1, SBI(0, 1)); BAR; WAIT_L(0); MMA(0, 1, At, B1); BAR;
    LDA(At, SAI(0, 1)); WAIT_V(4); BAR; WAIT_L(0); MMA(1, 0, At, B0); MMA(1, 1, At, B1); BAR; }
  { LDB(B0, SBI(1, 0)); LDA(At, SAI(1, 0)); WAIT_V(2); BAR; WAIT_L(0); MMA(0, 0, At, B0); BAR;
    LDB(B1, SBI(1, 1)); WAIT_V(0); BAR; WAIT_L(0); MMA(0, 1, At, B1); BAR;
    LDA(At, SAI(1, 1)); BAR; WAIT_L(0); MMA(1, 0, At, B0); MMA(1, 1, At, B1); BAR; }
  if (wr == 0) BAR;
#undef SAI
#undef SWZ_LANE
#undef SBI
#undef STAGE
#undef LDA
#undef LDB
#undef MMA
#undef WAIT_V
#undef WAIT_L
#undef BAR
#undef SCHED
  unsigned lane_e = __builtin_amdgcn_mbcnt_hi(~0u, __builtin_amdgcn_mbcnt_lo(~0u, 0u));
  asm volatile("" : "+v"(lane_e));
  const int lane = (int)lane_e, fr = lane & 15, fq = lane >> 4, tid = wid * 64 + lane;
  if (EPI == EPI_SWIGLU) {
    u16* H = (u16*)(p->ws + OFF_HP);
    const int hcl = wc * 32 + fr;
    const int hc0 = (bcol >> 1) + hcl;
    const float* rowss = (const float*)(p->ws + OFF_ROWSS) + (size_t)nid * MTOK;
    const float* bias = (const float*)(p->ws + OFF_BIAS) + (size_t)(nid * 3 + cond_of(brow)) * NFF;
    float bg[2], bu[2];
#pragma unroll
    for (int n = 0; n < 2; ++n) { bg[n] = bias[hc0 + n * 16]; bu[n] = bias[DFF + hc0 + n * 16]; }
    u16* Hs = shm;
#pragma unroll
    for (int ai = 0; ai < 2; ++ai)
#pragma unroll
      for (int m = 0; m < 4; ++m)
#pragma unroll
        for (int j = 0; j < 4; ++j) {
          const int rl = ai * 128 + wr * 64 + m * 16 + fq * 4 + j;
          const float rstd = rsqrtf(rowss[brow + rl] * (1.f / 1024.f) + EPS);
#pragma unroll
          for (int n = 0; n < 2; ++n) {
            float g = acc[ai][0][m][n][j] * rstd + bg[n], u = acc[ai][1][m][n][j] * rstd + bu[n];
            float h = g / (1.f + __expf(-g)) * u;
            Hs[rl * 136 + hcl + n * 16] = f2bf(h);
          }
        }
    __syncthreads();
#pragma unroll
    for (int i = 0; i < 8; ++i) {
      const int q = tid + 512 * i, r = q >> 4, c = q & 15;
      const u32x4 v = *(const u32x4*)(Hs + r * 136 + c * 8);
      *(u32x4*)(H + (size_t)(brow + r) * DFF + (bcol >> 1) + c * 8) = v;
    }
  } else if (EPI == EPI_RESID) {
    float* x = p->out + O_X;
    const float* mod = (const float*)(p->ws + OFF_MOD);
    u16* xn = (u16*)(p->ws + OFF_XN);
    float* rowss = (float*)(p->ws + OFF_ROWSS) + (size_t)nid * MTOK;
    const int cnd = cond_of(brow);
    const bool has_next = nid < 6;
    const int ln = (nid % 6) / 3, wn = nid % 3;
    const int col4 = bcol + lane * 4;
    float4 gt4 = *(const float4*)(mod + (l * 3 + cnd) * 9216 + gchunk * 1024 + col4);
    gt4.x *= coef; gt4.y *= coef; gt4.z *= coef; gt4.w *= coef;
    float4 gs4 = make_float4(0.f, 0.f, 0.f, 0.f);
    if (has_next) {
      const float4 ng = *(const float4*)(p->in[(ln ? I_L1 : I_L0) + L_NORM] + wn * 1024 + col4);
      const float4 sc = *(const float4*)(mod + (ln * 3 + cnd) * 9216 + (3 * wn + 1) * 1024 + col4);
      gs4 = make_float4(ng.x * (1.f + sc.x), ng.y * (1.f + sc.y), ng.z * (1.f + sc.z), ng.w * (1.f + sc.w));
    }
    float* Cs = (float*)shm;
    float4 xv0[16], xv1[16];
#pragma unroll
    for (int i = 0; i < 16; ++i) xv0[i] = *(const float4*)(x + (size_t)(brow + wid + 8 * i) * D + col4);
#pragma unroll
    for (int bj = 0; bj < 2; ++bj)
#pragma unroll
      for (int m = 0; m < 4; ++m)
#pragma unroll
        for (int n = 0; n < 2; ++n)
#pragma unroll
          for (int j = 0; j < 4; ++j)
            Cs[(wr * 64 + m * 16 + fq * 4 + j) * 260 + bj * 128 + wc * 32 + n * 16 + fr] = acc[0][bj][m][n][j];
    __syncthreads();
#pragma unroll
    for (int ai = 0; ai < 2; ++ai) {
      if (ai) {
#pragma unroll
        for (int i = 0; i < 16; ++i) xv1[i] = *(const float4*)(x + (size_t)(brow + 128 + wid + 8 * i) * D + col4);
        __syncthreads();
#pragma unroll
        for (int bj = 0; bj < 2; ++bj)
#pragma unroll
          for (int m = 0; m < 4; ++m)
#pragma unroll
            for (int n = 0; n < 2; ++n)
#pragma unroll
              for (int j = 0; j < 4; ++j)
                Cs[(wr * 64 + m * 16 + fq * 4 + j) * 260 + bj * 128 + wc * 32 + n * 16 + fr] = acc[1][bj][m][n][j];
        __syncthreads();
      }
#pragma unroll
      for (int i = 0; i < 16; ++i) {
        const int r = wid + 8 * i;
        const int row = brow + ai * 128 + r;
        const float4 a = *(const float4*)(Cs + r * 260 + lane * 4);
        float4 xv = ai ? xv1[i] : xv0[i];
        xv.x += gt4.x * a.x; xv.y += gt4.y * a.y; xv.z += gt4.z * a.z; xv.w += gt4.w * a.w;
        *(float4*)(x + (size_t)row * D + col4) = xv;
        float ss = xv.x * xv.x + xv.y * xv.y + xv.z * xv.z + xv.w * xv.w;
        if (has_next) *(uint2*)(xn + (size_t)row * D + col4) = make_uint2(pack2(xv.x * gs4.x, xv.y * gs4.y), pack2(xv.z * gs4.z, xv.w * gs4.w));
        ss = wave_sum(ss);
        if (lane == 0 && nid < 7) unsafeAtomicAdd(rowss + row, ss);
      }
    }
  } else {
    u16* proj = (u16*)(p->ws + OFF_HP);
    u16* Pst = shm;
    const bool isctx = brow < NCTX;
    const int c0 = bcol + wc * 64;
    const float* rc = (const float*)(p->ws + OFF_ROPE);
    const float* rowss = (const float*)(p->ws + OFF_ROWSS) + (size_t)nid * MTOK;
    const float* bias = (const float*)(p->ws + OFF_BIAS) + (size_t)(nid * 3 + cond_of(brow)) * NFF;
    float bz[2][2];
#pragma unroll
    for (int bj = 0; bj < 2; ++bj)
#pragma unroll
      for (int n = 0; n < 2; ++n) { int col = c0 + bj * 32 + n * 16 + fr; bz[bj][n] = (col < ((EPI == EPI_MIX0) ? P0N : P1N)) ? bias[col] : 0.f; }
    bool do_norm = false, do_rope = false;
    const float* ng = nullptr;
    float* o32 = nullptr; int ostr = 0;
    bool elementwise = false;
    if (EPI == EPI_MIX0) {
      if (c0 < 512) { do_norm = true; ng = p->in[I_L0 + L_X0]; do_rope = !isctx; }
      else if (c0 < 640) { do_norm = true; ng = p->in[I_L0 + L_X0] + 64; do_rope = !isctx; if (isctx) { o32 = p->out + O_K0 + (c0 - 512); ostr = 128; } }
      else if (c0 < 768) { if (isctx) { o32 = p->out + O_V0 + (c0 - 640); ostr = 128; } }
      else if (c0 >= 2304) elementwise = true;
    } else {
      if (c0 < 512) {}
      else if (c0 < 1024) { if (isctx) { o32 = p->out + O_KC1 + (c0 - 512); ostr = 512; } }
      else if (c0 < 1536) { if (isctx) { o32 = p->out + O_VC1 + (c0 - 1024); ostr = 512; } }
      else if (c0 < 2048) { do_rope = !isctx; }
      else if (c0 < 2176) { do_rope = !isctx; if (isctx) { o32 = p->out + O_KD1 + (c0 - 2048); ostr = 128; } }
      else { if (isctx) { o32 = p->out + O_VD1 + (c0 - 2176); ostr = 128; } }
    }
    if (elementwise) {
      float* gates = (float*)(p->ws + OFF_GATES);
      const float* gb = p->in[I_L0 + L_X1];
#pragma unroll
      for (int ai = 0; ai < 2; ++ai)
#pragma unroll
        for (int m = 0; m < 4; ++m)
#pragma unroll
          for (int j = 0; j < 4; ++j) {
            int row = brow + ai * 128 + wr * 64 + m * 16 + fq * 4 + j;
            const float rstd = rsqrtf(rowss[row] * (1.f / 1024.f) + EPS);
#pragma unroll
            for (int bj = 0; bj < 2; ++bj)
#pragma unroll
              for (int n = 0; n < 2; ++n) {
                int col = c0 + bj * 32 + n * 16 + fr;
                float v = acc[ai][bj][m][n][j] * rstd + bz[bj][n];
                if (col < 2336) gates[(size_t)row * 32 + (col - 2304)] = v + gb[col - 2304];
                else if (col < P0N) Pst[(row - brow) * 264 + (col - bcol)] = f2bf(v);
              }
          }
    } else {
#pragma unroll
      for (int ai = 0; ai < 2; ++ai)
#pragma unroll
        for (int m = 0; m < 4; ++m)
#pragma unroll
          for (int j = 0; j < 4; ++j) {
            int row = brow + ai * 128 + wr * 64 + m * 16 + fq * 4 + j;
            const float rstd0 = rsqrtf(rowss[row] * (1.f / 1024.f) + EPS);
            float v0 = acc[ai][0][m][0][j] * rstd0 + bz[0][0], v1 = acc[ai][0][m][1][j] * rstd0 + bz[0][1];
            float v2 = acc[ai][1][m][0][j] * rstd0 + bz[1][0], v3 = acc[ai][1][m][1][j] * rstd0 + bz[1][1];
            if (do_norm) {
              float ss = v0 * v0 + v1 * v1 + v2 * v2 + v3 * v3;
              ss = grp16_sum(ss);
              float rstd = rsqrtf(ss * (1.f / 64.f) + EPS);
              v0 = v0 * rstd * ng[fr]; v1 = v1 * rstd * ng[16 + fr]; v2 = v2 * rstd * ng[32 + fr]; v3 = v3 * rstd * ng[48 + fr];
            }
            if (do_rope) {
              int tk = (row - NCTX) & 1023;
              float ca = rc[tk * 32 + fr], sa = rc[32768 + tk * 32 + fr];
              float cb = rc[tk * 32 + 16 + fr], sb = rc[32768 + tk * 32 + 16 + fr];
              float a0 = v0 * ca - v2 * sa, a2 = v2 * ca + v0 * sa;
              float a1 = v1 * cb - v3 * sb, a3 = v3 * cb + v1 * sb;
              v0 = a0; v1 = a1; v2 = a2; v3 = a3;
            }
            u16* pr = Pst + (row - brow) * 264 + (c0 - bcol) + fr;
            pr[0] = f2bf(v0); pr[16] = f2bf(v1); pr[32] = f2bf(v2); pr[48] = f2bf(v3);
            if (o32) {
              float* o = o32 + (size_t)row * ostr + fr;
              o[0] = v0; o[16] = v1; o[32] = v2; o[48] = v3;
            }
          }
    }
    __syncthreads();
#pragma unroll 1
    for (int i = 0; i < 16; ++i) {
      const int q = tid + 512 * i, r = q >> 5, c = q & 31;
      const int col = bcol + c * 8;
      if (col < PSTR) *(u32x4*)(proj + (size_t)(brow + r) * PSTR + col) = *(const u32x4*)(Pst + r * 264 + c * 8);
    }
  }
}

template <int EPI>
__device__ __forceinline__ void gemm_phase(CP p, const u16* A, const u16* Bt, int K, int nN, int l, int gchunk, float coef, int nid, u16* smem, int side = 0) {
  const int tid = get_tid();
  const int nM = MTOK / BM, nwg = nM * nN;
  for (int t = blockIdx.x; t < nwg; t += gridDim.x) {
    int wgid = t;
    { int q = nwg / NXCD, r = nwg % NXCD, xcd = wgid % NXCD, off = wgid / NXCD;
      wgid = (xcd < r ? xcd * (q + 1) : r * (q + 1) + (xcd - r) * q) + off; }
    int nig = WGM * nN, gid = wgid / nig, fm = gid * WGM, gsz = min(nM - fm, WGM);
    int pm = fm + ((wgid % nig) % gsz), pn = (wgid % nig) / gsz;
    gemm256_tile<EPI>(p, A, Bt, K, pm * BM, pn * BM, l, gchunk, coef, nid, smem, tid);
  }
  if (EPI == EPI_RESID && side) { __syncthreads(); conv_side_job(p, side, nwg, (float*)smem); }
}

__device__ __forceinline__ void load_tile_bf16(float* dst, const u16* src, long rstride, float scale, int tid) {
  int r = tid >> 2, part = tid & 3;
  const uint4* s = (const uint4*)(src + (long)r * rstride + part * 16);
  uint4 a = s[0], b = s[1];
  float4* d = (float4*)(dst + r * TS + part * 16);
  d[0] = make_float4(bflo(a.x) * scale, bfhi(a.x) * scale, bflo(a.y) * scale, bfhi(a.y) * scale);
  d[1] = make_float4(bflo(a.z) * scale, bfhi(a.z) * scale, bflo(a.w) * scale, bfhi(a.w) * scale);
  d[2] = make_float4(bflo(b.x) * scale, bfhi(b.x) * scale, bflo(b.y) * scale, bfhi(b.y) * scale);
  d[3] = make_float4(bflo(b.z) * scale, bfhi(b.z) * scale, bflo(b.w) * scale, bfhi(b.w) * scale);
}
__device__ __forceinline__ void tile_ld_regs(const u16* src, long rstride, int tid, uint4& a, uint4& b) {
  int r = tid >> 2, part = tid & 3;
  const uint4* s = (const uint4*)(src + (long)r * rstride + part * 16);
  a = s[0]; b = s[1];
}
__device__ __forceinline__ void tile_st_regs(float* dst, int tid, const uint4& a, const uint4& b, float scale) {
  int r = tid >> 2, part = tid & 3;
  float4* d = (float4*)(dst + r * TS + part * 16);
  d[0] = make_float4(bflo(a.x) * scale, bfhi(a.x) * scale, bflo(a.y) * scale, bfhi(a.y) * scale);
  d[1] = make_float4(bflo(a.z) * scale, bfhi(a.z) * scale, bflo(a.w) * scale, bfhi(a.w) * scale);
  d[2] = make_float4(bflo(b.x) * scale, bfhi(b.x) * scale, bflo(b.y) * scale, bfhi(b.y) * scale);
  d[3] = make_float4(bflo(b.z) * scale, bfhi(b.z) * scale, bflo(b.w) * scale, bfhi(b.w) * scale);
}
__device__ __forceinline__ void load_tile_f32(float* dst, const float* src, long rstride, int tid) {
  int r = tid >> 2, part = tid & 3;
  const float4* s = (const float4*)(src + (long)r * rstride + part * 16);
  float4* d = (float4*)(dst + r * TS + part * 16);
  d[0] = s[0]; d[1] = s[1]; d[2] = s[2]; d[3] = s[3];
}
typedef __attribute__((ext_vector_type(2))) float f32x2;
__device__ __forceinline__ void qk_micro(const float* Qs, const float* Ks, int ty, int tx, float s[4][4]) {
  f32x2 s2[4][4];
#pragma unroll
  for (int i = 0; i < 4; ++i)
#pragma unroll
    for (int j = 0; j < 4; ++j) s2[i][j] = (f32x2){0.f, 0.f};
#pragma unroll 2
  for (int d4 = 0; d4 < 16; ++d4) {
    f32x4 q[4], k[4];
#pragma unroll
    for (int i = 0; i < 4; ++i) q[i] = *(const f32x4*)(Qs + (ty * 4 + i) * TS + d4 * 4);
#pragma unroll
    for (int j = 0; j < 4; ++j) k[j] = *(const f32x4*)(Ks + (tx + 16 * j) * TS + d4 * 4);
#pragma unroll
    for (int i = 0; i < 4; ++i)
#pragma unroll
      for (int j = 0; j < 4; ++j) {
        s2[i][j] += q[i].xy * k[j].xy;
        s2[i][j] += q[i].zw * k[j].zw;
      }
  }
#pragma unroll
  for (int i = 0; i < 4; ++i)
#pragma unroll
    for (int j = 0; j < 4; ++j) s[i][j] = s2[i][j].x + s2[i][j].y;
}
__device__ __forceinline__ void pv_micro(const float* Ps, const float* Vs, int ty, int tx, float o[4][4]) {
  f32x2 oa[4], ob[4];
#pragma unroll
  for (int i = 0; i < 4; ++i) { oa[i] = (f32x2){o[i][0], o[i][1]}; ob[i] = (f32x2){o[i][2], o[i][3]}; }
#pragma unroll 2
  for (int s4 = 0; s4 < 16; ++s4) {
    f32x4 pp[4], v[4];
#pragma unroll
    for (int i = 0; i < 4; ++i) pp[i] = *(const f32x4*)(Ps + (ty * 4 + i) * TS + s4 * 4);
#pragma unroll
    for (int q = 0; q < 4; ++q) v[q] = *(const f32x4*)(Vs + (s4 * 4 + q) * TS + tx * 4);
#pragma unroll
    for (int i = 0; i < 4; ++i)
#pragma unroll
      for (int q = 0; q < 4; ++q) {
        const float ps = pp[i][q];
        const f32x2 p2 = (f32x2){ps, ps};
        oa[i] += p2 * v[q].xy;
        ob[i] += p2 * v[q].zw;
      }
  }
#pragma unroll
  for (int i = 0; i < 4; ++i) { o[i][0] = oa[i].x; o[i][1] = oa[i].y; o[i][2] = ob[i].x; o[i][3] = ob[i].y; }
}

struct AttnDesc {
  int qrow0, qcol, ocol;
  const float* ck; const float* cv; int cstride; int nctx;
  int krow0, nloc, kcol, vcol;
  int mode;
  int a0;
  int r0;
  const float* rpb;
  float sink; int has_sink;
};

constexpr int AS_ = 72;
__device__ __forceinline__ void attn_item(CP p, const AttnDesc& d, float* sm) {
  const int tid = get_tid(), w = tid >> 6, lane = tid & 63, fr = lane & 15, fq = lane >> 4, half = w >> 2;
  const u16* proj = (const u16*)(p->ws + OFF_HP);
  u16* Ks = (u16*)sm;
  u16* Vt = Ks + 64 * AS_;
  u16* Ps = Vt + 64 * AS_ + w * (16 * AS_);
  bf16x8 qf[2];
  {
    const u16* qp = proj + (size_t)(d.qrow0 + w * 16 + fr) * PSTR + d.qcol + fq * 8;
    qf[0] = *(const bf16x8*)(qp);
    qf[1] = *(const bf16x8*)(qp + 32);
  }
  float m_i[4], l_i[4];
  f32x4 o[4];
#pragma unroll
  for (int j = 0; j < 4; ++j) {
    m_i[j] = d.has_sink ? d.sink : -1e30f;
    l_i[j] = (d.has_sink && fr == 0) ? 1.f : 0.f;
  }
#pragma unroll
  for (int n = 0; n < 4; ++n) o[n] = (f32x4){0.f, 0.f, 0.f, 0.f};
  const int ntiles = d.nctx + d.nloc;
  const int lrow = tid >> 3, lc8 = tid & 7;
  float4 kf0, kf1, vf0, vf1;
  u32x4 kq, vq;
  auto issue = [&](int tile) {
    if (tile < d.nctx) {
      const size_t off = (size_t)(tile * 64 + lrow) * d.cstride + lc8 * 8;
      kf0 = *(const float4*)(d.ck + off); kf1 = *(const float4*)(d.ck + off + 4);
      vf0 = *(const float4*)(d.cv + off); vf1 = *(const float4*)(d.cv + off + 4);
    } else {
      const u16* base = proj + (size_t)(d.krow0 + (tile - d.nctx) * 64 + lrow) * PSTR + lc8 * 8;
      kq = *(const u32x4*)(base + d.kcol);
      vq = *(const u32x4*)(base + d.vcol);
    }
  };
  issue(0);
  for (int tile = 0; tile < ntiles; ++tile) {
    __syncthreads();
    if (tile < d.nctx) {
      kq = (u32x4){pack2(kf0.x, kf0.y), pack2(kf0.z, kf0.w), pack2(kf1.x, kf1.y), pack2(kf1.z, kf1.w)};
      vq = (u32x4){pack2(vf0.x, vf0.y), pack2(vf0.z, vf0.w), pack2(vf1.x, vf1.y), pack2(vf1.z, vf1.w)};
    }
    *(u32x4*)(Ks + lrow * AS_ + lc8 * 8) = kq;
    {
      u16* vt = Vt + (lc8 * 8) * AS_ + lrow;
      vt[0 * AS_] = (u16)(vq.x & 0xffff); vt[1 * AS_] = (u16)(vq.x >> 16);
      vt[2 * AS_] = (u16)(vq.y & 0xffff); vt[3 * AS_] = (u16)(vq.y >> 16);
      vt[4 * AS_] = (u16)(vq.z & 0xffff); vt[5 * AS_] = (u16)(vq.z >> 16);
      vt[6 * AS_] = (u16)(vq.w & 0xffff); vt[7 * AS_] = (u16)(vq.w >> 16);
    }
    __syncthreads();
    if (tile + 1 < ntiles) issue(tile + 1);
    const int lt = tile - d.nctx;
    f32x4 sacc[4];
#pragma unroll
    for (int n = 0; n < 4; ++n) sacc[n] = (f32x4){0.f, 0.f, 0.f, 0.f};
#pragma unroll
    for (int ks = 0; ks < 2; ++ks)
#pragma unroll
      for (int n = 0; n < 4; ++n) {
        bf16x8 kb = *(const bf16x8*)(Ks + (n * 16 + fr) * AS_ + ks * 32 + fq * 8);
        sacc[n] = __builtin_amdgcn_mfma_f32_16x16x32_bf16(qf[ks], kb, sacc[n], 0, 0, 0);
      }
    float sv[4][4];
#pragma unroll
    for (int n = 0; n < 4; ++n)
#pragma unroll
      for (int j = 0; j < 4; ++j) sv[j][n] = sacc[n][j] * 0.125f;
    if (lt >= 0 && d.mode == 1) {
      const int rq = d.a0 + half;
      const int kr = d.r0 + lt;
      const int rq0 = min(max(rq - 4, 0), 8);
      const bool rowok = (kr >= rq0) && (kr < rq0 + 8);
      const int dy = min(max(kr - rq + 7, 0), 14);
      const float* rp = d.rpb + dy * 31;
#pragma unroll
      for (int j = 0; j < 4; ++j) {
        int qc = (w & 3) * 16 + fq * 4 + j;
        int ws = min(max(qc - 8, 0), 48);
#pragma unroll
        for (int n = 0; n < 4; ++n) {
          int kc = n * 16 + fr;
          bool ok = rowok && (kc >= ws) && (kc < ws + 16);
          int dx = min(max(kc - qc + 15, 0), 30);
          sv[j][n] = ok ? sv[j][n] + rp[dx] : -1e30f;
        }
      }
    } else if (lt >= 0 && d.mode == 2) {
      const int off = d.a0 + lt * 64 - half * 64;
#pragma unroll
      for (int j = 0; j < 4; ++j)
#pragma unroll
        for (int n = 0; n < 4; ++n) {
          int dd = off + (n * 16 + fr) - ((w & 3) * 16 + fq * 4 + j);
          bool ok = (dd <= 128) && (dd >= -128);
          sv[j][n] = ok ? sv[j][n] : -1e30f;
        }
    }
#pragma unroll
    for (int j = 0; j < 4; ++j) {
      float mx = fmaxf(fmaxf(sv[j][0], sv[j][1]), fmaxf(sv[j][2], sv[j][3]));
      mx = grp16_max(mx);
      float mn = fmaxf(m_i[j], mx);
      float alpha = __expf(m_i[j] - mn);
      float rs = 0.f;
#pragma unroll
      for (int n = 0; n < 4; ++n) {
        float pj = __expf(sv[j][n] - mn);
        rs += pj;
        Ps[(fq * 4 + j) * AS_ + n * 16 + fr] = f2bf(pj);
      }
      l_i[j] = l_i[j] * alpha + rs;
      m_i[j] = mn;
#pragma unroll
      for (int n = 0; n < 4; ++n) o[n][j] *= alpha;
    }
    __builtin_amdgcn_wave_barrier();
#pragma unroll
    for (int ks = 0; ks < 2; ++ks) {
      bf16x8 pa = *(const bf16x8*)(Ps + fr * AS_ + ks * 32 + fq * 8);
#pragma unroll
      for (int n = 0; n < 4; ++n) {
        bf16x8 vb = *(const bf16x8*)(Vt + (n * 16 + fr) * AS_ + ks * 32 + fq * 8);
        o[n] = __builtin_amdgcn_mfma_f32_16x16x32_bf16(pa, vb, o[n], 0, 0, 0);
      }
    }
    __builtin_amdgcn_wave_barrier();
  }
  u16* ymix = (u16*)(p->ws + OFF_YMIX);
#pragma unroll
  for (int j = 0; j < 4; ++j) {
    float inv = 1.f / grp16_sum(l_i[j]);
    u16* yp = ymix + (size_t)(d.qrow0 + w * 16 + fq * 4 + j) * D + d.ocol + fr;
#pragma unroll
    for (int n = 0; n < 4; ++n) yp[n * 16] = f2bf(o[n][j] * inv);
  }
}

constexpr int ST_SLOT = 65 * 64;
__device__ __forceinline__ int st_slot(int isctx, int b, int dir, int head, int cc) {
  int ch = (b * 2 + dir) * 8 + head;
  return isctx ? (ch * 4 + cc) : (2048 + ch * 16 + cc);
}
__device__ __forceinline__ void unpack16(const uint4& a, const uint4& b, float v[16]) {
  v[0] = bflo(a.x); v[1] = bfhi(a.x); v[2] = bflo(a.y); v[3] = bfhi(a.y); v[4] = bflo(a.z); v[5] = bfhi(a.z); v[6] = bflo(a.w); v[7] = bfhi(a.w);
  v[8] = bflo(b.x); v[9] = bfhi(b.x); v[10] = bflo(b.y); v[11] = bfhi(b.y); v[12] = bflo(b.z); v[13] = bfhi(b.z); v[14] = bflo(b.w); v[15] = bfhi(b.w);
}
__device__ __forceinline__ void store_t16(u16* dstT, int s, const uint4& a, const uint4& b) {
  dstT[0 * 72 + s] = (u16)(a.x & 0xffff); dstT[1 * 72 + s] = (u16)(a.x >> 16); dstT[2 * 72 + s] = (u16)(a.y & 0xffff); dstT[3 * 72 + s] = (u16)(a.y >> 16);
  dstT[4 * 72 + s] = (u16)(a.z & 0xffff); dstT[5 * 72 + s] = (u16)(a.z >> 16); dstT[6 * 72 + s] = (u16)(a.w & 0xffff); dstT[7 * 72 + s] = (u16)(a.w >> 16);
  dstT[8 * 72 + s] = (u16)(b.x & 0xffff); dstT[9 * 72 + s] = (u16)(b.x >> 16); dstT[10 * 72 + s] = (u16)(b.y & 0xffff); dstT[11 * 72 + s] = (u16)(b.y >> 16);
  dstT[12 * 72 + s] = (u16)(b.z & 0xffff); dstT[13 * 72 + s] = (u16)(b.z >> 16); dstT[14 * 72 + s] = (u16)(b.w & 0xffff); dstT[15 * 72 + s] = (u16)(b.w >> 16);
}

__device__ __forceinline__ void mlstm_state_item(CP p, int isctx, int b, int head, float* sm) {
  const int tid = get_tid(), dir = tid >> 8, t = tid & 255, w4 = t >> 6, lane = t & 63, fr = lane & 15, fq = lane >> 4;
  const u16* proj = (const u16*)(p->ws + OFF_HP);
  const float* gates = (const float*)(p->ws + OFF_GATES);
  u16* stCt = (u16*)(p->ws + OFF_STC);
  float* stm = (float*)(p->ws + OFF_STM);
  u16* KtW = (u16*)sm + dir * (2 * 64 * 72);
  u16* Vt = KtW + 64 * 72;
  const int nc = isctx ? 4 : 16, L = isctx ? 256 : 1024;
  const int seq0 = isctx ? b * 256 : NCTX + b * 1024;
  const int ch = (b * 2 + dir) * 8 + head;
  f32x4 cacc[4], nacc;
  float m;
  if (isctx) {
#pragma unroll
    for (int nt = 0; nt < 4; ++nt) cacc[nt] = (f32x4){0.f, 0.f, 0.f, 0.f};
    nacc = (f32x4){0.f, 0.f, 0.f, 0.f};
    m = 0.f;
  } else {
    const float* C0 = p->in[I_SC] + (size_t)ch * 4096;
#pragma unroll
    for (int nt = 0; nt < 4; ++nt)
#pragma unroll
      for (int j = 0; j < 4; ++j) cacc[nt][j] = C0[(w4 * 16 + fq * 4 + j) * 64 + nt * 16 + fr];
#pragma unroll
    for (int j = 0; j < 4; ++j) nacc[j] = p->in[I_SN][ch * 64 + w4 * 16 + fq * 4 + j];
    m = p->in[I_SM][ch];
  }
  const bf16x8 ones = (bf16x8){0x3F80, 0x3F80, 0x3F80, 0x3F80, 0x3F80, 0x3F80, 0x3F80, 0x3F80};
  const int srow = t >> 2, part = t & 3;
  uint4 ka, kb, va, vb;
  float g_li, g_fp;
  auto prefetch = [&](int cc) {
    const int tok0 = dir ? (L - 1 - cc * 64) : cc * 64;
    const long rs = dir ? -(long)PSTR : (long)PSTR;
    const u16* base = proj + (size_t)(seq0 + tok0) * PSTR;
    tile_ld_regs(base + 1280 + head * 64, rs, t, ka, kb);
    tile_ld_regs(base + 1792 + head * 64, rs, t, va, vb);
    const int tr = seq0 + (dir ? tok0 - lane : tok0 + lane);
    g_li = gates[(size_t)tr * 32 + (dir * 2) * 8 + head];
    g_fp = gates[(size_t)tr * 32 + (dir * 2 + 1) * 8 + head];
  };
  prefetch(0);
  for (int cc = 0; cc < nc; ++cc) {
    const int slot = st_slot(isctx, b, dir, head, cc);
#pragma unroll
    for (int nt = 0; nt < 4; ++nt)
      *(uint2*)(stCt + (size_t)slot * ST_SLOT + (nt * 16 + fr) * 64 + w4 * 16 + fq * 4) = make_uint2(pack2(cacc[nt][0], cacc[nt][1]), pack2(cacc[nt][2], cacc[nt][3]));
    if (fr == 0) *(uint2*)(stCt + (size_t)slot * ST_SLOT + 64 * 64 + w4 * 16 + fq * 4) = make_uint2(pack2(nacc[0], nacc[1]), pack2(nacc[2], nacc[3]));
    if (t == 0) stm[slot] = m;
    const float lf = logsigmoidf_(g_fp);
    const float bb = wave_scan_add(lf, lane);
    const float a = g_li - bb;
    const float amax = wave_max(a);
    const float blast = __shfl(bb, 63);
    const float mnew = blast + fmaxf(m, amax);
    const float wsv = expf(blast + a - mnew);
    const float wc = expf(blast + m - mnew);
    const float ws_row = __shfl(wsv, (w4 * 16 + (lane >> 2))) * 0.125f;
    __syncthreads();
    {
      float kv[16];
      unpack16(ka, kb, kv);
      u16* dk = KtW + (part * 16) * 72 + srow;
#pragma unroll
      for (int e = 0; e < 16; ++e) dk[e * 72] = f2bf(kv[e] * ws_row);
      store_t16(Vt + (part * 16) * 72, srow, va, vb);
    }
    __syncthreads();
    if (cc + 1 < nc) prefetch(cc + 1);
#pragma unroll
    for (int nt = 0; nt < 4; ++nt) { cacc[nt][0] *= wc; cacc[nt][1] *= wc; cacc[nt][2] *= wc; cacc[nt][3] *= wc; }
    nacc[0] *= wc; nacc[1] *= wc; nacc[2] *= wc; nacc[3] *= wc;
#pragma unroll
    for (int ks = 0; ks < 2; ++ks) {
      const bf16x8 af = *(const bf16x8*)(KtW + (w4 * 16 + fr) * 72 + ks * 32 + fq * 8);
#pragma unroll
      for (int nt = 0; nt < 4; ++nt) {
        const bf16x8 bfv = *(const bf16x8*)(Vt + (nt * 16 + fr) * 72 + ks * 32 + fq * 8);
        cacc[nt] = __builtin_amdgcn_mfma_f32_16x16x32_bf16(af, bfv, cacc[nt], 0, 0, 0);
      }
      nacc = __builtin_amdgcn_mfma_f32_16x16x32_bf16(af, ones, nacc, 0, 0, 0);
    }
    m = mnew;
  }
  __syncthreads();
  if (isctx) {
    float* Co = p->out + O_C + (size_t)ch * 4096;
#pragma unroll
    for (int nt = 0; nt < 4; ++nt)
#pragma unroll
      for (int j = 0; j < 4; ++j) Co[(w4 * 16 + fq * 4 + j) * 64 + nt * 16 + fr] = cacc[nt][j];
    if (fr == 0) {
#pragma unroll
      for (int j = 0; j < 4; ++j) p->out[O_N + ch * 64 + w4 * 16 + fq * 4 + j] = nacc[j];
    }
    if (t == 0) p->out[O_M + ch] = m;
  }
}

__device__ __forceinline__ void mlstm_out_item(CP p, int isctx, int b, int head, int c, float* sm) {
  const int tid = get_tid(), dir = tid >> 8, t = tid & 255, w4 = t >> 6, lane = t & 63, fr = lane & 15, fq = lane >> 4;
  const u16* proj = (const u16*)(p->ws + OFF_HP);
  const float* gates = (const float*)(p->ws + OFF_GATES);
  const u16* stCt = (const u16*)(p->ws + OFF_STC);
  const float* stm = (const float*)(p->ws + OFF_STM);
  constexpr int HALF16 = 64 * 72 * 2 + 80 * 72 + 4 * 16 * 72;
  u16* Ks = (u16*)sm + dir * HALF16;
  u16* Vt = Ks + 64 * 72;
  u16* Cts = Vt + 64 * 72;
  u16* Ws = Cts + 80 * 72 + w4 * (16 * 72);
  float* Hs = (float*)((u16*)sm + 2 * HALF16);
  const int nc = isctx ? 4 : 16;
  const int mb = (isctx ? b * 256 : NCTX + b * 1024) + c * 64;
  const int cc = dir ? nc - 1 - c : c;
  const int slot = st_slot(isctx, b, dir, head, cc);
  const float m0 = stm[slot];
  const int srow = t >> 2, part = t & 3;
  uint4 ka, kb, va, vb;
  {
    const long rs = dir ? -(long)PSTR : (long)PSTR;
    const u16* base = proj + (size_t)(mb + (dir ? 63 : 0)) * PSTR;
    tile_ld_regs(base + 1280 + head * 64, rs, t, ka, kb);
    tile_ld_regs(base + 1792 + head * 64, rs, t, va, vb);
  }
  u32x4 c0v, c1v, c2v;
  {
    const u16* cs = stCt + (size_t)slot * ST_SLOT;
    c0v = *(const u32x4*)(cs + t * 8);
    c1v = *(const u32x4*)(cs + (t + 256) * 8);
    c2v = (t < 8) ? *(const u32x4*)(cs + (t + 512) * 8) : (u32x4){0u, 0u, 0u, 0u};
  }
  bf16x8 qf[2];
  {
    const int tq = w4 * 16 + fr;
    const u16* qp = proj + (size_t)(mb + (dir ? 63 - tq : tq)) * PSTR + 768 + head * 64 + fq * 8;
    qf[0] = *(const bf16x8*)(qp);
    qf[1] = *(const bf16x8*)(qp + 32);
  }
  float a, M, bb;
  {
    const int tr = mb + (dir ? 63 - lane : lane);
    const float li = gates[(size_t)tr * 32 + (dir * 2) * 8 + head];
    const float fp = gates[(size_t)tr * 32 + (dir * 2 + 1) * 8 + head];
    const float lf = logsigmoidf_(fp);
    bb = wave_scan_add(lf, lane);
    a = li - bb;
    M = fmaxf(m0, wave_scan_max(a, lane));
  }
  __syncthreads();
  *(uint4*)(Ks + srow * 72 + part * 16) = ka;
  *(uint4*)(Ks + srow * 72 + part * 16 + 8) = kb;
  store_t16(Vt + (part * 16) * 72, srow, va, vb);
  *(u32x4*)(Cts + (t >> 3) * 72 + (t & 7) * 8) = c0v;
  *(u32x4*)(Cts + ((t + 256) >> 3) * 72 + (t & 7) * 8) = c1v;
  if (t < 8) *(u32x4*)(Cts + 64 * 72 + t * 8) = c2v;
  __syncthreads();
  f32x4 sacc[4];
#pragma unroll
  for (int nt = 0; nt < 4; ++nt) sacc[nt] = (f32x4){0.f, 0.f, 0.f, 0.f};
#pragma unroll
  for (int ks = 0; ks < 2; ++ks)
#pragma unroll
    for (int nt = 0; nt < 4; ++nt) {
      const bf16x8 kf = *(const bf16x8*)(Ks + (nt * 16 + fr) * 72 + ks * 32 + fq * 8);
      sacc[nt] = __builtin_amdgcn_mfma_f32_16x16x32_bf16(qf[ks], kf, sacc[nt], 0, 0, 0);
    }
  float a_s[4], M_t[4], b_t[4], rs[4];
#pragma unroll
  for (int nt = 0; nt < 4; ++nt) a_s[nt] = __shfl(a, nt * 16 + fr);
#pragma unroll
  for (int j = 0; j < 4; ++j) { M_t[j] = __shfl(M, w4 * 16 + fq * 4 + j); b_t[j] = __shfl(bb, w4 * 16 + fq * 4 + j); rs[j] = 0.f; }
#pragma unroll
  for (int j = 0; j < 4; ++j) {
    const int tt = w4 * 16 + fq * 4 + j;
#pragma unroll
    for (int nt = 0; nt < 4; ++nt) {
      const int ss = nt * 16 + fr;
      const float w = (ss <= tt) ? expf(a_s[nt] - M_t[j]) * (sacc[nt][j] * 0.125f) : 0.f;
      rs[j] += w;
      Ws[(fq * 4 + j) * 72 + ss] = f2bf(w);
    }
  }
  __builtin_amdgcn_wave_barrier();
  f32x4 num[4], qc[4], qn;
#pragma unroll
  for (int nt = 0; nt < 4; ++nt) { num[nt] = (f32x4){0.f, 0.f, 0.f, 0.f}; qc[nt] = (f32x4){0.f, 0.f, 0.f, 0.f}; }
  qn = (f32x4){0.f, 0.f, 0.f, 0.f};
#pragma unroll
  for (int ks = 0; ks < 2; ++ks) {
    const bf16x8 wa = *(const bf16x8*)(Ws + fr * 72 + ks * 32 + fq * 8);
#pragma unroll
    for (int nt = 0; nt < 4; ++nt) {
      const bf16x8 vb8 = *(const bf16x8*)(Vt + (nt * 16 + fr) * 72 + ks * 32 + fq * 8);
      num[nt] = __builtin_amdgcn_mfma_f32_16x16x32_bf16(wa, vb8, num[nt], 0, 0, 0);
      const bf16x8 cb8 = *(const bf16x8*)(Cts + (nt * 16 + fr) * 72 + ks * 32 + fq * 8);
      qc[nt] = __builtin_amdgcn_mfma_f32_16x16x32_bf16(qf[ks], cb8, qc[nt], 0, 0, 0);
    }
    const bf16x8 nb8 = *(const bf16x8*)(Cts + 64 * 72 + ks * 32 + fq * 8);
    qn = __builtin_amdgcn_mfma_f32_16x16x32_bf16(qf[ks], nb8, qn, 0, 0, 0);
  }
  float hv[4][4];
#pragma unroll
  for (int j = 0; j < 4; ++j) {
    const float wi = expf(m0 - M_t[j]);
    const float den = grp16_sum(rs[j]) + wi * qn[j];
    const float mt = b_t[j] + M_t[j];
    const float inv = 1.f / fmaxf(fabsf(den), expf(-mt));
#pragma unroll
    for (int nt = 0; nt < 4; ++nt) hv[j][nt] = (num[nt][j] + wi * qc[nt][j]) * inv;
  }
  if (dir == 1) {
#pragma unroll
    for (int j = 0; j < 4; ++j)
#pragma unroll
      for (int nt = 0; nt < 4; ++nt) Hs[(63 - (w4 * 16 + fq * 4 + j)) * 68 + nt * 16 + fr] = hv[j][nt];
  }
  __syncthreads();
  if (dir == 0) {
    const float* hg = p->in[I_L0 + L_X2] + head * 64;
    u16* ymix = (u16*)(p->ws + OFF_YMIX);
#pragma unroll
    for (int j = 0; j < 4; ++j) {
      const int tt = w4 * 16 + fq * 4 + j;
      float h[4], ss = 0.f;
#pragma unroll
      for (int nt = 0; nt < 4; ++nt) { h[nt] = hv[j][nt] + Hs[tt * 68 + nt * 16 + fr]; ss += h[nt] * h[nt]; }
      ss = grp16_sum(ss);
      const float rstd = rsqrtf(ss * (1.f / 64.f) + EPS);
      const int tr = mb + tt;
#pragma unroll
      for (int nt = 0; nt < 4; ++nt) {
        const int v = nt * 16 + fr;
        const float ob = bflo((unsigned)proj[(size_t)tr * PSTR + 2336 + head * 64 + v]);
        ymix[(size_t)tr * D + 512 + head * 64 + v] = f2bf(sigmoidf_(ob) * (h[nt] * rstd * hg[v]));
      }
    }
  }
}

__device__ __forceinline__ int next_item(int* ctr, int* s_item) {
  __syncthreads();
  if (get_tid() == 0) *s_item = atomicAdd(ctr, 1);
  __syncthreads();
  return *s_item;
}

__device__ __forceinline__ void mix0_phase_a(CP p, float* sm, int* s_item, int coff) {
  int* ctr = (int*)(p->ws + OFF_CTR) + 0 + coff;
  for (;;) {
    int it = next_item(ctr, s_item);
    if (it >= 912) break;
    if (it >= 128 && it < 144) {
      int v = it - 128; int b = v >> 3, head = v & 7;
      mlstm_state_item(p, 0, b, head, sm);
    } else if (it >= 656) {
      int v = it - 656; int b = v >> 3, head = v & 7;
      mlstm_state_item(p, 1, b, head, sm);
    } else {
      AttnDesc d;
      d.mode = 0; d.a0 = 0; d.r0 = 0; d.rpb = nullptr; d.sink = 0.f; d.has_sink = 0;
      if (it < 128) {
        int b = it >> 6, h = (it >> 3) & 7, qb = it & 7;
        d.qrow0 = NCTX + b * 1024 + qb * 128; d.qcol = h * 64; d.ocol = h * 64;
        d.ck = p->in[I_C0K] + (size_t)b * 256 * 128 + (h >> 2) * 64; d.cv = p->in[I_C0V] + (size_t)b * 256 * 128 + (h >> 2) * 64;
        d.cstride = 128; d.nctx = 4;
        d.krow0 = NCTX + b * 1024; d.nloc = 16; d.kcol = 512 + (h >> 2) * 64; d.vcol = 640 + (h >> 2) * 64;
      } else {
        int v = it - 144; int b = v >> 4, h = (v >> 1) & 7, qb = v & 1;
        d.qrow0 = b * 256 + qb * 128; d.qcol = h * 64; d.ocol = h * 64;
        d.ck = nullptr; d.cv = nullptr; d.cstride = 0; d.nctx = 0;
        d.krow0 = b * 256; d.nloc = 4; d.kcol = 512 + (h >> 2) * 64; d.vcol = 640 + (h >> 2) * 64;
      }
      attn_item(p, d, sm);
    }
  }
}

__device__ __forceinline__ void mix0_phase_b(CP p, float* sm, int* s_item, int coff) {
  int* ctr = (int*)(p->ws + OFF_CTR) + 1 + coff;
  for (;;) {
    int it = next_item(ctr, s_item);
    if (it >= 1280) break;
    if (it < 256) {
      int b = it >> 7, head = (it >> 4) & 7, c = it & 15;
      mlstm_out_item(p, 0, b, head, c, sm);
    } else {
      int v = it - 256; int b = v >> 5, head = (v >> 2) & 7, c = v & 3;
      mlstm_out_item(p, 1, b, head, c, sm);
    }
  }
}

__device__ __forceinline__ void mix1_phase(CP p, float* sm, int* s_item, int coff) {
  int* ctr = (int*)(p->ws + OFF_CTR) + 2 + coff;
  const float* sink = p->in[I_L1 + L_X1];
  for (;;) {
    int it = next_item(ctr, s_item);
    if (it >= 1280) break;
    AttnDesc d;
    d.mode = 0; d.a0 = 0; d.r0 = 0; d.rpb = nullptr; d.sink = 0.f; d.has_sink = 0;
    if (it < 128) {
      int b = it >> 6, h = (it >> 3) & 7, r = (it & 7) * 2;
      int r0 = min(max(r - 4, 0), 8);
      int r1 = min(max(r + 1 - 4, 0), 8) + 8;
      d.qrow0 = NCTX + b * 1024 + r * 64; d.qcol = h * 64; d.ocol = h * 64;
      d.ck = p->in[I_NAK] + (size_t)b * 256 * 512 + h * 64; d.cv = p->in[I_NAV] + (size_t)b * 256 * 512 + h * 64;
      d.cstride = 512; d.nctx = 4;
      d.krow0 = NCTX + b * 1024 + r0 * 64; d.nloc = r1 - r0; d.kcol = 512 + h * 64; d.vcol = 1024 + h * 64;
      d.mode = 1; d.a0 = r; d.r0 = r0; d.rpb = p->in[I_L1 + L_X0] + h * 15 * 31;
    } else if (it < 256) {
      int v = it - 128; int b = v >> 6, h = (v >> 3) & 7, qb = v & 7;
      int t0 = qb * 128;
      int s0 = max(t0 - 128, 0);
      int s1 = min(t0 + 256, 1024);
      d.qrow0 = NCTX + b * 1024 + t0; d.qcol = 1536 + h * 64; d.ocol = 512 + h * 64;
      d.ck = p->in[I_SWK] + (size_t)b * 256 * 128 + (h >> 2) * 64; d.cv = p->in[I_SWV] + (size_t)b * 256 * 128 + (h >> 2) * 64;
      d.cstride = 128; d.nctx = 4;
      d.krow0 = NCTX + b * 1024 + s0; d.nloc = (s1 - s0) >> 6; d.kcol = 2048 + (h >> 2) * 64; d.vcol = 2176 + (h >> 2) * 64;
      d.mode = 2; d.a0 = s0 - t0;
      d.sink = sink[h]; d.has_sink = 1;
    } else if (it < 768) {
      int v = it - 256; int b = v >> 4, h = (v >> 1) & 7, qb = v & 1;
      d.qrow0 = b * 256 + qb * 128; d.qcol = h * 64; d.ocol = h * 64;
      d.ck = nullptr; d.cv = nullptr; d.cstride = 0; d.nctx = 0;
      d.krow0 = b * 256; d.nloc = 4; d.kcol = 512 + h * 64; d.vcol = 1024 + h * 64;
    } else {
      int v = it - 768; int b = v >> 4, h = (v >> 1) & 7, qb = v & 1;
      d.qrow0 = b * 256 + qb * 128; d.qcol = 1536 + h * 64; d.ocol = 512 + h * 64;
      d.ck = nullptr; d.cv = nullptr; d.cstride = 0; d.nctx = 0;
      d.krow0 = b * 256; d.nloc = 4; d.kcol = 2048 + (h >> 2) * 64; d.vcol = 2176 + (h >> 2) * 64;
      d.sink = sink[h]; d.has_sink = 1;
    }
    attn_item(p, d, sm);
  }
}

#define XB_TMO      128
#define XB_XCNT(j)  (256  + 64 * (j))
#define XB_XSUB(j)  (1280 + 64 * (j))
#define XB_XGEN(j)  (2304 + 64 * (j))
#define XB_TOP      3328
#define XB_TOPGEN   3392
#define XCD_BAR_WORDS 3456
#define XB_SPIN_CAP (1u << 22)
__device__ __forceinline__ unsigned xb_ld(unsigned* p) { return __hip_atomic_load(p, __ATOMIC_RELAXED, __HIP_MEMORY_SCOPE_AGENT); }
__device__ __forceinline__ unsigned xb_add(unsigned* p, unsigned v) { return __hip_atomic_fetch_add(p, v, __ATOMIC_RELAXED, __HIP_MEMORY_SCOPE_AGENT); }
__device__ __forceinline__ unsigned xb_xcc_id() { return (unsigned)__builtin_amdgcn_s_getreg((3 << 11) | 20) & 0xFu; }
#define XB_SPIN(cond, bar) do { unsigned _sp = 0; while (cond) { __builtin_amdgcn_s_sleep(1); \
    if ((++_sp & 255u) == 0u) { if (xb_ld(&(bar)[XB_TMO])) break; if (_sp > XB_SPIN_CAP) { atomicAdd(&(bar)[XB_TMO], 1u); break; } } } } while (0)
struct XcdBarrier { unsigned* bar; unsigned x; volatile LAS unsigned* st; };
__device__ __forceinline__ XcdBarrier xcd_barrier_post(unsigned* bar, volatile LAS unsigned* st) {
  XcdBarrier b; b.bar = bar; b.x = xb_xcc_id(); b.st = st;
  if (threadIdx.x == 0) (void)xb_add(&bar[XB_XCNT(b.x)], 1u);
  return b;
}
__device__ __forceinline__ void xcd_barrier_complete(unsigned* bar, unsigned x, unsigned& nloc, unsigned& nx) {
  const unsigned G = gridDim.x * gridDim.y * gridDim.z;
  unsigned sum, cnt, mine, sp = 0u;
  for (;;) {
    sum = 0u; cnt = 0u; mine = 0u;
#pragma unroll
    for (unsigned j = 0; j < 16; ++j) { const unsigned c = xb_ld(&bar[XB_XCNT(j)]); sum += c; cnt += (c > 0u) ? 1u : 0u; mine = (j == x) ? c : mine; }
    if (sum == G) break;
    __builtin_amdgcn_s_sleep(1);
    if ((++sp & 255u) == 0u) { if (xb_ld(&bar[XB_TMO])) break; if (sp > XB_SPIN_CAP) { atomicAdd(&bar[XB_TMO], 1u); break; } }
  }
  nloc = mine > 0u ? mine : 1u; nx = cnt > 0u ? cnt : 1u;
}
__device__ __forceinline__ void xcd_barrier(const XcdBarrier& b) {
  asm volatile("s_waitcnt vmcnt(0)" ::: "memory");
  __syncthreads();
  if (threadIdx.x == 0) {
    unsigned* bar = b.bar;
    __builtin_amdgcn_s_waitcnt(0);
    unsigned nloc = b.st[0], nx = b.st[1];
    if (nloc == 0u) { xcd_barrier_complete(bar, b.x, nloc, nx); b.st[0] = nloc; b.st[1] = nx; }
    const unsigned old = xb_add(&bar[XB_XSUB(b.x)], 1u);
    const unsigned gen = old / nloc;
    if (old + 1u == (gen + 1u) * nloc) {
      __builtin_amdgcn_fence(__ATOMIC_RELEASE, "agent");
      asm volatile("s_waitcnt vmcnt(0)" ::: "memory");
      const unsigned og = xb_add(&bar[XB_TOP], 1u);
      const unsigned tg = og / nx;
      if (og + 1u == (tg + 1u) * nx) xb_add(&bar[XB_TOPGEN], 1u);
      else XB_SPIN(xb_ld(&bar[XB_TOPGEN]) == tg, bar);
      __builtin_amdgcn_fence(__ATOMIC_ACQUIRE, "agent");
      xb_add(&bar[XB_XGEN(b.x)], 1u);
      asm volatile("s_waitcnt vmcnt(0)" ::: "memory");
    } else {
      XB_SPIN(xb_ld(&bar[XB_XGEN(b.x)]) == gen, bar);
      __builtin_amdgcn_fence(__ATOMIC_ACQUIRE, "agent");
      asm volatile("s_waitcnt vmcnt(0)" ::: "memory");
    }
  }
  __syncthreads();
}

constexpr int NPHASE = 18;
__device__ __forceinline__ void run_phase(CP p, int ph, char* smem, int* s_item, const int dry) {
  float* smf = (float*)smem;
  u16* smh = (u16*)smem;
  const u16* xn = (const u16*)(p->ws + OFF_XN);
  const u16* hp = (const u16*)(p->ws + OFF_HP);
  const u16* ymix = (const u16*)(p->ws + OFF_YMIX);
  if (ph == 0) { prep_a_phase(p, smf); return; }
  if (ph == 1) { prep_b_phase(p, smf, dry); return; }
  if (ph == 17) { final_phase(p); return; }
  const int l = (ph >= 10) ? 1 : 0;
  int q = ph - (l ? 10 : 2);
  if (l == 1 && q >= 4) q += 1;
  if (q == 0 || q == 6) {
    const int f = (q == 6) ? 1 : 0;
    gemm_phase<EPI_SWIGLU>(p, xn, (const u16*)(p->ws + OFF_WIN + (l * 2 + f) * SZ_WIN), 1024, 22, l, 0, 0.f, l * 3 + (f ? 2 : 0), smh);
    return;
  }
  if (q == 1 || q == 5 || q == 7) {
    const u16* A = (q == 5) ? ymix : hp;
    const u16* Bt = (q == 5) ? (const u16*)(p->ws + OFF_WMO + (size_t)l * D * D * 2)
                             : (const u16*)(p->ws + OFF_WOUT + (l * 2 + (q == 7 ? 1 : 0)) * SZ_WOUT);
    const int K = (q == 5) ? 1024 : DFF;
    const int gch = (q == 1) ? 2 : (q == 5 ? 5 : 8);
    const float coef = dry ? 0.f : ((q == 5) ? 1.f : 0.5f);
    const int nid_next = l * 3 + ((q == 1) ? 1 : (q == 5 ? 2 : 3));
    gemm_phase<EPI_RESID>(p, A, Bt, K, 4, l, gch, coef, dry ? 7 : nid_next, smh, (dry || l) ? 0 : (q == 1 ? 1 : (q == 7 ? 2 : 0)));
    return;
  }
  if (q == 2) {
    if (l == 0) gemm_phase<EPI_MIX0>(p, xn, (const u16*)(p->ws + OFF_WMI0), 1024, 12, l, 0, 0.f, 1, smh);
    else gemm_phase<EPI_MIX1>(p, xn, (const u16*)(p->ws + OFF_WMI1), 1024, 9, l, 0, 0.f, 4, smh);
    return;
  }
  if (q == 3) { if (l == 0) mix0_phase_a(p, smf, s_item, dry * 3); else mix1_phase(p, smf, s_item, dry * 3); return; }
  if (q == 4) { mix0_phase_b(p, smf, s_item, dry * 3); return; }
}

__global__ void __launch_bounds__(512, 2) mega(Params kp, int ph0, int ph1, int dry) {
  extern __shared__ __attribute__((aligned(16))) char smem[];
  int* s_item_p = (int*)(smem + SMEM_BYTES);
  uint4* xb_words_p = (uint4*)(smem + SMEM_BYTES + 16);
  if (threadIdx.x == 0) *xb_words_p = make_uint4(0u, 0u, 0u, 0u);
  __syncthreads();
  XcdBarrier xb = xcd_barrier_post((unsigned*)(kp.ws + OFF_BAR), (volatile LAS unsigned*)xb_words_p);
  if (ph1 < 0) cg::this_grid().sync();
  for (int ph = ph0; ph < ph1; ++ph) {
    if (ph > ph0) xcd_barrier(xb);
    CP p = (CP)__builtin_amdgcn_kernarg_segment_ptr();
    asm volatile("" : "+s"(p));
    run_phase(p, ph, smem, s_item_p, dry);
  }
}

extern "C" void kernel_launch(void* const* d_in, const int* in_sizes, int n_in, void* d_out, int out_size, void* d_ws,
                              size_t ws_size, hipStream_t stream) {
  static int grid_blocks = 0;
  if (!grid_blocks) {
    int dev = 0, cus = 0, per_cu = 0;
    hipGetDevice(&dev);
    hipDeviceGetAttribute(&cus, hipDeviceAttributeMultiprocessorCount, dev);
    hipFuncSetAttribute((const void*)mega, hipFuncAttributeMaxDynamicSharedMemorySize, DYN_LDS);
    hipOccupancyMaxActiveBlocksPerMultiprocessor(&per_cu, mega, NTH, DYN_LDS);
    if (per_cu > 1) per_cu = 1;
    if (per_cu < 1) per_cu = 1;
    grid_blocks = cus * per_cu;
  }
  if (ws_size < WS_TOTAL) fprintf(stderr, "workspace too small: %zu < %zu\n", ws_size, (size_t)WS_TOTAL);
  Params p{};
  for (int i = 0; i < 37; ++i) p.in[i] = (const float*)d_in[i];
  p.out = (float*)d_out;
  p.ws = (char*)d_ws;
  hipMemsetAsync((char*)d_ws + OFF_CTR, 0, ZERO_BYTES, stream);
#if SINGLE_LAUNCH
  int ph0 = 0, ph1 = NPHASE, dry = 0;
  void* args[] = {&p, &ph0, &ph1, &dry};
  hipError_t e = hipLaunchCooperativeKernel((void*)mega, dim3(grid_blocks), dim3(NTH), args, DYN_LDS, stream);
  if (e != hipSuccess) fprintf(stderr, "cooperative launch failed: %s (grid %d)\n", hipGetErrorString(e), grid_blocks);
#else
  for (int ph = 0; ph < NPHASE; ++ph) {
    mega<<<grid_blocks, NTH, DYN_LDS, stream>>>(p, ph, ph + 1, 0);
    const bool g1 = (ph == 2 || ph == 8 || ph == 10 || ph == 15), g2 = (ph == 3 || ph == 9 || ph == 11 || ph == 16);
    const bool mi = (ph == 4 || ph == 12), mo = (ph == 7 || ph == 14), mx = (ph == 5 || ph == 6 || ph == 13);
    if (((REP_MASK & 1) && g1) || ((REP_MASK & 2) && g2) || ((REP_MASK & 4) && (mi || mo)) || ((REP_MASK & 8) && mx) ||
        ((REP_MASK & 16) && ph == 0) || ((REP_MASK & 32) && ph == 1))
      mega<<<grid_blocks, NTH, DYN_LDS, stream>>>(p, ph, ph + 1, 1);
  }
#endif
}
```

```cpp
#include <hip/hip_runtime.h>
#include <hip/hip_cooperative_groups.h>
#include <cstdio>
namespace cg = cooperative_groups;

#ifndef REP_MASK
#define REP_MASK 0
#endif
#ifndef SINGLE_LAUNCH
#define SINGLE_LAUNCH 1
#endif

typedef unsigned short u16;
typedef __attribute__((ext_vector_type(8))) short bf16x8;
typedef __attribute__((ext_vector_type(4))) float f32x4;
typedef __attribute__((ext_vector_type(4))) unsigned u32x4;
#define LAS __attribute__((address_space(3)))

constexpr int D = 1024, NCTX = 8192, MTOK = 10240;
constexpr int DFF = 2816, NFF = 5632;
constexpr int P0N = 2848, P0P = 3072, P1N = 2304;
constexpr int PSTR = 2944;
constexpr float EPS = 1e-6f;

enum { I_XP = 0, I_XS, I_C0K, I_C0V, I_SC, I_SN, I_SM, I_NAK, I_NAV, I_SWK, I_SWV, I_C, I_CCTX, I_NF,
       I_L0 = 14, I_L1 = 26 };
enum { L_ADAW = 0, L_ADAB, L_NORM, L_F1I, L_F1O, L_F2I, L_F2O, L_MI, L_MO, L_X0, L_X1, L_X2 };

constexpr size_t O_X = 0, O_K0 = 10485760, O_V0 = 11534336, O_C = 12582912, O_N = 14680064, O_M = 14712832,
                 O_KC1 = 14713344, O_VC1 = 18907648, O_KD1 = 23101952, O_VD1 = 24150528;

constexpr size_t SZ_WIN = (size_t)NFF * D * 2;
constexpr size_t SZ_WOUT = (size_t)D * DFF * 2;
constexpr size_t OFF_WIN = 0;
constexpr size_t OFF_WOUT = OFF_WIN + 4 * SZ_WIN;
constexpr size_t OFF_WMI0 = OFF_WOUT + 4 * SZ_WOUT;
constexpr size_t OFF_WMI1 = OFF_WMI0 + (size_t)P0P * D * 2;
constexpr size_t OFF_WMO = OFF_WMI1 + (size_t)P1N * D * 2;
constexpr size_t OFF_MOD = OFF_WMO + 2 * (size_t)D * D * 2;
constexpr size_t OFF_ROPE = OFF_MOD + 2 * 3 * 9216 * 4;
constexpr size_t OFF_CTR = OFF_ROPE + 2 * 1024 * 32 * 4;
constexpr size_t OFF_BAR = OFF_CTR + 256;
constexpr size_t OFF_ROWSS = OFF_CTR + 16384;
constexpr size_t OFF_BIAS = OFF_ROWSS + (size_t)7 * MTOK * 4;
constexpr size_t ZERO_BYTES = 16384 + (size_t)7 * MTOK * 4 + (size_t)2 * 3 * 3 * NFF * 4;
constexpr size_t OFF_XN = OFF_CTR + ZERO_BYTES;
constexpr size_t OFF_YMIX = OFF_XN + (size_t)MTOK * D * 2;
constexpr size_t OFF_HP = OFF_YMIX + (size_t)MTOK * D * 2;
constexpr size_t OFF_GATES = OFF_HP + (size_t)MTOK * PSTR * 2;
constexpr size_t OFF_STC = OFF_GATES + (size_t)MTOK * 32 * 4;
constexpr size_t OFF_STN = OFF_STC + (size_t)2560 * 4096 * 4;
constexpr size_t OFF_STM = OFF_STN + (size_t)2560 * 64 * 4;
constexpr size_t WS_TOTAL = OFF_STM + 2560 * 4;

constexpr int TS = 68;
constexpr int TILE_F = 64 * TS;
constexpr int SMEM_BYTES = 8 * TILE_F * 4 + 4096;
constexpr int NTH = 512;
constexpr int DYN_LDS = SMEM_BYTES + 32;

struct Params {
  const float* in[37];
  float* out;
  char* ws;
};
typedef const __attribute__((address_space(4))) Params* CP;

__device__ __forceinline__ int get_tid() { int t = threadIdx.x; asm volatile("" : "+v"(t)); return t; }
__device__ __forceinline__ u16 f2bf(float f) {
  unsigned u = __float_as_uint(f);
  u += 0x7fffu + ((u >> 16) & 1u);
  return (u16)(u >> 16);
}
__device__ __forceinline__ unsigned pack2(float a, float b) { return (unsigned)f2bf(a) | ((unsigned)f2bf(b) << 16); }
__device__ __forceinline__ float bflo(unsigned x) { return __uint_as_float(x << 16); }
__device__ __forceinline__ float bfhi(unsigned x) { return __uint_as_float(x & 0xffff0000u); }
__device__ __forceinline__ float grp16_sum(float v) {
  v += __shfl_xor(v, 1); v += __shfl_xor(v, 2); v += __shfl_xor(v, 4); v += __shfl_xor(v, 8); return v;
}
__device__ __forceinline__ float grp16_max(float v) {
  v = fmaxf(v, __shfl_xor(v, 1)); v = fmaxf(v, __shfl_xor(v, 2)); v = fmaxf(v, __shfl_xor(v, 4)); v = fmaxf(v, __shfl_xor(v, 8)); return v;
}
__device__ __forceinline__ float wave_sum(float v) {
  for (int o = 32; o; o >>= 1) v += __shfl_xor(v, o);
  return v;
}
__device__ __forceinline__ float wave_max(float v) {
  for (int o = 32; o; o >>= 1) v = fmaxf(v, __shfl_xor(v, o));
  return v;
}
__device__ __forceinline__ float wave_scan_add(float v, int lane) {
  for (int o = 1; o < 64; o <<= 1) { float t = __shfl_up(v, o); if (lane >= o) v += t; }
  return v;
}
__device__ __forceinline__ float wave_scan_max(float v, int lane) {
  for (int o = 1; o < 64; o <<= 1) { float t = __shfl_up(v, o); if (lane >= o) v = fmaxf(v, t); }
  return v;
}
__device__ __forceinline__ int cond_of(int row) { return row < NCTX ? 0 : 1 + ((row - NCTX) >> 10); }
__device__ __forceinline__ float sigmoidf_(float x) { return 1.f / (1.f + expf(-x)); }
__device__ __forceinline__ float logsigmoidf_(float x) { return fminf(x, 0.f) - log1pf(expf(-fabsf(x))); }

__device__ void conv_tile(const float* __restrict__ W, int K, int N, u16* __restrict__ Wt, int perm, int kt, int nt, float* T, int t, bool valid,
                          const float* shp, float* biasp) {
  {
    int r = t >> 4, c4 = t & 15;
    int c = c4 * 4;
    int src;
    if (perm == 1) src = ((nt & 3) < 2 ? 0 : DFF) + (nt >> 2) * 128 + (nt & 1) * 64 + c;
    else if (perm == 2) {
      int bj = (nt & 3) >> 1, wc = (nt & 1) * 2 + (c >> 5), w = c & 31;
      src = (nt >> 2) * 256 + wc * 64 + bj * 32 + w;
    } else src = nt * 64 + c;
    bool ok = valid && (src < N);
#pragma unroll
    for (int ps = 0; ps < 4; ++ps) {
      int k = r + ps * 16;
      float4 v = make_float4(0.f, 0.f, 0.f, 0.f);
      if (ok) v = *(const float4*)(W + (size_t)(kt * 64 + k) * N + src);
      float* tt = T + k * 65 + c;
      tt[0] = v.x; tt[1] = v.y; tt[2] = v.z; tt[3] = v.w;
    }
  }
  if (biasp && t < 192) T[4224 + t] = shp[(t >> 6) * 9216 + kt * 64 + (t & 63)];
  __syncthreads();
  if (valid && biasp && t < 192) {
    int a = t >> 6, c = t & 63;
    int src;
    if (perm == 1) src = ((nt & 3) < 2 ? 0 : DFF) + (nt >> 2) * 128 + (nt & 1) * 64 + c;
    else { int bj = (nt & 3) >> 1, wc = (nt & 1) * 2 + (c >> 5), w = c & 31; src = (nt >> 2) * 256 + wc * 64 + bj * 32 + w; }
    if (src < N) {
      const float* sh = T + 4224 + a * 64;
      float acc = 0.f;
#pragma unroll 16
      for (int k = 0; k < 64; ++k) acc += sh[k] * T[k * 65 + c];
      unsafeAtomicAdd(biasp + a * NFF + src, acc);
    }
  }
  if (valid) {
    int n = t >> 2, kp = t & 3;
    unsigned o[8];
#pragma unroll
    for (int i = 0; i < 8; ++i) {
      float a = T[(kp * 16 + 2 * i) * 65 + n], b = T[(kp * 16 + 2 * i + 1) * 65 + n];
      o[i] = pack2(a, b);
    }
    uint4* dst = (uint4*)(Wt + (size_t)(nt * 64 + n) * K + kt * 64 + kp * 16);
    dst[0] = make_uint4(o[0], o[1], o[2], o[3]);
    dst[1] = make_uint4(o[4], o[5], o[6], o[7]);
  }
  __syncthreads();
}

__device__ void adaln_unit(CP p, int u, float* sm, int t, bool valid) {
  int l = u / 144, cg_ = u % 144;
  if (!valid) { l = 0; cg_ = 0; }
  const float* W = p->in[(l ? I_L1 : I_L0) + L_ADAW];
  const float* B = p->in[(l ? I_L1 : I_L0) + L_ADAB];
  float* sc = sm;
  float* red = sm + 3072;
  for (int i = t; i < 3072; i += 256) {
    int cnd = i >> 10, k = i & 1023;
    float v = (cnd == 0) ? p->in[I_CCTX][k] : p->in[I_C][(cnd - 1) * 1024 + k];
    sc[i] = v / (1.f + expf(-v));
  }
  __syncthreads();
  int kp = t >> 4, c4 = t & 15;
  float acc[3][4];
#pragma unroll
  for (int a = 0; a < 3; ++a)
#pragma unroll
    for (int e = 0; e < 4; ++e) acc[a][e] = 0.f;
  for (int kk = 0; kk < 64; ++kk) {
    int k = kp * 64 + kk;
    float4 w = *(const float4*)(W + (size_t)k * 9216 + cg_ * 64 + c4 * 4);
#pragma unroll
    for (int a = 0; a < 3; ++a) {
      float s = sc[a * 1024 + k];
      acc[a][0] += s * w.x; acc[a][1] += s * w.y; acc[a][2] += s * w.z; acc[a][3] += s * w.w;
    }
  }
#pragma unroll
  for (int a = 0; a < 3; ++a)
#pragma unroll
    for (int e = 0; e < 4; ++e) red[(kp * 3 + a) * 64 + c4 * 4 + e] = acc[a][e];
  __syncthreads();
  if (valid && t < 192) {
    int a = t >> 6, col = t & 63;
    float s = 0.f;
    for (int q = 0; q < 16; ++q) s += red[(q * 3 + a) * 64 + col];
    s += B[cg_ * 64 + col];
    float* mod = (float*)(p->ws + OFF_MOD);
    mod[(l * 3 + a) * 9216 + cg_ * 64 + col] = s;
  }
  __syncthreads();
}

__device__ __forceinline__ int conv_units_of(int l, int kind) {
  return (kind == 0 || kind == 4) ? 1408 : ((kind == 1 || kind == 5) ? 704 : (kind == 3 ? 256 : (l ? 576 : 768)));
}
__device__ __forceinline__ void conv_job(CP p, int l, int kind, int tt, float* smh, int t, bool valid) {
  const float* mod = (const float*)(p->ws + OFF_MOD);
  float* bias = (float*)(p->ws + OFF_BIAS);
  const float* W; u16* Wt; int K, N, perm, ntn, which = -1;
  const int lb = l ? I_L1 : I_L0;
  if (kind == 0 || kind == 4) {
    const int f = kind == 4;
    W = p->in[lb + (f ? L_F2I : L_F1I)]; Wt = (u16*)(p->ws + OFF_WIN + (l * 2 + f) * SZ_WIN);
    K = 1024; N = NFF; perm = 1; ntn = 88; which = f ? 2 : 0;
  } else if (kind == 1 || kind == 5) {
    const int f = kind == 5;
    W = p->in[lb + (f ? L_F2O : L_F1O)]; Wt = (u16*)(p->ws + OFF_WOUT + (l * 2 + f) * SZ_WOUT);
    K = DFF; N = 1024; perm = 0; ntn = 16;
  } else if (kind == 2) {
    W = p->in[lb + L_MI]; Wt = (u16*)(p->ws + (l ? OFF_WMI1 : OFF_WMI0));
    K = 1024; N = l ? P1N : P0N; perm = 2; ntn = l ? 36 : 48; which = 1;
  } else {
    W = p->in[lb + L_MO]; Wt = (u16*)(p->ws + OFF_WMO + (size_t)l * D * D * 2);
    K = 1024; N = 1024; perm = 0; ntn = 16;
  }
  const int nt = tt % ntn, kt = tt / ntn;
  const bool wb = which >= 0;
  conv_tile(W, K, N, Wt, perm, kt, nt, smh, t, valid, wb ? mod + (l * 3) * 9216 + (3 * which) * 1024 : nullptr,
            wb ? bias + (size_t)((l * 3 + which) * 3) * NFF : nullptr);
}

__device__ __forceinline__ void conv_side_job(CP p, int side, int nwg, float* sm) {
  const int tid = get_tid(), half = tid >> 8, t = tid & 255;
  float* smh = sm + half * 8192;
  const int first = ((int)gridDim.x >= nwg + 32) ? nwg : 0;
  const int nb = (int)gridDim.x - first;
  if ((int)blockIdx.x < first) return;
  const int U = (side == 1) ? 3136 : (side == 2 ? 2112 : (side == 3 ? 2240 : 704));
  for (int ub = ((int)blockIdx.x - first) * 2; ub < U; ub += nb * 2) {
    int u = ub + half;
    const bool valid = u < U;
    if (!valid) u = 0;
    int l, kind, tt;
    if (side == 1) {
      l = 0;
      if (u < 768) { kind = 2; tt = u; } else if (u < 1024) { kind = 3; tt = u - 768; }
      else if (u < 2432) { kind = 4; tt = u - 1024; } else { kind = 5; tt = u - 2432; }
    } else if (side == 2) {
      l = 1;
      if (u < 1408) { kind = 0; tt = u; } else { kind = 1; tt = u - 1408; }
    } else if (side == 3) {
      l = 1;
      if (u < 576) { kind = 2; tt = u; } else if (u < 832) { kind = 3; tt = u - 576; } else { kind = 4; tt = u - 832; }
    } else {
      l = 1; kind = 5; tt = u;
    }
    conv_job(p, l, kind, tt, smh, t, valid);
  }
}

__device__ __forceinline__ void prep_a_phase(CP p, float* sm) {
  const int tid = get_tid(), half = tid >> 8, t = tid & 255;
  float* smh = sm + half * 8192;
  constexpr int U_CONV = 704, U_ADA = 288, U_ROPE = 64;
  for (int ub = blockIdx.x * 2; ub < U_ADA; ub += gridDim.x * 2) {
    int u = ub + half;
    adaln_unit(p, u, smh, t, u < U_ADA);
  }
  for (int ub = blockIdx.x * 2; ub < U_CONV; ub += gridDim.x * 2) {
    int u = ub + half;
    bool valid = u < U_CONV;
    if (!valid) u = 0;
    conv_job(p, 0, 1, u, smh, t, valid);
  }
  for (int u = blockIdx.x; u < U_ROPE; u += gridDim.x) {
    int e = u * 512 + tid;
    int tk = e >> 5, i = e & 31;
    float pos = (i < 16) ? (float)(tk >> 6) : (float)(tk & 63);
    float fr = powf(10000.f, -(float)(i & 15) / 16.f);
    float ang = pos * fr;
    float* rc = (float*)(p->ws + OFF_ROPE);
    rc[e] = cosf(ang);
    rc[32768 + e] = sinf(ang);
  }
}

__device__ __forceinline__ void prep_b_phase(CP p, float* sm, const int dry) {
  const int tid = get_tid(), half = tid >> 8, t = tid & 255, lane = tid & 63, w = tid >> 6;
  float* smh = sm + half * 8192;
  const float* mod = (const float*)(p->ws + OFF_MOD);
  constexpr int U_CONV = 1408;
  for (int ub = blockIdx.x * 2; ub < U_CONV; ub += gridDim.x * 2) {
    int u = ub + half;
    bool valid = u < U_CONV;
    if (!valid) u = 0;
    conv_job(p, 0, 0, u, smh, t, valid);
  }
  {
    float* x = p->out + O_X;
    u16* xn = (u16*)(p->ws + OFF_XN);
    float* rowss = (float*)(p->ws + OFF_ROWSS);
    const float4* g = (const float4*)(p->in[I_L0 + L_NORM]);
    for (int row = blockIdx.x * 8 + w; row < MTOK; row += gridDim.x * 8) {
      const float4* src = (row < NCTX) ? (const float4*)(p->in[I_XP] + (size_t)row * D) : (const float4*)(p->in[I_XS] + (size_t)(row - NCTX) * D);
      float4* xr = (float4*)(x + (size_t)row * D);
      const float4* sc = (const float4*)(mod + (size_t)cond_of(row) * 9216 + 1024);
      float ss = 0.f;
#pragma unroll
      for (int i = 0; i < 4; ++i) {
        int q = lane + i * 64;
        float4 v = src[q];
        ss += v.x * v.x + v.y * v.y + v.z * v.z + v.w * v.w;
        xr[q] = v;
        float4 gg = g[q], s2 = sc[q];
        uint2 o = make_uint2(pack2(v.x * (gg.x * (1.f + s2.x)), v.y * (gg.y * (1.f + s2.y))), pack2(v.z * (gg.z * (1.f + s2.z)), v.w * (gg.w * (1.f + s2.w))));
        *(uint2*)(xn + (size_t)row * D + q * 4) = o;
      }
      ss = wave_sum(ss);
      if (lane == 0) rowss[row] = ss;
    }
  }
}

__device__ __forceinline__ void final_phase(CP p) {
  const int tid = get_tid(), lane = tid & 63, w = tid >> 6;
  float* x = p->out + O_X;
  const float* rowss = (const float*)(p->ws + OFF_ROWSS) + 6 * MTOK;
  const float4* g = (const float4*)p->in[I_NF];
  for (int row = blockIdx.x * 8 + w; row < MTOK; row += gridDim.x * 8) {
    float4* xr = (float4*)(x + (size_t)row * D);
    const float rstd = rsqrtf(rowss[row] * (1.f / 1024.f) + EPS);
#pragma unroll
    for (int i = 0; i < 4; ++i) {
      int q = lane + i * 64;
      float4 v = xr[q], gg = g[q];
      xr[q] = make_float4(v.x * rstd * gg.x, v.y * rstd * gg.y, v.z * rstd * gg.z, v.w * rstd * gg.w);
    }
  }
}

enum { EPI_SWIGLU = 0, EPI_RESID = 1, EPI_MIX0 = 2, EPI_MIX1 = 3 };
constexpr int BM = 256, BK = 64, HALF = 128, HT = HALF * BK, NXCD = 8, WGM = 8;

__device__ __forceinline__ int lds_byte(int r, int c) {
  int st = (r >> 4) * 2 + (c >> 5), rr = r & 15, cc = c & 31, ob = rr * 64 + cc * 2;
  return st * 1024 + (ob ^ (((ob >> 9) & 1) << 5));
}
__device__ __forceinline__ void stage_rc(int b, int& R, int& C) {
  int st = b / 1024, sb = b % 1024, swz = sb ^ (((sb >> 9) & 1) << 5);
  R = (st >> 1) * 16 + swz / 64; C = (st & 1) * 32 + (swz % 64) / 2;
}

template <int EPI>
__device__ __forceinline__ void gemm256_tile(CP p, const u16* A, const u16* Bt, const int K,
                                             const int brow, const int bcol, int l, int gchunk, float coef, int nid, u16* shm, const int tid0) {
#define SWZ_LANE() ([]() { unsigned ln = __builtin_amdgcn_mbcnt_hi(~0u, __builtin_amdgcn_mbcnt_lo(~0u, 0u)); asm volatile("" : "+v"(ln)); \
    unsigned ob = (ln & 15u) * 64u + (ln >> 4) * 16u; return ob ^ (((ob >> 9) & 1u) << 5); }())
#define SAI(b, h) ((b) * 2 + (h))
#define SBI(b, h) (4 + (b) * 2 + (h))
#define STAGE(PI, BASE, br, kt) do { \
    const char* _gb = (const char*)(BASE) + ((long)(br) * K + (long)(kt) * BK) * 2; \
    char* _lp = (char*)shm + (PI) * (HT * 2) + wave_lds; \
    __builtin_amdgcn_global_load_lds((const unsigned*)(_gb + voff0), (LAS unsigned*)(_lp), 16, 0, 0); \
    __builtin_amdgcn_global_load_lds((const unsigned*)(_gb + (long)K * 128 + voff0), (LAS unsigned*)(_lp + 8192), 16, 0, 0); } while (0)
#define LDA(dst, PI) do { unsigned _o = SWZ_LANE() + a_uni; asm volatile("" : "+v"(_o)); _o &= 0x23F0u; \
    _Pragma("unroll") for (int m = 0; m < 4; ++m) _Pragma("unroll") for (int k = 0; k < 2; ++k) \
      dst[m][k] = *reinterpret_cast<const bf16x8*>((const char*)shm + (PI) * (HT * 2) + m * 2048 + k * 1024 + _o); } while (0)
#define LDB(dst, PI) do { unsigned _o = SWZ_LANE() + b_uni; asm volatile("" : "+v"(_o)); _o &= 0x33F0u; \
    _Pragma("unroll") for (int n = 0; n < 2; ++n) _Pragma("unroll") for (int k = 0; k < 2; ++k) \
      dst[n][k] = *reinterpret_cast<const bf16x8*>((const char*)shm + (PI) * (HT * 2) + n * 2048 + k * 1024 + _o); } while (0)
#define MMA(ai, bj, At_, Bt_) do { __builtin_amdgcn_s_setprio(1); \
    _Pragma("unroll") for (int m = 0; m < 4; ++m) _Pragma("unroll") for (int n = 0; n < 2; ++n) _Pragma("unroll") for (int k = 0; k < 2; ++k) \
      acc[ai][bj][m][n] = __builtin_amdgcn_mfma_f32_16x16x32_bf16(At_[m][k], Bt_[n][k], acc[ai][bj][m][n], 0, 0, 0); \
    __builtin_amdgcn_s_setprio(0); } while (0)
#define WAIT_V(n) asm volatile("s_waitcnt vmcnt(" #n ")" ::: "memory")
#define WAIT_L(n) asm volatile("s_waitcnt lgkmcnt(" #n ")" ::: "memory")
#define BAR __builtin_amdgcn_s_barrier()
#define SCHED __builtin_amdgcn_sched_barrier(0)
  const int wid = __builtin_amdgcn_readfirstlane(tid0 >> 6), wr = wid >> 2, wc = wid & 3;
  const int wave_lds = (wid & 7) * 1024;
  unsigned voff0;
  { int r_, c_; stage_rc(tid0 * 16, r_, c_); voff0 = (unsigned)(r_ * K + c_) * 2u; }
  const unsigned a_uni = (unsigned)(wr * 8192), b_uni = (unsigned)(wc * 4096);
  f32x4 acc[2][2][4][2];
#pragma unroll
  for (int a = 0; a < 2; ++a)
#pragma unroll
    for (int b = 0; b < 2; ++b)
#pragma unroll
      for (int m = 0; m < 4; ++m)
#pragma unroll
        for (int n = 0; n < 2; ++n) acc[a][b][m][n] = (f32x4){0.f, 0.f, 0.f, 0.f};
  bf16x8 At[4][2], B0[2][2], B1[2][2];
  const int nt = K / BK;
  WAIT_V(0);
  __syncthreads();
  STAGE(SBI(0, 0), Bt, bcol, 0); STAGE(SAI(0, 0), A, brow, 0);
  STAGE(SBI(0, 1), Bt, bcol + HALF, 0); STAGE(SAI(0, 1), A, brow + HALF, 0);
  if (wr == 1) BAR;
  WAIT_V(4); BAR;
  STAGE(SBI(1, 0), Bt, bcol, 1); STAGE(SAI(1, 0), A, brow, 1); STAGE(SBI(1, 1), Bt, bcol + HALF, 1);
  WAIT_V(6); BAR;
  for (int t = 0; t < nt - 2; t += 2) {
    LDB(B0, SBI(0, 0)); SCHED; LDA(At, SAI(0, 0)); STAGE(SAI(1, 1), A, brow + HALF, t + 1);
    WAIT_L(8); BAR; WAIT_L(0); MMA(0, 0, At, B0); BAR; SCHED;
    LDB(B1, SBI(0, 1)); STAGE(SBI(0, 0), Bt, bcol, t + 2);
    BAR; WAIT_L(0); MMA(0, 1, At, B1); BAR;
    LDA(At, SAI(0, 1)); STAGE(SAI(0, 0), A, brow, t + 2);
    BAR; WAIT_L(0); MMA(1, 0, At, B0); BAR; SCHED;
    STAGE(SBI(0, 1), Bt, bcol + HALF, t + 2);
    WAIT_V(6); BAR; MMA(1, 1, At, B1); BAR;
    LDB(B0, SBI(1, 0)); SCHED; LDA(At, SAI(1, 0)); STAGE(SAI(0, 1), A, brow + HALF, t + 2);
    WAIT_L(8); BAR; WAIT_L(0); MMA(0, 0, At, B0); BAR; SCHED;
    LDB(B1, SBI(1, 1)); STAGE(SBI(1, 0), Bt, bcol, t + 3);
    BAR; WAIT_L(0); MMA(0, 1, At, B1); BAR;
    LDA(At, SAI(1, 1)); STAGE(SAI(1, 0), A, brow, t + 3);
    BAR; WAIT_L(0); MMA(1, 0, At, B0); BAR; SCHED;
    STAGE(SBI(1, 1), Bt, bcol + HALF, t + 3);
    WAIT_V(6); BAR; MMA(1, 1, At, B1); BAR;
  }
  { LDB(B0, SBI(0, 0)); LDA(At, SAI(0, 0)); STAGE(SAI(1, 1), A, brow + HALF, nt - 1);
    BAR; WAIT_L(0); MMA(0, 0, At, B0); BAR;
    LDB(B1, SBI(0, 1)); BAR; WAIT_L(0); MMA(0, 1, At, B1); BAR;
    LDA(At, SAI(0, 1)); WAIT_V(4); BAR; WAIT_L(0); MMA(1, 0, At, B0); MMA(1, 1, At, B1); BAR; }
  { LDB(B0, SBI(1, 0)); LDA(At, SAI(1, 0)); WAIT_V(2); BAR; WAIT_L(0); MMA(0, 0, At, B0); BAR;
    LDB(B1, SBI(1, 1)); WAIT_V(0); BAR; WAIT_L(0); MMA(0, 1, At, B1); BAR;
    LDA(At, SAI(1, 1)); BAR; WAIT_L(0); MMA(1, 0, At, B0); MMA(1, 1, At, B1); BAR; }
  if (wr == 0) BAR;
#undef SAI
#undef SWZ_LANE
#undef SBI
#undef STAGE
#undef LDA
#undef LDB
#undef MMA
#undef WAIT_V
#undef WAIT_L
#undef BAR
#undef SCHED
  unsigned lane_e = __builtin_amdgcn_mbcnt_hi(~0u, __builtin_amdgcn_mbcnt_lo(~0u, 0u));
  asm volatile("" : "+v"(lane_e));
  const int lane = (int)lane_e, fr = lane & 15, fq = lane >> 4, tid = wid * 64 + lane;
  if (EPI == EPI_SWIGLU) {
    u16* H = (u16*)(p->ws + OFF_HP);
    const int hcl = wc * 32 + fr;
    const int hc0 = (bcol >> 1) + hcl;
    const float* rowss = (const float*)(p->ws + OFF_ROWSS) + (size_t)nid * MTOK;
    const float* bias = (const float*)(p->ws + OFF_BIAS) + (size_t)(nid * 3 + cond_of(brow)) * NFF;
    float bg[2], bu[2];
#pragma unroll
    for (int n = 0; n < 2; ++n) { bg[n] = bias[hc0 + n * 16]; bu[n] = bias[DFF + hc0 + n * 16]; }
    u16* Hs = shm;
#pragma unroll
    for (int ai = 0; ai < 2; ++ai)
#pragma unroll
      for (int m = 0; m < 4; ++m)
#pragma unroll
        for (int j = 0; j < 4; ++j) {
          const int rl = ai * 128 + wr * 64 + m * 16 + fq * 4 + j;
          const float rstd = rsqrtf(rowss[brow + rl] * (1.f / 1024.f) + EPS);
#pragma unroll
          for (int n = 0; n < 2; ++n) {
            float g = acc[ai][0][m][n][j] * rstd + bg[n], u = acc[ai][1][m][n][j] * rstd + bu[n];
            float h = g / (1.f + __expf(-g)) * u;
            Hs[rl * 136 + hcl + n * 16] = f2bf(h);
          }
        }
    __syncthreads();
#pragma unroll
    for (int i = 0; i < 8; ++i) {
      const int q = tid + 512 * i, r = q >> 4, c = q & 15;
      const u32x4 v = *(const u32x4*)(Hs + r * 136 + c * 8);
      *(u32x4*)(H + (size_t)(brow + r) * DFF + (bcol >> 1) + c * 8) = v;
    }
  } else if (EPI == EPI_RESID) {
    float* x = p->out + O_X;
    const float* mod = (const float*)(p->ws + OFF_MOD);
    u16* xn = (u16*)(p->ws + OFF_XN);
    float* rowss = (float*)(p->ws + OFF_ROWSS) + (size_t)nid * MTOK;
    const int cnd = cond_of(brow);
    const bool has_next = nid < 6;
    const int ln = (nid % 6) / 3, wn = nid % 3;
    const int col4 = bcol + lane * 4;
    float4 gt4 = *(const float4*)(mod + (l * 3 + cnd) * 9216 + gchunk * 1024 + col4);
    gt4.x *= coef; gt4.y *= coef; gt4.z *= coef; gt4.w *= coef;
    float4 gs4 = make_float4(0.f, 0.f, 0.f, 0.f);
    if (has_next) {
      const float4 ng = *(const float4*)(p->in[(ln ? I_L1 : I_L0) + L_NORM] + wn * 1024 + col4);
      const float4 sc = *(const float4*)(mod + (ln * 3 + cnd) * 9216 + (3 * wn + 1) * 1024 + col4);
      gs4 = make_float4(ng.x * (1.f + sc.x), ng.y * (1.f + sc.y), ng.z * (1.f + sc.z), ng.w * (1.f + sc.w));
    }
    float* Cs = (float*)shm;
    float4 xv0[16], xv1[16];
#pragma unroll
    for (int i = 0; i < 16; ++i) xv0[i] = *(const float4*)(x + (size_t)(brow + wid + 8 * i) * D + col4);
#pragma unroll
    for (int bj = 0; bj < 2; ++bj)
#pragma unroll
      for (int m = 0; m < 4; ++m)
#pragma unroll
        for (int n = 0; n < 2; ++n)
#pragma unroll
          for (int j = 0; j < 4; ++j)
            Cs[(wr * 64 + m * 16 + fq * 4 + j) * 260 + bj * 128 + wc * 32 + n * 16 + fr] = acc[0][bj][m][n][j];
    __syncthreads();
#pragma unroll
    for (int ai = 0; ai < 2; ++ai) {
      if (ai) {
#pragma unroll
        for (int i = 0; i < 16; ++i) xv1[i] = *(const float4*)(x + (size_t)(brow + 128 + wid + 8 * i) * D + col4);
        __syncthreads();
#pragma unroll
        for (int bj = 0; bj < 2; ++bj)
#pragma unroll
          for (int m = 0; m < 4; ++m)
#pragma unroll
            for (int n = 0; n < 2; ++n)
#pragma unroll
              for (int j = 0; j < 4; ++j)
                Cs[(wr * 64 + m * 16 + fq * 4 + j) * 260 + bj * 128 + wc * 32 + n * 16 + fr] = acc[1][bj][m][n][j];
        __syncthreads();
      }
#pragma unroll
      for (int i = 0; i < 16; ++i) {
        const int r = wid + 8 * i;
        const int row = brow + ai * 128 + r;
        const float4 a = *(const float4*)(Cs + r * 260 + lane * 4);
        float4 xv = ai ? xv1[i] : xv0[i];
        xv.x += gt4.x * a.x; xv.y += gt4.y * a.y; xv.z += gt4.z * a.z; xv.w += gt4.w * a.w;
        *(float4*)(x + (size_t)row * D + col4) = xv;
        float ss = xv.x * xv.x + xv.y * xv.y + xv.z * xv.z + xv.w * xv.w;
        if (has_next) *(uint2*)(xn + (size_t)row * D + col4) = make_uint2(pack2(xv.x * gs4.x, xv.y * gs4.y), pack2(xv.z * gs4.z, xv.w * gs4.w));
        ss = wave_sum(ss);
        if (lane == 0 && nid < 7) unsafeAtomicAdd(rowss + row, ss);
      }
    }
  } else {
    u16* proj = (u16*)(p->ws + OFF_HP);
    u16* Pst = shm;
    const bool isctx = brow < NCTX;
    const int c0 = bcol + wc * 64;
    const float* rc = (const float*)(p->ws + OFF_ROPE);
    const float* rowss = (const float*)(p->ws + OFF_ROWSS) + (size_t)nid * MTOK;
    const float* bias = (const float*)(p->ws + OFF_BIAS) + (size_t)(nid * 3 + cond_of(brow)) * NFF;
    float bz[2][2];
#pragma unroll
    for (int bj = 0; bj < 2; ++bj)
#pragma unroll
      for (int n = 0; n < 2; ++n) { int col = c0 + bj * 32 + n * 16 + fr; bz[bj][n] = (col < ((EPI == EPI_MIX0) ? P0N : P1N)) ? bias[col] : 0.f; }
    bool do_norm = false, do_rope = false;
    const float* ng = nullptr;
    float* o32 = nullptr; int ostr = 0;
    bool elementwise = false;
    if (EPI == EPI_MIX0) {
      if (c0 < 512) { do_norm = true; ng = p->in[I_L0 + L_X0]; do_rope = !isctx; }
      else if (c0 < 640) { do_norm = true; ng = p->in[I_L0 + L_X0] + 64; do_rope = !isctx; if (isctx) { o32 = p->out + O_K0 + (c0 - 512); ostr = 128; } }
      else if (c0 < 768) { if (isctx) { o32 = p->out + O_V0 + (c0 - 640); ostr = 128; } }
      else if (c0 >= 2304) elementwise = true;
    } else {
      if (c0 < 512) {}
      else if (c0 < 1024) { if (isctx) { o32 = p->out + O_KC1 + (c0 - 512); ostr = 512; } }
      else if (c0 < 1536) { if (isctx) { o32 = p->out + O_VC1 + (c0 - 1024); ostr = 512; } }
      else if (c0 < 2048) { do_rope = !isctx; }
      else if (c0 < 2176) { do_rope = !isctx; if (isctx) { o32 = p->out + O_KD1 + (c0 - 2048); ostr = 128; } }
      else { if (isctx) { o32 = p->out + O_VD1 + (c0 - 2176); ostr = 128; } }
    }
    if (elementwise) {
      float* gates = (float*)(p->ws + OFF_GATES);
      const float* gb = p->in[I_L0 + L_X1];
#pragma unroll
      for (int ai = 0; ai < 2; ++ai)
#pragma unroll
        for (int m = 0; m < 4; ++m)
#pragma unroll
          for (int j = 0; j < 4; ++j) {
            int row = brow + ai * 128 + wr * 64 + m * 16 + fq * 4 + j;
            const float rstd = rsqrtf(rowss[row] * (1.f / 1024.f) + EPS);
#pragma unroll
            for (int bj = 0; bj < 2; ++bj)
#pragma unroll
              for (int n = 0; n < 2; ++n) {
                int col = c0 + bj * 32 + n * 16 + fr;
                float v = acc[ai][bj][m][n][j] * rstd + bz[bj][n];
                if (col < 2336) gates[(size_t)row * 32 + (col - 2304)] = v + gb[col - 2304];
                else if (col < P0N) Pst[(row - brow) * 264 + (col - bcol)] = f2bf(v);
              }
          }
    } else {
#pragma unroll
      for (int ai = 0; ai < 2; ++ai)
#pragma unroll
        for (int m = 0; m < 4; ++m)
#pragma unroll
          for (int j = 0; j < 4; ++j) {
            int row = brow + ai * 128 + wr * 64 + m * 16 + fq * 4 + j;
            const float rstd0 = rsqrtf(rowss[row] * (1.f / 1024.f) + EPS);
            float v0 = acc[ai][0][m][0][j] * rstd0 + bz[0][0], v1 = acc[ai][0][m][1][j] * rstd0 + bz[0][1];
            float v2 = acc[ai][1][m][0][j] * rstd0 + bz[1][0], v3 = acc[ai][1][m][1][j] * rstd0 + bz[1][1];
            if (do_norm) {
              float ss = v0 * v0 + v1 * v1 + v2 * v2 + v3 * v3;
              ss = grp16_sum(ss);
              float rstd = rsqrtf(ss * (1.f / 64.f) + EPS);
              v0 = v0 * rstd * ng[fr]; v1 = v1 * rstd * ng[16 + fr]; v2 = v2 * rstd * ng[32 + fr]; v3 = v3 * rstd * ng[48 + fr];
            }
            if (do_rope) {
              int tk = (row - NCTX) & 1023;
              float ca = rc[tk * 32 + fr], sa = rc[32768 + tk * 32 + fr];
              float cb = rc[tk * 32 + 16 + fr], sb = rc[32768 + tk * 32 + 16 + fr];
              float a0 = v0 * ca - v2 * sa, a2 = v2 * ca + v0 * sa;
              float a1 = v1 * cb - v3 * sb, a3 = v3 * cb + v1 * sb;
              v0 = a0; v1 = a1; v2 = a2; v3 = a3;
            }
            u16* pr = Pst + (row - brow) * 264 + (c0 - bcol) + fr;
            pr[0] = f2bf(v0); pr[16] = f2bf(v1); pr[32] = f2bf(v2); pr[48] = f2bf(v3);
            if (o32) {
              float* o = o32 + (size_t)row * ostr + fr;
              o[0] = v0; o[16] = v1; o[32] = v2; o[48] = v3;
            }
          }
    }
    __syncthreads();
#pragma unroll 1
    for (int i = 0; i < 16; ++i) {
      const int q = tid + 512 * i, r = q >> 5, c = q & 31;
      const int col = bcol + c * 8;
      if (col < PSTR) *(u32x4*)(proj + (size_t)(brow + r) * PSTR + col) = *(const u32x4*)(Pst + r * 264 + c * 8);
    }
  }
}

template <int EPI>
__device__ __forceinline__ void gemm_phase(CP p, const u16* A, const u16* Bt, int K, int nN, int l, int gchunk, float coef, int nid, u16* smem, int side = 0) {
  const int tid = get_tid();
  const int nM = MTOK / BM, nwg = nM * nN;
  for (int t = blockIdx.x; t < nwg; t += gridDim.x) {
    int wgid = t;
    { int q = nwg / NXCD, r = nwg % NXCD, xcd = wgid % NXCD, off = wgid / NXCD;
      wgid = (xcd < r ? xcd * (q + 1) : r * (q + 1) + (xcd - r) * q) + off; }
    int nig = WGM * nN, gid = wgid / nig, fm = gid * WGM, gsz = min(nM - fm, WGM);
    int pm = fm + ((wgid % nig) % gsz), pn = (wgid % nig) / gsz;
    gemm256_tile<EPI>(p, A, Bt, K, pm * BM, pn * BM, l, gchunk, coef, nid, smem, tid);
  }
  if (EPI == EPI_RESID && side) { __syncthreads(); conv_side_job(p, side, nwg, (float*)smem); }
}

__device__ __forceinline__ void load_tile_bf16(float* dst, const u16* src, long rstride, float scale, int tid) {
  int r = tid >> 2, part = tid & 3;
  const uint4* s = (const uint4*)(src + (long)r * rstride + part * 16);
  uint4 a = s[0], b = s[1];
  float4* d = (float4*)(dst + r * TS + part * 16);
  d[0] = make_float4(bflo(a.x) * scale, bfhi(a.x) * scale, bflo(a.y) * scale, bfhi(a.y) * scale);
  d[1] = make_float4(bflo(a.z) * scale, bfhi(a.z) * scale, bflo(a.w) * scale, bfhi(a.w) * scale);
  d[2] = make_float4(bflo(b.x) * scale, bfhi(b.x) * scale, bflo(b.y) * scale, bfhi(b.y) * scale);
  d[3] = make_float4(bflo(b.z) * scale, bfhi(b.z) * scale, bflo(b.w) * scale, bfhi(b.w) * scale);
}
__device__ __forceinline__ void tile_ld_regs(const u16* src, long rstride, int tid, uint4& a, uint4& b) {
  int r = tid >> 2, part = tid & 3;
  const uint4* s = (const uint4*)(src + (long)r * rstride + part * 16);
  a = s[0]; b = s[1];
}
__device__ __forceinline__ void tile_st_regs(float* dst, int tid, const uint4& a, const uint4& b, float scale) {
  int r = tid >> 2, part = tid & 3;
  float4* d = (float4*)(dst + r * TS + part * 16);
  d[0] = make_float4(bflo(a.x) * scale, bfhi(a.x) * scale, bflo(a.y) * scale, bfhi(a.y) * scale);
  d[1] = make_float4(bflo(a.z) * scale, bfhi(a.z) * scale, bflo(a.w) * scale, bfhi(a.w) * scale);
  d[2] = make_float4(bflo(b.x) * scale, bfhi(b.x) * scale, bflo(b.y) * scale, bfhi(b.y) * scale);
  d[3] = make_float4(bflo(b.z) * scale, bfhi(b.z) * scale, bflo(b.w) * scale, bfhi(b.w) * scale);
}
__device__ __forceinline__ void load_tile_f32(float* dst, const float* src, long rstride, int tid) {
  int r = tid >> 2, part = tid & 3;
  const float4* s = (const float4*)(src + (long)r * rstride + part * 16);
  float4* d = (float4*)(dst + r * TS + part * 16);
  d[0] = s[0]; d[1] = s[1]; d[2] = s[2]; d[3] = s[3];
}
typedef __attribute__((ext_vector_type(2))) float f32x2;
__device__ __forceinline__ void qk_micro(const float* Qs, const float* Ks, int ty, int tx, float s[4][4]) {
  f32x2 s2[4][4];
#pragma unroll
  for (int i = 0; i < 4; ++i)
#pragma unroll
    for (int j = 0; j < 4; ++j) s2[i][j] = (f32x2){0.f, 0.f};
#pragma unroll 2
  for (int d4 = 0; d4 < 16; ++d4) {
    f32x4 q[4], k[4];
#pragma unroll
    for (int i = 0; i < 4; ++i) q[i] = *(const f32x4*)(Qs + (ty * 4 + i) * TS + d4 * 4);
#pragma unroll
    for (int j = 0; j < 4; ++j) k[j] = *(const f32x4*)(Ks + (tx + 16 * j) * TS + d4 * 4);
#pragma unroll
    for (int i = 0; i < 4; ++i)
#pragma unroll
      for (int j = 0; j < 4; ++j) {
        s2[i][j] += q[i].xy * k[j].xy;
        s2[i][j] += q[i].zw * k[j].zw;
      }
  }
#pragma unroll
  for (int i = 0; i < 4; ++i)
#pragma unroll
    for (int j = 0; j < 4; ++j) s[i][j] = s2[i][j].x + s2[i][j].y;
}
__device__ __forceinline__ void pv_micro(const float* Ps, const float* Vs, int ty, int tx, float o[4][4]) {
  f32x2 oa[4], ob[4];
#pragma unroll
  for (int i = 0; i < 4; ++i) { oa[i] = (f32x2){o[i][0], o[i][1]}; ob[i] = (f32x2){o[i][2], o[i][3]}; }
#pragma unroll 2
  for (int s4 = 0; s4 < 16; ++s4) {
    f32x4 pp[4], v[4];
#pragma unroll
    for (int i = 0; i < 4; ++i) pp[i] = *(const f32x4*)(Ps + (ty * 4 + i) * TS + s4 * 4);
#pragma unroll
    for (int q = 0; q < 4; ++q) v[q] = *(const f32x4*)(Vs + (s4 * 4 + q) * TS + tx * 4);
#pragma unroll
    for (int i = 0; i < 4; ++i)
#pragma unroll
      for (int q = 0; q < 4; ++q) {
        const float ps = pp[i][q];
        const f32x2 p2 = (f32x2){ps, ps};
        oa[i] += p2 * v[q].xy;
        ob[i] += p2 * v[q].zw;
      }
  }
#pragma unroll
  for (int i = 0; i < 4; ++i) { o[i][0] = oa[i].x; o[i][1] = oa[i].y; o[i][2] = ob[i].x; o[i][3] = ob[i].y; }
}

struct AttnDesc {
  int qrow0, qcol, ocol;
  const float* ck; const float* cv; int cstride; int nctx;
  int krow0, nloc, kcol, vcol;
  int mode;
  int a0;
  int r0;
  const float* rpb;
  float sink; int has_sink;
};

constexpr int AS_ = 72;
__device__ __forceinline__ void attn_item(CP p, const AttnDesc& d, float* sm) {
  const int tid = get_tid(), w = tid >> 6, lane = tid & 63, fr = lane & 15, fq = lane >> 4, half = w >> 2;
  const u16* proj = (const u16*)(p->ws + OFF_HP);
  u16* Ks = (u16*)sm;
  u16* Vt = Ks + 64 * AS_;
  u16* Ps = Vt + 64 * AS_ + w * (16 * AS_);
  bf16x8 qf[2];
  {
    const u16* qp = proj + (size_t)(d.qrow0 + w * 16 + fr) * PSTR + d.qcol + fq * 8;
    qf[0] = *(const bf16x8*)(qp);
    qf[1] = *(const bf16x8*)(qp + 32);
  }
  float m_i[4], l_i[4];
  f32x4 o[4];
#pragma unroll
  for (int j = 0; j < 4; ++j) {
    m_i[j] = d.has_sink ? d.sink : -1e30f;
    l_i[j] = (d.has_sink && fr == 0) ? 1.f : 0.f;
  }
#pragma unroll
  for (int n = 0; n < 4; ++n) o[n] = (f32x4){0.f, 0.f, 0.f, 0.f};
  const int ntiles = d.nctx + d.nloc;
  const int lrow = tid >> 3, lc8 = tid & 7;
  float4 kf0, kf1, vf0, vf1;
  u32x4 kq, vq;
  auto issue = [&](int tile) {
    if (tile < d.nctx) {
      const size_t off = (size_t)(tile * 64 + lrow) * d.cstride + lc8 * 8;
      kf0 = *(const float4*)(d.ck + off); kf1 = *(const float4*)(d.ck + off + 4);
      vf0 = *(const float4*)(d.cv + off); vf1 = *(const float4*)(d.cv + off + 4);
    } else {
      const u16* base = proj + (size_t)(d.krow0 + (tile - d.nctx) * 64 + lrow) * PSTR + lc8 * 8;
      kq = *(const u32x4*)(base + d.kcol);
      vq = *(const u32x4*)(base + d.vcol);
    }
  };
  issue(0);
  for (int tile = 0; tile < ntiles; ++tile) {
    __syncthreads();
    if (tile < d.nctx) {
      kq = (u32x4){pack2(kf0.x, kf0.y), pack2(kf0.z, kf0.w), pack2(kf1.x, kf1.y), pack2(kf1.z, kf1.w)};
      vq = (u32x4){pack2(vf0.x, vf0.y), pack2(vf0.z, vf0.w), pack2(vf1.x, vf1.y), pack2(vf1.z, vf1.w)};
    }
    *(u32x4*)(Ks + lrow * AS_ + lc8 * 8) = kq;
    {
      u16* vt = Vt + (lc8 * 8) * AS_ + lrow;
      vt[0 * AS_] = (u16)(vq.x & 0xffff); vt[1 * AS_] = (u16)(vq.x >> 16);
      vt[2 * AS_] = (u16)(vq.y & 0xffff); vt[3 * AS_] = (u16)(vq.y >> 16);
      vt[4 * AS_] = (u16)(vq.z & 0xffff); vt[5 * AS_] = (u16)(vq.z >> 16);
      vt[6 * AS_] = (u16)(vq.w & 0xffff); vt[7 * AS_] = (u16)(vq.w >> 16);
    }
    __syncthreads();
    if (tile + 1 < ntiles) issue(tile + 1);
    const int lt = tile - d.nctx;
    f32x4 sacc[4];
#pragma unroll
    for (int n = 0; n < 4; ++n) sacc[n] = (f32x4){0.f, 0.f, 0.f, 0.f};
#pragma unroll
    for (int ks = 0; ks < 2; ++ks)
#pragma unroll
      for (int n = 0; n < 4; ++n) {
        bf16x8 kb = *(const bf16x8*)(Ks + (n * 16 + fr) * AS_ + ks * 32 + fq * 8);
        sacc[n] = __builtin_amdgcn_mfma_f32_16x16x32_bf16(qf[ks], kb, sacc[n], 0, 0, 0);
      }
    float sv[4][4];
#pragma unroll
    for (int n = 0; n < 4; ++n)
#pragma unroll
      for (int j = 0; j < 4; ++j) sv[j][n] = sacc[n][j] * 0.125f;
    if (lt >= 0 && d.mode == 1) {
      const int rq = d.a0 + half;
      const int kr = d.r0 + lt;
      const int rq0 = min(max(rq - 4, 0), 8);
      const bool rowok = (kr >= rq0) && (kr < rq0 + 8);
      const int dy = min(max(kr - rq + 7, 0), 14);
      const float* rp = d.rpb + dy * 31;
#pragma unroll
      for (int j = 0; j < 4; ++j) {
        int qc = (w & 3) * 16 + fq * 4 + j;
        int ws = min(max(qc - 8, 0), 48);
#pragma unroll
        for (int n = 0; n < 4; ++n) {
          int kc = n * 16 + fr;
          bool ok = rowok && (kc >= ws) && (kc < ws + 16);
          int dx = min(max(kc - qc + 15, 0), 30);
          sv[j][n] = ok ? sv[j][n] + rp[dx] : -1e30f;
        }
      }
    } else if (lt >= 0 && d.mode == 2) {
      const int off = d.a0 + lt * 64 - half * 64;
#pragma unroll
      for (int j = 0; j < 4; ++j)
#pragma unroll
        for (int n = 0; n < 4; ++n) {
          int dd = off + (n * 16 + fr) - ((w & 3) * 16 + fq * 4 + j);
          bool ok = (dd <= 128) && (dd >= -128);
          sv[j][n] = ok ? sv[j][n] : -1e30f;
        }
    }
#pragma unroll
    for (int j = 0; j < 4; ++j) {
      float mx = fmaxf(fmaxf(sv[j][0], sv[j][1]), fmaxf(sv[j][2], sv[j][3]));
      mx = grp16_max(mx);
      float mn = fmaxf(m_i[j], mx);
      float alpha = __expf(m_i[j] - mn);
      float rs = 0.f;
#pragma unroll
      for (int n = 0; n < 4; ++n) {
        float pj = __expf(sv[j][n] - mn);
        rs += pj;
        Ps[(fq * 4 + j) * AS_ + n * 16 + fr] = f2bf(pj);
      }
      l_i[j] = l_i[j] * alpha + rs;
      m_i[j] = mn;
#pragma unroll
      for (int n = 0; n < 4; ++n) o[n][j] *= alpha;
    }
    __builtin_amdgcn_wave_barrier();
#pragma unroll
    for (int ks = 0; ks < 2; ++ks) {
      bf16x8 pa = *(const bf16x8*)(Ps + fr * AS_ + ks * 32 + fq * 8);
#pragma unroll
      for (int n = 0; n < 4; ++n) {
        bf16x8 vb = *(const bf16x8*)(Vt + (n * 16 + fr) * AS_ + ks * 32 + fq * 8);
        o[n] = __builtin_amdgcn_mfma_f32_16x16x32_bf16(pa, vb, o[n], 0, 0, 0);
      }
    }
    __builtin_amdgcn_wave_barrier();
  }
  u16* ymix = (u16*)(p->ws + OFF_YMIX);
#pragma unroll
  for (int j = 0; j < 4; ++j) {
    float inv = 1.f / grp16_sum(l_i[j]);
    u16* yp = ymix + (size_t)(d.qrow0 + w * 16 + fq * 4 + j) * D + d.ocol + fr;
#pragma unroll
    for (int n = 0; n < 4; ++n) yp[n * 16] = f2bf(o[n][j] * inv);
  }
}

constexpr int ST_SLOT = 65 * 64;
__device__ __forceinline__ int st_slot(int isctx, int b, int dir, int head, int cc) {
  int ch = (b * 2 + dir) * 8 + head;
  return isctx ? (ch * 4 + cc) : (2048 + ch * 16 + cc);
}
__device__ __forceinline__ void unpack16(const uint4& a, const uint4& b, float v[16]) {
  v[0] = bflo(a.x); v[1] = bfhi(a.x); v[2] = bflo(a.y); v[3] = bfhi(a.y); v[4] = bflo(a.z); v[5] = bfhi(a.z); v[6] = bflo(a.w); v[7] = bfhi(a.w);
  v[8] = bflo(b.x); v[9] = bfhi(b.x); v[10] = bflo(b.y); v[11] = bfhi(b.y); v[12] = bflo(b.z); v[13] = bfhi(b.z); v[14] = bflo(b.w); v[15] = bfhi(b.w);
}
__device__ __forceinline__ void store_t16(u16* dstT, int s, const uint4& a, const uint4& b) {
  dstT[0 * 72 + s] = (u16)(a.x & 0xffff); dstT[1 * 72 + s] = (u16)(a.x >> 16); dstT[2 * 72 + s] = (u16)(a.y & 0xffff); dstT[3 * 72 + s] = (u16)(a.y >> 16);
  dstT[4 * 72 + s] = (u16)(a.z & 0xffff); dstT[5 * 72 + s] = (u16)(a.z >> 16); dstT[6 * 72 + s] = (u16)(a.w & 0xffff); dstT[7 * 72 + s] = (u16)(a.w >> 16);
  dstT[8 * 72 + s] = (u16)(b.x & 0xffff); dstT[9 * 72 + s] = (u16)(b.x >> 16); dstT[10 * 72 + s] = (u16)(b.y & 0xffff); dstT[11 * 72 + s] = (u16)(b.y >> 16);
  dstT[12 * 72 + s] = (u16)(b.z & 0xffff); dstT[13 * 72 + s] = (u16)(b.z >> 16); dstT[14 * 72 + s] = (u16)(b.w & 0xffff); dstT[15 * 72 + s] = (u16)(b.w >> 16);
}

__device__ __forceinline__ void mlstm_state_item(CP p, int isctx, int b, int head, float* sm) {
  const int tid = get_tid(), dir = tid >> 8, t = tid & 255, w4 = t >> 6, lane = t & 63, fr = lane & 15, fq = lane >> 4;
  const u16* proj = (const u16*)(p->ws + OFF_HP);
  const float* gates = (const float*)(p->ws + OFF_GATES);
  u16* stCt = (u16*)(p->ws + OFF_STC);
  float* stm = (float*)(p->ws + OFF_STM);
  u16* KtW = (u16*)sm + dir * (2 * 64 * 72);
  u16* Vt = KtW + 64 * 72;
  const int nc = isctx ? 4 : 16, L = isctx ? 256 : 1024;
  const int seq0 = isctx ? b * 256 : NCTX + b * 1024;
  const int ch = (b * 2 + dir) * 8 + head;
  f32x4 cacc[4], nacc;
  float m;
  if (isctx) {
#pragma unroll
    for (int nt = 0; nt < 4; ++nt) cacc[nt] = (f32x4){0.f, 0.f, 0.f, 0.f};
    nacc = (f32x4){0.f, 0.f, 0.f, 0.f};
    m = 0.f;
  } else {
    const float* C0 = p->in[I_SC] + (size_t)ch * 4096;
#pragma unroll
    for (int nt = 0; nt < 4; ++nt)
#pragma unroll
      for (int j = 0; j < 4; ++j) cacc[nt][j] = C0[(w4 * 16 + fq * 4 + j) * 64 + nt * 16 + fr];
#pragma unroll
    for (int j = 0; j < 4; ++j) nacc[j] = p->in[I_SN][ch * 64 + w4 * 16 + fq * 4 + j];
    m = p->in[I_SM][ch];
  }
  const bf16x8 ones = (bf16x8){0x3F80, 0x3F80, 0x3F80, 0x3F80, 0x3F80, 0x3F80, 0x3F80, 0x3F80};
  const int srow = t >> 2, part = t & 3;
  uint4 ka, kb, va, vb;
  float g_li, g_fp;
  auto prefetch = [&](int cc) {
    const int tok0 = dir ? (L - 1 - cc * 64) : cc * 64;
    const long rs = dir ? -(long)PSTR : (long)PSTR;
    const u16* base = proj + (size_t)(seq0 + tok0) * PSTR;
    tile_ld_regs(base + 1280 + head * 64, rs, t, ka, kb);
    tile_ld_regs(base + 1792 + head * 64, rs, t, va, vb);
    const int tr = seq0 + (dir ? tok0 - lane : tok0 + lane);
    g_li = gates[(size_t)tr * 32 + (dir * 2) * 8 + head];
    g_fp = gates[(size_t)tr * 32 + (dir * 2 + 1) * 8 + head];
  };
  prefetch(0);
  for (int cc = 0; cc < nc; ++cc) {
    const int slot = st_slot(isctx, b, dir, head, cc);
#pragma unroll
    for (int nt = 0; nt < 4; ++nt)
      *(uint2*)(stCt + (size_t)slot * ST_SLOT + (nt * 16 + fr) * 64 + w4 * 16 + fq * 4) = make_uint2(pack2(cacc[nt][0], cacc[nt][1]), pack2(cacc[nt][2], cacc[nt][3]));
    if (fr == 0) *(uint2*)(stCt + (size_t)slot * ST_SLOT + 64 * 64 + w4 * 16 + fq * 4) = make_uint2(pack2(nacc[0], nacc[1]), pack2(nacc[2], nacc[3]));
    if (t == 0) stm[slot] = m;
    const float lf = logsigmoidf_(g_fp);
    const float bb = wave_scan_add(lf, lane);
    const float a = g_li - bb;
    const float amax = wave_max(a);
    const float blast = __shfl(bb, 63);
    const float mnew = blast + fmaxf(m, amax);
    const float wsv = expf(blast + a - mnew);
    const float wc = expf(blast + m - mnew);
    const float ws_row = __shfl(wsv, (w4 * 16 + (lane >> 2))) * 0.125f;
    __syncthreads();
    {
      float kv[16];
      unpack16(ka, kb, kv);
      u16* dk = KtW + (part * 16) * 72 + srow;
#pragma unroll
      for (int e = 0; e < 16; ++e) dk[e * 72] = f2bf(kv[e] * ws_row);
      store_t16(Vt + (part * 16) * 72, srow, va, vb);
    }
    __syncthreads();
    if (cc + 1 < nc) prefetch(cc + 1);
#pragma unroll
    for (int nt = 0; nt < 4; ++nt) { cacc[nt][0] *= wc; cacc[nt][1] *= wc; cacc[nt][2] *= wc; cacc[nt][3] *= wc; }
    nacc[0] *= wc; nacc[1] *= wc; nacc[2] *= wc; nacc[3] *= wc;
#pragma unroll
    for (int ks = 0; ks < 2; ++ks) {
      const bf16x8 af = *(const bf16x8*)(KtW + (w4 * 16 + fr) * 72 + ks * 32 + fq * 8);
#pragma unroll
      for (int nt = 0; nt < 4; ++nt) {
        const bf16x8 bfv = *(const bf16x8*)(Vt + (nt * 16 + fr) * 72 + ks * 32 + fq * 8);
        cacc[nt] = __builtin_amdgcn_mfma_f32_16x16x32_bf16(af, bfv, cacc[nt], 0, 0, 0);
      }
      nacc = __builtin_amdgcn_mfma_f32_16x16x32_bf16(af, ones, nacc, 0, 0, 0);
    }
    m = mnew;
  }
  __syncthreads();
  if (isctx) {
    float* Co = p->out + O_C + (size_t)ch * 4096;
#pragma unroll
    for (int nt = 0; nt < 4; ++nt)
#pragma unroll
      for (int j = 0; j < 4; ++j) Co[(w4 * 16 + fq * 4 + j) * 64 + nt * 16 + fr] = cacc[nt][j];
    if (fr == 0) {
#pragma unroll
      for (int j = 0; j < 4; ++j) p->out[O_N + ch * 64 + w4 * 16 + fq * 4 + j] = nacc[j];
    }
    if (t == 0) p->out[O_M + ch] = m;
  }
}

__device__ __forceinline__ void mlstm_out_item(CP p, int isctx, int b, int head, int c, float* sm) {
  const int tid = get_tid(), dir = tid >> 8, t = tid & 255, w4 = t >> 6, lane = t & 63, fr = lane & 15, fq = lane >> 4;
  const u16* proj = (const u16*)(p->ws + OFF_HP);
  const float* gates = (const float*)(p->ws + OFF_GATES);
  const u16* stCt = (const u16*)(p->ws + OFF_STC);
  const float* stm = (const float*)(p->ws + OFF_STM);
  constexpr int HALF16 = 64 * 72 * 2 + 80 * 72 + 4 * 16 * 72;
  u16* Ks = (u16*)sm + dir * HALF16;
  u16* Vt = Ks + 64 * 72;
  u16* Cts = Vt + 64 * 72;
  u16* Ws = Cts + 80 * 72 + w4 * (16 * 72);
  float* Hs = (float*)((u16*)sm + 2 * HALF16);
  const int nc = isctx ? 4 : 16;
  const int mb = (isctx ? b * 256 : NCTX + b * 1024) + c * 64;
  const int cc = dir ? nc - 1 - c : c;
  const int slot = st_slot(isctx, b, dir, head, cc);
  const float m0 = stm[slot];
  const int srow = t >> 2, part = t & 3;
  uint4 ka, kb, va, vb;
  {
    const long rs = dir ? -(long)PSTR : (long)PSTR;
    const u16* base = proj + (size_t)(mb + (dir ? 63 : 0)) * PSTR;
    tile_ld_regs(base + 1280 + head * 64, rs, t, ka, kb);
    tile_ld_regs(base + 1792 + head * 64, rs, t, va, vb);
  }
  u32x4 c0v, c1v, c2v;
  {
    const u16* cs = stCt + (size_t)slot * ST_SLOT;
    c0v = *(const u32x4*)(cs + t * 8);
    c1v = *(const u32x4*)(cs + (t + 256) * 8);
    c2v = (t < 8) ? *(const u32x4*)(cs + (t + 512) * 8) : (u32x4){0u, 0u, 0u, 0u};
  }
  bf16x8 qf[2];
  {
    const int tq = w4 * 16 + fr;
    const u16* qp = proj + (size_t)(mb + (dir ? 63 - tq : tq)) * PSTR + 768 + head * 64 + fq * 8;
    qf[0] = *(const bf16x8*)(qp);
    qf[1] = *(const bf16x8*)(qp + 32);
  }
  float a, M, bb;
  {
    const int tr = mb + (dir ? 63 - lane : lane);
    const float li = gates[(size_t)tr * 32 + (dir * 2) * 8 + head];
    const float fp = gates[(size_t)tr * 32 + (dir * 2 + 1) * 8 + head];
    const float lf = logsigmoidf_(fp);
    bb = wave_scan_add(lf, lane);
    a = li - bb;
    M = fmaxf(m0, wave_scan_max(a, lane));
  }
  __syncthreads();
  *(uint4*)(Ks + srow * 72 + part * 16) = ka;
  *(uint4*)(Ks + srow * 72 + part * 16 + 8) = kb;
  store_t16(Vt + (part * 16) * 72, srow, va, vb);
  *(u32x4*)(Cts + (t >> 3) * 72 + (t & 7) * 8) = c0v;
  *(u32x4*)(Cts + ((t + 256) >> 3) * 72 + (t & 7) * 8) = c1v;
  if (t < 8) *(u32x4*)(Cts + 64 * 72 + t * 8) = c2v;
  __syncthreads();
  f32x4 sacc[4];
#pragma unroll
  for (int nt = 0; nt < 4; ++nt) sacc[nt] = (f32x4){0.f, 0.f, 0.f, 0.f};
#pragma unroll
  for (int ks = 0; ks < 2; ++ks)
#pragma unroll
    for (int nt = 0; nt < 4; ++nt) {
      const bf16x8 kf = *(const bf16x8*)(Ks + (nt * 16 + fr) * 72 + ks * 32 + fq * 8);
      sacc[nt] = __builtin_amdgcn_mfma_f32_16x16x32_bf16(qf[ks], kf, sacc[nt], 0, 0, 0);
    }
  float a_s[4], M_t[4], b_t[4], rs[4];
#pragma unroll
  for (int nt = 0; nt < 4; ++nt) a_s[nt] = __shfl(a, nt * 16 + fr);
#pragma unroll
  for (int j = 0; j < 4; ++j) { M_t[j] = __shfl(M, w4 * 16 + fq * 4 + j); b_t[j] = __shfl(bb, w4 * 16 + fq * 4 + j); rs[j] = 0.f; }
#pragma unroll
  for (int j = 0; j < 4; ++j) {
    const int tt = w4 * 16 + fq * 4 + j;
#pragma unroll
    for (int nt = 0; nt < 4; ++nt) {
      const int ss = nt * 16 + fr;
      const float w = (ss <= tt) ? expf(a_s[nt] - M_t[j]) * (sacc[nt][j] * 0.125f) : 0.f;
      rs[j] += w;
      Ws[(fq * 4 + j) * 72 + ss] = f2bf(w);
    }
  }
  __builtin_amdgcn_wave_barrier();
  f32x4 num[4], qc[4], qn;
#pragma unroll
  for (int nt = 0; nt < 4; ++nt) { num[nt] = (f32x4){0.f, 0.f, 0.f, 0.f}; qc[nt] = (f32x4){0.f, 0.f, 0.f, 0.f}; }
  qn = (f32x4){0.f, 0.f, 0.f, 0.f};
#pragma unroll
  for (int ks = 0; ks < 2; ++ks) {
    const bf16x8 wa = *(const bf16x8*)(Ws + fr * 72 + ks * 32 + fq * 8);
#pragma unroll
    for (int nt = 0; nt < 4; ++nt) {
      const bf16x8 vb8 = *(const bf16x8*)(Vt + (nt * 16 + fr) * 72 + ks * 32 + fq * 8);
      num[nt] = __builtin_amdgcn_mfma_f32_16x16x32_bf16(wa, vb8, num[nt], 0, 0, 0);
      const bf16x8 cb8 = *(const bf16x8*)(Cts + (nt * 16 + fr) * 72 + ks * 32 + fq * 8);
      qc[nt] = __builtin_amdgcn_mfma_f32_16x16x32_bf16(qf[ks], cb8, qc[nt], 0, 0, 0);
    }
    const bf16x8 nb8 = *(const bf16x8*)(Cts + 64 * 72 + ks * 32 + fq * 8);
    qn = __builtin_amdgcn_mfma_f32_16x16x32_bf16(qf[ks], nb8, qn, 0, 0, 0);
  }
  float hv[4][4];
#pragma unroll
  for (int j = 0; j < 4; ++j) {
    const float wi = expf(m0 - M_t[j]);
    const float den = grp16_sum(rs[j]) + wi * qn[j];
    const float mt = b_t[j] + M_t[j];
    const float inv = 1.f / fmaxf(fabsf(den), expf(-mt));
#pragma unroll
    for (int nt = 0; nt < 4; ++nt) hv[j][nt] = (num[nt][j] + wi * qc[nt][j]) * inv;
  }
  if (dir == 1) {
#pragma unroll
    for (int j = 0; j < 4; ++j)
#pragma unroll
      for (int nt = 0; nt < 4; ++nt) Hs[(63 - (w4 * 16 + fq * 4 + j)) * 68 + nt * 16 + fr] = hv[j][nt];
  }
  __syncthreads();
  if (dir == 0) {
    const float* hg = p->in[I_L0 + L_X2] + head * 64;
    u16* ymix = (u16*)(p->ws + OFF_YMIX);
#pragma unroll
    for (int j = 0; j < 4; ++j) {
      const int tt = w4 * 16 + fq * 4 + j;
      float h[4], ss = 0.f;
#pragma unroll
      for (int nt = 0; nt < 4; ++nt) { h[nt] = hv[j][nt] + Hs[tt * 68 + nt * 16 + fr]; ss += h[nt] * h[nt]; }
      ss = grp16_sum(ss);
      const float rstd = rsqrtf(ss * (1.f / 64.f) + EPS);
      const int tr = mb + tt;
#pragma unroll
      for (int nt = 0; nt < 4; ++nt) {
        const int v = nt * 16 + fr;
        const float ob = bflo((unsigned)proj[(size_t)tr * PSTR + 2336 + head * 64 + v]);
        ymix[(size_t)tr * D + 512 + head * 64 + v] = f2bf(sigmoidf_(ob) * (h[nt] * rstd * hg[v]));
      }
    }
  }
}

__device__ __forceinline__ int next_item(int* ctr, int* s_item) {
  __syncthreads();
  if (get_tid() == 0) *s_item = atomicAdd(ctr, 1);
  __syncthreads();
  return *s_item;
}

__device__ __forceinline__ void mix0_phase_a(CP p, float* sm, int* s_item, int coff) {
  int* ctr = (int*)(p->ws + OFF_CTR) + 0 + coff;
  for (;;) {
    int it = next_item(ctr, s_item);
    if (it >= 912) break;
    if (it >= 128 && it < 144) {
      int v = it - 128; int b = v >> 3, head = v & 7;
      mlstm_state_item(p, 0, b, head, sm);
    } else if (it >= 656) {
      int v = it - 656; int b = v >> 3, head = v & 7;
      mlstm_state_item(p, 1, b, head, sm);
    } else {
      AttnDesc d;
      d.mode = 0; d.a0 = 0; d.r0 = 0; d.rpb = nullptr; d.sink = 0.f; d.has_sink = 0;
      if (it < 128) {
        int b = it >> 6, h = (it >> 3) & 7, qb = it & 7;
        d.qrow0 = NCTX + b * 1024 + qb * 128; d.qcol = h * 64; d.ocol = h * 64;
        d.ck = p->in[I_C0K] + (size_t)b * 256 * 128 + (h >> 2) * 64; d.cv = p->in[I_C0V] + (size_t)b * 256 * 128 + (h >> 2) * 64;
        d.cstride = 128; d.nctx = 4;
        d.krow0 = NCTX + b * 1024; d.nloc = 16; d.kcol = 512 + (h >> 2) * 64; d.vcol = 640 + (h >> 2) * 64;
      } else {
        int v = it - 144; int b = v >> 4, h = (v >> 1) & 7, qb = v & 1;
        d.qrow0 = b * 256 + qb * 128; d.qcol = h * 64; d.ocol = h * 64;
        d.ck = nullptr; d.cv = nullptr; d.cstride = 0; d.nctx = 0;
        d.krow0 = b * 256; d.nloc = 4; d.kcol = 512 + (h >> 2) * 64; d.vcol = 640 + (h >> 2) * 64;
      }
      attn_item(p, d, sm);
    }
  }
}

__device__ __forceinline__ void mix0_phase_b(CP p, float* sm, int* s_item, int coff) {
  int* ctr = (int*)(p->ws + OFF_CTR) + 1 + coff;
  for (;;) {
    int it = next_item(ctr, s_item);
    if (it >= 1280) break;
    if (it < 256) {
      int b = it >> 7, head = (it >> 4) & 7, c = it & 15;
      mlstm_out_item(p, 0, b, head, c, sm);
    } else {
      int v = it - 256; int b = v >> 5, head = (v >> 2) & 7, c = v & 3;
      mlstm_out_item(p, 1, b, head, c, sm);
    }
  }
}

__device__ __forceinline__ void mix1_phase(CP p, float* sm, int* s_item, int coff) {
  int* ctr = (int*)(p->ws + OFF_CTR) + 2 + coff;
  const float* sink = p->in[I_L1 + L_X1];
  for (;;) {
    int it = next_item(ctr, s_item);
    if (it >= 1280) break;
    AttnDesc d;
    d.mode = 0; d.a0 = 0; d.r0 = 0; d.rpb = nullptr; d.sink = 0.f; d.has_sink = 0;
    if (it < 128) {
      int b = it >> 6, h = (it >> 3) & 7, r = (it & 7) * 2;
      int r0 = min(max(r - 4, 0), 8);
      int r1 = min(max(r + 1 - 4, 0), 8) + 8;
      d.qrow0 = NCTX + b * 1024 + r * 64; d.qcol = h * 64; d.ocol = h * 64;
      d.ck = p->in[I_NAK] + (size_t)b * 256 * 512 + h * 64; d.cv = p->in[I_NAV] + (size_t)b * 256 * 512 + h * 64;
      d.cstride = 512; d.nctx = 4;
      d.krow0 = NCTX + b * 1024 + r0 * 64; d.nloc = r1 - r0; d.kcol = 512 + h * 64; d.vcol = 1024 + h * 64;
      d.mode = 1; d.a0 = r; d.r0 = r0; d.rpb = p->in[I_L1 + L_X0] + h * 15 * 31;
    } else if (it < 256) {
      int v = it - 128; int b = v >> 6, h = (v >> 3) & 7, qb = v & 7;
      int t0 = qb * 128;
      int s0 = max(t0 - 128, 0);
      int s1 = min(t0 + 256, 1024);
      d.qrow0 = NCTX + b * 1024 + t0; d.qcol = 1536 + h * 64; d.ocol = 512 + h * 64;
      d.ck = p->in[I_SWK] + (size_t)b * 256 * 128 + (h >> 2) * 64; d.cv = p->in[I_SWV] + (size_t)b * 256 * 128 + (h >> 2) * 64;
      d.cstride = 128; d.nctx = 4;
      d.krow0 = NCTX + b * 1024 + s0; d.nloc = (s1 - s0) >> 6; d.kcol = 2048 + (h >> 2) * 64; d.vcol = 2176 + (h >> 2) * 64;
      d.mode = 2; d.a0 = s0 - t0;
      d.sink = sink[h]; d.has_sink = 1;
    } else if (it < 768) {
      int v = it - 256; int b = v >> 4, h = (v >> 1) & 7, qb = v & 1;
      d.qrow0 = b * 256 + qb * 128; d.qcol = h * 64; d.ocol = h * 64;
      d.ck = nullptr; d.cv = nullptr; d.cstride = 0; d.nctx = 0;
      d.krow0 = b * 256; d.nloc = 4; d.kcol = 512 + h * 64; d.vcol = 1024 + h * 64;
    } else {
      int v = it - 768; int b = v >> 4, h = (v >> 1) & 7, qb = v & 1;
      d.qrow0 = b * 256 + qb * 128; d.qcol = 1536 + h * 64; d.ocol = 512 + h * 64;
      d.ck = nullptr; d.cv = nullptr; d.cstride = 0; d.nctx = 0;
      d.krow0 = b * 256; d.nloc = 4; d.kcol = 2048 + (h >> 2) * 64; d.vcol = 2176 + (h >> 2) * 64;
      d.sink = sink[h]; d.has_sink = 1;
    }
    attn_item(p, d, sm);
  }
}

#define XB_TMO      128
#define XB_XCNT(j)  (256  + 64 * (j))
#define XB_XSUB(j)  (1280 + 64 * (j))
#define XB_XGEN(j)  (2304 + 64 * (j))
#define XB_TOP      3328
#define XB_TOPGEN   3392
#define XCD_BAR_WORDS 3456
#define XB_SPIN_CAP (1u << 22)
__device__ __forceinline__ unsigned xb_ld(unsigned* p) { return __hip_atomic_load(p, __ATOMIC_RELAXED, __HIP_MEMORY_SCOPE_AGENT); }
__device__ __forceinline__ unsigned xb_add(unsigned* p, unsigned v) { return __hip_atomic_fetch_add(p, v, __ATOMIC_RELAXED, __HIP_MEMORY_SCOPE_AGENT); }
__device__ __forceinline__ unsigned xb_xcc_id() { return (unsigned)__builtin_amdgcn_s_getreg((3 << 11) | 20) & 0xFu; }
#define XB_SPIN(cond, bar) do { unsigned _sp = 0; while (cond) { __builtin_amdgcn_s_sleep(1); \
    if ((++_sp & 255u) == 0u) { if (xb_ld(&(bar)[XB_TMO])) break; if (_sp > XB_SPIN_CAP) { atomicAdd(&(bar)[XB_TMO], 1u); break; } } } } while (0)
struct XcdBarrier { unsigned* bar; unsigned x; volatile LAS unsigned* st; };
__device__ __forceinline__ XcdBarrier xcd_barrier_post(unsigned* bar, volatile LAS unsigned* st) {
  XcdBarrier b; b.bar = bar; b.x = xb_xcc_id(); b.st = st;
  if (threadIdx.x == 0) (void)xb_add(&bar[XB_XCNT(b.x)], 1u);
  return b;
}
__device__ __forceinline__ void xcd_barrier_complete(unsigned* bar, unsigned x, unsigned& nloc, unsigned& nx) {
  const unsigned G = gridDim.x * gridDim.y * gridDim.z;
  unsigned sum, cnt, mine, sp = 0u;
  for (;;) {
    sum = 0u; cnt = 0u; mine = 0u;
#pragma unroll
    for (unsigned j = 0; j < 16; ++j) { const unsigned c = xb_ld(&bar[XB_XCNT(j)]); sum += c; cnt += (c > 0u) ? 1u : 0u; mine = (j == x) ? c : mine; }
    if (sum == G) break;
    __builtin_amdgcn_s_sleep(1);
    if ((++sp & 255u) == 0u) { if (xb_ld(&bar[XB_TMO])) break; if (sp > XB_SPIN_CAP) { atomicAdd(&bar[XB_TMO], 1u); break; } }
  }
  nloc = mine > 0u ? mine : 1u; nx = cnt > 0u ? cnt : 1u;
}
__device__ __forceinline__ void xcd_barrier(const XcdBarrier& b) {
  asm volatile("s_waitcnt vmcnt(0)" ::: "memory");
  __syncthreads();
  if (threadIdx.x == 0) {
    unsigned* bar = b.bar;
    __builtin_amdgcn_s_waitcnt(0);
    unsigned nloc = b.st[0], nx = b.st[1];
    if (nloc == 0u) { xcd_barrier_complete(bar, b.x, nloc, nx); b.st[0] = nloc; b.st[1] = nx; }
    const unsigned old = xb_add(&bar[XB_XSUB(b.x)], 1u);
    const unsigned gen = old / nloc;
    if (old + 1u == (gen + 1u) * nloc) {
      __builtin_amdgcn_fence(__ATOMIC_RELEASE, "agent");
      asm volatile("s_waitcnt vmcnt(0)" ::: "memory");
      const unsigned og = xb_add(&bar[XB_TOP], 1u);
      const unsigned tg = og / nx;
      if (og + 1u == (tg + 1u) * nx) xb_add(&bar[XB_TOPGEN], 1u);
      else XB_SPIN(xb_ld(&bar[XB_TOPGEN]) == tg, bar);
      __builtin_amdgcn_fence(__ATOMIC_ACQUIRE, "agent");
      xb_add(&bar[XB_XGEN(b.x)], 1u);
      asm volatile("s_waitcnt vmcnt(0)" ::: "memory");
    } else {
      XB_SPIN(xb_ld(&bar[XB_XGEN(b.x)]) == gen, bar);
      __builtin_amdgcn_fence(__ATOMIC_ACQUIRE, "agent");
      asm volatile("s_waitcnt vmcnt(0)" ::: "memory");
    }
  }
  __syncthreads();
}

constexpr int NPHASE = 18;
__device__ __forceinline__ void run_phase(CP p, int ph, char* smem, int* s_item, const int dry) {
  float* smf = (float*)smem;
  u16* smh = (u16*)smem;
  const u16* xn = (const u16*)(p->ws + OFF_XN);
  const u16* hp = (const u16*)(p->ws + OFF_HP);
  const u16* ymix = (const u16*)(p->ws + OFF_YMIX);
  if (ph == 0) { prep_a_phase(p, smf); return; }
  if (ph == 1) { prep_b_phase(p, smf, dry); return; }
  if (ph == 17) { final_phase(p); return; }
  const int l = (ph >= 10) ? 1 : 0;
  int q = ph - (l ? 10 : 2);
  if (l == 1 && q >= 4) q += 1;
  if (q == 0 || q == 6) {
    const int f = (q == 6) ? 1 : 0;
    gemm_phase<EPI_SWIGLU>(p, xn, (const u16*)(p->ws + OFF_WIN + (l * 2 + f) * SZ_WIN), 1024, 22, l, 0, 0.f, l * 3 + (f ? 2 : 0), smh);
    return;
  }
  if (q == 1 || q == 5 || q == 7) {
    const u16* A = (q == 5) ? ymix : hp;
    const u16* Bt = (q == 5) ? (const u16*)(p->ws + OFF_WMO + (size_t)l * D * D * 2)
                             : (const u16*)(p->ws + OFF_WOUT + (l * 2 + (q == 7 ? 1 : 0)) * SZ_WOUT);
    const int K = (q == 5) ? 1024 : DFF;
    const int gch = (q == 1) ? 2 : (q == 5 ? 5 : 8);
    const float coef = dry ? 0.f : ((q == 5) ? 1.f : 0.5f);
    const int nid_next = l * 3 + ((q == 1) ? 1 : (q == 5 ? 2 : 3));
    gemm_phase<EPI_RESID>(p, A, Bt, K, 4, l, gch, coef, dry ? 7 : nid_next, smh, dry ? 0 : (l == 0 ? (q == 1 ? 1 : (q == 5 ? 2 : 3)) : (q == 1 ? 4 : 0)));
    return;
  }
  if (q == 2) {
    if (l == 0) gemm_phase<EPI_MIX0>(p, xn, (const u16*)(p->ws + OFF_WMI0), 1024, 12, l, 0, 0.f, 1, smh);
    else gemm_phase<EPI_MIX1>(p, xn, (const u16*)(p->ws + OFF_WMI1), 1024, 9, l, 0, 0.f, 4, smh);
    return;
  }
  if (q == 3) { if (l == 0) mix0_phase_a(p, smf, s_item, dry * 3); else mix1_phase(p, smf, s_item, dry * 3); return; }
  if (q == 4) { mix0_phase_b(p, smf, s_item, dry * 3); return; }
}

__global__ void __launch_bounds__(512, 2) mega(Params kp, int ph0, int ph1, int dry) {
  extern __shared__ __attribute__((aligned(16))) char smem[];
  int* s_item_p = (int*)(smem + SMEM_BYTES);
  uint4* xb_words_p = (uint4*)(smem + SMEM_BYTES + 16);
  if (threadIdx.x == 0) *xb_words_p = make_uint4(0u, 0u, 0u, 0u);
  __syncthreads();
  XcdBarrier xb = xcd_barrier_post((unsigned*)(kp.ws + OFF_BAR), (volatile LAS unsigned*)xb_words_p);
  if (ph1 < 0) cg::this_grid().sync();
  for (int ph = ph0; ph < ph1; ++ph) {
    if (ph > ph0) xcd_barrier(xb);
    CP p = (CP)__builtin_amdgcn_kernarg_segment_ptr();
    asm volatile("" : "+s"(p));
    run_phase(p, ph, smem, s_item_p, dry);
  }
}

extern "C" void kernel_launch(void* const* d_in, const int* in_sizes, int n_in, void* d_out, int out_size, void* d_ws,
                              size_t ws_size, hipStream_t stream) {
  static int grid_blocks = 0;
  if (!grid_blocks) {
    int dev = 0, cus = 0, per_cu = 0;
    hipGetDevice(&dev);
    hipDeviceGetAttribute(&cus, hipDeviceAttributeMultiprocessorCount, dev);
    hipFuncSetAttribute((const void*)mega, hipFuncAttributeMaxDynamicSharedMemorySize, DYN_LDS);
    hipOccupancyMaxActiveBlocksPerMultiprocessor(&per_cu, mega, NTH, DYN_LDS);
    if (per_cu > 1) per_cu = 1;
    if (per_cu < 1) per_cu = 1;
    grid_blocks = cus * per_cu;
  }
  if (ws_size < WS_TOTAL) fprintf(stderr, "workspace too small: %zu < %zu\n", ws_size, (size_t)WS_TOTAL);
  Params p{};
  for (int i = 0; i < 37; ++i) p.in[i] = (const float*)d_in[i];
  p.out = (float*)d_out;
  p.ws = (char*)d_ws;
  hipMemsetAsync((char*)d_ws + OFF_CTR, 0, ZERO_BYTES, stream);
#if SINGLE_LAUNCH
  int ph0 = 0, ph1 = NPHASE, dry = 0;
  void* args[] = {&p, &ph0, &ph1, &dry};
  hipError_t e = hipLaunchCooperativeKernel((void*)mega, dim3(grid_blocks), dim3(NTH), args, DYN_LDS, stream);
  if (e != hipSuccess) fprintf(stderr, "cooperative launch failed: %s (grid %d)\n", hipGetErrorString(e), grid_blocks);
#else
  for (int ph = 0; ph < NPHASE; ++ph) {
    mega<<<grid_blocks, NTH, DYN_LDS, stream>>>(p, ph, ph + 1, 0);
    const bool g1 = (ph == 2 || ph == 8 || ph == 10 || ph == 15), g2 = (ph == 3 || ph == 9 || ph == 11 || ph == 16);
    const bool mi = (ph == 4 || ph == 12), mo = (ph == 7 || ph == 14), mx = (ph == 5 || ph == 6 || ph == 13);
    if (((REP_MASK & 1) && g1) || ((REP_MASK & 2) && g2) || ((REP_MASK & 4) && (mi || mo)) || ((REP_MASK & 8) && mx) ||
        ((REP_MASK & 16) && ph == 0) || ((REP_MASK & 32) && ph == 1))
      mega<<<grid_blocks, NTH, DYN_LDS, stream>>>(p, ph, ph + 1, 1);
  }
#endif
}
```

```cpp
#include <hip/hip_runtime.h>
#include <hip/hip_cooperative_groups.h>
#include <cstdio>
namespace cg = cooperative_groups;

#ifndef REP_MASK
#define REP_MASK 0
#endif
#ifndef SINGLE_LAUNCH
#define SINGLE_LAUNCH 1
#endif

typedef unsigned short u16;
typedef __attribute__((ext_vector_type(8))) short bf16x8;
typedef __attribute__((ext_vector_type(4))) float f32x4;
typedef __attribute__((ext_vector_type(4))) unsigned u32x4;
#define LAS __attribute__((address_space(3)))

constexpr int D = 1024, NCTX = 8192, MTOK = 10240;
constexpr int DFF = 2816, NFF = 5632;
constexpr int P0N = 2848, P0P = 3072, P1N = 2304;
constexpr int PSTR = 2944;
constexpr float EPS = 1e-6f;

enum { I_XP = 0, I_XS, I_C0K, I_C0V, I_SC, I_SN, I_SM, I_NAK, I_NAV, I_SWK, I_SWV, I_C, I_CCTX, I_NF,
       I_L0 = 14, I_L1 = 26 };
enum { L_ADAW = 0, L_ADAB, L_NORM, L_F1I, L_F1O, L_F2I, L_F2O, L_MI, L_MO, L_X0, L_X1, L_X2 };

constexpr size_t O_X = 0, O_K0 = 10485760, O_V0 = 11534336, O_C = 12582912, O_N = 14680064, O_M = 14712832,
                 O_KC1 = 14713344, O_VC1 = 18907648, O_KD1 = 23101952, O_VD1 = 24150528;

constexpr size_t SZ_WIN = (size_t)NFF * D * 2;
constexpr size_t SZ_WOUT = (size_t)D * DFF * 2;
constexpr size_t OFF_WIN = 0;
constexpr size_t OFF_WOUT = OFF_WIN + 4 * SZ_WIN;
constexpr size_t OFF_WMI0 = OFF_WOUT + 4 * SZ_WOUT;
constexpr size_t OFF_WMI1 = OFF_WMI0 + (size_t)P0P * D * 2;
constexpr size_t OFF_WMO = OFF_WMI1 + (size_t)P1N * D * 2;
constexpr size_t OFF_MOD = OFF_WMO + 2 * (size_t)D * D * 2;
constexpr size_t OFF_ROPE = OFF_MOD + 2 * 3 * 9216 * 4;
constexpr size_t OFF_CTR = OFF_ROPE + 2 * 1024 * 32 * 4;
constexpr size_t OFF_BAR = OFF_CTR + 256;
constexpr size_t OFF_ROWSS = OFF_CTR + 16384;
constexpr size_t OFF_BIAS = OFF_ROWSS + (size_t)7 * MTOK * 4;
constexpr size_t ZERO_BYTES = 16384 + (size_t)7 * MTOK * 4 + (size_t)2 * 3 * 3 * NFF * 4;
constexpr size_t OFF_XN = OFF_CTR + ZERO_BYTES;
constexpr size_t OFF_YMIX = OFF_XN + (size_t)MTOK * D * 2;
constexpr size_t OFF_HP = OFF_YMIX + (size_t)MTOK * D * 2;
constexpr size_t OFF_GATES = OFF_HP + (size_t)MTOK * PSTR * 2;
constexpr size_t OFF_STC = OFF_GATES + (size_t)MTOK * 32 * 4;
constexpr size_t OFF_STN = OFF_STC + (size_t)2560 * 4096 * 4;
constexpr size_t OFF_STM = OFF_STN + (size_t)2560 * 64 * 4;
constexpr size_t WS_TOTAL = OFF_STM + 2560 * 4;

constexpr int TS = 68;
constexpr int TILE_F = 64 * TS;
constexpr int SMEM_BYTES = 8 * TILE_F * 4 + 4096;
constexpr int NTH = 512;
constexpr int DYN_LDS = SMEM_BYTES + 64 + 256;

struct Params {
  const float* in[37];
  float* out;
  char* ws;
};
typedef const __attribute__((address_space(4))) Params* CP;

constexpr int TIDTAB_OFF = SMEM_BYTES + 64;
__device__ __forceinline__ int hw_wave_slot() { return (int)(__builtin_amdgcn_s_getreg((5 << 11) | 4) & 63u); }
__device__ __forceinline__ int get_tid() {
  extern __shared__ __attribute__((aligned(16))) char smem[];
  const volatile LAS int* tab = (const volatile LAS int*)(smem + TIDTAB_OFF);
  int wv = tab[hw_wave_slot()];
  int t = wv * 64 + (int)__builtin_amdgcn_mbcnt_hi(~0u, __builtin_amdgcn_mbcnt_lo(~0u, 0u));
  asm volatile("" : "+v"(t));
  return t;
}
__device__ __forceinline__ u16 f2bf(float f) {
  unsigned u = __float_as_uint(f);
  u += 0x7fffu + ((u >> 16) & 1u);
  return (u16)(u >> 16);
}
__device__ __forceinline__ unsigned pack2(float a, float b) { return (unsigned)f2bf(a) | ((unsigned)f2bf(b) << 16); }
__device__ __forceinline__ float bflo(unsigned x) { return __uint_as_float(x << 16); }
__device__ __forceinline__ float bfhi(unsigned x) { return __uint_as_float(x & 0xffff0000u); }
template <int CTRL>
__device__ __forceinline__ float dpp_mov(float v) {
  return __builtin_bit_cast(float, __builtin_amdgcn_update_dpp(0, __builtin_bit_cast(int, v), CTRL, 0xF, 0xF, true));
}
__device__ __forceinline__ float grp16_sum(float v) {
  v += dpp_mov<0xB1>(v); v += dpp_mov<0x4E>(v); v += dpp_mov<0x141>(v); v += dpp_mov<0x140>(v); return v;
}
__device__ __forceinline__ float grp16_max(float v) {
  v = fmaxf(v, dpp_mov<0xB1>(v)); v = fmaxf(v, dpp_mov<0x4E>(v)); v = fmaxf(v, dpp_mov<0x141>(v)); v = fmaxf(v, dpp_mov<0x140>(v)); return v;
}
__device__ __forceinline__ float rl_f(float v, int l) { return __builtin_bit_cast(float, __builtin_amdgcn_readlane(__builtin_bit_cast(int, v), l)); }
__device__ __forceinline__ float wave_sum(float v) {
  v = grp16_sum(v);
  return (rl_f(v, 0) + rl_f(v, 16)) + (rl_f(v, 32) + rl_f(v, 48));
}
__device__ __forceinline__ float wave_max(float v) {
  v = grp16_max(v);
  return fmaxf(fmaxf(rl_f(v, 0), rl_f(v, 16)), fmaxf(rl_f(v, 32), rl_f(v, 48)));
}
__device__ __forceinline__ float wave_scan_add(float v, int lane) {
  for (int o = 1; o < 64; o <<= 1) { float t = __shfl_up(v, o); if (lane >= o) v += t; }
  return v;
}
__device__ __forceinline__ float wave_scan_max(float v, int lane) {
  for (int o = 1; o < 64; o <<= 1) { float t = __shfl_up(v, o); if (lane >= o) v = fmaxf(v, t); }
  return v;
}
__device__ __forceinline__ int cond_of(int row) { return row < NCTX ? 0 : 1 + ((row - NCTX) >> 10); }
__device__ __forceinline__ float sigmoidf_(float x) { return 1.f / (1.f + expf(-x)); }
__device__ __forceinline__ float logsigmoidf_(float x) { return fminf(x, 0.f) - log1pf(expf(-fabsf(x))); }

__device__ void conv_tile(const float* __restrict__ W, int K, int N, u16* __restrict__ Wt, int perm, int kt, int nt, float* T, int t, bool valid,
                          const float* shp, float* biasp) {
  {
    int r = t >> 4, c4 = t & 15;
    int c = c4 * 4;
    int src;
    if (perm == 1) src = ((nt & 3) < 2 ? 0 : DFF) + (nt >> 2) * 128 + (nt & 1) * 64 + c;
    else if (perm == 2) {
      int bj = (nt & 3) >> 1, wc = (nt & 1) * 2 + (c >> 5), w = c & 31;
      src = (nt >> 2) * 256 + wc * 64 + bj * 32 + w;
    } else src = nt * 64 + c;
    bool ok = valid && (src < N);
#pragma unroll
    for (int ps = 0; ps < 4; ++ps) {
      int k = r + ps * 16;
      float4 v = make_float4(0.f, 0.f, 0.f, 0.f);
      if (ok) v = *(const float4*)(W + (size_t)(kt * 64 + k) * N + src);
      float* tt = T + k * 65 + c;
      tt[0] = v.x; tt[1] = v.y; tt[2] = v.z; tt[3] = v.w;
    }
  }
  if (biasp && t < 192) T[4224 + t] = shp[(t >> 6) * 9216 + kt * 64 + (t & 63)];
  __syncthreads();
  if (valid && biasp && t < 192) {
    int a = t >> 6, c = t & 63;
    int src;
    if (perm == 1) src = ((nt & 3) < 2 ? 0 : DFF) + (nt >> 2) * 128 + (nt & 1) * 64 + c;
    else { int bj = (nt & 3) >> 1, wc = (nt & 1) * 2 + (c >> 5), w = c & 31; src = (nt >> 2) * 256 + wc * 64 + bj * 32 + w; }
    if (src < N) {
      const float* sh = T + 4224 + a * 64;
      float acc = 0.f;
#pragma unroll 16
      for (int k = 0; k < 64; ++k) acc += sh[k] * T[k * 65 + c];
      unsafeAtomicAdd(biasp + a * NFF + src, acc);
    }
  }
  if (valid) {
    int n = t >> 2, kp = t & 3;
    unsigned o[8];
#pragma unroll
    for (int i = 0; i < 8; ++i) {
      float a = T[(kp * 16 + 2 * i) * 65 + n], b = T[(kp * 16 + 2 * i + 1) * 65 + n];
      o[i] = pack2(a, b);
    }
    uint4* dst = (uint4*)(Wt + (size_t)(nt * 64 + n) * K + kt * 64 + kp * 16);
    dst[0] = make_uint4(o[0], o[1], o[2], o[3]);
    dst[1] = make_uint4(o[4], o[5], o[6], o[7]);
  }
  __syncthreads();
}

__device__ void adaln_unit(CP p, int u, float* sm, int t, bool valid) {
  int l = u / 144, cg_ = u % 144;
  if (!valid) { l = 0; cg_ = 0; }
  const float* W = p->in[(l ? I_L1 : I_L0) + L_ADAW];
  const float* B = p->in[(l ? I_L1 : I_L0) + L_ADAB];
  float* sc = sm;
  float* red = sm + 3072;
  for (int i = t; i < 3072; i += 256) {
    int cnd = i >> 10, k = i & 1023;
    float v = (cnd == 0) ? p->in[I_CCTX][k] : p->in[I_C][(cnd - 1) * 1024 + k];
    sc[i] = v / (1.f + expf(-v));
  }
  __syncthreads();
  int kp = t >> 4, c4 = t & 15;
  float acc[3][4];
#pragma unroll
  for (int a = 0; a < 3; ++a)
#pragma unroll
    for (int e = 0; e < 4; ++e) acc[a][e] = 0.f;
  for (int kk = 0; kk < 64; ++kk) {
    int k = kp * 64 + kk;
    float4 w = *(const float4*)(W + (size_t)k * 9216 + cg_ * 64 + c4 * 4);
#pragma unroll
    for (int a = 0; a < 3; ++a) {
      float s = sc[a * 1024 + k];
      acc[a][0] += s * w.x; acc[a][1] += s * w.y; acc[a][2] += s * w.z; acc[a][3] += s * w.w;
    }
  }
#pragma unroll
  for (int a = 0; a < 3; ++a)
#pragma unroll
    for (int e = 0; e < 4; ++e) red[(kp * 3 + a) * 64 + c4 * 4 + e] = acc[a][e];
  __syncthreads();
  if (valid && t < 192) {
    int a = t >> 6, col = t & 63;
    float s = 0.f;
    for (int q = 0; q < 16; ++q) s += red[(q * 3 + a) * 64 + col];
    s += B[cg_ * 64 + col];
    float* mod = (float*)(p->ws + OFF_MOD);
    mod[(l * 3 + a) * 9216 + cg_ * 64 + col] = s;
  }
  __syncthreads();
}

__device__ __forceinline__ int conv_units_of(int l, int kind) {
  return (kind == 0 || kind == 4) ? 1408 : ((kind == 1 || kind == 5) ? 704 : (kind == 3 ? 256 : (l ? 576 : 768)));
}
__device__ __forceinline__ void conv_job(CP p, int l, int kind, int tt, float* smh, int t, bool valid) {
  const float* mod = (const float*)(p->ws + OFF_MOD);
  float* bias = (float*)(p->ws + OFF_BIAS);
  const float* W; u16* Wt; int K, N, perm, ntn, which = -1;
  const int lb = l ? I_L1 : I_L0;
  if (kind == 0 || kind == 4) {
    const int f = kind == 4;
    W = p->in[lb + (f ? L_F2I : L_F1I)]; Wt = (u16*)(p->ws + OFF_WIN + (l * 2 + f) * SZ_WIN);
    K = 1024; N = NFF; perm = 1; ntn = 88; which = f ? 2 : 0;
  } else if (kind == 1 || kind == 5) {
    const int f = kind == 5;
    W = p->in[lb + (f ? L_F2O : L_F1O)]; Wt = (u16*)(p->ws + OFF_WOUT + (l * 2 + f) * SZ_WOUT);
    K = DFF; N = 1024; perm = 0; ntn = 16;
  } else if (kind == 2) {
    W = p->in[lb + L_MI]; Wt = (u16*)(p->ws + (l ? OFF_WMI1 : OFF_WMI0));
    K = 1024; N = l ? P1N : P0N; perm = 2; ntn = l ? 36 : 48; which = 1;
  } else {
    W = p->in[lb + L_MO]; Wt = (u16*)(p->ws + OFF_WMO + (size_t)l * D * D * 2);
    K = 1024; N = 1024; perm = 0; ntn = 16;
  }
  const int nt = tt % ntn, kt = tt / ntn;
  const bool wb = which >= 0;
  conv_tile(W, K, N, Wt, perm, kt, nt, smh, t, valid, wb ? mod + (l * 3) * 9216 + (3 * which) * 1024 : nullptr,
            wb ? bias + (size_t)((l * 3 + which) * 3) * NFF : nullptr);
}

__device__ __forceinline__ void conv_side_job(CP p, int side, int nwg, float* sm) {
  const int tid = get_tid(), half = tid >> 8, t = tid & 255;
  float* smh = sm + half * 8192;
  const int first = ((int)gridDim.x >= nwg + 32) ? nwg : 0;
  const int nb = (int)gridDim.x - first;
  if ((int)blockIdx.x < first) return;
  const int U = (side == 1) ? 3136 : (side == 2 ? 2112 : (side == 3 ? 2240 : 704));
  for (int ub = ((int)blockIdx.x - first) * 2; ub < U; ub += nb * 2) {
    int u = ub + half;
    const bool valid = u < U;
    if (!valid) u = 0;
    int l, kind, tt;
    if (side == 1) {
      l = 0;
      if (u < 768) { kind = 2; tt = u; } else if (u < 1024) { kind = 3; tt = u - 768; }
      else if (u < 2432) { kind = 4; tt = u - 1024; } else { kind = 5; tt = u - 2432; }
    } else if (side == 2) {
      l = 1;
      if (u < 1408) { kind = 0; tt = u; } else { kind = 1; tt = u - 1408; }
    } else if (side == 3) {
      l = 1;
      if (u < 576) { kind = 2; tt = u; } else if (u < 832) { kind = 3; tt = u - 576; } else { kind = 4; tt = u - 832; }
    } else {
      l = 1; kind = 5; tt = u;
    }
    conv_job(p, l, kind, tt, smh, t, valid);
  }
}

__device__ __forceinline__ void prep_a_phase(CP p, float* sm) {
  const int tid = get_tid(), half = tid >> 8, t = tid & 255;
  float* smh = sm + half * 8192;
  constexpr int U_CONV = 704, U_ADA = 288, U_ROPE = 64;
  for (int ub = blockIdx.x * 2; ub < U_ADA; ub += gridDim.x * 2) {
    int u = ub + half;
    adaln_unit(p, u, smh, t, u < U_ADA);
  }
  for (int ub = blockIdx.x * 2; ub < U_CONV; ub += gridDim.x * 2) {
    int u = ub + half;
    bool valid = u < U_CONV;
    if (!valid) u = 0;
    conv_job(p, 0, 1, u, smh, t, valid);
  }
  for (int u = blockIdx.x; u < U_ROPE; u += gridDim.x) {
    int e = u * 512 + tid;
    int tk = e >> 5, i = e & 31;
    float pos = (i < 16) ? (float)(tk >> 6) : (float)(tk & 63);
    float fr = powf(10000.f, -(float)(i & 15) / 16.f);
    float ang = pos * fr;
    float* rc = (float*)(p->ws + OFF_ROPE);
    rc[e] = cosf(ang);
    rc[32768 + e] = sinf(ang);
  }
}

__device__ __forceinline__ void prep_b_phase(CP p, float* sm, const int dry) {
  const int tid = get_tid(), half = tid >> 8, t = tid & 255, lane = tid & 63, w = tid >> 6;
  float* smh = sm + half * 8192;
  const float* mod = (const float*)(p->ws + OFF_MOD);
  constexpr int U_CONV = 1408;
  for (int ub = blockIdx.x * 2; ub < U_CONV; ub += gridDim.x * 2) {
    int u = ub + half;
    bool valid = u < U_CONV;
    if (!valid) u = 0;
    conv_job(p, 0, 0, u, smh, t, valid);
  }
  {
    float* x = p->out + O_X;
    u16* xn = (u16*)(p->ws + OFF_XN);
    float* rowss = (float*)(p->ws + OFF_ROWSS);
    const float4* g = (const float4*)(p->in[I_L0 + L_NORM]);
    for (int row = blockIdx.x * 8 + w; row < MTOK; row += gridDim.x * 8) {
      const float4* src = (row < NCTX) ? (const float4*)(p->in[I_XP] + (size_t)row * D) : (const float4*)(p->in[I_XS] + (size_t)(row - NCTX) * D);
      float4* xr = (float4*)(x + (size_t)row * D);
      const float4* sc = (const float4*)(mod + (size_t)cond_of(row) * 9216 + 1024);
      float ss = 0.f;
#pragma unroll
      for (int i = 0; i < 4; ++i) {
        int q = lane + i * 64;
        float4 v = src[q];
        ss += v.x * v.x + v.y * v.y + v.z * v.z + v.w * v.w;
        xr[q] = v;
        float4 gg = g[q], s2 = sc[q];
        uint2 o = make_uint2(pack2(v.x * (gg.x * (1.f + s2.x)), v.y * (gg.y * (1.f + s2.y))), pack2(v.z * (gg.z * (1.f + s2.z)), v.w * (gg.w * (1.f + s2.w))));
        *(uint2*)(xn + (size_t)row * D + q * 4) = o;
      }
      ss = wave_sum(ss);
      if (lane == 0) rowss[row] = ss;
    }
  }
}

__device__ __forceinline__ void final_phase(CP p) {
  const int tid = get_tid(), lane = tid & 63, w = tid >> 6;
  float* x = p->out + O_X;
  const float* rowss = (const float*)(p->ws + OFF_ROWSS) + 6 * MTOK;
  const float4* g = (const float4*)p->in[I_NF];
  for (int row = blockIdx.x * 8 + w; row < MTOK; row += gridDim.x * 8) {
    float4* xr = (float4*)(x + (size_t)row * D);
    const float rstd = rsqrtf(rowss[row] * (1.f / 1024.f) + EPS);
#pragma unroll
    for (int i = 0; i < 4; ++i) {
      int q = lane + i * 64;
      float4 v = xr[q], gg = g[q];
      xr[q] = make_float4(v.x * rstd * gg.x, v.y * rstd * gg.y, v.z * rstd * gg.z, v.w * rstd * gg.w);
    }
  }
}

enum { EPI_SWIGLU = 0, EPI_RESID = 1, EPI_MIX0 = 2, EPI_MIX1 = 3 };
constexpr int BM = 256, BK = 64, HALF = 128, HT = HALF * BK, NXCD = 8, WGM = 8;

__device__ __forceinline__ int lds_byte(int r, int c) {
  int st = (r >> 4) * 2 + (c >> 5), rr = r & 15, cc = c & 31, ob = rr * 64 + cc * 2;
  return st * 1024 + (ob ^ (((ob >> 9) & 1) << 5));
}
__device__ __forceinline__ void stage_rc(int b, int& R, int& C) {
  int st = b / 1024, sb = b % 1024, swz = sb ^ (((sb >> 9) & 1) << 5);
  R = (st >> 1) * 16 + swz / 64; C = (st & 1) * 32 + (swz % 64) / 2;
}

template <int EPI>
__device__ __forceinline__ void gemm256_tile(CP p, const u16* A, const u16* Bt, const int K,
                                             const int brow, const int bcol, int l, int gchunk, float coef, int nid, u16* shm) {
#define SWZ_LANE() ([]() { unsigned ln = __builtin_amdgcn_mbcnt_hi(~0u, __builtin_amdgcn_mbcnt_lo(~0u, 0u)); asm volatile("" : "+v"(ln)); \
    unsigned ob = (ln & 15u) * 64u + (ln >> 4) * 16u; return ob ^ (((ob >> 9) & 1u) << 5); }())
#define SAI(b, h) ((b) * 2 + (h))
#define SBI(b, h) (4 + (b) * 2 + (h))
#define STAGE(PI, BASE, br, kt) do { \
    const char* _gb = (const char*)(BASE) + ((long)(br) * K + (long)(kt) * BK) * 2; \
    char* _lp = (char*)shm + (PI) * (HT * 2) + wave_lds; \
    __builtin_amdgcn_global_load_lds((const unsigned*)(_gb + voff0), (LAS unsigned*)(_lp), 16, 0, 0); \
    __builtin_amdgcn_global_load_lds((const unsigned*)(_gb + (long)K * 128 + voff0), (LAS unsigned*)(_lp + 8192), 16, 0, 0); } while (0)
#define LDA(dst, PI) do { unsigned _o = SWZ_LANE() + a_uni; asm volatile("" : "+v"(_o)); _o &= 0x23F0u; \
    _Pragma("unroll") for (int m = 0; m < 4; ++m) _Pragma("unroll") for (int k = 0; k < 2; ++k) \
      dst[m][k] = *reinterpret_cast<const bf16x8*>((const char*)shm + (PI) * (HT * 2) + m * 2048 + k * 1024 + _o); } while (0)
#define LDB(dst, PI) do { unsigned _o = SWZ_LANE() + b_uni; asm volatile("" : "+v"(_o)); _o &= 0x33F0u; \
    _Pragma("unroll") for (int n = 0; n < 2; ++n) _Pragma("unroll") for (int k = 0; k < 2; ++k) \
      dst[n][k] = *reinterpret_cast<const bf16x8*>((const char*)shm + (PI) * (HT * 2) + n * 2048 + k * 1024 + _o); } while (0)
#define MMA(ai, bj, At_, Bt_) do { __builtin_amdgcn_s_setprio(1); \
    _Pragma("unroll") for (int m = 0; m < 4; ++m) _Pragma("unroll") for (int n = 0; n < 2; ++n) _Pragma("unroll") for (int k = 0; k < 2; ++k) \
      acc[ai][bj][m][n] = __builtin_amdgcn_mfma_f32_16x16x32_bf16(At_[m][k], Bt_[n][k], acc[ai][bj][m][n], 0, 0, 0); \
    __builtin_amdgcn_s_setprio(0); } while (0)
#define WAIT_V(n) asm volatile("s_waitcnt vmcnt(" #n ")" ::: "memory")
#define WAIT_L(n) asm volatile("s_waitcnt lgkmcnt(" #n ")" ::: "memory")
#define BAR __builtin_amdgcn_s_barrier()
#define SCHED __builtin_amdgcn_sched_barrier(0)
  const int tid0 = get_tid();
  const int coef_bits = __builtin_amdgcn_readfirstlane(__float_as_int(coef));
  const int wid = __builtin_amdgcn_readfirstlane(tid0 >> 6), wr = wid >> 2, wc = wid & 3;
  const int wave_lds = (wid & 7) * 1024;
  unsigned voff0;
  { int r_, c_; stage_rc(tid0 * 16, r_, c_); voff0 = (unsigned)(r_ * K + c_) * 2u; }
  const unsigned a_uni = (unsigned)(wr * 8192), b_uni = (unsigned)(wc * 4096);
  f32x4 acc[2][2][4][2];
#pragma unroll
  for (int a = 0; a < 2; ++a)
#pragma unroll
    for (int b = 0; b < 2; ++b)
#pragma unroll
      for (int m = 0; m < 4; ++m)
#pragma unroll
        for (int n = 0; n < 2; ++n) acc[a][b][m][n] = (f32x4){0.f, 0.f, 0.f, 0.f};
  bf16x8 At[4][2], B0[2][2], B1[2][2];
  const int nt = K / BK;
  WAIT_V(0);
  __syncthreads();
  STAGE(SBI(0, 0), Bt, bcol, 0); STAGE(SAI(0, 0), A, brow, 0);
  STAGE(SBI(0, 1), Bt, bcol + HALF, 0); STAGE(SAI(0, 1), A, brow + HALF, 0);
  if (wr == 1) BAR;
  STAGE(SBI(1, 0), Bt, bcol, 1); STAGE(SBI(1, 1), Bt, bcol + HALF, 1);
  WAIT_V(4); BAR; BAR;
  for (int t = 0; t < nt - 2; t += 2) {
    LDB(B0, SBI(0, 0)); LDB(B1, SBI(0, 1)); SCHED; LDA(At, SAI(0, 0));
    STAGE(SAI(1, 0), A, brow, t + 1); STAGE(SAI(1, 1), A, brow + HALF, t + 1);
    WAIT_L(8); BAR; WAIT_L(0); MMA(0, 0, At, B0); MMA(0, 1, At, B1); BAR; SCHED;
    LDA(At, SAI(0, 1)); STAGE(SBI(0, 0), Bt, bcol, t + 2); STAGE(SBI(0, 1), Bt, bcol + HALF, t + 2);
    WAIT_V(4); WAIT_L(0); BAR; MMA(1, 0, At, B0); MMA(1, 1, At, B1); BAR; SCHED;
    LDB(B0, SBI(1, 0)); LDB(B1, SBI(1, 1)); SCHED; LDA(At, SAI(1, 0));
    STAGE(SAI(0, 0), A, brow, t + 2); STAGE(SAI(0, 1), A, brow + HALF, t + 2);
    WAIT_L(8); BAR; WAIT_L(0); MMA(0, 0, At, B0); MMA(0, 1, At, B1); BAR; SCHED;
    LDA(At, SAI(1, 1)); STAGE(SBI(1, 0), Bt, bcol, t + 3); STAGE(SBI(1, 1), Bt, bcol + HALF, t + 3);
    WAIT_V(4); WAIT_L(0); BAR; MMA(1, 0, At, B0); MMA(1, 1, At, B1); BAR; SCHED;
  }
  { LDB(B0, SBI(0, 0)); LDB(B1, SBI(0, 1)); SCHED; LDA(At, SAI(0, 0));
    STAGE(SAI(1, 0), A, brow, nt - 1); STAGE(SAI(1, 1), A, brow + HALF, nt - 1);
    WAIT_L(8); BAR; WAIT_L(0); MMA(0, 0, At, B0); MMA(0, 1, At, B1); BAR; SCHED;
    LDA(At, SAI(0, 1)); WAIT_V(0); WAIT_L(0); BAR; MMA(1, 0, At, B0); MMA(1, 1, At, B1); BAR; SCHED;
    LDB(B0, SBI(1, 0)); LDB(B1, SBI(1, 1)); SCHED; LDA(At, SAI(1, 0));
    BAR; WAIT_L(0); MMA(0, 0, At, B0); MMA(0, 1, At, B1); BAR; SCHED;
    LDA(At, SAI(1, 1)); WAIT_L(0); BAR; MMA(1, 0, At, B0); MMA(1, 1, At, B1); BAR; }
  if (wr == 0) BAR;
#undef SAI
#undef SWZ_LANE
#undef SBI
#undef STAGE
#undef LDA
#undef LDB
#undef MMA
#undef WAIT_V
#undef WAIT_L
#undef BAR
#undef SCHED
  unsigned lane_e = __builtin_amdgcn_mbcnt_hi(~0u, __builtin_amdgcn_mbcnt_lo(~0u, 0u));
  asm volatile("" : "+v"(lane_e));
  const int lane = (int)lane_e, fr = lane & 15, fq = lane >> 4, tid = wid * 64 + lane;
  if (EPI == EPI_SWIGLU) {
    u16* H = (u16*)(p->ws + OFF_HP);
    const int hcl = wc * 32 + fr;
    const int hc0 = (bcol >> 1) + hcl;
    const float* rowss = (const float*)(p->ws + OFF_ROWSS) + (size_t)nid * MTOK;
    const float* bias = (const float*)(p->ws + OFF_BIAS) + (size_t)(nid * 3 + cond_of(brow)) * NFF;
    float bg[2], bu[2];
#pragma unroll
    for (int n = 0; n < 2; ++n) { bg[n] = bias[hc0 + n * 16]; bu[n] = bias[DFF + hc0 + n * 16]; }
    u16* Hs = shm;
#pragma unroll
    for (int ai = 0; ai < 2; ++ai)
#pragma unroll
      for (int m = 0; m < 4; ++m)
#pragma unroll
        for (int j = 0; j < 4; ++j) {
          const int rl = ai * 128 + wr * 64 + m * 16 + fq * 4 + j;
          const float rstd = rsqrtf(rowss[brow + rl] * (1.f / 1024.f) + EPS);
#pragma unroll
          for (int n = 0; n < 2; ++n) {
            float g = acc[ai][0][m][n][j] * rstd + bg[n], u = acc[ai][1][m][n][j] * rstd + bu[n];
            float h = g / (1.f + __expf(-g)) * u;
            Hs[rl * 136 + hcl + n * 16] = f2bf(h);
          }
        }
    __syncthreads();
#pragma unroll
    for (int i = 0; i < 8; ++i) {
      const int q = tid + 512 * i, r = q >> 4, c = q & 15;
      const u32x4 v = *(const u32x4*)(Hs + r * 136 + c * 8);
      *(u32x4*)(H + (size_t)(brow + r) * DFF + (bcol >> 1) + c * 8) = v;
    }
  } else if (EPI == EPI_RESID) {
    float* x = p->out + O_X;
    const float* mod = (const float*)(p->ws + OFF_MOD);
    u16* xn = (u16*)(p->ws + OFF_XN);
    float* rowss = (float*)(p->ws + OFF_ROWSS) + (size_t)nid * MTOK;
    const int cnd = cond_of(brow);
    const bool has_next = nid < 6;
    const int ln = (nid % 6) / 3, wn = nid % 3;
    const int col4 = bcol + lane * 4;
    float4 gt4 = *(const float4*)(mod + (l * 3 + cnd) * 9216 + gchunk * 1024 + col4);
    int cbl = coef_bits; asm volatile("" : "+s"(cbl)); const float cf = __int_as_float(cbl);
    gt4.x *= cf; gt4.y *= cf; gt4.z *= cf; gt4.w *= cf;
    float4 gs4 = make_float4(0.f, 0.f, 0.f, 0.f);
    if (has_next) {
      const float4 ng = *(const float4*)(p->in[(ln ? I_L1 : I_L0) + L_NORM] + wn * 1024 + col4);
      const float4 sc = *(const float4*)(mod + (ln * 3 + cnd) * 9216 + (3 * wn + 1) * 1024 + col4);
      gs4 = make_float4(ng.x * (1.f + sc.x), ng.y * (1.f + sc.y), ng.z * (1.f + sc.z), ng.w * (1.f + sc.w));
    }
    float* Cs = (float*)shm;
    float4 xv0[16], xv1[16];
#pragma unroll
    for (int i = 0; i < 16; ++i) xv0[i] = *(const float4*)(x + (size_t)(brow + wid + 8 * i) * D + col4);
#pragma unroll
    for (int bj = 0; bj < 2; ++bj)
#pragma unroll
      for (int m = 0; m < 4; ++m)
#pragma unroll
        for (int n = 0; n < 2; ++n)
#pragma unroll
          for (int j = 0; j < 4; ++j)
            Cs[(wr * 64 + m * 16 + fq * 4 + j) * 260 + bj * 128 + wc * 32 + n * 16 + fr] = acc[0][bj][m][n][j];
    __syncthreads();
#pragma unroll
    for (int ai = 0; ai < 2; ++ai) {
      if (ai) {
#pragma unroll
        for (int i = 0; i < 16; ++i) xv1[i] = *(const float4*)(x + (size_t)(brow + 128 + wid + 8 * i) * D + col4);
        __syncthreads();
#pragma unroll
        for (int bj = 0; bj < 2; ++bj)
#pragma unroll
          for (int m = 0; m < 4; ++m)
#pragma unroll
            for (int n = 0; n < 2; ++n)
#pragma unroll
              for (int j = 0; j < 4; ++j)
                Cs[(wr * 64 + m * 16 + fq * 4 + j) * 260 + bj * 128 + wc * 32 + n * 16 + fr] = acc[1][bj][m][n][j];
        __syncthreads();
      }
#pragma unroll
      for (int i = 0; i < 16; ++i) {
        const int r = wid + 8 * i;
        const int row = brow + ai * 128 + r;
        const float4 a = *(const float4*)(Cs + r * 260 + lane * 4);
        float4 xv = ai ? xv1[i] : xv0[i];
        xv.x += gt4.x * a.x; xv.y += gt4.y * a.y; xv.z += gt4.z * a.z; xv.w += gt4.w * a.w;
        *(float4*)(x + (size_t)row * D + col4) = xv;
        float ss = xv.x * xv.x + xv.y * xv.y + xv.z * xv.z + xv.w * xv.w;
        if (has_next) *(uint2*)(xn + (size_t)row * D + col4) = make_uint2(pack2(xv.x * gs4.x, xv.y * gs4.y), pack2(xv.z * gs4.z, xv.w * gs4.w));
        ss = wave_sum(ss);
        if (lane == 0 && nid < 7) unsafeAtomicAdd(rowss + row, ss);
      }
    }
  } else {
    u16* proj = (u16*)(p->ws + OFF_HP);
    u16* Pst = shm;
    const bool isctx = brow < NCTX;
    const int c0 = bcol + wc * 64;
    const float* rc = (const float*)(p->ws + OFF_ROPE);
    const float* rowss = (const float*)(p->ws + OFF_ROWSS) + (size_t)nid * MTOK;
    const float* bias = (const float*)(p->ws + OFF_BIAS) + (size_t)(nid * 3 + cond_of(brow)) * NFF;
    float bz[2][2];
#pragma unroll
    for (int bj = 0; bj < 2; ++bj)
#pragma unroll
      for (int n = 0; n < 2; ++n) { int col = c0 + bj * 32 + n * 16 + fr; bz[bj][n] = (col < ((EPI == EPI_MIX0) ? P0N : P1N)) ? bias[col] : 0.f; }
    bool do_norm = false, do_rope = false;
    const float* ng = nullptr;
    float* o32 = nullptr; int ostr = 0;
    bool elementwise = false;
    if (EPI == EPI_MIX0) {
      if (c0 < 512) { do_norm = true; ng = p->in[I_L0 + L_X0]; do_rope = !isctx; }
      else if (c0 < 640) { do_norm = true; ng = p->in[I_L0 + L_X0] + 64; do_rope = !isctx; if (isctx) { o32 = p->out + O_K0 + (c0 - 512); ostr = 128; } }
      else if (c0 < 768) { if (isctx) { o32 = p->out + O_V0 + (c0 - 640); ostr = 128; } }
      else if (c0 >= 2304) elementwise = true;
    } else {
      if (c0 < 512) {}
      else if (c0 < 1024) { if (isctx) { o32 = p->out + O_KC1 + (c0 - 512); ostr = 512; } }
      else if (c0 < 1536) { if (isctx) { o32 = p->out + O_VC1 + (c0 - 1024); ostr = 512; } }
      else if (c0 < 2048) { do_rope = !isctx; }
      else if (c0 < 2176) { do_rope = !isctx; if (isctx) { o32 = p->out + O_KD1 + (c0 - 2048); ostr = 128; } }
      else { if (isctx) { o32 = p->out + O_VD1 + (c0 - 2176); ostr = 128; } }
    }
    if (elementwise) {
      float* gates = (float*)(p->ws + OFF_GATES);
      const float* gb = p->in[I_L0 + L_X1];
#pragma unroll
      for (int ai = 0; ai < 2; ++ai)
#pragma unroll
        for (int m = 0; m < 4; ++m)
#pragma unroll
          for (int j = 0; j < 4; ++j) {
            int row = brow + ai * 128 + wr * 64 + m * 16 + fq * 4 + j;
            const float rstd = rsqrtf(rowss[row] * (1.f / 1024.f) + EPS);
#pragma unroll
            for (int bj = 0; bj < 2; ++bj)
#pragma unroll
              for (int n = 0; n < 2; ++n) {
                int col = c0 + bj * 32 + n * 16 + fr;
                float v = acc[ai][bj][m][n][j] * rstd + bz[bj][n];
                if (col < 2336) gates[(size_t)row * 32 + (col - 2304)] = v + gb[col - 2304];
                else if (col < P0N) Pst[(row - brow) * 264 + (col - bcol)] = f2bf(v);
              }
          }
    } else {
#pragma unroll
      for (int ai = 0; ai < 2; ++ai)
#pragma unroll
        for (int m = 0; m < 4; ++m)
#pragma unroll
          for (int j = 0; j < 4; ++j) {
            int row = brow + ai * 128 + wr * 64 + m * 16 + fq * 4 + j;
            const float rstd0 = rsqrtf(rowss[row] * (1.f / 1024.f) + EPS);
            float v0 = acc[ai][0][m][0][j] * rstd0 + bz[0][0], v1 = acc[ai][0][m][1][j] * rstd0 + bz[0][1];
            float v2 = acc[ai][1][m][0][j] * rstd0 + bz[1][0], v3 = acc[ai][1][m][1][j] * rstd0 + bz[1][1];
            if (do_norm) {
              float ss = v0 * v0 + v1 * v1 + v2 * v2 + v3 * v3;
              ss = grp16_sum(ss);
              float rstd = rsqrtf(ss * (1.f / 64.f) + EPS);
              v0 = v0 * rstd * ng[fr]; v1 = v1 * rstd * ng[16 + fr]; v2 = v2 * rstd * ng[32 + fr]; v3 = v3 * rstd * ng[48 + fr];
            }
            if (do_rope) {
              int tk = (row - NCTX) & 1023;
              float ca = rc[tk * 32 + fr], sa = rc[32768 + tk * 32 + fr];
              float cb = rc[tk * 32 + 16 + fr], sb = rc[32768 + tk * 32 + 16 + fr];
              float a0 = v0 * ca - v2 * sa, a2 = v2 * ca + v0 * sa;
              float a1 = v1 * cb - v3 * sb, a3 = v3 * cb + v1 * sb;
              v0 = a0; v1 = a1; v2 = a2; v3 = a3;
            }
            u16* pr = Pst + (row - brow) * 264 + (c0 - bcol) + fr;
            pr[0] = f2bf(v0); pr[16] = f2bf(v1); pr[32] = f2bf(v2); pr[48] = f2bf(v3);
            if (o32) {
              float* o = o32 + (size_t)row * ostr + fr;
              o[0] = v0; o[16] = v1; o[32] = v2; o[48] = v3;
            }
          }
    }
    __syncthreads();
#pragma unroll 1
    for (int i = 0; i < 16; ++i) {
      const int q = tid + 512 * i, r = q >> 5, c = q & 31;
      const int col = bcol + c * 8;
      if (col < PSTR) *(u32x4*)(proj + (size_t)(brow + r) * PSTR + col) = *(const u32x4*)(Pst + r * 264 + c * 8);
    }
  }
}

template <int EPI>
__device__ __forceinline__ void gemm_phase(CP p, const u16* A, const u16* Bt, int K, int nN, int l, int gchunk, float coef, int nid, u16* smem, int side = 0) {
  const int nM = MTOK / BM, nwg = nM * nN;
  for (int t = blockIdx.x; t < nwg; t += gridDim.x) {
    int wgid = t;
    { int q = nwg / NXCD, r = nwg % NXCD, xcd = wgid % NXCD, off = wgid / NXCD;
      wgid = (xcd < r ? xcd * (q + 1) : r * (q + 1) + (xcd - r) * q) + off; }
    int nig = WGM * nN, gid = wgid / nig, fm = gid * WGM, gsz = min(nM - fm, WGM);
    int pm = fm + ((wgid % nig) % gsz), pn = (wgid % nig) / gsz;
    gemm256_tile<EPI>(p, A, Bt, K, pm * BM, pn * BM, l, gchunk, coef, nid, smem);
  }
  if (EPI == EPI_RESID && side) { __syncthreads(); conv_side_job(p, side, nwg, (float*)smem); }
}

__device__ __forceinline__ void load_tile_bf16(float* dst, const u16* src, long rstride, float scale, int tid) {
  int r = tid >> 2, part = tid & 3;
  const uint4* s = (const uint4*)(src + (long)r * rstride + part * 16);
  uint4 a = s[0], b = s[1];
  float4* d = (float4*)(dst + r * TS + part * 16);
  d[0] = make_float4(bflo(a.x) * scale, bfhi(a.x) * scale, bflo(a.y) * scale, bfhi(a.y) * scale);
  d[1] = make_float4(bflo(a.z) * scale, bfhi(a.z) * scale, bflo(a.w) * scale, bfhi(a.w) * scale);
  d[2] = make_float4(bflo(b.x) * scale, bfhi(b.x) * scale, bflo(b.y) * scale, bfhi(b.y) * scale);
  d[3] = make_float4(bflo(b.z) * scale, bfhi(b.z) * scale, bflo(b.w) * scale, bfhi(b.w) * scale);
}
__device__ __forceinline__ void tile_ld_regs(const u16* src, long rstride, int tid, uint4& a, uint4& b) {
  int r = tid >> 2, part = tid & 3;
  const uint4* s = (const uint4*)(src + (long)r * rstride + part * 16);
  a = s[0]; b = s[1];
}
__device__ __forceinline__ void tile_st_regs(float* dst, int tid, const uint4& a, const uint4& b, float scale) {
  int r = tid >> 2, part = tid & 3;
  float4* d = (float4*)(dst + r * TS + part * 16);
  d[0] = make_float4(bflo(a.x) * scale, bfhi(a.x) * scale, bflo(a.y) * scale, bfhi(a.y) * scale);
  d[1] = make_float4(bflo(a.z) * scale, bfhi(a.z) * scale, bflo(a.w) * scale, bfhi(a.w) * scale);
  d[2] = make_float4(bflo(b.x) * scale, bfhi(b.x) * scale, bflo(b.y) * scale, bfhi(b.y) * scale);
  d[3] = make_float4(bflo(b.z) * scale, bfhi(b.z) * scale, bflo(b.w) * scale, bfhi(b.w) * scale);
}
__device__ __forceinline__ void load_tile_f32(float* dst, const float* src, long rstride, int tid) {
  int r = tid >> 2, part = tid & 3;
  const float4* s = (const float4*)(src + (long)r * rstride + part * 16);
  float4* d = (float4*)(dst + r * TS + part * 16);
  d[0] = s[0]; d[1] = s[1]; d[2] = s[2]; d[3] = s[3];
}
typedef __attribute__((ext_vector_type(2))) float f32x2;
__device__ __forceinline__ void qk_micro(const float* Qs, const float* Ks, int ty, int tx, float s[4][4]) {
  f32x2 s2[4][4];
#pragma unroll
  for (int i = 0; i < 4; ++i)
#pragma unroll
    for (int j = 0; j < 4; ++j) s2[i][j] = (f32x2){0.f, 0.f};
#pragma unroll 2
  for (int d4 = 0; d4 < 16; ++d4) {
    f32x4 q[4], k[4];
#pragma unroll
    for (int i = 0; i < 4; ++i) q[i] = *(const f32x4*)(Qs + (ty * 4 + i) * TS + d4 * 4);
#pragma unroll
    for (int j = 0; j < 4; ++j) k[j] = *(const f32x4*)(Ks + (tx + 16 * j) * TS + d4 * 4);
#pragma unroll
    for (int i = 0; i < 4; ++i)
#pragma unroll
      for (int j = 0; j < 4; ++j) {
        s2[i][j] += q[i].xy * k[j].xy;
        s2[i][j] += q[i].zw * k[j].zw;
      }
  }
#pragma unroll
  for (int i = 0; i < 4; ++i)
#pragma unroll
    for (int j = 0; j < 4; ++j) s[i][j] = s2[i][j].x + s2[i][j].y;
}
__device__ __forceinline__ void pv_micro(const float* Ps, const float* Vs, int ty, int tx, float o[4][4]) {
  f32x2 oa[4], ob[4];
#pragma unroll
  for (int i = 0; i < 4; ++i) { oa[i] = (f32x2){o[i][0], o[i][1]}; ob[i] = (f32x2){o[i][2], o[i][3]}; }
#pragma unroll 2
  for (int s4 = 0; s4 < 16; ++s4) {
    f32x4 pp[4], v[4];
#pragma unroll
    for (int i = 0; i < 4; ++i) pp[i] = *(const f32x4*)(Ps + (ty * 4 + i) * TS + s4 * 4);
#pragma unroll
    for (int q = 0; q < 4; ++q) v[q] = *(const f32x4*)(Vs + (s4 * 4 + q) * TS + tx * 4);
#pragma unroll
    for (int i = 0; i < 4; ++i)
#pragma unroll
      for (int q = 0; q < 4; ++q) {
        const float ps = pp[i][q];
        const f32x2 p2 = (f32x2){ps, ps};
        oa[i] += p2 * v[q].xy;
        ob[i] += p2 * v[q].zw;
      }
  }
#pragma unroll
  for (int i = 0; i < 4; ++i) { o[i][0] = oa[i].x; o[i][1] = oa[i].y; o[i][2] = ob[i].x; o[i][3] = ob[i].y; }
}

struct AttnDesc {
  int qrow0, qcol, ocol;
  const float* ck; const float* cv; int cstride; int nctx;
  int krow0, nloc, kcol, vcol;
  int mode;
  int a0;
  int r0;
  const float* rpb;
  float sink; int has_sink;
};

constexpr int AS_ = 72;
__device__ __forceinline__ void attn_item(CP p, const AttnDesc& d, float* sm) {
  const int tid = get_tid(), w = tid >> 6, lane = tid & 63, fr = lane & 15, fq = lane >> 4, half = w >> 2;
  const u16* proj = (const u16*)(p->ws + OFF_HP);
  u16* Ks = (u16*)sm;
  u16* Vt = Ks + 64 * AS_;
  u16* Ps = Vt + 64 * AS_ + w * (16 * AS_);
  bf16x8 qf[2];
  {
    const u16* qp = proj + (size_t)(d.qrow0 + w * 16 + fr) * PSTR + d.qcol + fq * 8;
    qf[0] = *(const bf16x8*)(qp);
    qf[1] = *(const bf16x8*)(qp + 32);
  }
  float m_i[4], l_i[4];
  f32x4 o[4];
#pragma unroll
  for (int j = 0; j < 4; ++j) {
    m_i[j] = d.has_sink ? d.sink : -1e30f;
    l_i[j] = (d.has_sink && fr == 0) ? 1.f : 0.f;
  }
#pragma unroll
  for (int n = 0; n < 4; ++n) o[n] = (f32x4){0.f, 0.f, 0.f, 0.f};
  const int ntiles = d.nctx + d.nloc;
  const int lrow = tid >> 3, lc8 = tid & 7;
  float4 kf0, kf1, vf0, vf1;
  u32x4 kq, vq;
  auto issue = [&](int tile) {
    if (tile < d.nctx) {
      const size_t off = (size_t)(tile * 64 + lrow) * d.cstride + lc8 * 8;
      kf0 = *(const float4*)(d.ck + off); kf1 = *(const float4*)(d.ck + off + 4);
      vf0 = *(const float4*)(d.cv + off); vf1 = *(const float4*)(d.cv + off + 4);
    } else {
      const u16* base = proj + (size_t)(d.krow0 + (tile - d.nctx) * 64 + lrow) * PSTR + lc8 * 8;
      kq = *(const u32x4*)(base + d.kcol);
      vq = *(const u32x4*)(base + d.vcol);
    }
  };
  issue(0);
  for (int tile = 0; tile < ntiles; ++tile) {
    __syncthreads();
    if (tile < d.nctx) {
      kq = (u32x4){pack2(kf0.x, kf0.y), pack2(kf0.z, kf0.w), pack2(kf1.x, kf1.y), pack2(kf1.z, kf1.w)};
      vq = (u32x4){pack2(vf0.x, vf0.y), pack2(vf0.z, vf0.w), pack2(vf1.x, vf1.y), pack2(vf1.z, vf1.w)};
    }
    *(u32x4*)(Ks + lrow * AS_ + lc8 * 8) = kq;
    {
      u16* vt = Vt + (lc8 * 8) * AS_ + lrow;
      vt[0 * AS_] = (u16)(vq.x & 0xffff); vt[1 * AS_] = (u16)(vq.x >> 16);
      vt[2 * AS_] = (u16)(vq.y & 0xffff); vt[3 * AS_] = (u16)(vq.y >> 16);
      vt[4 * AS_] = (u16)(vq.z & 0xffff); vt[5 * AS_] = (u16)(vq.z >> 16);
      vt[6 * AS_] = (u16)(vq.w & 0xffff); vt[7 * AS_] = (u16)(vq.w >> 16);
    }
    __syncthreads();
    if (tile + 1 < ntiles) issue(tile + 1);
    const int lt = tile - d.nctx;
    f32x4 sacc[4];
#pragma unroll
    for (int n = 0; n < 4; ++n) sacc[n] = (f32x4){0.f, 0.f, 0.f, 0.f};
#pragma unroll
    for (int ks = 0; ks < 2; ++ks)
#pragma unroll
      for (int n = 0; n < 4; ++n) {
        bf16x8 kb = *(const bf16x8*)(Ks + (n * 16 + fr) * AS_ + ks * 32 + fq * 8);
        sacc[n] = __builtin_amdgcn_mfma_f32_16x16x32_bf16(qf[ks], kb, sacc[n], 0, 0, 0);
      }
    float sv[4][4];
#pragma unroll
    for (int n = 0; n < 4; ++n)
#pragma unroll
      for (int j = 0; j < 4; ++j) sv[j][n] = sacc[n][j] * 0.125f;
    if (lt >= 0 && d.mode == 1) {
      const int rq = d.a0 + half;
      const int kr = d.r0 + lt;
      const int rq0 = min(max(rq - 4, 0), 8);
      const bool rowok = (kr >= rq0) && (kr < rq0 + 8);
      const int dy = min(max(kr - rq + 7, 0), 14);
      const float* rp = d.rpb + dy * 31;
#pragma unroll
      for (int j = 0; j < 4; ++j) {
        int qc = (w & 3) * 16 + fq * 4 + j;
        int ws = min(max(qc - 8, 0), 48);
#pragma unroll
        for (int n = 0; n < 4; ++n) {
          int kc = n * 16 + fr;
          bool ok = rowok && (kc >= ws) && (kc < ws + 16);
          int dx = min(max(kc - qc + 15, 0), 30);
          sv[j][n] = ok ? sv[j][n] + rp[dx] : -1e30f;
        }
      }
    } else if (lt >= 0 && d.mode == 2) {
      const int off = d.a0 + lt * 64 - half * 64;
#pragma unroll
      for (int j = 0; j < 4; ++j)
#pragma unroll
        for (int n = 0; n < 4; ++n) {
          int dd = off + (n * 16 + fr) - ((w & 3) * 16 + fq * 4 + j);
          bool ok = (dd <= 128) && (dd >= -128);
          sv[j][n] = ok ? sv[j][n] : -1e30f;
        }
    }
#pragma unroll
    for (int j = 0; j < 4; ++j) {
      float mx = fmaxf(fmaxf(sv[j][0], sv[j][1]), fmaxf(sv[j][2], sv[j][3]));
      mx = grp16_max(mx);
      float mn = fmaxf(m_i[j], mx);
      float alpha = __expf(m_i[j] - mn);
      float rs = 0.f;
#pragma unroll
      for (int n = 0; n < 4; ++n) {
        float pj = __expf(sv[j][n] - mn);
        rs += pj;
        Ps[(fq * 4 + j) * AS_ + n * 16 + fr] = f2bf(pj);
      }
      l_i[j] = l_i[j] * alpha + rs;
      m_i[j] = mn;
#pragma unroll
      for (int n = 0; n < 4; ++n) o[n][j] *= alpha;
    }
    __builtin_amdgcn_wave_barrier();
#pragma unroll
    for (int ks = 0; ks < 2; ++ks) {
      bf16x8 pa = *(const bf16x8*)(Ps + fr * AS_ + ks * 32 + fq * 8);
#pragma unroll
      for (int n = 0; n < 4; ++n) {
        bf16x8 vb = *(const bf16x8*)(Vt + (n * 16 + fr) * AS_ + ks * 32 + fq * 8);
        o[n] = __builtin_amdgcn_mfma_f32_16x16x32_bf16(pa, vb, o[n], 0, 0, 0);
      }
    }
    __builtin_amdgcn_wave_barrier();
  }
  u16* ymix = (u16*)(p->ws + OFF_YMIX);
#pragma unroll
  for (int j = 0; j < 4; ++j) {
    float inv = 1.f / grp16_sum(l_i[j]);
    u16* yp = ymix + (size_t)(d.qrow0 + w * 16 + fq * 4 + j) * D + d.ocol + fr;
#pragma unroll
    for (int n = 0; n < 4; ++n) yp[n * 16] = f2bf(o[n][j] * inv);
  }
}

constexpr int ST_SLOT = 65 * 64;
__device__ __forceinline__ int st_slot(int isctx, int b, int dir, int head, int cc) {
  int ch = (b * 2 + dir) * 8 + head;
  return isctx ? (ch * 4 + cc) : (2048 + ch * 16 + cc);
}
__device__ __forceinline__ void unpack16(const uint4& a, const uint4& b, float v[16]) {
  v[0] = bflo(a.x); v[1] = bfhi(a.x); v[2] = bflo(a.y); v[3] = bfhi(a.y); v[4] = bflo(a.z); v[5] = bfhi(a.z); v[6] = bflo(a.w); v[7] = bfhi(a.w);
  v[8] = bflo(b.x); v[9] = bfhi(b.x); v[10] = bflo(b.y); v[11] = bfhi(b.y); v[12] = bflo(b.z); v[13] = bfhi(b.z); v[14] = bflo(b.w); v[15] = bfhi(b.w);
}
__device__ __forceinline__ void store_t16(u16* dstT, int s, const uint4& a, const uint4& b) {
  dstT[0 * 72 + s] = (u16)(a.x & 0xffff); dstT[1 * 72 + s] = (u16)(a.x >> 16); dstT[2 * 72 + s] = (u16)(a.y & 0xffff); dstT[3 * 72 + s] = (u16)(a.y >> 16);
  dstT[4 * 72 + s] = (u16)(a.z & 0xffff); dstT[5 * 72 + s] = (u16)(a.z >> 16); dstT[6 * 72 + s] = (u16)(a.w & 0xffff); dstT[7 * 72 + s] = (u16)(a.w >> 16);
  dstT[8 * 72 + s] = (u16)(b.x & 0xffff); dstT[9 * 72 + s] = (u16)(b.x >> 16); dstT[10 * 72 + s] = (u16)(b.y & 0xffff); dstT[11 * 72 + s] = (u16)(b.y >> 16);
  dstT[12 * 72 + s] = (u16)(b.z & 0xffff); dstT[13 * 72 + s] = (u16)(b.z >> 16); dstT[14 * 72 + s] = (u16)(b.w & 0xffff); dstT[15 * 72 + s] = (u16)(b.w >> 16);
}

__device__ __forceinline__ void mlstm_state_item(CP p, int isctx, int b, int head, float* sm) {
  const int tid = get_tid(), dir = tid >> 8, t = tid & 255, w4 = t >> 6, lane = t & 63, fr = lane & 15, fq = lane >> 4;
  const u16* proj = (const u16*)(p->ws + OFF_HP);
  const float* gates = (const float*)(p->ws + OFF_GATES);
  u16* stCt = (u16*)(p->ws + OFF_STC);
  float* stm = (float*)(p->ws + OFF_STM);
  u16* KtW = (u16*)sm + dir * (2 * 64 * 72);
  u16* Vt = KtW + 64 * 72;
  const int nc = isctx ? 4 : 16, L = isctx ? 256 : 1024;
  const int seq0 = isctx ? b * 256 : NCTX + b * 1024;
  const int ch = (b * 2 + dir) * 8 + head;
  f32x4 cacc[4], nacc;
  float m;
  if (isctx) {
#pragma unroll
    for (int nt = 0; nt < 4; ++nt) cacc[nt] = (f32x4){0.f, 0.f, 0.f, 0.f};
    nacc = (f32x4){0.f, 0.f, 0.f, 0.f};
    m = 0.f;
  } else {
    const float* C0 = p->in[I_SC] + (size_t)ch * 4096;
#pragma unroll
    for (int nt = 0; nt < 4; ++nt)
#pragma unroll
      for (int j = 0; j < 4; ++j) cacc[nt][j] = C0[(w4 * 16 + fq * 4 + j) * 64 + nt * 16 + fr];
#pragma unroll
    for (int j = 0; j < 4; ++j) nacc[j] = p->in[I_SN][ch * 64 + w4 * 16 + fq * 4 + j];
    m = p->in[I_SM][ch];
  }
  const bf16x8 ones = (bf16x8){0x3F80, 0x3F80, 0x3F80, 0x3F80, 0x3F80, 0x3F80, 0x3F80, 0x3F80};
  const int srow = t >> 2, part = t & 3;
  uint4 ka, kb, va, vb;
  float g_li, g_fp;
  auto prefetch = [&](int cc) {
    const int tok0 = dir ? (L - 1 - cc * 64) : cc * 64;
    const long rs = dir ? -(long)PSTR : (long)PSTR;
    const u16* base = proj + (size_t)(seq0 + tok0) * PSTR;
    tile_ld_regs(base + 1280 + head * 64, rs, t, ka, kb);
    tile_ld_regs(base + 1792 + head * 64, rs, t, va, vb);
    const int tr = seq0 + (dir ? tok0 - lane : tok0 + lane);
    g_li = gates[(size_t)tr * 32 + (dir * 2) * 8 + head];
    g_fp = gates[(size_t)tr * 32 + (dir * 2 + 1) * 8 + head];
  };
  prefetch(0);
  for (int cc = 0; cc < nc; ++cc) {
    const int slot = st_slot(isctx, b, dir, head, cc);
#pragma unroll
    for (int nt = 0; nt < 4; ++nt)
      *(uint2*)(stCt + (size_t)slot * ST_SLOT + (nt * 16 + fr) * 64 + w4 * 16 + fq * 4) = make_uint2(pack2(cacc[nt][0], cacc[nt][1]), pack2(cacc[nt][2], cacc[nt][3]));
    if (fr == 0) *(uint2*)(stCt + (size_t)slot * ST_SLOT + 64 * 64 + w4 * 16 + fq * 4) = make_uint2(pack2(nacc[0], nacc[1]), pack2(nacc[2], nacc[3]));
    if (t == 0) stm[slot] = m;
    const float lf = logsigmoidf_(g_fp);
    const float bb = wave_scan_add(lf, lane);
    const float a = g_li - bb;
    const float amax = wave_max(a);
    const float blast = __shfl(bb, 63);
    const float mnew = blast + fmaxf(m, amax);
    const float wsv = expf(blast + a - mnew);
    const float wc = expf(blast + m - mnew);
    const float ws_row = __shfl(wsv, (w4 * 16 + (lane >> 2))) * 0.125f;
    __syncthreads();
    {
      float kv[16];
      unpack16(ka, kb, kv);
      u16* dk = KtW + (part * 16) * 72 + srow;
#pragma unroll
      for (int e = 0; e < 16; ++e) dk[e * 72] = f2bf(kv[e] * ws_row);
      store_t16(Vt + (part * 16) * 72, srow, va, vb);
    }
    __syncthreads();
    if (cc + 1 < nc) prefetch(cc + 1);
#pragma unroll
    for (int nt = 0; nt < 4; ++nt) { cacc[nt][0] *= wc; cacc[nt][1] *= wc; cacc[nt][2] *= wc; cacc[nt][3] *= wc; }
    nacc[0] *= wc; nacc[1] *= wc; nacc[2] *= wc; nacc[3] *= wc;
#pragma unroll
    for (int ks = 0; ks < 2; ++ks) {
      const bf16x8 af = *(const bf16x8*)(KtW + (w4 * 16 + fr) * 72 + ks * 32 + fq * 8);
#pragma unroll
      for (int nt = 0; nt < 4; ++nt) {
        const bf16x8 bfv = *(const bf16x8*)(Vt + (nt * 16 + fr) * 72 + ks * 32 + fq * 8);
        cacc[nt] = __builtin_amdgcn_mfma_f32_16x16x32_bf16(af, bfv, cacc[nt], 0, 0, 0);
      }
      nacc = __builtin_amdgcn_mfma_f32_16x16x32_bf16(af, ones, nacc, 0, 0, 0);
    }
    m = mnew;
  }
  __syncthreads();
  if (isctx) {
    float* Co = p->out + O_C + (size_t)ch * 4096;
#pragma unroll
    for (int nt = 0; nt < 4; ++nt)
#pragma unroll
      for (int j = 0; j < 4; ++j) Co[(w4 * 16 + fq * 4 + j) * 64 + nt * 16 + fr] = cacc[nt][j];
    if (fr == 0) {
#pragma unroll
      for (int j = 0; j < 4; ++j) p->out[O_N + ch * 64 + w4 * 16 + fq * 4 + j] = nacc[j];
    }
    if (t == 0) p->out[O_M + ch] = m;
  }
}

__device__ __forceinline__ void mlstm_out_item(CP p, int isctx, int b, int head, int c, float* sm) {
  const int tid = get_tid(), dir = tid >> 8, t = tid & 255, w4 = t >> 6, lane = t & 63, fr = lane & 15, fq = lane >> 4;
  const u16* proj = (const u16*)(p->ws + OFF_HP);
  const float* gates = (const float*)(p->ws + OFF_GATES);
  const u16* stCt = (const u16*)(p->ws + OFF_STC);
  const float* stm = (const float*)(p->ws + OFF_STM);
  constexpr int HALF16 = 64 * 72 * 2 + 80 * 72 + 4 * 16 * 72;
  u16* Ks = (u16*)sm + dir * HALF16;
  u16* Vt = Ks + 64 * 72;
  u16* Cts = Vt + 64 * 72;
  u16* Ws = Cts + 80 * 72 + w4 * (16 * 72);
  float* Hs = (float*)((u16*)sm + 2 * HALF16);
  const int nc = isctx ? 4 : 16;
  const int mb = (isctx ? b * 256 : NCTX + b * 1024) + c * 64;
  const int cc = dir ? nc - 1 - c : c;
  const int slot = st_slot(isctx, b, dir, head, cc);
  const float m0 = stm[slot];
  const int srow = t >> 2, part = t & 3;
  uint4 ka, kb, va, vb;
  {
    const long rs = dir ? -(long)PSTR : (long)PSTR;
    const u16* base = proj + (size_t)(mb + (dir ? 63 : 0)) * PSTR;
    tile_ld_regs(base + 1280 + head * 64, rs, t, ka, kb);
    tile_ld_regs(base + 1792 + head * 64, rs, t, va, vb);
  }
  u32x4 c0v, c1v, c2v;
  {
    const u16* cs = stCt + (size_t)slot * ST_SLOT;
    c0v = *(const u32x4*)(cs + t * 8);
    c1v = *(const u32x4*)(cs + (t + 256) * 8);
    c2v = (t < 8) ? *(const u32x4*)(cs + (t + 512) * 8) : (u32x4){0u, 0u, 0u, 0u};
  }
  bf16x8 qf[2];
  {
    const int tq = w4 * 16 + fr;
    const u16* qp = proj + (size_t)(mb + (dir ? 63 - tq : tq)) * PSTR + 768 + head * 64 + fq * 8;
    qf[0] = *(const bf16x8*)(qp);
    qf[1] = *(const bf16x8*)(qp + 32);
  }
  float a, M, bb;
  {
    const int tr = mb + (dir ? 63 - lane : lane);
    const float li = gates[(size_t)tr * 32 + (dir * 2) * 8 + head];
    const float fp = gates[(size_t)tr * 32 + (dir * 2 + 1) * 8 + head];
    const float lf = logsigmoidf_(fp);
    bb = wave_scan_add(lf, lane);
    a = li - bb;
    M = fmaxf(m0, wave_scan_max(a, lane));
  }
  __syncthreads();
  *(uint4*)(Ks + srow * 72 + part * 16) = ka;
  *(uint4*)(Ks + srow * 72 + part * 16 + 8) = kb;
  store_t16(Vt + (part * 16) * 72, srow, va, vb);
  *(u32x4*)(Cts + (t >> 3) * 72 + (t & 7) * 8) = c0v;
  *(u32x4*)(Cts + ((t + 256) >> 3) * 72 + (t & 7) * 8) = c1v;
  if (t < 8) *(u32x4*)(Cts + 64 * 72 + t * 8) = c2v;
  __syncthreads();
  f32x4 sacc[4];
#pragma unroll
  for (int nt = 0; nt < 4; ++nt) sacc[nt] = (f32x4){0.f, 0.f, 0.f, 0.f};
#pragma unroll
  for (int ks = 0; ks < 2; ++ks)
#pragma unroll
    for (int nt = 0; nt < 4; ++nt) {
      const bf16x8 kf = *(const bf16x8*)(Ks + (nt * 16 + fr) * 72 + ks * 32 + fq * 8);
      sacc[nt] = __builtin_amdgcn_mfma_f32_16x16x32_bf16(qf[ks], kf, sacc[nt], 0, 0, 0);
    }
  float a_s[4], M_t[4], b_t[4], rs[4];
#pragma unroll
  for (int nt = 0; nt < 4; ++nt) a_s[nt] = __shfl(a, nt * 16 + fr);
#pragma unroll
  for (int j = 0; j < 4; ++j) { M_t[j] = __shfl(M, w4 * 16 + fq * 4 + j); b_t[j] = __shfl(bb, w4 * 16 + fq * 4 + j); rs[j] = 0.f; }
#pragma unroll
  for (int j = 0; j < 4; ++j) {
    const int tt = w4 * 16 + fq * 4 + j;
#pragma unroll
    for (int nt = 0; nt < 4; ++nt) {
      const int ss = nt * 16 + fr;
      const float w = (ss <= tt) ? expf(a_s[nt] - M_t[j]) * (sacc[nt][j] * 0.125f) : 0.f;
      rs[j] += w;
      Ws[(fq * 4 + j) * 72 + ss] = f2bf(w);
    }
  }
  __builtin_amdgcn_wave_barrier();
  f32x4 num[4], qc[4], qn;
#pragma unroll
  for (int nt = 0; nt < 4; ++nt) { num[nt] = (f32x4){0.f, 0.f, 0.f, 0.f}; qc[nt] = (f32x4){0.f, 0.f, 0.f, 0.f}; }
  qn = (f32x4){0.f, 0.f, 0.f, 0.f};
#pragma unroll
  for (int ks = 0; ks < 2; ++ks) {
    const bf16x8 wa = *(const bf16x8*)(Ws + fr * 72 + ks * 32 + fq * 8);
#pragma unroll
    for (int nt = 0; nt < 4; ++nt) {
      const bf16x8 vb8 = *(const bf16x8*)(Vt + (nt * 16 + fr) * 72 + ks * 32 + fq * 8);
      num[nt] = __builtin_amdgcn_mfma_f32_16x16x32_bf16(wa, vb8, num[nt], 0, 0, 0);
      const bf16x8 cb8 = *(const bf16x8*)(Cts + (nt * 16 + fr) * 72 + ks * 32 + fq * 8);
      qc[nt] = __builtin_amdgcn_mfma_f32_16x16x32_bf16(qf[ks], cb8, qc[nt], 0, 0, 0);
    }
    const bf16x8 nb8 = *(const bf16x8*)(Cts + 64 * 72 + ks * 32 + fq * 8);
    qn = __builtin_amdgcn_mfma_f32_16x16x32_bf16(qf[ks], nb8, qn, 0, 0, 0);
  }
  float hv[4][4];
#pragma unroll
  for (int j = 0; j < 4; ++j) {
    const float wi = expf(m0 - M_t[j]);
    const float den = grp16_sum(rs[j]) + wi * qn[j];
    const float mt = b_t[j] + M_t[j];
    const float inv = 1.f / fmaxf(fabsf(den), expf(-mt));
#pragma unroll
    for (int nt = 0; nt < 4; ++nt) hv[j][nt] = (num[nt][j] + wi * qc[nt][j]) * inv;
  }
  if (dir == 1) {
#pragma unroll
    for (int j = 0; j < 4; ++j)
#pragma unroll
      for (int nt = 0; nt < 4; ++nt) Hs[(63 - (w4 * 16 + fq * 4 + j)) * 68 + nt * 16 + fr] = hv[j][nt];
  }
  __syncthreads();
  if (dir == 0) {
    const float* hg = p->in[I_L0 + L_X2] + head * 64;
    u16* ymix = (u16*)(p->ws + OFF_YMIX);
#pragma unroll
    for (int j = 0; j < 4; ++j) {
      const int tt = w4 * 16 + fq * 4 + j;
      float h[4], ss = 0.f;
#pragma unroll
      for (int nt = 0; nt < 4; ++nt) { h[nt] = hv[j][nt] + Hs[tt * 68 + nt * 16 + fr]; ss += h[nt] * h[nt]; }
      ss = grp16_sum(ss);
      const float rstd = rsqrtf(ss * (1.f / 64.f) + EPS);
      const int tr = mb + tt;
#pragma unroll
      for (int nt = 0; nt < 4; ++nt) {
        const int v = nt * 16 + fr;
        const float ob = bflo((unsigned)proj[(size_t)tr * PSTR + 2336 + head * 64 + v]);
        ymix[(size_t)tr * D + 512 + head * 64 + v] = f2bf(sigmoidf_(ob) * (h[nt] * rstd * hg[v]));
      }
    }
  }
}

__device__ __forceinline__ int next_item(int* ctr, int* s_item) {
  __syncthreads();
  if (get_tid() == 0) *s_item = atomicAdd(ctr, 1);
  __syncthreads();
  return *s_item;
}

__device__ __forceinline__ void mix0_phase_a(CP p, float* sm, int* s_item, int coff) {
  int* ctr = (int*)(p->ws + OFF_CTR) + 0 + coff;
  for (;;) {
    int it = next_item(ctr, s_item);
    if (it >= 912) break;
    if (it >= 128 && it < 144) {
      int v = it - 128; int b = v >> 3, head = v & 7;
      mlstm_state_item(p, 0, b, head, sm);
    } else if (it >= 656) {
      int v = it - 656; int b = v >> 3, head = v & 7;
      mlstm_state_item(p, 1, b, head, sm);
    } else {
      AttnDesc d;
      d.mode = 0; d.a0 = 0; d.r0 = 0; d.rpb = nullptr; d.sink = 0.f; d.has_sink = 0;
      if (it < 128) {
        int b = it >> 6, h = (it >> 3) & 7, qb = it & 7;
        d.qrow0 = NCTX + b * 1024 + qb * 128; d.qcol = h * 64; d.ocol = h * 64;
        d.ck = p->in[I_C0K] + (size_t)b * 256 * 128 + (h >> 2) * 64; d.cv = p->in[I_C0V] + (size_t)b * 256 * 128 + (h >> 2) * 64;
        d.cstride = 128; d.nctx = 4;
        d.krow0 = NCTX + b * 1024; d.nloc = 16; d.kcol = 512 + (h >> 2) * 64; d.vcol = 640 + (h >> 2) * 64;
      } else {
        int v = it - 144; int b = v >> 4, h = (v >> 1) & 7, qb = v & 1;
        d.qrow0 = b * 256 + qb * 128; d.qcol = h * 64; d.ocol = h * 64;
        d.ck = nullptr; d.cv = nullptr; d.cstride = 0; d.nctx = 0;
        d.krow0 = b * 256; d.nloc = 4; d.kcol = 512 + (h >> 2) * 64; d.vcol = 640 + (h >> 2) * 64;
      }
      attn_item(p, d, sm);
    }
  }
}

__device__ __forceinline__ void mix0_phase_b(CP p, float* sm, int* s_item, int coff) {
  int* ctr = (int*)(p->ws + OFF_CTR) + 1 + coff;
  for (;;) {
    int it = next_item(ctr, s_item);
    if (it >= 1280) break;
    if (it < 256) {
      int b = it >> 7, head = (it >> 4) & 7, c = it & 15;
      mlstm_out_item(p, 0, b, head, c, sm);
    } else {
      int v = it - 256; int b = v >> 5, head = (v >> 2) & 7, c = v & 3;
      mlstm_out_item(p, 1, b, head, c, sm);
    }
  }
}

__device__ __forceinline__ void mix1_phase(CP p, float* sm, int* s_item, int coff) {
  int* ctr = (int*)(p->ws + OFF_CTR) + 2 + coff;
  const float* sink = p->in[I_L1 + L_X1];
  for (;;) {
    int it = next_item(ctr, s_item);
    if (it >= 1280) break;
    AttnDesc d;
    d.mode = 0; d.a0 = 0; d.r0 = 0; d.rpb = nullptr; d.sink = 0.f; d.has_sink = 0;
    if (it < 128) {
      int b = it >> 6, h = (it >> 3) & 7, r = (it & 7) * 2;
      int r0 = min(max(r - 4, 0), 8);
      int r1 = min(max(r + 1 - 4, 0), 8) + 8;
      d.qrow0 = NCTX + b * 1024 + r * 64; d.qcol = h * 64; d.ocol = h * 64;
      d.ck = p->in[I_NAK] + (size_t)b * 256 * 512 + h * 64; d.cv = p->in[I_NAV] + (size_t)b * 256 * 512 + h * 64;
      d.cstride = 512; d.nctx = 4;
      d.krow0 = NCTX + b * 1024 + r0 * 64; d.nloc = r1 - r0; d.kcol = 512 + h * 64; d.vcol = 1024 + h * 64;
      d.mode = 1; d.a0 = r; d.r0 = r0; d.rpb = p->in[I_L1 + L_X0] + h * 15 * 31;
    } else if (it < 256) {
      int v = it - 128; int b = v >> 6, h = (v >> 3) & 7, qb = v & 7;
      int t0 = qb * 128;
      int s0 = max(t0 - 128, 0);
      int s1 = min(t0 + 256, 1024);
      d.qrow0 = NCTX + b * 1024 + t0; d.qcol = 1536 + h * 64; d.ocol = 512 + h * 64;
      d.ck = p->in[I_SWK] + (size_t)b * 256 * 128 + (h >> 2) * 64; d.cv = p->in[I_SWV] + (size_t)b * 256 * 128 + (h >> 2) * 64;
      d.cstride = 128; d.nctx = 4;
      d.krow0 = NCTX + b * 1024 + s0; d.nloc = (s1 - s0) >> 6; d.kcol = 2048 + (h >> 2) * 64; d.vcol = 2176 + (h >> 2) * 64;
      d.mode = 2; d.a0 = s0 - t0;
      d.sink = sink[h]; d.has_sink = 1;
    } else if (it < 768) {
      int v = it - 256; int b = v >> 4, h = (v >> 1) & 7, qb = v & 1;
      d.qrow0 = b * 256 + qb * 128; d.qcol = h * 64; d.ocol = h * 64;
      d.ck = nullptr; d.cv = nullptr; d.cstride = 0; d.nctx = 0;
      d.krow0 = b * 256; d.nloc = 4; d.kcol = 512 + h * 64; d.vcol = 1024 + h * 64;
    } else {
      int v = it - 768; int b = v >> 4, h = (v >> 1) & 7, qb = v & 1;
      d.qrow0 = b * 256 + qb * 128; d.qcol = 1536 + h * 64; d.ocol = 512 + h * 64;
      d.ck = nullptr; d.cv = nullptr; d.cstride = 0; d.nctx = 0;
      d.krow0 = b * 256; d.nloc = 4; d.kcol = 2048 + (h >> 2) * 64; d.vcol = 2176 + (h >> 2) * 64;
      d.sink = sink[h]; d.has_sink = 1;
    }
    attn_item(p, d, sm);
  }
}

#define XB_TMO      128
#define XB_XCNT(j)  (256  + 64 * (j))
#define XB_XSUB(j)  (1280 + 64 * (j))
#define XB_XGEN(j)  (2304 + 64 * (j))
#define XB_TOP      3328
#define XB_TOPGEN   3392
#define XCD_BAR_WORDS 3456
#define XB_SPIN_CAP (1u << 22)
__device__ __forceinline__ unsigned xb_ld(unsigned* p) { return __hip_atomic_load(p, __ATOMIC_RELAXED, __HIP_MEMORY_SCOPE_AGENT); }
__device__ __forceinline__ unsigned xb_add(unsigned* p, unsigned v) { return __hip_atomic_fetch_add(p, v, __ATOMIC_RELAXED, __HIP_MEMORY_SCOPE_AGENT); }
__device__ __forceinline__ unsigned xb_xcc_id() { return (unsigned)__builtin_amdgcn_s_getreg((3 << 11) | 20) & 0xFu; }
#define XB_SPIN(cond, bar) do { unsigned _sp = 0; while (cond) { __builtin_amdgcn_s_sleep(1); \
    if ((++_sp & 255u) == 0u) { if (xb_ld(&(bar)[XB_TMO])) break; if (_sp > XB_SPIN_CAP) { atomicAdd(&(bar)[XB_TMO], 1u); break; } } } } while (0)
struct XcdBarrier { unsigned* bar; unsigned x; volatile LAS unsigned* st; };
__device__ __forceinline__ XcdBarrier xcd_barrier_post(unsigned* bar, volatile LAS unsigned* st) {
  XcdBarrier b; b.bar = bar; b.x = xb_xcc_id(); b.st = st;
  if (threadIdx.x == 0) (void)xb_add(&bar[XB_XCNT(b.x)], 1u);
  return b;
}
__device__ __forceinline__ void xcd_barrier_complete(unsigned* bar, unsigned x, unsigned& nloc, unsigned& nx) {
  const unsigned G = gridDim.x * gridDim.y * gridDim.z;
  unsigned sum, cnt, mine, sp = 0u;
  for (;;) {
    sum = 0u; cnt = 0u; mine = 0u;
#pragma unroll
    for (unsigned j = 0; j < 16; ++j) { const unsigned c = xb_ld(&bar[XB_XCNT(j)]); sum += c; cnt += (c > 0u) ? 1u : 0u; mine = (j == x) ? c : mine; }
    if (sum == G) break;
    __builtin_amdgcn_s_sleep(1);
    if ((++sp & 255u) == 0u) { if (xb_ld(&bar[XB_TMO])) break; if (sp > XB_SPIN_CAP) { atomicAdd(&bar[XB_TMO], 1u); break; } }
  }
  nloc = mine > 0u ? mine : 1u; nx = cnt > 0u ? cnt : 1u;
}
__device__ __forceinline__ void xcd_barrier(const XcdBarrier& b) {
  asm volatile("s_waitcnt vmcnt(0)" ::: "memory");
  __syncthreads();
  if (threadIdx.x == 0) {
    unsigned* bar = b.bar;
    __builtin_amdgcn_s_waitcnt(0);
    unsigned nloc = b.st[0], nx = b.st[1];
    if (nloc == 0u) { xcd_barrier_complete(bar, b.x, nloc, nx); b.st[0] = nloc; b.st[1] = nx; }
    const unsigned old = xb_add(&bar[XB_XSUB(b.x)], 1u);
    const unsigned gen = old / nloc;
    if (old + 1u == (gen + 1u) * nloc) {
      __builtin_amdgcn_fence(__ATOMIC_RELEASE, "agent");
      asm volatile("s_waitcnt vmcnt(0)" ::: "memory");
      const unsigned og = xb_add(&bar[XB_TOP], 1u);
      const unsigned tg = og / nx;
      if (og + 1u == (tg + 1u) * nx) xb_add(&bar[XB_TOPGEN], 1u);
      else XB_SPIN(xb_ld(&bar[XB_TOPGEN]) == tg, bar);
      __builtin_amdgcn_fence(__ATOMIC_ACQUIRE, "agent");
      xb_add(&bar[XB_XGEN(b.x)], 1u);
      asm volatile("s_waitcnt vmcnt(0)" ::: "memory");
    } else {
      XB_SPIN(xb_ld(&bar[XB_XGEN(b.x)]) == gen, bar);
      __builtin_amdgcn_fence(__ATOMIC_ACQUIRE, "agent");
      asm volatile("s_waitcnt vmcnt(0)" ::: "memory");
    }
  }
  __syncthreads();
}

constexpr int NPHASE = 18;
__device__ __forceinline__ void run_phase(CP p, int ph, char* smem, int* s_item, const int dry) {
  float* smf = (float*)smem;
  u16* smh = (u16*)smem;
  const u16* xn = (const u16*)(p->ws + OFF_XN);
  const u16* hp = (const u16*)(p->ws + OFF_HP);
  const u16* ymix = (const u16*)(p->ws + OFF_YMIX);
  if (ph == 0) { prep_a_phase(p, smf); return; }
  if (ph == 1) { prep_b_phase(p, smf, dry); return; }
  if (ph == 17) { final_phase(p); return; }
  const int l = (ph >= 10) ? 1 : 0;
  int q = ph - (l ? 10 : 2);
  if (l == 1 && q >= 4) q += 1;
  if (q == 0 || q == 6) {
    const int f = (q == 6) ? 1 : 0;
    gemm_phase<EPI_SWIGLU>(p, xn, (const u16*)(p->ws + OFF_WIN + (l * 2 + f) * SZ_WIN), 1024, 22, l, 0, 0.f, l * 3 + (f ? 2 : 0), smh);
    return;
  }
  if (q == 1 || q == 5 || q == 7) {
    const u16* A = (q == 5) ? ymix : hp;
    const u16* Bt = (q == 5) ? (const u16*)(p->ws + OFF_WMO + (size_t)l * D * D * 2)
                             : (const u16*)(p->ws + OFF_WOUT + (l * 2 + (q == 7 ? 1 : 0)) * SZ_WOUT);
    const int K = (q == 5) ? 1024 : DFF;
    const int gch = (q == 1) ? 2 : (q == 5 ? 5 : 8);
    const float coef = __int_as_float(dry ? 0 : ((q == 5) ? 0x3f800000 : 0x3f000000));
    const int nid_next = l * 3 + ((q == 1) ? 1 : (q == 5 ? 2 : 3));
    gemm_phase<EPI_RESID>(p, A, Bt, K, 4, l, gch, coef, dry ? 7 : nid_next, smh, dry ? 0 : (l == 0 ? (q == 1 ? 1 : (q == 5 ? 2 : 3)) : (q == 1 ? 4 : 0)));
    return;
  }
  if (q == 2) {
    if (l == 0) gemm_phase<EPI_MIX0>(p, xn, (const u16*)(p->ws + OFF_WMI0), 1024, 12, l, 0, 0.f, 1, smh);
    else gemm_phase<EPI_MIX1>(p, xn, (const u16*)(p->ws + OFF_WMI1), 1024, 9, l, 0, 0.f, 4, smh);
    return;
  }
  if (q == 3) { if (l == 0) mix0_phase_a(p, smf, s_item, dry * 3); else mix1_phase(p, smf, s_item, dry * 3); return; }
  if (q == 4) { mix0_phase_b(p, smf, s_item, dry * 3); return; }
}

__global__ void __launch_bounds__(512, 2) mega(Params kp, int ph0, int ph1, int dry) {
  extern __shared__ __attribute__((aligned(16))) char smem[];
  int* s_item_p = (int*)(smem + SMEM_BYTES);
  uint4* xb_words_p = (uint4*)(smem + SMEM_BYTES + 16);
  if (threadIdx.x == 0) *xb_words_p = make_uint4(0u, 0u, 0u, 0u);
  if ((threadIdx.x & 63) == 0) ((volatile int*)(smem + TIDTAB_OFF))[hw_wave_slot()] = (int)(threadIdx.x >> 6);
  __syncthreads();
  XcdBarrier xb = xcd_barrier_post((unsigned*)(kp.ws + OFF_BAR), (volatile LAS unsigned*)xb_words_p);
  if (ph1 < 0) cg::this_grid().sync();
  for (int ph = ph0; ph < ph1; ++ph) {
    if (ph > ph0) xcd_barrier(xb);
    CP p = (CP)__builtin_amdgcn_kernarg_segment_ptr();
    asm volatile("" : "+s"(p));
    run_phase(p, ph, smem, s_item_p, dry);
  }
}

extern "C" void kernel_launch(void* const* d_in, const int* in_sizes, int n_in, void* d_out, int out_size, void* d_ws,
                              size_t ws_size, hipStream_t stream) {
  static int grid_blocks = 0;
  if (!grid_blocks) {
    int dev = 0, cus = 0, per_cu = 0;
    hipGetDevice(&dev);
    hipDeviceGetAttribute(&cus, hipDeviceAttributeMultiprocessorCount, dev);
    hipFuncSetAttribute((const void*)mega, hipFuncAttributeMaxDynamicSharedMemorySize, DYN_LDS);
    hipOccupancyMaxActiveBlocksPerMultiprocessor(&per_cu, mega, NTH, DYN_LDS);
    if (per_cu > 1) per_cu = 1;
    if (per_cu < 1) per_cu = 1;
    grid_blocks = cus * per_cu;
  }
  if (ws_size < WS_TOTAL) fprintf(stderr, "workspace too small: %zu < %zu\n", ws_size, (size_t)WS_TOTAL);
  Params p{};
  for (int i = 0; i < 37; ++i) p.in[i] = (const float*)d_in[i];
  p.out = (float*)d_out;
  p.ws = (char*)d_ws;
  hipMemsetAsync((char*)d_ws + OFF_CTR, 0, ZERO_BYTES, stream);
#if SINGLE_LAUNCH
  int ph0 = 0, ph1 = NPHASE, dry = 0;
  void* args[] = {&p, &ph0, &ph1, &dry};
  hipError_t e = hipLaunchCooperativeKernel((void*)mega, dim3(grid_blocks), dim3(NTH), args, DYN_LDS, stream);
  if (e != hipSuccess) fprintf(stderr, "cooperative launch failed: %s (grid %d)\n", hipGetErrorString(e), grid_blocks);
#else
  for (int ph = 0; ph < NPHASE; ++ph) {
    mega<<<grid_blocks, NTH, DYN_LDS, stream>>>(p, ph, ph + 1, 0);
    const bool g1 = (ph == 2 || ph == 8 || ph == 10 || ph == 15), g2 = (ph == 3 || ph == 9 || ph == 11 || ph == 16);
    const bool mi = (ph == 4 || ph == 12), mo = (ph == 7 || ph == 14), mx = (ph == 5 || ph == 6 || ph == 13);
    if (((REP_MASK & 1) && g1) || ((REP_MASK & 2) && g2) || ((REP_MASK & 4) && (mi || mo)) || ((REP_MASK & 8) && mx) ||
        ((REP_MASK & 16) && ph == 0) || ((REP_MASK & 32) && ph == 1))
      mega<<<grid_blocks, NTH, DYN_LDS, stream>>>(p, ph, ph + 1, 1);
  }
#endif
}
```

```cpp
#include <hip/hip_runtime.h>
#include <hip/hip_cooperative_groups.h>
#include <cstdio>
namespace cg = cooperative_groups;

#ifndef REP_MASK
#define REP_MASK 0
#endif
#ifndef SINGLE_LAUNCH
#define SINGLE_LAUNCH 1
#endif

typedef unsigned short u16;
typedef __attribute__((ext_vector_type(8))) short bf16x8;
typedef __attribute__((ext_vector_type(4))) float f32x4;
typedef __attribute__((ext_vector_type(4))) unsigned u32x4;
#define LAS __attribute__((address_space(3)))

constexpr int D = 1024, NCTX = 8192, MTOK = 10240;
constexpr int DFF = 2816, NFF = 5632;
constexpr int P0N = 2848, P0P = 3072, P1N = 2304;
constexpr int PSTR = 2944;
constexpr float EPS = 1e-6f;

enum { I_XP = 0, I_XS, I_C0K, I_C0V, I_SC, I_SN, I_SM, I_NAK, I_NAV, I_SWK, I_SWV, I_C, I_CCTX, I_NF,
       I_L0 = 14, I_L1 = 26 };
enum { L_ADAW = 0, L_ADAB, L_NORM, L_F1I, L_F1O, L_F2I, L_F2O, L_MI, L_MO, L_X0, L_X1, L_X2 };

constexpr size_t O_X = 0, O_K0 = 10485760, O_V0 = 11534336, O_C = 12582912, O_N = 14680064, O_M = 14712832,
                 O_KC1 = 14713344, O_VC1 = 18907648, O_KD1 = 23101952, O_VD1 = 24150528;

constexpr size_t SZ_WIN = (size_t)NFF * D * 2;
constexpr size_t SZ_WOUT = (size_t)D * DFF * 2;
constexpr size_t OFF_WIN = 0;
constexpr size_t OFF_WOUT = OFF_WIN + 4 * SZ_WIN;
constexpr size_t OFF_WMI0 = OFF_WOUT + 4 * SZ_WOUT;
constexpr size_t OFF_WMI1 = OFF_WMI0 + (size_t)P0P * D * 2;
constexpr size_t OFF_WMO = OFF_WMI1 + (size_t)P1N * D * 2;
constexpr size_t OFF_MOD = OFF_WMO + 2 * (size_t)D * D * 2;
constexpr size_t OFF_ROPE = OFF_MOD + 2 * 3 * 9216 * 4;
constexpr size_t OFF_CTR = OFF_ROPE + 2 * 1024 * 32 * 4;
constexpr size_t OFF_BAR = OFF_CTR + 256;
constexpr size_t OFF_ROWSS = OFF_CTR + 16384;
constexpr size_t OFF_BIAS = OFF_ROWSS + (size_t)7 * MTOK * 4;
constexpr size_t ZERO_BYTES = 16384 + (size_t)7 * MTOK * 4 + (size_t)2 * 3 * 3 * NFF * 4;
constexpr size_t OFF_XN = OFF_CTR + ZERO_BYTES;
constexpr size_t OFF_YMIX = OFF_XN + (size_t)MTOK * D * 2;
constexpr size_t OFF_HP = OFF_YMIX + (size_t)MTOK * D * 2;
constexpr size_t OFF_GATES = OFF_HP + (size_t)MTOK * PSTR * 2;
constexpr size_t OFF_STC = OFF_GATES + (size_t)MTOK * 32 * 4;
constexpr size_t OFF_STN = OFF_STC + (size_t)2560 * 4096 * 4;
constexpr size_t OFF_STM = OFF_STN + (size_t)2560 * 64 * 4;
constexpr size_t OFF_XB = OFF_STM + 2560 * 4;
constexpr size_t WS_TOTAL = OFF_XB + (size_t)MTOK * D * 2;

constexpr int TS = 68;
constexpr int TILE_F = 64 * TS;
constexpr int SMEM_BYTES = 8 * TILE_F * 4 + 4096;
constexpr int NTH = 512;
constexpr int DYN_LDS = SMEM_BYTES + 64 + 256;

struct Params {
  const float* in[37];
  float* out;
  char* ws;
};
typedef const __attribute__((address_space(4))) Params* CP;

constexpr int TIDTAB_OFF = SMEM_BYTES + 64;
__device__ __forceinline__ int hw_wave_slot() { return (int)(__builtin_amdgcn_s_getreg((5 << 11) | 4) & 63u); }
__device__ __forceinline__ int get_tid() {
  extern __shared__ __attribute__((aligned(16))) char smem[];
  const volatile LAS int* tab = (const volatile LAS int*)(smem + TIDTAB_OFF);
  int wv = tab[hw_wave_slot()];
  int t = wv * 64 + (int)__builtin_amdgcn_mbcnt_hi(~0u, __builtin_amdgcn_mbcnt_lo(~0u, 0u));
  asm volatile("" : "+v"(t));
  return t;
}
__device__ __forceinline__ u16 f2bf(float f) {
  unsigned u = __float_as_uint(f);
  u += 0x7fffu + ((u >> 16) & 1u);
  return (u16)(u >> 16);
}
__device__ __forceinline__ unsigned pack2(float a, float b) { return (unsigned)f2bf(a) | ((unsigned)f2bf(b) << 16); }
__device__ __forceinline__ float bflo(unsigned x) { return __uint_as_float(x << 16); }
__device__ __forceinline__ float bfhi(unsigned x) { return __uint_as_float(x & 0xffff0000u); }
template <int CTRL>
__device__ __forceinline__ float dpp_mov(float v) {
  return __builtin_bit_cast(float, __builtin_amdgcn_update_dpp(0, __builtin_bit_cast(int, v), CTRL, 0xF, 0xF, true));
}
__device__ __forceinline__ float grp16_sum(float v) {
  v += dpp_mov<0xB1>(v); v += dpp_mov<0x4E>(v); v += dpp_mov<0x141>(v); v += dpp_mov<0x140>(v); return v;
}
__device__ __forceinline__ float grp16_max(float v) {
  v = fmaxf(v, dpp_mov<0xB1>(v)); v = fmaxf(v, dpp_mov<0x4E>(v)); v = fmaxf(v, dpp_mov<0x141>(v)); v = fmaxf(v, dpp_mov<0x140>(v)); return v;
}
__device__ __forceinline__ float rl_f(float v, int l) { return __builtin_bit_cast(float, __builtin_amdgcn_readlane(__builtin_bit_cast(int, v), l)); }
__device__ __forceinline__ float wave_sum(float v) {
  v = grp16_sum(v);
  return (rl_f(v, 0) + rl_f(v, 16)) + (rl_f(v, 32) + rl_f(v, 48));
}
__device__ __forceinline__ float wave_max(float v) {
  v = grp16_max(v);
  return fmaxf(fmaxf(rl_f(v, 0), rl_f(v, 16)), fmaxf(rl_f(v, 32), rl_f(v, 48)));
}
__device__ __forceinline__ float wave_scan_add(float v, int lane) {
  for (int o = 1; o < 64; o <<= 1) { float t = __shfl_up(v, o); if (lane >= o) v += t; }
  return v;
}
__device__ __forceinline__ float wave_scan_max(float v, int lane) {
  for (int o = 1; o < 64; o <<= 1) { float t = __shfl_up(v, o); if (lane >= o) v = fmaxf(v, t); }
  return v;
}
__device__ __forceinline__ int cond_of(int row) { return row < NCTX ? 0 : 1 + ((row - NCTX) >> 10); }
__device__ __forceinline__ float sigmoidf_(float x) { return 1.f / (1.f + expf(-x)); }
__device__ __forceinline__ float logsigmoidf_(float x) { return fminf(x, 0.f) - log1pf(expf(-fabsf(x))); }

__device__ void conv_tile(const float* __restrict__ W, int K, int N, u16* __restrict__ Wt, int perm, int kt, int nt, float* T, int t, bool valid,
                          const float* shp, float* biasp) {
  {
    int r = t >> 4, c4 = t & 15;
    int c = c4 * 4;
    int src;
    if (perm == 1) src = ((nt & 3) < 2 ? 0 : DFF) + (nt >> 2) * 128 + (nt & 1) * 64 + c;
    else if (perm == 2) {
      int bj = (nt & 3) >> 1, wc = (nt & 1) * 2 + (c >> 5), w = c & 31;
      src = (nt >> 2) * 256 + wc * 64 + bj * 32 + w;
    } else src = nt * 64 + c;
    bool ok = valid && (src < N);
#pragma unroll
    for (int ps = 0; ps < 4; ++ps) {
      int k = r + ps * 16;
      float4 v = make_float4(0.f, 0.f, 0.f, 0.f);
      if (ok) v = *(const float4*)(W + (size_t)(kt * 64 + k) * N + src);
      float* tt = T + k * 65 + c;
      tt[0] = v.x; tt[1] = v.y; tt[2] = v.z; tt[3] = v.w;
    }
  }
  if (biasp && t < 192) T[4224 + t] = shp[(t >> 6) * 9216 + kt * 64 + (t & 63)];
  __syncthreads();
  if (valid && biasp && t < 192) {
    int a = t >> 6, c = t & 63;
    int src;
    if (perm == 1) src = ((nt & 3) < 2 ? 0 : DFF) + (nt >> 2) * 128 + (nt & 1) * 64 + c;
    else { int bj = (nt & 3) >> 1, wc = (nt & 1) * 2 + (c >> 5), w = c & 31; src = (nt >> 2) * 256 + wc * 64 + bj * 32 + w; }
    if (src < N) {
      const float* sh = T + 4224 + a * 64;
      float acc = 0.f;
#pragma unroll 16
      for (int k = 0; k < 64; ++k) acc += sh[k] * T[k * 65 + c];
      unsafeAtomicAdd(biasp + a * NFF + src, acc);
    }
  }
  if (valid) {
    int n = t >> 2, kp = t & 3;
    unsigned o[8];
#pragma unroll
    for (int i = 0; i < 8; ++i) {
      float a = T[(kp * 16 + 2 * i) * 65 + n], b = T[(kp * 16 + 2 * i + 1) * 65 + n];
      o[i] = pack2(a, b);
    }
    uint4* dst = (uint4*)(Wt + (size_t)(nt * 64 + n) * K + kt * 64 + kp * 16);
    dst[0] = make_uint4(o[0], o[1], o[2], o[3]);
    dst[1] = make_uint4(o[4], o[5], o[6], o[7]);
  }
  __syncthreads();
}

__device__ void adaln_unit(CP p, int u, float* sm, int t, bool valid) {
  int l = u / 144, cg_ = u % 144;
  if (!valid) { l = 0; cg_ = 0; }
  const float* W = p->in[(l ? I_L1 : I_L0) + L_ADAW];
  const float* B = p->in[(l ? I_L1 : I_L0) + L_ADAB];
  float* sc = sm;
  float* red = sm + 3072;
  for (int i = t; i < 3072; i += 256) {
    int cnd = i >> 10, k = i & 1023;
    float v = (cnd == 0) ? p->in[I_CCTX][k] : p->in[I_C][(cnd - 1) * 1024 + k];
    sc[i] = v / (1.f + expf(-v));
  }
  __syncthreads();
  int kp = t >> 4, c4 = t & 15;
  float acc[3][4];
#pragma unroll
  for (int a = 0; a < 3; ++a)
#pragma unroll
    for (int e = 0; e < 4; ++e) acc[a][e] = 0.f;
  for (int kk = 0; kk < 64; ++kk) {
    int k = kp * 64 + kk;
    float4 w = *(const float4*)(W + (size_t)k * 9216 + cg_ * 64 + c4 * 4);
#pragma unroll
    for (int a = 0; a < 3; ++a) {
      float s = sc[a * 1024 + k];
      acc[a][0] += s * w.x; acc[a][1] += s * w.y; acc[a][2] += s * w.z; acc[a][3] += s * w.w;
    }
  }
#pragma unroll
  for (int a = 0; a < 3; ++a)
#pragma unroll
    for (int e = 0; e < 4; ++e) red[(kp * 3 + a) * 64 + c4 * 4 + e] = acc[a][e];
  __syncthreads();
  if (valid && t < 192) {
    int a = t >> 6, col = t & 63;
    float s = 0.f;
    for (int q = 0; q < 16; ++q) s += red[(q * 3 + a) * 64 + col];
    s += B[cg_ * 64 + col];
    float* mod = (float*)(p->ws + OFF_MOD);
    mod[(l * 3 + a) * 9216 + cg_ * 64 + col] = s;
  }
  __syncthreads();
}

__device__ __forceinline__ int conv_units_of(int l, int kind) {
  return (kind == 0 || kind == 4) ? 1408 : ((kind == 1 || kind == 5) ? 704 : (kind == 3 ? 256 : (l ? 576 : 768)));
}
__device__ __forceinline__ void conv_job(CP p, int l, int kind, int tt, float* smh, int t, bool valid) {
  const float* mod = (const float*)(p->ws + OFF_MOD);
  float* bias = (float*)(p->ws + OFF_BIAS);
  const float* W; u16* Wt; int K, N, perm, ntn, which = -1;
  const int lb = l ? I_L1 : I_L0;
  if (kind == 0 || kind == 4) {
    const int f = kind == 4;
    W = p->in[lb + (f ? L_F2I : L_F1I)]; Wt = (u16*)(p->ws + OFF_WIN + (l * 2 + f) * SZ_WIN);
    K = 1024; N = NFF; perm = 1; ntn = 88; which = f ? 2 : 0;
  } else if (kind == 1 || kind == 5) {
    const int f = kind == 5;
    W = p->in[lb + (f ? L_F2O : L_F1O)]; Wt = (u16*)(p->ws + OFF_WOUT + (l * 2 + f) * SZ_WOUT);
    K = DFF; N = 1024; perm = 0; ntn = 16;
  } else if (kind == 2) {
    W = p->in[lb + L_MI]; Wt = (u16*)(p->ws + (l ? OFF_WMI1 : OFF_WMI0));
    K = 1024; N = l ? P1N : P0N; perm = 2; ntn = l ? 36 : 48; which = 1;
  } else {
    W = p->in[lb + L_MO]; Wt = (u16*)(p->ws + OFF_WMO + (size_t)l * D * D * 2);
    K = 1024; N = 1024; perm = 0; ntn = 16;
  }
  const int nt = tt % ntn, kt = tt / ntn;
  const bool wb = which >= 0;
  conv_tile(W, K, N, Wt, perm, kt, nt, smh, t, valid, wb ? mod + (l * 3) * 9216 + (3 * which) * 1024 : nullptr,
            wb ? bias + (size_t)((l * 3 + which) * 3) * NFF : nullptr);
}

__device__ __forceinline__ void conv_side_job(CP p, int side, int nwg, float* sm) {
  const int tid = get_tid(), half = tid >> 8, t = tid & 255;
  float* smh = sm + half * 8192;
  const int first = ((int)gridDim.x >= nwg + 32) ? nwg : 0;
  const int nb = (int)gridDim.x - first;
  if ((int)blockIdx.x < first) return;
  const int U = (side == 1) ? 3136 : (side == 2 ? 2112 : (side == 3 ? 2240 : 704));
  for (int ub = ((int)blockIdx.x - first) * 2; ub < U; ub += nb * 2) {
    int u = ub + half;
    const bool valid = u < U;
    if (!valid) u = 0;
    int l, kind, tt;
    if (side == 1) {
      l = 0;
      if (u < 768) { kind = 2; tt = u; } else if (u < 1024) { kind = 3; tt = u - 768; }
      else if (u < 2432) { kind = 4; tt = u - 1024; } else { kind = 5; tt = u - 2432; }
    } else if (side == 2) {
      l = 1;
      if (u < 1408) { kind = 0; tt = u; } else { kind = 1; tt = u - 1408; }
    } else if (side == 3) {
      l = 1;
      if (u < 576) { kind = 2; tt = u; } else if (u < 832) { kind = 3; tt = u - 576; } else { kind = 4; tt = u - 832; }
    } else {
      l = 1; kind = 5; tt = u;
    }
    conv_job(p, l, kind, tt, smh, t, valid);
  }
}

__device__ __forceinline__ void prep_a_phase(CP p, float* sm) {
  const int tid = get_tid(), half = tid >> 8, t = tid & 255;
  float* smh = sm + half * 8192;
  constexpr int U_CONV = 704, U_ADA = 288, U_ROPE = 64;
  for (int ub = blockIdx.x * 2; ub < U_ADA; ub += gridDim.x * 2) {
    int u = ub + half;
    adaln_unit(p, u, smh, t, u < U_ADA);
  }
  for (int ub = blockIdx.x * 2; ub < U_CONV; ub += gridDim.x * 2) {
    int u = ub + half;
    bool valid = u < U_CONV;
    if (!valid) u = 0;
    conv_job(p, 0, 1, u, smh, t, valid);
  }
  for (int u = blockIdx.x; u < U_ROPE; u += gridDim.x) {
    int e = u * 512 + tid;
    int tk = e >> 5, i = e & 31;
    float pos = (i < 16) ? (float)(tk >> 6) : (float)(tk & 63);
    float fr = powf(10000.f, -(float)(i & 15) / 16.f);
    float ang = pos * fr;
    float* rc = (float*)(p->ws + OFF_ROPE);
    rc[e] = cosf(ang);
    rc[32768 + e] = sinf(ang);
  }
}

__device__ __forceinline__ void prep_b_phase(CP p, float* sm, const int dry) {
  const int tid = get_tid(), half = tid >> 8, t = tid & 255, lane = tid & 63, w = tid >> 6;
  float* smh = sm + half * 8192;
  const float* mod = (const float*)(p->ws + OFF_MOD);
  constexpr int U_CONV = 1408;
  for (int ub = blockIdx.x * 2; ub < U_CONV; ub += gridDim.x * 2) {
    int u = ub + half;
    bool valid = u < U_CONV;
    if (!valid) u = 0;
    conv_job(p, 0, 0, u, smh, t, valid);
  }
  {
    u16* xb = (u16*)(p->ws + OFF_XB);
    u16* xn = (u16*)(p->ws + OFF_XN);
    float* rowss = (float*)(p->ws + OFF_ROWSS);
    const float4* g = (const float4*)(p->in[I_L0 + L_NORM]);
    for (int row = blockIdx.x * 8 + w; row < MTOK; row += gridDim.x * 8) {
      const float4* src = (row < NCTX) ? (const float4*)(p->in[I_XP] + (size_t)row * D) : (const float4*)(p->in[I_XS] + (size_t)(row - NCTX) * D);
      const float4* sc = (const float4*)(mod + (size_t)cond_of(row) * 9216 + 1024);
      float ss = 0.f;
#pragma unroll
      for (int i = 0; i < 4; ++i) {
        int q = lane + i * 64;
        float4 v = src[q];
        ss += v.x * v.x + v.y * v.y + v.z * v.z + v.w * v.w;
        *(uint2*)(xb + (size_t)row * D + q * 4) = make_uint2(pack2(v.x, v.y), pack2(v.z, v.w));
        float4 gg = g[q], s2 = sc[q];
        uint2 o = make_uint2(pack2(v.x * (gg.x * (1.f + s2.x)), v.y * (gg.y * (1.f + s2.y))), pack2(v.z * (gg.z * (1.f + s2.z)), v.w * (gg.w * (1.f + s2.w))));
        *(uint2*)(xn + (size_t)row * D + q * 4) = o;
      }
      ss = wave_sum(ss);
      if (lane == 0) rowss[row] = ss;
    }
  }
}

__device__ __forceinline__ void final_phase(CP p) {
  const int tid = get_tid(), lane = tid & 63, w = tid >> 6;
  float* x = p->out + O_X;
  const float* rowss = (const float*)(p->ws + OFF_ROWSS) + 6 * MTOK;
  const float4* g = (const float4*)p->in[I_NF];
  for (int row = blockIdx.x * 8 + w; row < MTOK; row += gridDim.x * 8) {
    float4* xr = (float4*)(x + (size_t)row * D);
    const float rstd = rsqrtf(rowss[row] * (1.f / 1024.f) + EPS);
#pragma unroll
    for (int i = 0; i < 4; ++i) {
      int q = lane + i * 64;
      float4 v = xr[q], gg = g[q];
      xr[q] = make_float4(v.x * rstd * gg.x, v.y * rstd * gg.y, v.z * rstd * gg.z, v.w * rstd * gg.w);
    }
  }
}

enum { EPI_SWIGLU = 0, EPI_RESID = 1, EPI_MIX0 = 2, EPI_MIX1 = 3 };
constexpr int BM = 256, BK = 64, HALF = 128, HT = HALF * BK, NXCD = 8, WGM = 8;

__device__ __forceinline__ int lds_byte(int r, int c) {
  int st = (r >> 4) * 2 + (c >> 5), rr = r & 15, cc = c & 31, ob = rr * 64 + cc * 2;
  return st * 1024 + (ob ^ (((ob >> 9) & 1) << 5));
}
__device__ __forceinline__ void stage_rc(int b, int& R, int& C) {
  int st = b / 1024, sb = b % 1024, swz = sb ^ (((sb >> 9) & 1) << 5);
  R = (st >> 1) * 16 + swz / 64; C = (st & 1) * 32 + (swz % 64) / 2;
}

template <int EPI>
__device__ __forceinline__ void gemm256_tile(CP p, const u16* A, const u16* Bt, const int K,
                                             const int brow, const int bcol, int l, int gchunk, float coef, int nid, u16* shm) {
#define SWZ_LANE() ([]() { unsigned ln = __builtin_amdgcn_mbcnt_hi(~0u, __builtin_amdgcn_mbcnt_lo(~0u, 0u)); asm volatile("" : "+v"(ln)); \
    unsigned ob = (ln & 15u) * 64u + (ln >> 4) * 16u; return ob ^ (((ob >> 9) & 1u) << 5); }())
#define SAI(b, h) ((b) * 2 + (h))
#define SBI(b, h) (4 + (b) * 2 + (h))
#define STAGE(PI, BASE, br, kt) do { \
    const char* _gb = (const char*)(BASE) + ((long)(br) * K + (long)(kt) * BK) * 2; \
    char* _lp = (char*)shm + (PI) * (HT * 2) + wave_lds; \
    __builtin_amdgcn_global_load_lds((const unsigned*)(_gb + voff0), (LAS unsigned*)(_lp), 16, 0, 0); \
    __builtin_amdgcn_global_load_lds((const unsigned*)(_gb + (long)K * 128 + voff0), (LAS unsigned*)(_lp + 8192), 16, 0, 0); } while (0)
#define LDA(dst, PI) do { unsigned _o = SWZ_LANE() + a_uni; asm volatile("" : "+v"(_o)); _o &= 0x23F0u; \
    _Pragma("unroll") for (int m = 0; m < 4; ++m) _Pragma("unroll") for (int k = 0; k < 2; ++k) \
      dst[m][k] = *reinterpret_cast<const bf16x8*>((const char*)shm + (PI) * (HT * 2) + m * 2048 + k * 1024 + _o); } while (0)
#define LDB(dst, PI) do { unsigned _o = SWZ_LANE() + b_uni; asm volatile("" : "+v"(_o)); _o &= 0x33F0u; \
    _Pragma("unroll") for (int n = 0; n < 2; ++n) _Pragma("unroll") for (int k = 0; k < 2; ++k) \
      dst[n][k] = *reinterpret_cast<const bf16x8*>((const char*)shm + (PI) * (HT * 2) + n * 2048 + k * 1024 + _o); } while (0)
#define MMA(ai, bj, At_, Bt_) do { __builtin_amdgcn_s_setprio(1); \
    _Pragma("unroll") for (int m = 0; m < 4; ++m) _Pragma("unroll") for (int n = 0; n < 2; ++n) _Pragma("unroll") for (int k = 0; k < 2; ++k) \
      acc[ai][bj][m][n] = __builtin_amdgcn_mfma_f32_16x16x32_bf16(At_[m][k], Bt_[n][k], acc[ai][bj][m][n], 0, 0, 0); \
    __builtin_amdgcn_s_setprio(0); } while (0)
#define WAIT_V(n) asm volatile("s_waitcnt vmcnt(" #n ")" ::: "memory")
#define WAIT_L(n) asm volatile("s_waitcnt lgkmcnt(" #n ")" ::: "memory")
#define BAR __builtin_amdgcn_s_barrier()
#define SCHED __builtin_amdgcn_sched_barrier(0)
  const int tid0 = get_tid();
  const int coef_bits = __builtin_amdgcn_readfirstlane(__float_as_int(coef));
  const int wid = __builtin_amdgcn_readfirstlane(tid0 >> 6), wr = wid >> 2, wc = wid & 3;
  const int wave_lds = (wid & 7) * 1024;
  unsigned voff0;
  { int r_, c_; stage_rc(tid0 * 16, r_, c_); voff0 = (unsigned)(r_ * K + c_) * 2u; }
  const unsigned a_uni = (unsigned)(wr * 8192), b_uni = (unsigned)(wc * 4096);
  f32x4 acc[2][2][4][2];
#pragma unroll
  for (int a = 0; a < 2; ++a)
#pragma unroll
    for (int b = 0; b < 2; ++b)
#pragma unroll
      for (int m = 0; m < 4; ++m)
#pragma unroll
        for (int n = 0; n < 2; ++n) acc[a][b][m][n] = (f32x4){0.f, 0.f, 0.f, 0.f};
  bf16x8 At[4][2], B0[2][2], B1[2][2];
  const int nt = K / BK;
  WAIT_V(0);
  __syncthreads();
  STAGE(SBI(0, 0), Bt, bcol, 0); STAGE(SAI(0, 0), A, brow, 0);
  STAGE(SBI(0, 1), Bt, bcol + HALF, 0); STAGE(SAI(0, 1), A, brow + HALF, 0);
  if (wr == 1) BAR;
  STAGE(SBI(1, 0), Bt, bcol, 1); STAGE(SBI(1, 1), Bt, bcol + HALF, 1);
  WAIT_V(4); BAR; BAR;
  for (int t = 0; t < nt - 2; t += 2) {
    LDB(B0, SBI(0, 0)); LDB(B1, SBI(0, 1)); SCHED; LDA(At, SAI(0, 0));
    STAGE(SAI(1, 0), A, brow, t + 1); STAGE(SAI(1, 1), A, brow + HALF, t + 1);
    WAIT_L(8); BAR; WAIT_L(0); MMA(0, 0, At, B0); MMA(0, 1, At, B1); BAR; SCHED;
    LDA(At, SAI(0, 1)); STAGE(SBI(0, 0), Bt, bcol, t + 2); STAGE(SBI(0, 1), Bt, bcol + HALF, t + 2);
    WAIT_V(4); WAIT_L(0); BAR; MMA(1, 0, At, B0); MMA(1, 1, At, B1); BAR; SCHED;
    LDB(B0, SBI(1, 0)); LDB(B1, SBI(1, 1)); SCHED; LDA(At, SAI(1, 0));
    STAGE(SAI(0, 0), A, brow, t + 2); STAGE(SAI(0, 1), A, brow + HALF, t + 2);
    WAIT_L(8); BAR; WAIT_L(0); MMA(0, 0, At, B0); MMA(0, 1, At, B1); BAR; SCHED;
    LDA(At, SAI(1, 1)); STAGE(SBI(1, 0), Bt, bcol, t + 3); STAGE(SBI(1, 1), Bt, bcol + HALF, t + 3);
    WAIT_V(4); WAIT_L(0); BAR; MMA(1, 0, At, B0); MMA(1, 1, At, B1); BAR; SCHED;
  }
  { LDB(B0, SBI(0, 0)); LDB(B1, SBI(0, 1)); SCHED; LDA(At, SAI(0, 0));
    STAGE(SAI(1, 0), A, brow, nt - 1); STAGE(SAI(1, 1), A, brow + HALF, nt - 1);
    WAIT_L(8); BAR; WAIT_L(0); MMA(0, 0, At, B0); MMA(0, 1, At, B1); BAR; SCHED;
    LDA(At, SAI(0, 1)); WAIT_V(0); WAIT_L(0); BAR; MMA(1, 0, At, B0); MMA(1, 1, At, B1); BAR; SCHED;
    LDB(B0, SBI(1, 0)); LDB(B1, SBI(1, 1)); SCHED; LDA(At, SAI(1, 0));
    BAR; WAIT_L(0); MMA(0, 0, At, B0); MMA(0, 1, At, B1); BAR; SCHED;
    LDA(At, SAI(1, 1)); WAIT_L(0); BAR; MMA(1, 0, At, B0); MMA(1, 1, At, B1); BAR; }
  if (wr == 0) BAR;
#undef SAI
#undef SWZ_LANE
#undef SBI
#undef STAGE
#undef LDA
#undef LDB
#undef MMA
#undef WAIT_V
#undef WAIT_L
#undef BAR
#undef SCHED
  unsigned lane_e = __builtin_amdgcn_mbcnt_hi(~0u, __builtin_amdgcn_mbcnt_lo(~0u, 0u));
  asm volatile("" : "+v"(lane_e));
  const int lane = (int)lane_e, fr = lane & 15, fq = lane >> 4, tid = wid * 64 + lane;
  if (EPI == EPI_SWIGLU) {
    u16* H = (u16*)(p->ws + OFF_HP);
    const int hcl = wc * 32 + fr;
    const int hc0 = (bcol >> 1) + hcl;
    const float* rowss = (const float*)(p->ws + OFF_ROWSS) + (size_t)nid * MTOK;
    const float* bias = (const float*)(p->ws + OFF_BIAS) + (size_t)(nid * 3 + cond_of(brow)) * NFF;
    float bg[2], bu[2];
#pragma unroll
    for (int n = 0; n < 2; ++n) { bg[n] = bias[hc0 + n * 16]; bu[n] = bias[DFF + hc0 + n * 16]; }
    u16* Hs = shm;
#pragma unroll
    for (int ai = 0; ai < 2; ++ai)
#pragma unroll
      for (int m = 0; m < 4; ++m)
#pragma unroll
        for (int j = 0; j < 4; ++j) {
          const int rl = ai * 128 + wr * 64 + m * 16 + fq * 4 + j;
          const float rstd = rsqrtf(rowss[brow + rl] * (1.f / 1024.f) + EPS);
#pragma unroll
          for (int n = 0; n < 2; ++n) {
            float g = acc[ai][0][m][n][j] * rstd + bg[n], u = acc[ai][1][m][n][j] * rstd + bu[n];
            float h = g / (1.f + __expf(-g)) * u;
            Hs[rl * 136 + hcl + n * 16] = f2bf(h);
          }
        }
    __syncthreads();
#pragma unroll
    for (int i = 0; i < 8; ++i) {
      const int q = tid + 512 * i, r = q >> 4, c = q & 15;
      const u32x4 v = *(const u32x4*)(Hs + r * 136 + c * 8);
      *(u32x4*)(H + (size_t)(brow + r) * DFF + (bcol >> 1) + c * 8) = v;
    }
  } else if (EPI == EPI_RESID) {
    float* x = p->out + O_X;
    u16* xb = (u16*)(p->ws + OFF_XB);
    const float* mod = (const float*)(p->ws + OFF_MOD);
    u16* xn = (u16*)(p->ws + OFF_XN);
    float* rowss = (float*)(p->ws + OFF_ROWSS) + (size_t)nid * MTOK;
    const int cnd = cond_of(brow);
    const bool has_next = nid < 6;
    const int ln = (nid % 6) / 3, wn = nid % 3;
    const int col4 = bcol + lane * 4;
    float4 gt4 = *(const float4*)(mod + (l * 3 + cnd) * 9216 + gchunk * 1024 + col4);
    int cbl = coef_bits; asm volatile("" : "+s"(cbl)); const float cf = __int_as_float(cbl);
    gt4.x *= cf; gt4.y *= cf; gt4.z *= cf; gt4.w *= cf;
    float4 gs4 = make_float4(0.f, 0.f, 0.f, 0.f);
    if (has_next) {
      const float4 ng = *(const float4*)(p->in[(ln ? I_L1 : I_L0) + L_NORM] + wn * 1024 + col4);
      const float4 sc = *(const float4*)(mod + (ln * 3 + cnd) * 9216 + (3 * wn + 1) * 1024 + col4);
      gs4 = make_float4(ng.x * (1.f + sc.x), ng.y * (1.f + sc.y), ng.z * (1.f + sc.z), ng.w * (1.f + sc.w));
    }
    float* Cs = (float*)shm;
    uint2 xv0[16], xv1[16];
#pragma unroll
    for (int i = 0; i < 16; ++i) xv0[i] = *(const uint2*)(xb + (size_t)(brow + wid + 8 * i) * D + col4);
#pragma unroll
    for (int bj = 0; bj < 2; ++bj)
#pragma unroll
      for (int m = 0; m < 4; ++m)
#pragma unroll
        for (int n = 0; n < 2; ++n)
#pragma unroll
          for (int j = 0; j < 4; ++j)
            Cs[(wr * 64 + m * 16 + fq * 4 + j) * 260 + bj * 128 + wc * 32 + n * 16 + fr] = acc[0][bj][m][n][j];
    __syncthreads();
#pragma unroll
    for (int ai = 0; ai < 2; ++ai) {
      if (ai) {
#pragma unroll
        for (int i = 0; i < 16; ++i) xv1[i] = *(const uint2*)(xb + (size_t)(brow + 128 + wid + 8 * i) * D + col4);
        __syncthreads();
#pragma unroll
        for (int bj = 0; bj < 2; ++bj)
#pragma unroll
          for (int m = 0; m < 4; ++m)
#pragma unroll
            for (int n = 0; n < 2; ++n)
#pragma unroll
              for (int j = 0; j < 4; ++j)
                Cs[(wr * 64 + m * 16 + fq * 4 + j) * 260 + bj * 128 + wc * 32 + n * 16 + fr] = acc[1][bj][m][n][j];
        __syncthreads();
      }
#pragma unroll
      for (int i = 0; i < 16; ++i) {
        const int r = wid + 8 * i;
        const int row = brow + ai * 128 + r;
        const float4 a = *(const float4*)(Cs + r * 260 + lane * 4);
        const uint2 xu = ai ? xv1[i] : xv0[i];
        float4 xv = make_float4(bflo(xu.x), bfhi(xu.x), bflo(xu.y), bfhi(xu.y));
        xv.x += gt4.x * a.x; xv.y += gt4.y * a.y; xv.z += gt4.z * a.z; xv.w += gt4.w * a.w;
        if (nid == 6) *(float4*)(x + (size_t)row * D + col4) = xv;
        else *(uint2*)(xb + (size_t)row * D + col4) = make_uint2(pack2(xv.x, xv.y), pack2(xv.z, xv.w));
        float ss = xv.x * xv.x + xv.y * xv.y + xv.z * xv.z + xv.w * xv.w;
        if (has_next) *(uint2*)(xn + (size_t)row * D + col4) = make_uint2(pack2(xv.x * gs4.x, xv.y * gs4.y), pack2(xv.z * gs4.z, xv.w * gs4.w));
        ss = wave_sum(ss);
        if (lane == 0 && nid < 7) unsafeAtomicAdd(rowss + row, ss);
      }
    }
  } else {
    u16* proj = (u16*)(p->ws + OFF_HP);
    u16* Pst = shm;
    const bool isctx = brow < NCTX;
    const int c0 = bcol + wc * 64;
    const float* rc = (const float*)(p->ws + OFF_ROPE);
    const float* rowss = (const float*)(p->ws + OFF_ROWSS) + (size_t)nid * MTOK;
    const float* bias = (const float*)(p->ws + OFF_BIAS) + (size_t)(nid * 3 + cond_of(brow)) * NFF;
    float bz[2][2];
#pragma unroll
    for (int bj = 0; bj < 2; ++bj)
#pragma unroll
      for (int n = 0; n < 2; ++n) { int col = c0 + bj * 32 + n * 16 + fr; bz[bj][n] = (col < ((EPI == EPI_MIX0) ? P0N : P1N)) ? bias[col] : 0.f; }
    bool do_norm = false, do_rope = false;
    const float* ng = nullptr;
    float* o32 = nullptr; int ostr = 0;
    bool elementwise = false;
    if (EPI == EPI_MIX0) {
      if (c0 < 512) { do_norm = true; ng = p->in[I_L0 + L_X0]; do_rope = !isctx; }
      else if (c0 < 640) { do_norm = true; ng = p->in[I_L0 + L_X0] + 64; do_rope = !isctx; if (isctx) { o32 = p->out + O_K0 + (c0 - 512); ostr = 128; } }
      else if (c0 < 768) { if (isctx) { o32 = p->out + O_V0 + (c0 - 640); ostr = 128; } }
      else if (c0 >= 2304) elementwise = true;
    } else {
      if (c0 < 512) {}
      else if (c0 < 1024) { if (isctx) { o32 = p->out + O_KC1 + (c0 - 512); ostr = 512; } }
      else if (c0 < 1536) { if (isctx) { o32 = p->out + O_VC1 + (c0 - 1024); ostr = 512; } }
      else if (c0 < 2048) { do_rope = !isctx; }
      else if (c0 < 2176) { do_rope = !isctx; if (isctx) { o32 = p->out + O_KD1 + (c0 - 2048); ostr = 128; } }
      else { if (isctx) { o32 = p->out + O_VD1 + (c0 - 2176); ostr = 128; } }
    }
    if (elementwise) {
      float* gates = (float*)(p->ws + OFF_GATES);
      const float* gb = p->in[I_L0 + L_X1];
#pragma unroll
      for (int ai = 0; ai < 2; ++ai)
#pragma unroll
        for (int m = 0; m < 4; ++m)
#pragma unroll
          for (int j = 0; j < 4; ++j) {
            int row = brow + ai * 128 + wr * 64 + m * 16 + fq * 4 + j;
            const float rstd = rsqrtf(rowss[row] * (1.f / 1024.f) + EPS);
#pragma unroll
            for (int bj = 0; bj < 2; ++bj)
#pragma unroll
              for (int n = 0; n < 2; ++n) {
                int col = c0 + bj * 32 + n * 16 + fr;
                float v = acc[ai][bj][m][n][j] * rstd + bz[bj][n];
                if (col < 2336) gates[(size_t)row * 32 + (col - 2304)] = v + gb[col - 2304];
                else if (col < P0N) Pst[(row - brow) * 264 + (col - bcol)] = f2bf(v);
              }
          }
    } else {
#pragma unroll
      for (int ai = 0; ai < 2; ++ai)
#pragma unroll
        for (int m = 0; m < 4; ++m)
#pragma unroll
          for (int j = 0; j < 4; ++j) {
            int row = brow + ai * 128 + wr * 64 + m * 16 + fq * 4 + j;
            const float rstd0 = rsqrtf(rowss[row] * (1.f / 1024.f) + EPS);
            float v0 = acc[ai][0][m][0][j] * rstd0 + bz[0][0], v1 = acc[ai][0][m][1][j] * rstd0 + bz[0][1];
            float v2 = acc[ai][1][m][0][j] * rstd0 + bz[1][0], v3 = acc[ai][1][m][1][j] * rstd0 + bz[1][1];
            if (do_norm) {
              float ss = v0 * v0 + v1 * v1 + v2 * v2 + v3 * v3;
              ss = grp16_sum(ss);
              float rstd = rsqrtf(ss * (1.f / 64.f) + EPS);
              v0 = v0 * rstd * ng[fr]; v1 = v1 * rstd * ng[16 + fr]; v2 = v2 * rstd * ng[32 + fr]; v3 = v3 * rstd * ng[48 + fr];
            }
            if (do_rope) {
              int tk = (row - NCTX) & 1023;
              float ca = rc[tk * 32 + fr], sa = rc[32768 + tk * 32 + fr];
              float cb = rc[tk * 32 + 16 + fr], sb = rc[32768 + tk * 32 + 16 + fr];
              float a0 = v0 * ca - v2 * sa, a2 = v2 * ca + v0 * sa;
              float a1 = v1 * cb - v3 * sb, a3 = v3 * cb + v1 * sb;
              v0 = a0; v1 = a1; v2 = a2; v3 = a3;
            }
            u16* pr = Pst + (row - brow) * 264 + (c0 - bcol) + fr;
            pr[0] = f2bf(v0); pr[16] = f2bf(v1); pr[32] = f2bf(v2); pr[48] = f2bf(v3);
            if (o32) {
              float* o = o32 + (size_t)row * ostr + fr;
              o[0] = v0; o[16] = v1; o[32] = v2; o[48] = v3;
            }
          }
    }
    __syncthreads();
#pragma unroll 1
    for (int i = 0; i < 16; ++i) {
      const int q = tid + 512 * i, r = q >> 5, c = q & 31;
      const int col = bcol + c * 8;
      if (col < PSTR) *(u32x4*)(proj + (size_t)(brow + r) * PSTR + col) = *(const u32x4*)(Pst + r * 264 + c * 8);
    }
  }
}

template <int EPI>
__device__ __forceinline__ void gemm_phase(CP p, const u16* A, const u16* Bt, int K, int nN, int l, int gchunk, float coef, int nid, u16* smem, int side = 0) {
  const int nM = MTOK / BM, nwg = nM * nN;
  for (int t = blockIdx.x; t < nwg; t += gridDim.x) {
    int wgid = t;
    { int q = nwg / NXCD, r = nwg % NXCD, xcd = wgid % NXCD, off = wgid / NXCD;
      wgid = (xcd < r ? xcd * (q + 1) : r * (q + 1) + (xcd - r) * q) + off; }
    int nig = WGM * nN, gid = wgid / nig, fm = gid * WGM, gsz = min(nM - fm, WGM);
    int pm = fm + ((wgid % nig) % gsz), pn = (wgid % nig) / gsz;
    gemm256_tile<EPI>(p, A, Bt, K, pm * BM, pn * BM, l, gchunk, coef, nid, smem);
  }
  if (EPI == EPI_RESID && side) { __syncthreads(); conv_side_job(p, side, nwg, (float*)smem); }
}

__device__ __forceinline__ void load_tile_bf16(float* dst, const u16* src, long rstride, float scale, int tid) {
  int r = tid >> 2, part = tid & 3;
  const uint4* s = (const uint4*)(src + (long)r * rstride + part * 16);
  uint4 a = s[0], b = s[1];
  float4* d = (float4*)(dst + r * TS + part * 16);
  d[0] = make_float4(bflo(a.x) * scale, bfhi(a.x) * scale, bflo(a.y) * scale, bfhi(a.y) * scale);
  d[1] = make_float4(bflo(a.z) * scale, bfhi(a.z) * scale, bflo(a.w) * scale, bfhi(a.w) * scale);
  d[2] = make_float4(bflo(b.x) * scale, bfhi(b.x) * scale, bflo(b.y) * scale, bfhi(b.y) * scale);
  d[3] = make_float4(bflo(b.z) * scale, bfhi(b.z) * scale, bflo(b.w) * scale, bfhi(b.w) * scale);
}
__device__ __forceinline__ void tile_ld_regs(const u16* src, long rstride, int tid, uint4& a, uint4& b) {
  int r = tid >> 2, part = tid & 3;
  const uint4* s = (const uint4*)(src + (long)r * rstride + part * 16);
  a = s[0]; b = s[1];
}
__device__ __forceinline__ void tile_st_regs(float* dst, int tid, const uint4& a, const uint4& b, float scale) {
  int r = tid >> 2, part = tid & 3;
  float4* d = (float4*)(dst + r * TS + part * 16);
  d[0] = make_float4(bflo(a.x) * scale, bfhi(a.x) * scale, bflo(a.y) * scale, bfhi(a.y) * scale);
  d[1] = make_float4(bflo(a.z) * scale, bfhi(a.z) * scale, bflo(a.w) * scale, bfhi(a.w) * scale);
  d[2] = make_float4(bflo(b.x) * scale, bfhi(b.x) * scale, bflo(b.y) * scale, bfhi(b.y) * scale);
  d[3] = make_float4(bflo(b.z) * scale, bfhi(b.z) * scale, bflo(b.w) * scale, bfhi(b.w) * scale);
}
__device__ __forceinline__ void load_tile_f32(float* dst, const float* src, long rstride, int tid) {
  int r = tid >> 2, part = tid & 3;
  const float4* s = (const float4*)(src + (long)r * rstride + part * 16);
  float4* d = (float4*)(dst + r * TS + part * 16);
  d[0] = s[0]; d[1] = s[1]; d[2] = s[2]; d[3] = s[3];
}
typedef __attribute__((ext_vector_type(2))) float f32x2;
__device__ __forceinline__ void qk_micro(const float* Qs, const float* Ks, int ty, int tx, float s[4][4]) {
  f32x2 s2[4][4];
#pragma unroll
  for (int i = 0; i < 4; ++i)
#pragma unroll
    for (int j = 0; j < 4; ++j) s2[i][j] = (f32x2){0.f, 0.f};
#pragma unroll 2
  for (int d4 = 0; d4 < 16; ++d4) {
    f32x4 q[4], k[4];
#pragma unroll
    for (int i = 0; i < 4; ++i) q[i] = *(const f32x4*)(Qs + (ty * 4 + i) * TS + d4 * 4);
#pragma unroll
    for (int j = 0; j < 4; ++j) k[j] = *(const f32x4*)(Ks + (tx + 16 * j) * TS + d4 * 4);
#pragma unroll
    for (int i = 0; i < 4; ++i)
#pragma unroll
      for (int j = 0; j < 4; ++j) {
        s2[i][j] += q[i].xy * k[j].xy;
        s2[i][j] += q[i].zw * k[j].zw;
      }
  }
#pragma unroll
  for (int i = 0; i < 4; ++i)
#pragma unroll
    for (int j = 0; j < 4; ++j) s[i][j] = s2[i][j].x + s2[i][j].y;
}
__device__ __forceinline__ void pv_micro(const float* Ps, const float* Vs, int ty, int tx, float o[4][4]) {
  f32x2 oa[4], ob[4];
#pragma unroll
  for (int i = 0; i < 4; ++i) { oa[i] = (f32x2){o[i][0], o[i][1]}; ob[i] = (f32x2){o[i][2], o[i][3]}; }
#pragma unroll 2
  for (int s4 = 0; s4 < 16; ++s4) {
    f32x4 pp[4], v[4];
#pragma unroll
    for (int i = 0; i < 4; ++i) pp[i] = *(const f32x4*)(Ps + (ty * 4 + i) * TS + s4 * 4);
#pragma unroll
    for (int q = 0; q < 4; ++q) v[q] = *(const f32x4*)(Vs + (s4 * 4 + q) * TS + tx * 4);
#pragma unroll
    for (int i = 0; i < 4; ++i)
#pragma unroll
      for (int q = 0; q < 4; ++q) {
        const float ps = pp[i][q];
        const f32x2 p2 = (f32x2){ps, ps};
        oa[i] += p2 * v[q].xy;
        ob[i] += p2 * v[q].zw;
      }
  }
#pragma unroll
  for (int i = 0; i < 4; ++i) { o[i][0] = oa[i].x; o[i][1] = oa[i].y; o[i][2] = ob[i].x; o[i][3] = ob[i].y; }
}

struct AttnDesc {
  int qrow0, qcol, ocol;
  const float* ck; const float* cv; int cstride; int nctx;
  int krow0, nloc, kcol, vcol;
  int mode;
  int a0;
  int r0;
  const float* rpb;
  float sink; int has_sink;
};

constexpr int AS_ = 72;
__device__ __forceinline__ void attn_item(CP p, const AttnDesc& d, float* sm) {
  const int tid = get_tid(), w = tid >> 6, lane = tid & 63, fr = lane & 15, fq = lane >> 4, half = w >> 2;
  const u16* proj = (const u16*)(p->ws + OFF_HP);
  u16* Ks = (u16*)sm;
  u16* Vt = Ks + 64 * AS_;
  u16* Ps = Vt + 64 * AS_ + w * (16 * AS_);
  bf16x8 qf[2];
  {
    const u16* qp = proj + (size_t)(d.qrow0 + w * 16 + fr) * PSTR + d.qcol + fq * 8;
    qf[0] = *(const bf16x8*)(qp);
    qf[1] = *(const bf16x8*)(qp + 32);
  }
  float m_i[4], l_i[4];
  f32x4 o[4];
#pragma unroll
  for (int j = 0; j < 4; ++j) {
    m_i[j] = d.has_sink ? d.sink : -1e30f;
    l_i[j] = (d.has_sink && fr == 0) ? 1.f : 0.f;
  }
#pragma unroll
  for (int n = 0; n < 4; ++n) o[n] = (f32x4){0.f, 0.f, 0.f, 0.f};
  const int ntiles = d.nctx + d.nloc;
  const int lrow = tid >> 3, lc8 = tid & 7;
  float4 kf0, kf1, vf0, vf1;
  u32x4 kq, vq;
  auto issue = [&](int tile) {
    if (tile < d.nctx) {
      const size_t off = (size_t)(tile * 64 + lrow) * d.cstride + lc8 * 8;
      kf0 = *(const float4*)(d.ck + off); kf1 = *(const float4*)(d.ck + off + 4);
      vf0 = *(const float4*)(d.cv + off); vf1 = *(const float4*)(d.cv + off + 4);
    } else {
      const u16* base = proj + (size_t)(d.krow0 + (tile - d.nctx) * 64 + lrow) * PSTR + lc8 * 8;
      kq = *(const u32x4*)(base + d.kcol);
      vq = *(const u32x4*)(base + d.vcol);
    }
  };
  issue(0);
  for (int tile = 0; tile < ntiles; ++tile) {
    __syncthreads();
    if (tile < d.nctx) {
      kq = (u32x4){pack2(kf0.x, kf0.y), pack2(kf0.z, kf0.w), pack2(kf1.x, kf1.y), pack2(kf1.z, kf1.w)};
      vq = (u32x4){pack2(vf0.x, vf0.y), pack2(vf0.z, vf0.w), pack2(vf1.x, vf1.y), pack2(vf1.z, vf1.w)};
    }
    *(u32x4*)(Ks + lrow * AS_ + lc8 * 8) = kq;
    {
      u16* vt = Vt + (lc8 * 8) * AS_ + lrow;
      vt[0 * AS_] = (u16)(vq.x & 0xffff); vt[1 * AS_] = (u16)(vq.x >> 16);
      vt[2 * AS_] = (u16)(vq.y & 0xffff); vt[3 * AS_] = (u16)(vq.y >> 16);
      vt[4 * AS_] = (u16)(vq.z & 0xffff); vt[5 * AS_] = (u16)(vq.z >> 16);
      vt[6 * AS_] = (u16)(vq.w & 0xffff); vt[7 * AS_] = (u16)(vq.w >> 16);
    }
    __syncthreads();
    if (tile + 1 < ntiles) issue(tile + 1);
    const int lt = tile - d.nctx;
    f32x4 sacc[4];
#pragma unroll
    for (int n = 0; n < 4; ++n) sacc[n] = (f32x4){0.f, 0.f, 0.f, 0.f};
#pragma unroll
    for (int ks = 0; ks < 2; ++ks)
#pragma unroll
      for (int n = 0; n < 4; ++n) {
        bf16x8 kb = *(const bf16x8*)(Ks + (n * 16 + fr) * AS_ + ks * 32 + fq * 8);
        sacc[n] = __builtin_amdgcn_mfma_f32_16x16x32_bf16(qf[ks], kb, sacc[n], 0, 0, 0);
      }
    float sv[4][4];
#pragma unroll
    for (int n = 0; n < 4; ++n)
#pragma unroll
      for (int j = 0; j < 4; ++j) sv[j][n] = sacc[n][j] * 0.125f;
    if (lt >= 0 && d.mode == 1) {
      const int rq = d.a0 + half;
      const int kr = d.r0 + lt;
      const int rq0 = min(max(rq - 4, 0), 8);
      const bool rowok = (kr >= rq0) && (kr < rq0 + 8);
      const int dy = min(max(kr - rq + 7, 0), 14);
      const float* rp = d.rpb + dy * 31;
#pragma unroll
      for (int j = 0; j < 4; ++j) {
        int qc = (w & 3) * 16 + fq * 4 + j;
        int ws = min(max(qc - 8, 0), 48);
#pragma unroll
        for (int n = 0; n < 4; ++n) {
          int kc = n * 16 + fr;
          bool ok = rowok && (kc >= ws) && (kc < ws + 16);
          int dx = min(max(kc - qc + 15, 0), 30);
          sv[j][n] = ok ? sv[j][n] + rp[dx] : -1e30f;
        }
      }
    } else if (lt >= 0 && d.mode == 2) {
      const int off = d.a0 + lt * 64 - half * 64;
#pragma unroll
      for (int j = 0; j < 4; ++j)
#pragma unroll
        for (int n = 0; n < 4; ++n) {
          int dd = off + (n * 16 + fr) - ((w & 3) * 16 + fq * 4 + j);
          bool ok = (dd <= 128) && (dd >= -128);
          sv[j][n] = ok ? sv[j][n] : -1e30f;
        }
    }
#pragma unroll
    for (int j = 0; j < 4; ++j) {
      float mx = fmaxf(fmaxf(sv[j][0], sv[j][1]), fmaxf(sv[j][2], sv[j][3]));
      mx = grp16_max(mx);
      float mn = fmaxf(m_i[j], mx);
      float alpha = __expf(m_i[j] - mn);
      float rs = 0.f;
#pragma unroll
      for (int n = 0; n < 4; ++n) {
        float pj = __expf(sv[j][n] - mn);
        rs += pj;
        Ps[(fq * 4 + j) * AS_ + n * 16 + fr] = f2bf(pj);
      }
      l_i[j] = l_i[j] * alpha + rs;
      m_i[j] = mn;
#pragma unroll
      for (int n = 0; n < 4; ++n) o[n][j] *= alpha;
    }
    __builtin_amdgcn_wave_barrier();
#pragma unroll
    for (int ks = 0; ks < 2; ++ks) {
      bf16x8 pa = *(const bf16x8*)(Ps + fr * AS_ + ks * 32 + fq * 8);
#pragma unroll
      for (int n = 0; n < 4; ++n) {
        bf16x8 vb = *(const bf16x8*)(Vt + (n * 16 + fr) * AS_ + ks * 32 + fq * 8);
        o[n] = __builtin_amdgcn_mfma_f32_16x16x32_bf16(pa, vb, o[n], 0, 0, 0);
      }
    }
    __builtin_amdgcn_wave_barrier();
  }
  u16* ymix = (u16*)(p->ws + OFF_YMIX);
#pragma unroll
  for (int j = 0; j < 4; ++j) {
    float inv = 1.f / grp16_sum(l_i[j]);
    u16* yp = ymix + (size_t)(d.qrow0 + w * 16 + fq * 4 + j) * D + d.ocol + fr;
#pragma unroll
    for (int n = 0; n < 4; ++n) yp[n * 16] = f2bf(o[n][j] * inv);
  }
}

constexpr int ST_SLOT = 65 * 64;
__device__ __forceinline__ int st_slot(int isctx, int b, int dir, int head, int cc) {
  int ch = (b * 2 + dir) * 8 + head;
  return isctx ? (ch * 4 + cc) : (2048 + ch * 16 + cc);
}
__device__ __forceinline__ void unpack16(const uint4& a, const uint4& b, float v[16]) {
  v[0] = bflo(a.x); v[1] = bfhi(a.x); v[2] = bflo(a.y); v[3] = bfhi(a.y); v[4] = bflo(a.z); v[5] = bfhi(a.z); v[6] = bflo(a.w); v[7] = bfhi(a.w);
  v[8] = bflo(b.x); v[9] = bfhi(b.x); v[10] = bflo(b.y); v[11] = bfhi(b.y); v[12] = bflo(b.z); v[13] = bfhi(b.z); v[14] = bflo(b.w); v[15] = bfhi(b.w);
}
__device__ __forceinline__ void store_t16(u16* dstT, int s, const uint4& a, const uint4& b) {
  dstT[0 * 72 + s] = (u16)(a.x & 0xffff); dstT[1 * 72 + s] = (u16)(a.x >> 16); dstT[2 * 72 + s] = (u16)(a.y & 0xffff); dstT[3 * 72 + s] = (u16)(a.y >> 16);
  dstT[4 * 72 + s] = (u16)(a.z & 0xffff); dstT[5 * 72 + s] = (u16)(a.z >> 16); dstT[6 * 72 + s] = (u16)(a.w & 0xffff); dstT[7 * 72 + s] = (u16)(a.w >> 16);
  dstT[8 * 72 + s] = (u16)(b.x & 0xffff); dstT[9 * 72 + s] = (u16)(b.x >> 16); dstT[10 * 72 + s] = (u16)(b.y & 0xffff); dstT[11 * 72 + s] = (u16)(b.y >> 16);
  dstT[12 * 72 + s] = (u16)(b.z & 0xffff); dstT[13 * 72 + s] = (u16)(b.z >> 16); dstT[14 * 72 + s] = (u16)(b.w & 0xffff); dstT[15 * 72 + s] = (u16)(b.w >> 16);
}

__device__ __forceinline__ void mlstm_state_item(CP p, int isctx, int b, int head, float* sm) {
  const int tid = get_tid(), dir = tid >> 8, t = tid & 255, w4 = t >> 6, lane = t & 63, fr = lane & 15, fq = lane >> 4;
  const u16* proj = (const u16*)(p->ws + OFF_HP);
  const float* gates = (const float*)(p->ws + OFF_GATES);
  u16* stCt = (u16*)(p->ws + OFF_STC);
  float* stm = (float*)(p->ws + OFF_STM);
  u16* KtW = (u16*)sm + dir * (2 * 64 * 72);
  u16* Vt = KtW + 64 * 72;
  const int nc = isctx ? 4 : 16, L = isctx ? 256 : 1024;
  const int seq0 = isctx ? b * 256 : NCTX + b * 1024;
  const int ch = (b * 2 + dir) * 8 + head;
  f32x4 cacc[4], nacc;
  float m;
  if (isctx) {
#pragma unroll
    for (int nt = 0; nt < 4; ++nt) cacc[nt] = (f32x4){0.f, 0.f, 0.f, 0.f};
    nacc = (f32x4){0.f, 0.f, 0.f, 0.f};
    m = 0.f;
  } else {
    const float* C0 = p->in[I_SC] + (size_t)ch * 4096;
#pragma unroll
    for (int nt = 0; nt < 4; ++nt)
#pragma unroll
      for (int j = 0; j < 4; ++j) cacc[nt][j] = C0[(w4 * 16 + fq * 4 + j) * 64 + nt * 16 + fr];
#pragma unroll
    for (int j = 0; j < 4; ++j) nacc[j] = p->in[I_SN][ch * 64 + w4 * 16 + fq * 4 + j];
    m = p->in[I_SM][ch];
  }
  const bf16x8 ones = (bf16x8){0x3F80, 0x3F80, 0x3F80, 0x3F80, 0x3F80, 0x3F80, 0x3F80, 0x3F80};
  const int srow = t >> 2, part = t & 3;
  uint4 ka, kb, va, vb;
  float g_li, g_fp;
  auto prefetch = [&](int cc) {
    const int tok0 = dir ? (L - 1 - cc * 64) : cc * 64;
    const long rs = dir ? -(long)PSTR : (long)PSTR;
    const u16* base = proj + (size_t)(seq0 + tok0) * PSTR;
    tile_ld_regs(base + 1280 + head * 64, rs, t, ka, kb);
    tile_ld_regs(base + 1792 + head * 64, rs, t, va, vb);
    const int tr = seq0 + (dir ? tok0 - lane : tok0 + lane);
    g_li = gates[(size_t)tr * 32 + (dir * 2) * 8 + head];
    g_fp = gates[(size_t)tr * 32 + (dir * 2 + 1) * 8 + head];
  };
  prefetch(0);
  for (int cc = 0; cc < nc; ++cc) {
    const int slot = st_slot(isctx, b, dir, head, cc);
#pragma unroll
    for (int nt = 0; nt < 4; ++nt)
      *(uint2*)(stCt + (size_t)slot * ST_SLOT + (nt * 16 + fr) * 64 + w4 * 16 + fq * 4) = make_uint2(pack2(cacc[nt][0], cacc[nt][1]), pack2(cacc[nt][2], cacc[nt][3]));
    if (fr == 0) *(uint2*)(stCt + (size_t)slot * ST_SLOT + 64 * 64 + w4 * 16 + fq * 4) = make_uint2(pack2(nacc[0], nacc[1]), pack2(nacc[2], nacc[3]));
    if (t == 0) stm[slot] = m;
    const float lf = logsigmoidf_(g_fp);
    const float bb = wave_scan_add(lf, lane);
    const float a = g_li - bb;
    const float amax = wave_max(a);
    const float blast = __shfl(bb, 63);
    const float mnew = blast + fmaxf(m, amax);
    const float wsv = expf(blast + a - mnew);
    const float wc = expf(blast + m - mnew);
    const float ws_row = __shfl(wsv, (w4 * 16 + (lane >> 2))) * 0.125f;
    __syncthreads();
    {
      float kv[16];
      unpack16(ka, kb, kv);
      u16* dk = KtW + (part * 16) * 72 + srow;
#pragma unroll
      for (int e = 0; e < 16; ++e) dk[e * 72] = f2bf(kv[e] * ws_row);
      store_t16(Vt + (part * 16) * 72, srow, va, vb);
    }
    __syncthreads();
    if (cc + 1 < nc) prefetch(cc + 1);
#pragma unroll
    for (int nt = 0; nt < 4; ++nt) { cacc[nt][0] *= wc; cacc[nt][1] *= wc; cacc[nt][2] *= wc; cacc[nt][3] *= wc; }
    nacc[0] *= wc; nacc[1] *= wc; nacc[2] *= wc; nacc[3] *= wc;
#pragma unroll
    for (int ks = 0; ks < 2; ++ks) {
      const bf16x8 af = *(const bf16x8*)(KtW + (w4 * 16 + fr) * 72 + ks * 32 + fq * 8);
#pragma unroll
      for (int nt = 0; nt < 4; ++nt) {
        const bf16x8 bfv = *(const bf16x8*)(Vt + (nt * 16 + fr) * 72 + ks * 32 + fq * 8);
        cacc[nt] = __builtin_amdgcn_mfma_f32_16x16x32_bf16(af, bfv, cacc[nt], 0, 0, 0);
      }
      nacc = __builtin_amdgcn_mfma_f32_16x16x32_bf16(af, ones, nacc, 0, 0, 0);
    }
    m = mnew;
  }
  __syncthreads();
  if (isctx) {
    float* Co = p->out + O_C + (size_t)ch * 4096;
#pragma unroll
    for (int nt = 0; nt < 4; ++nt)
#pragma unroll
      for (int j = 0; j < 4; ++j) Co[(w4 * 16 + fq * 4 + j) * 64 + nt * 16 + fr] = cacc[nt][j];
    if (fr == 0) {
#pragma unroll
      for (int j = 0; j < 4; ++j) p->out[O_N + ch * 64 + w4 * 16 + fq * 4 + j] = nacc[j];
    }
    if (t == 0) p->out[O_M + ch] = m;
  }
}

__device__ __forceinline__ void mlstm_out_item(CP p, int isctx, int b, int head, int c, float* sm) {
  const int tid = get_tid(), dir = tid >> 8, t = tid & 255, w4 = t >> 6, lane = t & 63, fr = lane & 15, fq = lane >> 4;
  const u16* proj = (const u16*)(p->ws + OFF_HP);
  const float* gates = (const float*)(p->ws + OFF_GATES);
  const u16* stCt = (const u16*)(p->ws + OFF_STC);
  const float* stm = (const float*)(p->ws + OFF_STM);
  constexpr int HALF16 = 64 * 72 * 2 + 80 * 72 + 4 * 16 * 72;
  u16* Ks = (u16*)sm + dir * HALF16;
  u16* Vt = Ks + 64 * 72;
  u16* Cts = Vt + 64 * 72;
  u16* Ws = Cts + 80 * 72 + w4 * (16 * 72);
  float* Hs = (float*)((u16*)sm + 2 * HALF16);
  const int nc = isctx ? 4 : 16;
  const int mb = (isctx ? b * 256 : NCTX + b * 1024) + c * 64;
  const int cc = dir ? nc - 1 - c : c;
  const int slot = st_slot(isctx, b, dir, head, cc);
  const float m0 = stm[slot];
  const int srow = t >> 2, part = t & 3;
  uint4 ka, kb, va, vb;
  {
    const long rs = dir ? -(long)PSTR : (long)PSTR;
    const u16* base = proj + (size_t)(mb + (dir ? 63 : 0)) * PSTR;
    tile_ld_regs(base + 1280 + head * 64, rs, t, ka, kb);
    tile_ld_regs(base + 1792 + head * 64, rs, t, va, vb);
  }
  u32x4 c0v, c1v, c2v;
  {
    const u16* cs = stCt + (size_t)slot * ST_SLOT;
    c0v = *(const u32x4*)(cs + t * 8);
    c1v = *(const u32x4*)(cs + (t + 256) * 8);
    c2v = (t < 8) ? *(const u32x4*)(cs + (t + 512) * 8) : (u32x4){0u, 0u, 0u, 0u};
  }
  bf16x8 qf[2];
  {
    const int tq = w4 * 16 + fr;
    const u16* qp = proj + (size_t)(mb + (dir ? 63 - tq : tq)) * PSTR + 768 + head * 64 + fq * 8;
    qf[0] = *(const bf16x8*)(qp);
    qf[1] = *(const bf16x8*)(qp + 32);
  }
  float a, M, bb;
  {
    const int tr = mb + (dir ? 63 - lane : lane);
    const float li = gates[(size_t)tr * 32 + (dir * 2) * 8 + head];
    const float fp = gates[(size_t)tr * 32 + (dir * 2 + 1) * 8 + head];
    const float lf = logsigmoidf_(fp);
    bb = wave_scan_add(lf, lane);
    a = li - bb;
    M = fmaxf(m0, wave_scan_max(a, lane));
  }
  __syncthreads();
  *(uint4*)(Ks + srow * 72 + part * 16) = ka;
  *(uint4*)(Ks + srow * 72 + part * 16 + 8) = kb;
  store_t16(Vt + (part * 16) * 72, srow, va, vb);
  *(u32x4*)(Cts + (t >> 3) * 72 + (t & 7) * 8) = c0v;
  *(u32x4*)(Cts + ((t + 256) >> 3) * 72 + (t & 7) * 8) = c1v;
  if (t < 8) *(u32x4*)(Cts + 64 * 72 + t * 8) = c2v;
  __syncthreads();
  f32x4 sacc[4];
#pragma unroll
  for (int nt = 0; nt < 4; ++nt) sacc[nt] = (f32x4){0.f, 0.f, 0.f, 0.f};
#pragma unroll
  for (int ks = 0; ks < 2; ++ks)
#pragma unroll
    for (int nt = 0; nt < 4; ++nt) {
      const bf16x8 kf = *(const bf16x8*)(Ks + (nt * 16 + fr) * 72 + ks * 32 + fq * 8);
      sacc[nt] = __builtin_amdgcn_mfma_f32_16x16x32_bf16(qf[ks], kf, sacc[nt], 0, 0, 0);
    }
  float a_s[4], M_t[4], b_t[4], rs[4];
#pragma unroll
  for (int nt = 0; nt < 4; ++nt) a_s[nt] = __shfl(a, nt * 16 + fr);
#pragma unroll
  for (int j = 0; j < 4; ++j) { M_t[j] = __shfl(M, w4 * 16 + fq * 4 + j); b_t[j] = __shfl(bb, w4 * 16 + fq * 4 + j); rs[j] = 0.f; }
#pragma unroll
  for (int j = 0; j < 4; ++j) {
    const int tt = w4 * 16 + fq * 4 + j;
#pragma unroll
    for (int nt = 0; nt < 4; ++nt) {
      const int ss = nt * 16 + fr;
      const float w = (ss <= tt) ? expf(a_s[nt] - M_t[j]) * (sacc[nt][j] * 0.125f) : 0.f;
      rs[j] += w;
      Ws[(fq * 4 + j) * 72 + ss] = f2bf(w);
    }
  }
  __builtin_amdgcn_wave_barrier();
  f32x4 num[4], qc[4], qn;
#pragma unroll
  for (int nt = 0; nt < 4; ++nt) { num[nt] = (f32x4){0.f, 0.f, 0.f, 0.f}; qc[nt] = (f32x4){0.f, 0.f, 0.f, 0.f}; }
  qn = (f32x4){0.f, 0.f, 0.f, 0.f};
#pragma unroll
  for (int ks = 0; ks < 2; ++ks) {
    const bf16x8 wa = *(const bf16x8*)(Ws + fr * 72 + ks * 32 + fq * 8);
#pragma unroll
    for (int nt = 0; nt < 4; ++nt) {
      const bf16x8 vb8 = *(const bf16x8*)(Vt + (nt * 16 + fr) * 72 + ks * 32 + fq * 8);
      num[nt] = __builtin_amdgcn_mfma_f32_16x16x32_bf16(wa, vb8, num[nt], 0, 0, 0);
      const bf16x8 cb8 = *(const bf16x8*)(Cts + (nt * 16 + fr) * 72 + ks * 32 + fq * 8);
      qc[nt] = __builtin_amdgcn_mfma_f32_16x16x32_bf16(qf[ks], cb8, qc[nt], 0, 0, 0);
    }
    const bf16x8 nb8 = *(const bf16x8*)(Cts + 64 * 72 + ks * 32 + fq * 8);
    qn = __builtin_amdgcn_mfma_f32_16x16x32_bf16(qf[ks], nb8, qn, 0, 0, 0);
  }
  float hv[4][4];
#pragma unroll
  for (int j = 0; j < 4; ++j) {
    const float wi = expf(m0 - M_t[j]);
    const float den = grp16_sum(rs[j]) + wi * qn[j];
    const float mt = b_t[j] + M_t[j];
    const float inv = 1.f / fmaxf(fabsf(den), expf(-mt));
#pragma unroll
    for (int nt = 0; nt < 4; ++nt) hv[j][nt] = (num[nt][j] + wi * qc[nt][j]) * inv;
  }
  if (dir == 1) {
#pragma unroll
    for (int j = 0; j < 4; ++j)
#pragma unroll
      for (int nt = 0; nt < 4; ++nt) Hs[(63 - (w4 * 16 + fq * 4 + j)) * 68 + nt * 16 + fr] = hv[j][nt];
  }
  __syncthreads();
  if (dir == 0) {
    const float* hg = p->in[I_L0 + L_X2] + head * 64;
    u16* ymix = (u16*)(p->ws + OFF_YMIX);
#pragma unroll
    for (int j = 0; j < 4; ++j) {
      const int tt = w4 * 16 + fq * 4 + j;
      float h[4], ss = 0.f;
#pragma unroll
      for (int nt = 0; nt < 4; ++nt) { h[nt] = hv[j][nt] + Hs[tt * 68 + nt * 16 + fr]; ss += h[nt] * h[nt]; }
      ss = grp16_sum(ss);
      const float rstd = rsqrtf(ss * (1.f / 64.f) + EPS);
      const int tr = mb + tt;
#pragma unroll
      for (int nt = 0; nt < 4; ++nt) {
        const int v = nt * 16 + fr;
        const float ob = bflo((unsigned)proj[(size_t)tr * PSTR + 2336 + head * 64 + v]);
        ymix[(size_t)tr * D + 512 + head * 64 + v] = f2bf(sigmoidf_(ob) * (h[nt] * rstd * hg[v]));
      }
    }
  }
}

__device__ __forceinline__ int next_item(int* ctr, int* s_item) {
  __syncthreads();
  if (get_tid() == 0) *s_item = atomicAdd(ctr, 1);
  __syncthreads();
  return *s_item;
}

__device__ __forceinline__ void mix0_phase_a(CP p, float* sm, int* s_item, int coff) {
  int* ctr = (int*)(p->ws + OFF_CTR) + 0 + coff;
  for (;;) {
    int it = next_item(ctr, s_item);
    if (it >= 912) break;
    if (it >= 128 && it < 144) {
      int v = it - 128; int b = v >> 3, head = v & 7;
      mlstm_state_item(p, 0, b, head, sm);
    } else if (it >= 656) {
      int v = it - 656; int b = v >> 3, head = v & 7;
      mlstm_state_item(p, 1, b, head, sm);
    } else {
      AttnDesc d;
      d.mode = 0; d.a0 = 0; d.r0 = 0; d.rpb = nullptr; d.sink = 0.f; d.has_sink = 0;
      if (it < 128) {
        int b = it >> 6, h = (it >> 3) & 7, qb = it & 7;
        d.qrow0 = NCTX + b * 1024 + qb * 128; d.qcol = h * 64; d.ocol = h * 64;
        d.ck = p->in[I_C0K] + (size_t)b * 256 * 128 + (h >> 2) * 64; d.cv = p->in[I_C0V] + (size_t)b * 256 * 128 + (h >> 2) * 64;
        d.cstride = 128; d.nctx = 4;
        d.krow0 = NCTX + b * 1024; d.nloc = 16; d.kcol = 512 + (h >> 2) * 64; d.vcol = 640 + (h >> 2) * 64;
      } else {
        int v = it - 144; int b = v >> 4, h = (v >> 1) & 7, qb = v & 1;
        d.qrow0 = b * 256 + qb * 128; d.qcol = h * 64; d.ocol = h * 64;
        d.ck = nullptr; d.cv = nullptr; d.cstride = 0; d.nctx = 0;
        d.krow0 = b * 256; d.nloc = 4; d.kcol = 512 + (h >> 2) * 64; d.vcol = 640 + (h >> 2) * 64;
      }
      attn_item(p, d, sm);
    }
  }
}

__device__ __forceinline__ void mix0_phase_b(CP p, float* sm, int* s_item, int coff) {
  int* ctr = (int*)(p->ws + OFF_CTR) + 1 + coff;
  for (;;) {
    int it = next_item(ctr, s_item);
    if (it >= 1280) break;
    if (it < 256) {
      int b = it >> 7, head = (it >> 4) & 7, c = it & 15;
      mlstm_out_item(p, 0, b, head, c, sm);
    } else {
      int v = it - 256; int b = v >> 5, head = (v >> 2) & 7, c = v & 3;
      mlstm_out_item(p, 1, b, head, c, sm);
    }
  }
}

__device__ __forceinline__ void mix1_phase(CP p, float* sm, int* s_item, int coff) {
  int* ctr = (int*)(p->ws + OFF_CTR) + 2 + coff;
  const float* sink = p->in[I_L1 + L_X1];
  for (;;) {
    int it = next_item(ctr, s_item);
    if (it >= 1280) break;
    AttnDesc d;
    d.mode = 0; d.a0 = 0; d.r0 = 0; d.rpb = nullptr; d.sink = 0.f; d.has_sink = 0;
    if (it < 128) {
      int b = it >> 6, h = (it >> 3) & 7, r = (it & 7) * 2;
      int r0 = min(max(r - 4, 0), 8);
      int r1 = min(max(r + 1 - 4, 0), 8) + 8;
      d.qrow0 = NCTX + b * 1024 + r * 64; d.qcol = h * 64; d.ocol = h * 64;
      d.ck = p->in[I_NAK] + (size_t)b * 256 * 512 + h * 64; d.cv = p->in[I_NAV] + (size_t)b * 256 * 512 + h * 64;
      d.cstride = 512; d.nctx = 4;
      d.krow0 = NCTX + b * 1024 + r0 * 64; d.nloc = r1 - r0; d.kcol = 512 + h * 64; d.vcol = 1024 + h * 64;
      d.mode = 1; d.a0 = r; d.r0 = r0; d.rpb = p->in[I_L1 + L_X0] + h * 15 * 31;
    } else if (it < 256) {
      int v = it - 128; int b = v >> 6, h = (v >> 3) & 7, qb = v & 7;
      int t0 = qb * 128;
      int s0 = max(t0 - 128, 0);
      int s1 = min(t0 + 256, 1024);
      d.qrow0 = NCTX + b * 1024 + t0; d.qcol = 1536 + h * 64; d.ocol = 512 + h * 64;
      d.ck = p->in[I_SWK] + (size_t)b * 256 * 128 + (h >> 2) * 64; d.cv = p->in[I_SWV] + (size_t)b * 256 * 128 + (h >> 2) * 64;
      d.cstride = 128; d.nctx = 4;
      d.krow0 = NCTX + b * 1024 + s0; d.nloc = (s1 - s0) >> 6; d.kcol = 2048 + (h >> 2) * 64; d.vcol = 2176 + (h >> 2) * 64;
      d.mode = 2; d.a0 = s0 - t0;
      d.sink = sink[h]; d.has_sink = 1;
    } else if (it < 768) {
      int v = it - 256; int b = v >> 4, h = (v >> 1) & 7, qb = v & 1;
      d.qrow0 = b * 256 + qb * 128; d.qcol = h * 64; d.ocol = h * 64;
      d.ck = nullptr; d.cv = nullptr; d.cstride = 0; d.nctx = 0;
      d.krow0 = b * 256; d.nloc = 4; d.kcol = 512 + h * 64; d.vcol = 1024 + h * 64;
    } else {
      int v = it - 768; int b = v >> 4, h = (v >> 1) & 7, qb = v & 1;
      d.qrow0 = b * 256 + qb * 128; d.qcol = 1536 + h * 64; d.ocol = 512 + h * 64;
      d.ck = nullptr; d.cv = nullptr; d.cstride = 0; d.nctx = 0;
      d.krow0 = b * 256; d.nloc = 4; d.kcol = 2048 + (h >> 2) * 64; d.vcol = 2176 + (h >> 2) * 64;
      d.sink = sink[h]; d.has_sink = 1;
    }
    attn_item(p, d, sm);
  }
}

#define XB_TMO      128
#define XB_XCNT(j)  (256  + 64 * (j))
#define XB_XSUB(j)  (1280 + 64 * (j))
#define XB_XGEN(j)  (2304 + 64 * (j))
#define XB_TOP      3328
#define XB_TOPGEN   3392
#define XCD_BAR_WORDS 3456
#define XB_SPIN_CAP (1u << 22)
__device__ __forceinline__ unsigned xb_ld(unsigned* p) { return __hip_atomic_load(p, __ATOMIC_RELAXED, __HIP_MEMORY_SCOPE_AGENT); }
__device__ __forceinline__ unsigned xb_add(unsigned* p, unsigned v) { return __hip_atomic_fetch_add(p, v, __ATOMIC_RELAXED, __HIP_MEMORY_SCOPE_AGENT); }
__device__ __forceinline__ unsigned xb_xcc_id() { return (unsigned)__builtin_amdgcn_s_getreg((3 << 11) | 20) & 0xFu; }
#define XB_SPIN(cond, bar) do { unsigned _sp = 0; while (cond) { __builtin_amdgcn_s_sleep(1); \
    if ((++_sp & 255u) == 0u) { if (xb_ld(&(bar)[XB_TMO])) break; if (_sp > XB_SPIN_CAP) { atomicAdd(&(bar)[XB_TMO], 1u); break; } } } } while (0)
struct XcdBarrier { unsigned* bar; unsigned x; volatile LAS unsigned* st; };
__device__ __forceinline__ XcdBarrier xcd_barrier_post(unsigned* bar, volatile LAS unsigned* st) {
  XcdBarrier b; b.bar = bar; b.x = xb_xcc_id(); b.st = st;
  if (threadIdx.x == 0) (void)xb_add(&bar[XB_XCNT(b.x)], 1u);
  return b;
}
__device__ __forceinline__ void xcd_barrier_complete(unsigned* bar, unsigned x, unsigned& nloc, unsigned& nx) {
  const unsigned G = gridDim.x * gridDim.y * gridDim.z;
  unsigned sum, cnt, mine, sp = 0u;
  for (;;) {
    sum = 0u; cnt = 0u; mine = 0u;
#pragma unroll
    for (unsigned j = 0; j < 16; ++j) { const unsigned c = xb_ld(&bar[XB_XCNT(j)]); sum += c; cnt += (c > 0u) ? 1u : 0u; mine = (j == x) ? c : mine; }
    if (sum == G) break;
    __builtin_amdgcn_s_sleep(1);
    if ((++sp & 255u) == 0u) { if (xb_ld(&bar[XB_TMO])) break; if (sp > XB_SPIN_CAP) { atomicAdd(&bar[XB_TMO], 1u); break; } }
  }
  nloc = mine > 0u ? mine : 1u; nx = cnt > 0u ? cnt : 1u;
}
__device__ __forceinline__ void xcd_barrier(const XcdBarrier& b) {
  asm volatile("s_waitcnt vmcnt(0)" ::: "memory");
  __syncthreads();
  if (threadIdx.x == 0) {
    unsigned* bar = b.bar;
    __builtin_amdgcn_s_waitcnt(0);
    unsigned nloc = b.st[0], nx = b.st[1];
    if (nloc == 0u) { xcd_barrier_complete(bar, b.x, nloc, nx); b.st[0] = nloc; b.st[1] = nx; }
    const unsigned old = xb_add(&bar[XB_XSUB(b.x)], 1u);
    const unsigned gen = old / nloc;
    if (old + 1u == (gen + 1u) * nloc) {
      __builtin_amdgcn_fence(__ATOMIC_RELEASE, "agent");
      asm volatile("s_waitcnt vmcnt(0)" ::: "memory");
      const unsigned og = xb_add(&bar[XB_TOP], 1u);
      const unsigned tg = og / nx;
      if (og + 1u == (tg + 1u) * nx) xb_add(&bar[XB_TOPGEN], 1u);
      else XB_SPIN(xb_ld(&bar[XB_TOPGEN]) == tg, bar);
      __builtin_amdgcn_fence(__ATOMIC_ACQUIRE, "agent");
      xb_add(&bar[XB_XGEN(b.x)], 1u);
      asm volatile("s_waitcnt vmcnt(0)" ::: "memory");
    } else {
      XB_SPIN(xb_ld(&bar[XB_XGEN(b.x)]) == gen, bar);
      __builtin_amdgcn_fence(__ATOMIC_ACQUIRE, "agent");
      asm volatile("s_waitcnt vmcnt(0)" ::: "memory");
    }
  }
  __syncthreads();
}

constexpr int NPHASE = 18;
__device__ __forceinline__ void run_phase(CP p, int ph, char* smem, int* s_item, const int dry) {
  float* smf = (float*)smem;
  u16* smh = (u16*)smem;
  const u16* xn = (const u16*)(p->ws + OFF_XN);
  const u16* hp = (const u16*)(p->ws + OFF_HP);
  const u16* ymix = (const u16*)(p->ws + OFF_YMIX);
  if (ph == 0) { prep_a_phase(p, smf); return; }
  if (ph == 1) { prep_b_phase(p, smf, dry); return; }
  if (ph == 17) { final_phase(p); return; }
  const int l = (ph >= 10) ? 1 : 0;
  int q = ph - (l ? 10 : 2);
  if (l == 1 && q >= 4) q += 1;
  if (q == 0 || q == 6) {
    const int f = (q == 6) ? 1 : 0;
    gemm_phase<EPI_SWIGLU>(p, xn, (const u16*)(p->ws + OFF_WIN + (l * 2 + f) * SZ_WIN), 1024, 22, l, 0, 0.f, l * 3 + (f ? 2 : 0), smh);
    return;
  }
  if (q == 1 || q == 5 || q == 7) {
    const u16* A = (q == 5) ? ymix : hp;
    const u16* Bt = (q == 5) ? (const u16*)(p->ws + OFF_WMO + (size_t)l * D * D * 2)
                             : (const u16*)(p->ws + OFF_WOUT + (l * 2 + (q == 7 ? 1 : 0)) * SZ_WOUT);
    const int K = (q == 5) ? 1024 : DFF;
    const int gch = (q == 1) ? 2 : (q == 5 ? 5 : 8);
    const float coef = __int_as_float(dry ? 0 : ((q == 5) ? 0x3f800000 : 0x3f000000));
    const int nid_next = l * 3 + ((q == 1) ? 1 : (q == 5 ? 2 : 3));
    gemm_phase<EPI_RESID>(p, A, Bt, K, 4, l, gch, coef, dry ? 7 : nid_next, smh, dry ? 0 : (l == 0 ? (q == 1 ? 1 : (q == 5 ? 2 : 3)) : (q == 1 ? 4 : 0)));
    return;
  }
  if (q == 2) {
    if (l == 0) gemm_phase<EPI_MIX0>(p, xn, (const u16*)(p->ws + OFF_WMI0), 1024, 12, l, 0, 0.f, 1, smh);
    else gemm_phase<EPI_MIX1>(p, xn, (const u16*)(p->ws + OFF_WMI1), 1024, 9, l, 0, 0.f, 4, smh);
    return;
  }
  if (q == 3) { if (l == 0) mix0_phase_a(p, smf, s_item, dry * 3); else mix1_phase(p, smf, s_item, dry * 3); return; }
  if (q == 4) { mix0_phase_b(p, smf, s_item, dry * 3); return; }
}

__global__ void __launch_bounds__(512, 2) mega(Params kp, int ph0, int ph1, int dry) {
  extern __shared__ __attribute__((aligned(16))) char smem[];
  int* s_item_p = (int*)(smem + SMEM_BYTES);
  uint4* xb_words_p = (uint4*)(smem + SMEM_BYTES + 16);
  if (threadIdx.x == 0) *xb_words_p = make_uint4(0u, 0u, 0u, 0u);
  if ((threadIdx.x & 63) == 0) ((volatile int*)(smem + TIDTAB_OFF))[hw_wave_slot()] = (int)(threadIdx.x >> 6);
  __syncthreads();
  XcdBarrier xb = xcd_barrier_post((unsigned*)(kp.ws + OFF_BAR), (volatile LAS unsigned*)xb_words_p);
  if (ph1 < 0) cg::this_grid().sync();
  for (int ph = ph0; ph < ph1; ++ph) {
    if (ph > ph0) xcd_barrier(xb);
    CP p = (CP)__builtin_amdgcn_kernarg_segment_ptr();
    asm volatile("" : "+s"(p));
    run_phase(p, ph, smem, s_item_p, dry);
  }
}

extern "C" void kernel_launch(void* const* d_in, const int* in_sizes, int n_in, void* d_out, int out_size, void* d_ws,
                              size_t ws_size, hipStream_t stream) {
  static int grid_blocks = 0;
  if (!grid_blocks) {
    int dev = 0, cus = 0, per_cu = 0;
    hipGetDevice(&dev);
    hipDeviceGetAttribute(&cus, hipDeviceAttributeMultiprocessorCount, dev);
    hipFuncSetAttribute((const void*)mega, hipFuncAttributeMaxDynamicSharedMemorySize, DYN_LDS);
    hipOccupancyMaxActiveBlocksPerMultiprocessor(&per_cu, mega, NTH, DYN_LDS);
    if (per_cu > 1) per_cu = 1;
    if (per_cu < 1) per_cu = 1;
    grid_blocks = cus * per_cu;
  }
  if (ws_size < WS_TOTAL) fprintf(stderr, "workspace too small: %zu < %zu\n", ws_size, (size_t)WS_TOTAL);
  Params p{};
  for (int i = 0; i < 37; ++i) p.in[i] = (const float*)d_in[i];
  p.out = (float*)d_out;
  p.ws = (char*)d_ws;
  hipMemsetAsync((char*)d_ws + OFF_CTR, 0, ZERO_BYTES, stream);
#if SINGLE_LAUNCH
  int ph0 = 0, ph1 = NPHASE, dry = 0;
  void* args[] = {&p, &ph0, &ph1, &dry};
  hipError_t e = hipLaunchCooperativeKernel((void*)mega, dim3(grid_blocks), dim3(NTH), args, DYN_LDS, stream);
  if (e != hipSuccess) fprintf(stderr, "cooperative launch failed: %s (grid %d)\n", hipGetErrorString(e), grid_blocks);
#else
  for (int ph = 0; ph < NPHASE; ++ph) {
    mega<<<grid_blocks, NTH, DYN_LDS, stream>>>(p, ph, ph + 1, 0);
    const bool g1 = (ph == 2 || ph == 8 || ph == 10 || ph == 15), g2 = (ph == 3 || ph == 9 || ph == 11 || ph == 16);
    const bool mi = (ph == 4 || ph == 12), mo = (ph == 7 || ph == 14), mx = (ph == 5 || ph == 6 || ph == 13);
    if (((REP_MASK & 1) && g1) || ((REP_MASK & 2) && g2) || ((REP_MASK & 4) && (mi || mo)) || ((REP_MASK & 8) && mx) ||
        ((REP_MASK & 16) && ph == 0) || ((REP_MASK & 32) && ph == 1))
      mega<<<grid_blocks, NTH, DYN_LDS, stream>>>(p, ph, ph + 1, 1);
  }
#endif
}
```
